# Optimizing an MI355X kernel written in HIP

```python
import math
import jax, jax.numpy as jnp
from jax import lax
import numpy as np

D_MODEL = 1024
BATCH = 4
SEQ = 4096
DEPTH = 1

CHUNK = 64
Q_BLOCK = 128

MLA_HEADS = 8
MLA_NOPE = 64
MLA_ROPE = 32
MLA_V = 64
MLA_Q_RANK = 256
MLA_KV_RANK = 128
ROPE_THETA = 10000.0
D_MLA = MLA_HEADS * MLA_V

HG_HEADS = 4
HG_DK = 128
HG_DV = 128
D_HG = HG_HEADS * HG_DV

D_MIX = D_MLA + D_HG
IN_SIZES = (MLA_Q_RANK, MLA_KV_RANK, MLA_ROPE, HG_HEADS * HG_DK, HG_HEADS * HG_DV, HG_HEADS * HG_DK, HG_HEADS * HG_DV)
IN_COLS = sum(IN_SIZES)

N_GROUPS = 4
EXPERTS_PER_GROUP = 8
N_EXPERTS = N_GROUPS * EXPERTS_PER_GROUP
TOP_K = 2
D_EXPERT = 512
MOE_BLOCK = 128

RMS_EPS = 1e-6
LN_EPS = 1e-5
ALPHA = (2.0 * DEPTH) ** 0.25
BETA = (8.0 * DEPTH) ** -0.25

kernel_name = "hybrid_mla_hgrn2_hiermoe_deepnorm"


def rms_norm(x, g):
    xf = x.astype(jnp.float32)
    y = xf * lax.rsqrt(jnp.mean(xf * xf, axis=-1, keepdims=True) + RMS_EPS)
    return (y * g.astype(jnp.float32)).astype(x.dtype)


def layer_norm(x, g, b):
    xf = x.astype(jnp.float32)
    mu = jnp.mean(xf, axis=-1, keepdims=True)
    xc = xf - mu
    var = jnp.mean(xc * xc, axis=-1, keepdims=True)
    y = xc * lax.rsqrt(var + LN_EPS) * g.astype(jnp.float32) + b.astype(jnp.float32)
    return y.astype(x.dtype)


def rope(x, cos, sin):
    x1, x2 = jnp.split(x, 2, axis=-1)
    return jnp.concatenate([x1 * cos - x2 * sin, x2 * cos + x1 * sin], axis=-1)


def mla_group(c_q, c_kv, k_r, positions, q_norm_g, w_uq, kv_norm_g, w_ukv):
    B, S, _ = c_q.shape
    dt = c_q.dtype
    inv_freq = ROPE_THETA ** (-jnp.arange(0, MLA_ROPE, 2, dtype=jnp.float32) / MLA_ROPE)
    ang = positions.astype(jnp.float32)[..., None] * inv_freq
    cos = jnp.cos(ang).astype(dt)
    sin = jnp.sin(ang).astype(dt)
    q = (rms_norm(c_q, q_norm_g) @ w_uq).reshape(B, S, MLA_HEADS, MLA_NOPE + MLA_ROPE)
    q_nope = q[..., :MLA_NOPE]
    q_rope = rope(q[..., MLA_NOPE:], cos[:, :, None, :], sin[:, :, None, :])
    kv = (rms_norm(c_kv, kv_norm_g) @ w_ukv).reshape(B, S, MLA_HEADS, MLA_NOPE + MLA_V)
    k_nope = kv[..., :MLA_NOPE]
    v = kv[..., MLA_NOPE:]
    k_rope = rope(k_r, cos, sin)
    scale = (MLA_NOPE + MLA_ROPE) ** -0.5
    nqb = S // Q_BLOCK
    key_chunk = jnp.arange(S, dtype=jnp.int32) // CHUNK

    def one_block(args):
        qn, qr, qb = args
        s = jnp.einsum('bqhd,bkhd->bhqk', qn, k_nope) + jnp.einsum('bqhr,bkr->bhqk', qr, k_rope)
        s = s.astype(jnp.float32) * scale
        q_chunk = (qb * Q_BLOCK + jnp.arange(Q_BLOCK, dtype=jnp.int32)) // CHUNK
        mask = key_chunk[None, :] <= q_chunk[:, None]
        p = jax.nn.softmax(jnp.where(mask, s, -jnp.inf), axis=-1).astype(v.dtype)
        return jnp.einsum('bhqk,bkhd->bqhd', p, v)

    qn_b = q_nope.reshape(B, nqb, Q_BLOCK, MLA_HEADS, MLA_NOPE).transpose(1, 0, 2, 3, 4)
    qr_b = q_rope.reshape(B, nqb, Q_BLOCK, MLA_HEADS, MLA_ROPE).transpose(1, 0, 2, 3, 4)
    out = lax.map(one_block, (qn_b, qr_b, jnp.arange(nqb, dtype=jnp.int32)))
    return out.transpose(1, 0, 2, 3, 4).reshape(B, S, D_MLA)


def hgrn2_group(f_pre, i_in, q_in, g_in, lb_logits, layer, hg_norm_g):
    B, S, _ = f_pre.shape
    dt = f_pre.dtype
    lb = jnp.cumsum(jax.nn.softmax(lb_logits.astype(jnp.float32), axis=0), axis=0)[layer]
    f = lb + (1.0 - lb) * jax.nn.sigmoid(f_pre.astype(jnp.float32))
    log_f = jnp.log(f)
    k = 1.0 - f
    nc = S // CHUNK

    def to_chunks(t, d):
        return t.astype(jnp.float32).reshape(B, nc, CHUNK, HG_HEADS, d).transpose(1, 0, 3, 2, 4)

    qc = to_chunks(q_in, HG_DK)
    kc = to_chunks(k, HG_DK)
    vc = to_chunks(i_in, HG_DV)
    lfc = to_chunks(log_f, HG_DK)
    causal = jnp.tril(jnp.ones((CHUNK, CHUNK), dtype=bool))

    def step(state, inp):
        q, kk, v, lf = inp
        b = jnp.cumsum(lf, axis=2)
        diff = b[:, :, :, None, :] - b[:, :, None, :, :]
        decay = jnp.exp(jnp.where(causal[:, :, None], diff, -jnp.inf))
        a = jnp.einsum('bhtd,bhsd,bhtsd->bhts', q, kk, decay)
        o = jnp.einsum('bhts,bhse->bhte', a, v) + jnp.einsum('bhtd,bhde->bhte', q * jnp.exp(b), state)
        b_last = b[:, :, -1:, :]
        new_state = jnp.exp(b_last[:, :, 0, :])[..., None] * state + jnp.einsum('bhsd,bhse->bhde', kk * jnp.exp(b_last - b), v)
        return new_state, o

    s0 = jnp.zeros((B, HG_HEADS, HG_DK, HG_DV), jnp.float32)
    _, o = lax.scan(step, s0, (qc, kc, vc, lfc))
    o = o.transpose(1, 0, 3, 2, 4).reshape(B, S, HG_HEADS, HG_DV)
    g = g_in.astype(jnp.float32).reshape(B, S, HG_HEADS, HG_DV)
    o = rms_norm(o, hg_norm_g) * jax.nn.silu(g)
    return o.reshape(B, S, D_HG).astype(dt)


def hier_moe(h, w_router_group, b_router_group, w_router_expert, b_router_expert, w1, w3, w2):
    B, S, D = h.shape
    N = B * S
    xt = h.reshape(N, D)
    g_logits = (xt @ w_router_group).astype(jnp.float32) + b_router_group.astype(jnp.float32)
    g_prob = jax.nn.softmax(g_logits, axis=-1)
    grp = jnp.argmax(g_logits, axis=-1).astype(jnp.int32)
    p_grp = jnp.take_along_axis(g_prob, grp[:, None], axis=-1)
    e_logits = ((xt @ w_router_expert).astype(jnp.float32) + b_router_expert.astype(jnp.float32)).reshape(N, N_GROUPS, EXPERTS_PER_GROUP)
    e_in = jnp.take_along_axis(e_logits, grp[:, None, None], axis=1)[:, 0]
    top_v, top_i = lax.top_k(e_in, TOP_K)
    gate = p_grp * jax.nn.softmax(top_v, axis=-1)
    expert = grp[:, None] * EXPERTS_PER_GROUP + top_i.astype(jnp.int32)

    A = N * TOP_K
    eid = expert.reshape(A)
    tid = jnp.repeat(jnp.arange(N, dtype=jnp.int32), TOP_K)
    gflat = gate.reshape(A)
    counts = jnp.zeros((N_EXPERTS,), jnp.int32).at[eid].add(1)
    padded = ((counts + MOE_BLOCK - 1) // MOE_BLOCK) * MOE_BLOCK
    pad_end = jnp.cumsum(padded)
    pad_start = pad_end - padded
    raw_start = jnp.cumsum(counts) - counts
    order = jnp.argsort(eid)
    se = eid[order]
    dest = pad_start[se] + (jnp.arange(A, dtype=jnp.int32) - raw_start[se])
    nb = (A + N_EXPERTS * (MOE_BLOCK - 1) + MOE_BLOCK - 1) // MOE_BLOCK
    P = nb * MOE_BLOCK
    slot_tok = jnp.full((P,), N, jnp.int32).at[dest].set(tid[order])
    slot_gate = jnp.zeros((P,), jnp.float32).at[dest].set(gflat[order])
    block_start = jnp.arange(nb, dtype=jnp.int32) * MOE_BLOCK
    block_exp = jnp.minimum(jnp.searchsorted(pad_end, block_start, side='right'), N_EXPERTS - 1).astype(jnp.int32)
    x_pad = jnp.concatenate([xt, jnp.zeros((1, D), xt.dtype)], axis=0)
    xb = x_pad[slot_tok].reshape(nb, MOE_BLOCK, D)

    def run_block(args):
        xblk, e = args
        return (jax.nn.silu(xblk @ w1[e]) * (xblk @ w3[e])) @ w2[e]

    yb = lax.map(run_block, (xb, block_exp)).reshape(P, D)
    out = jnp.zeros((N + 1, D), yb.dtype).at[slot_tok].add(yb * slot_gate[:, None].astype(yb.dtype))
    return out[:N].reshape(B, S, D)


def setup_inputs(seed: int = 0) -> dict:
    key = jax.random.key(seed)
    ks = jax.random.split(key, 24)

    def nrm(k, shape, scale):
        return jax.random.normal(k, shape, jnp.float32) * scale

    x = nrm(ks[0], (BATCH, SEQ, D_MODEL), 1.0)
    positions = jax.random.randint(ks[1], (BATCH, 1), 0, 65536, dtype=jnp.int32) + jnp.arange(SEQ, dtype=jnp.int32)[None, :]
    col_scale = jnp.concatenate([
        jnp.ones((MLA_Q_RANK + MLA_KV_RANK + MLA_ROPE + HG_HEADS * HG_DK,), jnp.float32),
        jnp.full((HG_HEADS * HG_DV,), BETA, jnp.float32),
        jnp.ones((HG_HEADS * HG_DK + HG_HEADS * HG_DV,), jnp.float32)])
    w_in = nrm(ks[2], (DEPTH, D_MODEL, IN_COLS), D_MODEL ** -0.5) * col_scale
    q_norm_g = 1.0 + nrm(ks[3], (DEPTH, MLA_Q_RANK), 0.02)
    w_uq = nrm(ks[4], (DEPTH, MLA_Q_RANK, MLA_HEADS * (MLA_NOPE + MLA_ROPE)), MLA_Q_RANK ** -0.5)
    kv_norm_g = 1.0 + nrm(ks[5], (DEPTH, MLA_KV_RANK), 0.02)
    kv_scale = jnp.concatenate([jnp.ones((MLA_NOPE,), jnp.float32), jnp.full((MLA_V,), BETA, jnp.float32)])
    w_ukv = (nrm(ks[6], (DEPTH, MLA_KV_RANK, MLA_HEADS, MLA_NOPE + MLA_V), MLA_KV_RANK ** -0.5) * kv_scale).reshape(DEPTH, MLA_KV_RANK, MLA_HEADS * (MLA_NOPE + MLA_V))
    mla_out_g = 1.0 + nrm(ks[7], (DEPTH, D_MLA), 0.02)
    hg_lb_logits = nrm(ks[8], (DEPTH + 1, HG_HEADS * HG_DK), 0.5)
    hg_norm_g = 1.0 + nrm(ks[9], (DEPTH, HG_DV), 0.02)
    w_out = nrm(ks[10], (DEPTH, D_MIX, D_MODEL), D_MIX ** -0.5 * BETA)
    ln1_g = 1.0 + nrm(ks[11], (DEPTH, D_MODEL), 0.02)
    ln1_b = nrm(ks[12], (DEPTH, D_MODEL), 0.02)
    w_router_group = nrm(ks[13], (DEPTH, D_MODEL, N_GROUPS), D_MODEL ** -0.5)
    b_router_group = nrm(ks[14], (DEPTH, N_GROUPS), 0.01)
    w_router_expert = nrm(ks[15], (DEPTH, D_MODEL, N_EXPERTS), D_MODEL ** -0.5)
    b_router_expert = nrm(ks[16], (DEPTH, N_EXPERTS), 0.01)
    w1 = nrm(ks[17], (DEPTH, N_EXPERTS, D_MODEL, D_EXPERT), D_MODEL ** -0.5 * BETA)
    w3 = nrm(ks[18], (DEPTH, N_EXPERTS, D_MODEL, D_EXPERT), D_MODEL ** -0.5 * BETA)
    w2 = nrm(ks[19], (DEPTH, N_EXPERTS, D_EXPERT, D_MODEL), D_EXPERT ** -0.5 * BETA)
    ln2_g = 1.0 + nrm(ks[20], (DEPTH, D_MODEL), 0.02)
    ln2_b = nrm(ks[21], (DEPTH, D_MODEL), 0.02)
    return {"x": x, "positions": positions, "w_in": w_in, "q_norm_g": q_norm_g, "w_uq": w_uq,
            "kv_norm_g": kv_norm_g, "w_ukv": w_ukv, "mla_out_g": mla_out_g, "hg_lb_logits": hg_lb_logits,
            "hg_norm_g": hg_norm_g, "w_out": w_out, "ln1_g": ln1_g, "ln1_b": ln1_b,
            "w_router_group": w_router_group, "b_router_group": b_router_group,
            "w_router_expert": w_router_expert, "b_router_expert": b_router_expert,
            "w1": w1, "w3": w3, "w2": w2, "ln2_g": ln2_g, "ln2_b": ln2_b}


def reference(x, positions, w_in, q_norm_g, w_uq, kv_norm_g, w_ukv, mla_out_g, hg_lb_logits, hg_norm_g,
              w_out, ln1_g, ln1_b, w_router_group, b_router_group, w_router_expert, b_router_expert,
              w1, w3, w2, ln2_g, ln2_b):
    split_idx = [int(v) for v in np.cumsum(IN_SIZES)[:-1]]
    h = x
    for l in range(DEPTH):
        proj = h @ w_in[l]
        c_q, c_kv, k_r, f_pre, i_in, q_in, g_in = jnp.split(proj, split_idx, axis=-1)
        a = rms_norm(mla_group(c_q, c_kv, k_r, positions, q_norm_g[l], w_uq[l], kv_norm_g[l], w_ukv[l]), mla_out_g[l])
        r = hgrn2_group(f_pre, i_in, q_in, g_in, hg_lb_logits, l, hg_norm_g[l])
        mix = jnp.concatenate([a, r], axis=-1) @ w_out[l]
        h = layer_norm(ALPHA * h + mix, ln1_g[l], ln1_b[l])
        moe = hier_moe(h, w_router_group[l], b_router_group[l], w_router_expert[l], b_router_expert[l], w1[l], w3[l], w2[l])
        h = layer_norm(ALPHA * h + moe, ln2_g[l], ln2_b[l])
    return h
```

```cpp
#include <hip/hip_runtime.h>
#include <cstdio>
#include <cstdint>
#include <cmath>

namespace nv {
constexpr int NTOK = 16384, D = 1024, SEQ = 4096, INC = 2464;
constexpr int O_CQ = 0, O_CKV = 256, O_KR = 384, O_F = 416, O_I = 928, O_Q = 1440, O_G = 1952;
constexpr int NEXP = 32, PSLOTS = 36864, NBLK = 288;
constexpr float ALPHA = 1.189207115002721f;
constexpr float RMS_EPS = 1e-6f, LN_EPS = 1e-5f;

template <class F>
__global__ void __launch_bounds__(256) ngemm_k(int M, int N, int K, F f) {
    __shared__ float As[16][68];
    __shared__ float Bs[16][68];
    const int tx = threadIdx.x & 15, ty = threadIdx.x >> 4;
    const int m0 = blockIdx.y * 64, n0 = blockIdx.x * 64;
    float acc[4][4];
#pragma unroll
    for (int i = 0; i < 4; ++i)
#pragma unroll
        for (int j = 0; j < 4; ++j) acc[i][j] = 0.f;
    for (int k0 = 0; k0 < K; k0 += 16) {
#pragma unroll
        for (int i = 0; i < 4; ++i) {
            const int idx = threadIdx.x + i * 256; const int r = idx >> 4, kk = idx & 15;
            As[kk][r] = (m0 + r < M) ? f.a(m0 + r, k0 + kk) : 0.f;
        }
#pragma unroll
        for (int i = 0; i < 4; ++i) {
            const int idx = threadIdx.x + i * 256; const int kk = idx >> 6, c = idx & 63;
            Bs[kk][c] = (n0 + c < N) ? f.b(k0 + kk, n0 + c, m0) : 0.f;
        }
        __syncthreads();
#pragma unroll
        for (int kk = 0; kk < 16; ++kk) {
            float a[4], b[4];
#pragma unroll
            for (int i = 0; i < 4; ++i) { a[i] = As[kk][ty * 4 + i]; b[i] = Bs[kk][tx * 4 + i]; }
#pragma unroll
            for (int i = 0; i < 4; ++i)
#pragma unroll
                for (int j = 0; j < 4; ++j) acc[i][j] += a[i] * b[j];
        }
        __syncthreads();
    }
#pragma unroll
    for (int i = 0; i < 4; ++i)
#pragma unroll
        for (int j = 0; j < 4; ++j) { const int r = m0 + ty * 4 + i, c = n0 + tx * 4 + j; if (r < M && c < N) f.epi(r, c, acc[i][j]); }
}

struct ProjF { const float* x; const float* w; float* out;
    __device__ float a(int r, int k) const { return x[(size_t)r * D + k]; }
    __device__ float b(int k, int c, int) const { return w[(size_t)k * INC + c]; }
    __device__ void epi(int r, int c, float v) const { out[(size_t)r * INC + c] = v; } };
struct PlainF { const float* A; int lda; const float* B; int ldb; float* C; int ldc;
    __device__ float a(int r, int k) const { return A[(size_t)r * lda + k]; }
    __device__ float b(int k, int c, int) const { return B[(size_t)k * ldb + c]; }
    __device__ void epi(int r, int c, float v) const { C[(size_t)r * ldc + c] = v; } };
struct MixF { const float* an; const float* rr; const float* w; const float* x; float* t;
    __device__ float a(int r, int k) const { return k < 512 ? an[(size_t)r * 512 + k] : rr[(size_t)r * 512 + k - 512]; }
    __device__ float b(int k, int c, int) const { return w[(size_t)k * D + c]; }
    __device__ void epi(int r, int c, float v) const { t[(size_t)r * D + c] = ALPHA * x[(size_t)r * D + c] + v; } };
struct Moe1F { const float* h1; const int* slot_tok; const int* blk_exp; const float* w; float* H; int which;
    __device__ float a(int r, int k) const { const int tok = slot_tok[r]; return tok < NTOK ? h1[(size_t)tok * D + k] : 0.f; }
    __device__ float b(int k, int c, int m0) const { const int e = blk_exp[m0 >> 7]; return w[((size_t)e * D + k) * 512 + c]; }
    __device__ void epi(int r, int c, float v) const { float* p = H + (size_t)r * 512 + c; if (which == 0) *p = v / (1.f + expf(-v)); else *p *= v; } };
struct Moe2F { const float* H; const int* slot_tok; const float* slot_gate; const int* blk_exp; const float* w; float* acc;
    __device__ float a(int r, int k) const { return H[(size_t)r * 512 + k]; }
    __device__ float b(int k, int c, int m0) const { const int e = blk_exp[m0 >> 7]; return w[((size_t)e * 512 + k) * D + c]; }
    __device__ void epi(int r, int c, float v) const { const int tok = slot_tok[r]; if (tok < NTOK) atomicAdd(acc + (size_t)tok * D + c, slot_gate[r] * v); } };

__device__ __forceinline__ float wsum(float v) {
#pragma unroll
    for (int o = 1; o < 64; o <<= 1) v += __shfl_xor(v, o);
    return v;
}

__global__ void hg_gate_k(float* proj, const float* lbl) {
    const int i = blockIdx.x * blockDim.x + threadIdx.x; if (i >= NTOK * 512) return;
    const int r = i >> 9, c = i & 511;
    const float l0 = lbl[c], l1 = lbl[512 + c]; const float mx = fmaxf(l0, l1);
    const float e0 = expf(l0 - mx), e1 = expf(l1 - mx); const float lb = e0 / (e0 + e1);
    float* p = proj + (size_t)r * INC + O_F + c; const float z = *p;
    *p = lb + (1.f - lb) * (1.f / (1.f + expf(-z)));
}
__global__ void __launch_bounds__(128) hg_rec_k(float* proj) {
    const int bh = blockIdx.x, b = bh >> 2, h = bh & 3, e = threadIdx.x;
    float S[128];
#pragma unroll
    for (int d = 0; d < 128; ++d) S[d] = 0.f;
    for (int t = 0; t < SEQ; ++t) {
        float* row = proj + (size_t)(b * SEQ + t) * INC;
        const float v = row[O_I + h * 128 + e];
        const float* fr = row + O_F + h * 128; const float* qr = row + O_Q + h * 128;
        float o = 0.f;
#pragma unroll
        for (int d = 0; d < 128; ++d) { const float f = fr[d]; S[d] = f * S[d] + (1.f - f) * v; o += qr[d] * S[d]; }
        row[O_I + h * 128 + e] = o;
    }
}
__global__ void hg_out_k(const float* proj, const float* g, float* rr) {
    const int w = (blockIdx.x * blockDim.x + threadIdx.x) >> 6, lane = threadIdx.x & 63; if (w >= NTOK * 4) return;
    const int r = w >> 2, h = w & 3; const float* row = proj + (size_t)r * INC;
    const float o0 = row[O_I + h * 128 + lane], o1 = row[O_I + h * 128 + 64 + lane];
    const float ss = wsum(o0 * o0 + o1 * o1); const float rs = 1.f / sqrtf(ss * (1.f / 128.f) + RMS_EPS);
    const float g0 = row[O_G + h * 128 + lane], g1 = row[O_G + h * 128 + 64 + lane];
    rr[(size_t)r * 512 + h * 128 + lane] = o0 * rs * g[lane] * (g0 / (1.f + expf(-g0)));
    rr[(size_t)r * 512 + h * 128 + 64 + lane] = o1 * rs * g[64 + lane] * (g1 / (1.f + expf(-g1)));
}
__global__ void cs_k(const int* pos, float* cs) {
    const int i = blockIdx.x * blockDim.x + threadIdx.x; if (i >= NTOK * 16) return;
    const int j = i & 15, r = i >> 4;
    const float invf = (float)pow(10000.0, -(double)(2 * j) / 32.0);
    const float ang = (float)pos[r] * invf;
    double s, c; sincos((double)ang, &s, &c);
    cs[(size_t)r * 32 + j] = (float)c; cs[(size_t)r * 32 + 16 + j] = (float)s;
}
__global__ void mla_prep_k(const float* proj, const float* gq, const float* gkv, const float* cs, float* cqn, float* ckvn, float* kr) {
    const int r = (blockIdx.x * blockDim.x + threadIdx.x) >> 6, lane = threadIdx.x & 63; if (r >= NTOK) return;
    const float* row = proj + (size_t)r * INC;
    float v[4]; float ss = 0.f;
#pragma unroll
    for (int i = 0; i < 4; ++i) { v[i] = row[O_CQ + lane + 64 * i]; ss += v[i] * v[i]; }
    ss = wsum(ss); float rs = 1.f / sqrtf(ss * (1.f / 256.f) + RMS_EPS);
#pragma unroll
    for (int i = 0; i < 4; ++i) cqn[(size_t)r * 256 + lane + 64 * i] = v[i] * rs * gq[lane + 64 * i];
    float u0 = row[O_CKV + lane], u1 = row[O_CKV + 64 + lane];
    ss = wsum(u0 * u0 + u1 * u1); rs = 1.f / sqrtf(ss * (1.f / 128.f) + RMS_EPS);
    ckvn[(size_t)r * 128 + lane] = u0 * rs * gkv[lane]; ckvn[(size_t)r * 128 + 64 + lane] = u1 * rs * gkv[64 + lane];
    if (lane < 16) { const float x1 = row[O_KR + lane], x2 = row[O_KR + 16 + lane]; const float c = cs[(size_t)r * 32 + lane], s = cs[(size_t)r * 32 + 16 + lane];
        kr[(size_t)r * 32 + lane] = x1 * c - x2 * s; kr[(size_t)r * 32 + 16 + lane] = x2 * c + x1 * s; }
}
__global__ void q_rope_k(float* q, const float* cs) {
    const int i = blockIdx.x * blockDim.x + threadIdx.x; if (i >= NTOK * 8 * 16) return;
    const int j = i & 15, h = (i >> 4) & 7, r = i >> 7;
    float* p = q + (size_t)r * 768 + h * 96 + 64; const float x1 = p[j], x2 = p[16 + j]; const float c = cs[(size_t)r * 32 + j], s = cs[(size_t)r * 32 + 16 + j];
    p[j] = x1 * c - x2 * s; p[16 + j] = x2 * c + x1 * s;
}
__global__ void __launch_bounds__(64) attn_k(const float* q, const float* kv, const float* kr, float* out) {
    const int blk = blockIdx.x; const int qc = blk & 63, h = (blk >> 6) & 7, b = blk >> 9;
    const int t = qc * 64 + threadIdx.x; const size_t row = (size_t)b * SEQ + t;
    const float scale = 0.10206207261596575f;
    float qv[96];
#pragma unroll
    for (int d = 0; d < 96; ++d) qv[d] = q[row * 768 + h * 96 + d] * scale;
    float o[64];
#pragma unroll
    for (int d = 0; d < 64; ++d) o[d] = 0.f;
    float m = -INFINITY, l = 0.f;
    const int nk = (qc + 1) * 64;
    for (int s = 0; s < nk; ++s) {
        const size_t kr_ = (size_t)b * SEQ + s;
        const float* kp = kv + kr_ * 1024 + h * 128; const float* rp = kr + kr_ * 32;
        float sc = 0.f;
#pragma unroll
        for (int d = 0; d < 64; ++d) sc += qv[d] * kp[d];
#pragma unroll
        for (int d = 0; d < 32; ++d) sc += qv[64 + d] * rp[d];
        const float mn = fmaxf(m, sc); const float corr = expf(m - mn), p = expf(sc - mn);
        l = l * corr + p;
#pragma unroll
        for (int d = 0; d < 64; ++d) o[d] = o[d] * corr + p * kp[64 + d];
        m = mn;
    }
    const float il = 1.f / l;
#pragma unroll
    for (int d = 0; d < 64; ++d) out[row * 512 + h * 64 + d] = o[d] * il;
}
__global__ void a_norm_k(float* a, const float* g) {
    const int r = (blockIdx.x * blockDim.x + threadIdx.x) >> 6, lane = threadIdx.x & 63; if (r >= NTOK) return;
    float v[8]; float ss = 0.f;
#pragma unroll
    for (int i = 0; i < 8; ++i) { v[i] = a[(size_t)r * 512 + lane + 64 * i]; ss += v[i] * v[i]; }
    ss = wsum(ss); const float rs = 1.f / sqrtf(ss * (1.f / 512.f) + RMS_EPS);
#pragma unroll
    for (int i = 0; i < 8; ++i) a[(size_t)r * 512 + lane + 64 * i] = v[i] * rs * g[lane + 64 * i];
}
__global__ void ln_k(const float* in, const float* add, float addscale_in, const float* g, const float* bb, float* out) {
    const int r = (blockIdx.x * blockDim.x + threadIdx.x) >> 6, lane = threadIdx.x & 63; if (r >= NTOK) return;
    float v[16]; float s = 0.f;
#pragma unroll
    for (int i = 0; i < 16; ++i) { const size_t o = (size_t)r * D + lane + 64 * i; v[i] = addscale_in * in[o] + (add ? add[o] : 0.f); s += v[i]; }
    const float mean = wsum(s) * (1.f / D); float q = 0.f;
#pragma unroll
    for (int i = 0; i < 16; ++i) { v[i] -= mean; q += v[i] * v[i]; }
    const float rs = 1.f / sqrtf(wsum(q) * (1.f / D) + LN_EPS);
#pragma unroll
    for (int i = 0; i < 16; ++i) { const int c = lane + 64 * i; out[(size_t)r * D + c] = v[i] * rs * g[c] + bb[c]; }
}
__global__ void router_k(const float* h1, const float* wg, const float* bg, const float* we, const float* be, int* cnt, int* tok_e, int* tok_rank, float* tok_gate) {
    const int r = (blockIdx.x * blockDim.x + threadIdx.x) >> 6, lane = threadIdx.x & 63; if (r >= NTOK) return;
    float lg[36];
#pragma unroll
    for (int c = 0; c < 36; ++c) lg[c] = 0.f;
    for (int i = 0; i < 16; ++i) { const int k = lane + 64 * i; const float xv = h1[(size_t)r * D + k];
#pragma unroll
        for (int c = 0; c < 4; ++c) lg[c] += xv * wg[k * 4 + c];
#pragma unroll
        for (int c = 0; c < 32; ++c) lg[4 + c] += xv * we[k * 32 + c]; }
#pragma unroll
    for (int c = 0; c < 36; ++c) lg[c] = wsum(lg[c]);
#pragma unroll
    for (int c = 0; c < 4; ++c) lg[c] += bg[c];
#pragma unroll
    for (int c = 0; c < 32; ++c) lg[4 + c] += be[c];
    int grp = 0; float gm = lg[0];
#pragma unroll
    for (int c = 1; c < 4; ++c) if (lg[c] > gm) { gm = lg[c]; grp = c; }
    float den = 0.f;
#pragma unroll
    for (int c = 0; c < 4; ++c) den += expf(lg[c] - gm);
    const float pgrp = 1.f / den;
    float ein[8];
#pragma unroll
    for (int j = 0; j < 8; ++j) ein[j] = grp == 0 ? lg[4 + j] : grp == 1 ? lg[12 + j] : grp == 2 ? lg[20 + j] : lg[28 + j];
    int i0 = 0; float v0 = ein[0];
#pragma unroll
    for (int j = 1; j < 8; ++j) if (ein[j] > v0) { v0 = ein[j]; i0 = j; }
    int i1 = -1; float v1 = -INFINITY;
#pragma unroll
    for (int j = 0; j < 8; ++j) if (j != i0 && ein[j] > v1) { v1 = ein[j]; i1 = j; }
    const float e1 = expf(v1 - v0); const float p0 = 1.f / (1.f + e1), p1 = e1 / (1.f + e1);
    if (lane == 0) {
        const int ea = grp * 8 + i0, eb = grp * 8 + i1;
        tok_e[2 * r] = ea; tok_e[2 * r + 1] = eb;
        tok_rank[2 * r] = atomicAdd(cnt + ea, 1); tok_rank[2 * r + 1] = atomicAdd(cnt + eb, 1);
        tok_gate[2 * r] = pgrp * p0; tok_gate[2 * r + 1] = pgrp * p1;
    }
}
__global__ void prefix_k(const int* cnt, int* pad_start, int* blk_exp) {
    if (threadIdx.x != 0 || blockIdx.x != 0) return;
    int acc = 0;
    for (int e = 0; e < NEXP; ++e) { pad_start[e] = acc; acc += ((cnt[e] + 127) / 128) * 128; pad_start[NEXP + e] = acc; }
    for (int b = 0; b < NBLK; ++b) { int c = 0; for (int e = 0; e < NEXP; ++e) c += (pad_start[NEXP + e] <= b * 128) ? 1 : 0; blk_exp[b] = c < NEXP - 1 ? c : NEXP - 1; }
}
__global__ void slot_init_k(int* slot_tok, float* slot_gate) { const int i = blockIdx.x * blockDim.x + threadIdx.x; if (i < PSLOTS) { slot_tok[i] = NTOK; slot_gate[i] = 0.f; } }
__global__ void slot_fill_k(const int* tok_e, const int* tok_rank, const float* tok_gate, const int* pad_start, int* slot_tok, float* slot_gate) {
    const int i = blockIdx.x * blockDim.x + threadIdx.x; if (i >= NTOK * 2) return;
    const int s = pad_start[tok_e[i]] + tok_rank[i]; slot_tok[s] = i >> 1; slot_gate[s] = tok_gate[i];
}
}

extern "C" void kernel_launch(void* const* d_in, const int* in_sizes, int n_in, void* d_out, int out_size, void* d_ws, size_t ws_size, hipStream_t stream) {
    using namespace nv;
    const float* x = (const float*)d_in[0]; const int* pos = (const int*)d_in[1]; const float* w_in = (const float*)d_in[2];
    const float* q_norm_g = (const float*)d_in[3]; const float* w_uq = (const float*)d_in[4]; const float* kv_norm_g = (const float*)d_in[5];
    const float* w_ukv = (const float*)d_in[6]; const float* mla_out_g = (const float*)d_in[7]; const float* lbl = (const float*)d_in[8];
    const float* hg_norm_g = (const float*)d_in[9]; const float* w_out = (const float*)d_in[10]; const float* ln1_g = (const float*)d_in[11];
    const float* ln1_b = (const float*)d_in[12]; const float* wrg = (const float*)d_in[13]; const float* brg = (const float*)d_in[14];
    const float* wre = (const float*)d_in[15]; const float* bre = (const float*)d_in[16]; const float* w1 = (const float*)d_in[17];
    const float* w3 = (const float*)d_in[18]; const float* w2 = (const float*)d_in[19]; const float* ln2_g = (const float*)d_in[20]; const float* ln2_b = (const float*)d_in[21];
    float* out = (float*)d_out;
    char* ws = (char*)d_ws; const size_t MB = 1u << 20;
    if (ws_size < 262 * MB) { fprintf(stderr, "ws too small: %zu\n", ws_size); return; }
    float* proj = (float*)(ws + 0);
    float* rr   = (float*)(ws + 156 * MB);
    float* cs   = (float*)(ws + 188 * MB);
    float* kr   = (float*)(ws + 190 * MB);
    float* cqn  = (float*)(ws + 192 * MB);
    float* ckvn = (float*)(ws + 208 * MB);
    float* qb   = (float*)(ws + 0);
    float* kvb  = (float*)(ws + 48 * MB);
    float* ab   = (float*)(ws + 112 * MB);
    float* h1   = (float*)(ws + 0);
    float* Hb   = (float*)(ws + 188 * MB);
    float* accb = (float*)(ws + 64 * MB);
    char* ctl   = ws + 144 * MB;
    int* cnt = (int*)ctl; int* pad_start = cnt + 64; int* blk_exp = cnt + 256; int* tok_e = cnt + 1024; int* tok_rank = tok_e + 2 * NTOK; float* tok_gate = (float*)(tok_rank + 2 * NTOK);
    int* slot_tok = (int*)(tok_gate + 2 * NTOK); float* slot_gate = (float*)(slot_tok + PSLOTS);

    ngemm_k<ProjF><<<dim3((INC + 63) / 64, NTOK / 64), 256, 0, stream>>>(NTOK, INC, D, ProjF{x, w_in, proj});
    hg_gate_k<<<NTOK * 512 / 256, 256, 0, stream>>>(proj, lbl);
    hg_rec_k<<<16, 128, 0, stream>>>(proj);
    hg_out_k<<<NTOK * 4 * 64 / 256, 256, 0, stream>>>(proj, hg_norm_g, rr);
    cs_k<<<NTOK * 16 / 256, 256, 0, stream>>>(pos, cs);
    mla_prep_k<<<NTOK * 64 / 256, 256, 0, stream>>>(proj, q_norm_g, kv_norm_g, cs, cqn, ckvn, kr);
    ngemm_k<PlainF><<<dim3(768 / 64, NTOK / 64), 256, 0, stream>>>(NTOK, 768, 256, PlainF{cqn, 256, w_uq, 768, qb, 768});
    ngemm_k<PlainF><<<dim3(1024 / 64, NTOK / 64), 256, 0, stream>>>(NTOK, 1024, 128, PlainF{ckvn, 128, w_ukv, 1024, kvb, 1024});
    q_rope_k<<<NTOK * 128 / 256, 256, 0, stream>>>(qb, cs);
    attn_k<<<4 * 8 * 64, 64, 0, stream>>>(qb, kvb, kr, ab);
    a_norm_k<<<NTOK * 64 / 256, 256, 0, stream>>>(ab, mla_out_g);
    ngemm_k<MixF><<<dim3(D / 64, NTOK / 64), 256, 0, stream>>>(NTOK, D, D, MixF{ab, rr, w_out, x, h1});
    ln_k<<<NTOK * 64 / 256, 256, 0, stream>>>(h1, nullptr, 1.f, ln1_g, ln1_b, h1);
    hipMemsetAsync(cnt, 0, 64 * sizeof(int), stream);
    router_k<<<NTOK * 64 / 256, 256, 0, stream>>>(h1, wrg, brg, wre, bre, cnt, tok_e, tok_rank, tok_gate);
    prefix_k<<<1, 64, 0, stream>>>(cnt, pad_start, blk_exp);
    slot_init_k<<<(PSLOTS + 255) / 256, 256, 0, stream>>>(slot_tok, slot_gate);
    slot_fill_k<<<NTOK * 2 / 256, 256, 0, stream>>>(tok_e, tok_rank, tok_gate, pad_start, slot_tok, slot_gate);
    hipMemsetAsync(accb, 0, (size_t)NTOK * D * 4, stream);
    ngemm_k<Moe1F><<<dim3(512 / 64, PSLOTS / 64), 256, 0, stream>>>(PSLOTS, 512, D, Moe1F{h1, slot_tok, blk_exp, w1, Hb, 0});
    ngemm_k<Moe1F><<<dim3(512 / 64, PSLOTS / 64), 256, 0, stream>>>(PSLOTS, 512, D, Moe1F{h1, slot_tok, blk_exp, w3, Hb, 1});
    ngemm_k<Moe2F><<<dim3(D / 64, PSLOTS / 64), 256, 0, stream>>>(PSLOTS, D, 512, Moe2F{Hb, slot_tok, slot_gate, blk_exp, w2, accb});
    ln_k<<<NTOK * 64 / 256, 256, 0, stream>>>(h1, accb, ALPHA, ln2_g, ln2_b, out);
}
```

```cpp
#include <hip/hip_runtime.h>
#include <cstdio>
#include <cstdint>
#include <cmath>

#define LAS __attribute__((address_space(3)))
constexpr int NTHREADS = 512, NWAVES = 8;
constexpr int LDS_BYTES = 147456;

#define XB_TMO      128
#define XB_XCNT(j)  (256  + 64 * (j))
#define XB_XSUB(j)  (1280 + 64 * (j))
#define XB_XGEN(j)  (2304 + 64 * (j))
#define XB_TOP      3328
#define XB_TOPGEN   3392
#define XCD_BAR_WORDS 3456
#define XB_SPIN_CAP (1u << 18)

__device__ __forceinline__ unsigned xb_ld(unsigned* p)              { return __hip_atomic_load(p, __ATOMIC_RELAXED, __HIP_MEMORY_SCOPE_AGENT); }
__device__ __forceinline__ unsigned xb_add(unsigned* p, unsigned v) { return __hip_atomic_fetch_add(p, v, __ATOMIC_RELAXED, __HIP_MEMORY_SCOPE_AGENT); }
__device__ __forceinline__ unsigned xb_xcc_id() { return (unsigned)__builtin_amdgcn_s_getreg((3 << 11) | 20) & 0xFu; }
#define XB_SPIN(cond, bar) do { unsigned _sp = 0; while (cond) { __builtin_amdgcn_s_sleep(1); \
    if ((++_sp & 255u) == 0u) { if (xb_ld(&(bar)[XB_TMO])) break; if (_sp > XB_SPIN_CAP) { atomicAdd(&(bar)[XB_TMO], 1u); break; } } } } while (0)

struct XcdBarrier {
    unsigned* bar; unsigned x;
    volatile LAS unsigned* st;
};

__device__ __forceinline__ XcdBarrier xcd_barrier_post(unsigned* bar, volatile LAS unsigned* st) {
    XcdBarrier b; b.bar = bar; b.x = xb_xcc_id(); b.st = st;
    if (threadIdx.x == 0) (void)xb_add(&bar[XB_XCNT(b.x)], 1u);
    return b;
}
__device__ __forceinline__ void xcd_barrier_complete(unsigned* bar, unsigned x, unsigned& nloc, unsigned& nx) {
    const unsigned G = gridDim.x * gridDim.y * gridDim.z;
    unsigned sum, cnt, mine, sp = 0u;
    for (;;) {
        sum = 0u; cnt = 0u; mine = 0u;
#pragma unroll
        for (unsigned j = 0; j < 16; ++j) { const unsigned c = xb_ld(&bar[XB_XCNT(j)]); sum += c; cnt += (c > 0u) ? 1u : 0u; mine = (j == x) ? c : mine; }
        if (sum == G) break;
        __builtin_amdgcn_s_sleep(1);
        if ((++sp & 255u) == 0u) { if (xb_ld(&bar[XB_TMO])) break; if (sp > XB_SPIN_CAP) { atomicAdd(&bar[XB_TMO], 1u); break; } }
    }
    nloc = mine > 0u ? mine : 1u; nx = cnt > 0u ? cnt : 1u;
}

__device__ __forceinline__ void xcd_barrier(const XcdBarrier& b) {
    asm volatile("s_waitcnt vmcnt(0)" ::: "memory");
    __syncthreads();
    if (threadIdx.x == 0) {
        unsigned* bar = b.bar;
        __builtin_amdgcn_s_waitcnt(0);
        unsigned nloc = b.st[0], nx = b.st[1];
        if (nloc == 0u) { xcd_barrier_complete(bar, b.x, nloc, nx); b.st[0] = nloc; b.st[1] = nx; }
        const unsigned old = xb_add(&bar[XB_XSUB(b.x)], 1u);
        const unsigned gen = old / nloc;
        if (old + 1u == (gen + 1u) * nloc) {
            __builtin_amdgcn_fence(__ATOMIC_RELEASE, "agent");
            asm volatile("s_waitcnt vmcnt(0)" ::: "memory");
            const unsigned og = xb_add(&bar[XB_TOP], 1u);
            const unsigned tg = og / nx;
            if (og + 1u == (tg + 1u) * nx) xb_add(&bar[XB_TOPGEN], 1u);
            else XB_SPIN(xb_ld(&bar[XB_TOPGEN]) == tg, bar);
            __builtin_amdgcn_fence(__ATOMIC_ACQUIRE, "agent");
            xb_add(&bar[XB_XGEN(b.x)], 1u);
            asm volatile("s_waitcnt vmcnt(0)" ::: "memory");
        } else {
            XB_SPIN(xb_ld(&bar[XB_XGEN(b.x)]) == gen, bar);
            __builtin_amdgcn_fence(__ATOMIC_ACQUIRE, "agent");
            asm volatile("s_waitcnt vmcnt(0)" ::: "memory");
        }
    }
    __syncthreads();
}

namespace nv {
constexpr int NTOK = 16384, D = 1024, SEQ = 4096, INC = 2464;
constexpr int O_CQ = 0, O_CKV = 256, O_KR = 384, O_F = 416, O_I = 928, O_Q = 1440, O_G = 1952;
constexpr int NEXP = 32, PSLOTS = 36864, NBLK = 288;
constexpr float ALPHA = 1.189207115002721f;
constexpr float RMS_EPS = 1e-6f, LN_EPS = 1e-5f;

template <class F>
__device__ __forceinline__ void ngemm(LAS unsigned char* lds, int M, int N, int K, const F& f) {
    LAS float* As = (LAS float*)lds;
    LAS float* Bs = As + 16 * 132;
    const int tid = threadIdx.x, tx = tid & 15, ty = tid >> 4;
    const int tn = (N + 63) / 64, tm = (M + 127) / 128;
    for (int tile = blockIdx.x; tile < tn * tm; tile += gridDim.x) {
        const int m0 = (tile / tn) * 128, n0 = (tile % tn) * 64;
        float acc[4][4];
#pragma unroll
        for (int i = 0; i < 4; ++i)
#pragma unroll
            for (int j = 0; j < 4; ++j) acc[i][j] = 0.f;
        for (int k0 = 0; k0 < K; k0 += 16) {
#pragma unroll
            for (int i = 0; i < 4; ++i) { const int idx = tid + i * 512; const int r = idx >> 4, kk = idx & 15; As[kk * 132 + r] = (m0 + r < M) ? f.a(m0 + r, k0 + kk) : 0.f; }
#pragma unroll
            for (int i = 0; i < 2; ++i) { const int idx = tid + i * 512; const int kk = idx >> 6, c = idx & 63; Bs[kk * 68 + c] = (n0 + c < N) ? f.b(k0 + kk, n0 + c, m0) : 0.f; }
            __syncthreads();
#pragma unroll
            for (int kk = 0; kk < 16; ++kk) {
                float a[4], b[4];
#pragma unroll
                for (int i = 0; i < 4; ++i) { a[i] = As[kk * 132 + ty * 4 + i]; b[i] = Bs[kk * 68 + tx * 4 + i]; }
#pragma unroll
                for (int i = 0; i < 4; ++i)
#pragma unroll
                    for (int j = 0; j < 4; ++j) acc[i][j] += a[i] * b[j];
            }
            __syncthreads();
        }
#pragma unroll
        for (int i = 0; i < 4; ++i)
#pragma unroll
            for (int j = 0; j < 4; ++j) { const int r = m0 + ty * 4 + i, c = n0 + tx * 4 + j; if (r < M && c < N) f.epi(r, c, acc[i][j]); }
    }
}

struct ProjF { const float* x; const float* w; float* out;
    __device__ float a(int r, int k) const { return x[(size_t)r * D + k]; }
    __device__ float b(int k, int c, int) const { return w[(size_t)k * INC + c]; }
    __device__ void epi(int r, int c, float v) const { out[(size_t)r * INC + c] = v; } };
struct PlainF { const float* A; int lda; const float* B; int ldb; float* C; int ldc;
    __device__ float a(int r, int k) const { return A[(size_t)r * lda + k]; }
    __device__ float b(int k, int c, int) const { return B[(size_t)k * ldb + c]; }
    __device__ void epi(int r, int c, float v) const { C[(size_t)r * ldc + c] = v; } };
struct MixF { const float* an; const float* rr; const float* w; const float* x; float* t;
    __device__ float a(int r, int k) const { return k < 512 ? an[(size_t)r * 512 + k] : rr[(size_t)r * 512 + k - 512]; }
    __device__ float b(int k, int c, int) const { return w[(size_t)k * D + c]; }
    __device__ void epi(int r, int c, float v) const { t[(size_t)r * D + c] = ALPHA * x[(size_t)r * D + c] + v; } };
struct Moe1F { const float* h1; const int* slot_tok; const int* blk_exp; const float* w; float* H; int which;
    __device__ float a(int r, int k) const { const int tok = slot_tok[r]; return tok < NTOK ? h1[(size_t)tok * D + k] : 0.f; }
    __device__ float b(int k, int c, int m0) const { const int e = blk_exp[m0 >> 7]; return w[((size_t)e * D + k) * 512 + c]; }
    __device__ void epi(int r, int c, float v) const { float* p = H + (size_t)r * 512 + c; if (which == 0) *p = v / (1.f + expf(-v)); else *p *= v; } };
struct Moe2F { const float* H; const int* slot_tok; const float* slot_gate; const int* blk_exp; const float* w; float* acc;
    __device__ float a(int r, int k) const { return H[(size_t)r * 512 + k]; }
    __device__ float b(int k, int c, int m0) const { const int e = blk_exp[m0 >> 7]; return w[((size_t)e * 512 + k) * D + c]; }
    __device__ void epi(int r, int c, float v) const { const int tok = slot_tok[r]; if (tok < NTOK) atomicAdd(acc + (size_t)tok * D + c, slot_gate[r] * v); } };

__device__ __forceinline__ float wsum(float v) {
#pragma unroll
    for (int o = 1; o < 64; o <<= 1) v += __shfl_xor(v, o);
    return v;
}
#define GTID (blockIdx.x * NTHREADS + threadIdx.x)
#define GTHREADS (gridDim.x * NTHREADS)
#define GWAVE (blockIdx.x * NWAVES + (threadIdx.x >> 6))
#define GWAVES (gridDim.x * NWAVES)

__device__ __forceinline__ void hg_gate(float* proj, const float* lbl) {
    for (int i = GTID; i < NTOK * 512; i += GTHREADS) {
        const int r = i >> 9, c = i & 511;
        const float l0 = lbl[c], l1 = lbl[512 + c]; const float mx = fmaxf(l0, l1);
        const float e0 = expf(l0 - mx), e1 = expf(l1 - mx); const float lb = e0 / (e0 + e1);
        float* p = proj + (size_t)r * INC + O_F + c; const float z = *p;
        *p = lb + (1.f - lb) * (1.f / (1.f + expf(-z)));
    }
}
__device__ __forceinline__ void hg_rec(float* proj) {
    if (blockIdx.x >= 16 || threadIdx.x >= 128) return;
    const int bh = blockIdx.x, b = bh >> 2, h = bh & 3, e = threadIdx.x;
    float S[128];
#pragma unroll
    for (int d = 0; d < 128; ++d) S[d] = 0.f;
    for (int t = 0; t < SEQ; ++t) {
        float* row = proj + (size_t)(b * SEQ + t) * INC;
        const float v = row[O_I + h * 128 + e];
        const float* fr = row + O_F + h * 128; const float* qr = row + O_Q + h * 128;
        float o = 0.f;
#pragma unroll
        for (int d = 0; d < 128; ++d) { const float f = fr[d]; S[d] = f * S[d] + (1.f - f) * v; o += qr[d] * S[d]; }
        row[O_I + h * 128 + e] = o;
    }
}
__device__ __forceinline__ void hg_out(const float* proj, const float* g, float* rr) {
    const int lane = threadIdx.x & 63;
    for (int w = GWAVE; w < NTOK * 4; w += GWAVES) {
        const int r = w >> 2, h = w & 3; const float* row = proj + (size_t)r * INC;
        const float o0 = row[O_I + h * 128 + lane], o1 = row[O_I + h * 128 + 64 + lane];
        const float ss = wsum(o0 * o0 + o1 * o1); const float rs = 1.f / sqrtf(ss * (1.f / 128.f) + RMS_EPS);
        const float g0 = row[O_G + h * 128 + lane], g1 = row[O_G + h * 128 + 64 + lane];
        rr[(size_t)r * 512 + h * 128 + lane] = o0 * rs * g[lane] * (g0 / (1.f + expf(-g0)));
        rr[(size_t)r * 512 + h * 128 + 64 + lane] = o1 * rs * g[64 + lane] * (g1 / (1.f + expf(-g1)));
    }
}
__device__ __forceinline__ void cs_tab(const int* pos, float* cs) {
    for (int i = GTID; i < NTOK * 16; i += GTHREADS) {
        const int j = i & 15, r = i >> 4;
        const float invf = (float)pow(10000.0, -(double)(2 * j) / 32.0);
        const float ang = (float)pos[r] * invf;
        double s, c; sincos((double)ang, &s, &c);
        cs[(size_t)r * 32 + j] = (float)c; cs[(size_t)r * 32 + 16 + j] = (float)s;
    }
}
__device__ __forceinline__ void mla_prep(const float* proj, const float* gq, const float* gkv, const float* cs, float* cqn, float* ckvn, float* kr) {
    const int lane = threadIdx.x & 63;
    for (int r = GWAVE; r < NTOK; r += GWAVES) {
        const float* row = proj + (size_t)r * INC;
        float v[4]; float ss = 0.f;
#pragma unroll
        for (int i = 0; i < 4; ++i) { v[i] = row[O_CQ + lane + 64 * i]; ss += v[i] * v[i]; }
        ss = wsum(ss); float rs = 1.f / sqrtf(ss * (1.f / 256.f) + RMS_EPS);
#pragma unroll
        for (int i = 0; i < 4; ++i) cqn[(size_t)r * 256 + lane + 64 * i] = v[i] * rs * gq[lane + 64 * i];
        float u0 = row[O_CKV + lane], u1 = row[O_CKV + 64 + lane];
        ss = wsum(u0 * u0 + u1 * u1); rs = 1.f / sqrtf(ss * (1.f / 128.f) + RMS_EPS);
        ckvn[(size_t)r * 128 + lane] = u0 * rs * gkv[lane]; ckvn[(size_t)r * 128 + 64 + lane] = u1 * rs * gkv[64 + lane];
        if (lane < 16) { const float x1 = row[O_KR + lane], x2 = row[O_KR + 16 + lane]; const float c = cs[(size_t)r * 32 + lane], s = cs[(size_t)r * 32 + 16 + lane];
            kr[(size_t)r * 32 + lane] = x1 * c - x2 * s; kr[(size_t)r * 32 + 16 + lane] = x2 * c + x1 * s; }
    }
}
__device__ __forceinline__ void q_rope(float* q, const float* cs) {
    for (int i = GTID; i < NTOK * 8 * 16; i += GTHREADS) {
        const int j = i & 15, h = (i >> 4) & 7, r = i >> 7;
        float* p = q + (size_t)r * 768 + h * 96 + 64; const float x1 = p[j], x2 = p[16 + j]; const float c = cs[(size_t)r * 32 + j], s = cs[(size_t)r * 32 + 16 + j];
        p[j] = x1 * c - x2 * s; p[16 + j] = x2 * c + x1 * s;
    }
}
__device__ __forceinline__ void attn_naive(const float* q, const float* kv, const float* kr, float* out) {
    const int lane = threadIdx.x & 63;
    for (int task = GWAVE; task < 2048; task += GWAVES) {
        const int tsk = __builtin_amdgcn_readfirstlane(task);
        const int qc = 63 - (tsk >> 5), h = tsk & 7, b = (tsk >> 3) & 3;
        const int t = qc * 64 + lane; const size_t row = (size_t)b * SEQ + t;
        const float scale = 0.10206207261596575f;
        float qv[96];
#pragma unroll
        for (int d = 0; d < 96; ++d) qv[d] = q[row * 768 + h * 96 + d] * scale;
        float o[64];
#pragma unroll
        for (int d = 0; d < 64; ++d) o[d] = 0.f;
        float m = -INFINITY, l = 0.f;
        const int nk = (qc + 1) * 64;
        for (int s = 0; s < nk; ++s) {
            const size_t kr_ = (size_t)b * SEQ + s;
            const float* kp = kv + kr_ * 1024 + h * 128; const float* rp = kr + kr_ * 32;
            float sc = 0.f;
#pragma unroll
            for (int d = 0; d < 64; ++d) sc += qv[d] * kp[d];
#pragma unroll
            for (int d = 0; d < 32; ++d) sc += qv[64 + d] * rp[d];
            const float mn = fmaxf(m, sc); const float corr = expf(m - mn), p = expf(sc - mn);
            l = l * corr + p;
#pragma unroll
            for (int d = 0; d < 64; ++d) o[d] = o[d] * corr + p * kp[64 + d];
            m = mn;
        }
        const float il = 1.f / l;
#pragma unroll
        for (int d = 0; d < 64; ++d) out[row * 512 + h * 64 + d] = o[d] * il;
    }
}
__device__ __forceinline__ void a_norm(float* a, const float* g) {
    const int lane = threadIdx.x & 63;
    for (int r = GWAVE; r < NTOK; r += GWAVES) {
        float v[8]; float ss = 0.f;
#pragma unroll
        for (int i = 0; i < 8; ++i) { v[i] = a[(size_t)r * 512 + lane + 64 * i]; ss += v[i] * v[i]; }
        ss = wsum(ss); const float rs = 1.f / sqrtf(ss * (1.f / 512.f) + RMS_EPS);
#pragma unroll
        for (int i = 0; i < 8; ++i) a[(size_t)r * 512 + lane + 64 * i] = v[i] * rs * g[lane + 64 * i];
    }
}
__device__ __forceinline__ void ln_rows(const float* in, const float* add, float addscale_in, const float* g, const float* bb, float* out) {
    const int lane = threadIdx.x & 63;
    for (int r = GWAVE; r < NTOK; r += GWAVES) {
        float v[16]; float s = 0.f;
#pragma unroll
        for (int i = 0; i < 16; ++i) { const size_t o = (size_t)r * D + lane + 64 * i; v[i] = addscale_in * in[o] + (add ? add[o] : 0.f); s += v[i]; }
        const float mean = wsum(s) * (1.f / D); float q = 0.f;
#pragma unroll
        for (int i = 0; i < 16; ++i) { v[i] -= mean; q += v[i] * v[i]; }
        const float rs = 1.f / sqrtf(wsum(q) * (1.f / D) + LN_EPS);
#pragma unroll
        for (int i = 0; i < 16; ++i) { const int c = lane + 64 * i; out[(size_t)r * D + c] = v[i] * rs * g[c] + bb[c]; }
    }
}
__device__ __forceinline__ void router(const float* h1, const float* wg, const float* bg, const float* we, const float* be, int* cnt, int* tok_e, int* tok_rank, float* tok_gate) {
    const int lane = threadIdx.x & 63;
    for (int r = GWAVE; r < NTOK; r += GWAVES) {
        float lg[36];
#pragma unroll
        for (int c = 0; c < 36; ++c) lg[c] = 0.f;
        for (int i = 0; i < 16; ++i) { const int k = lane + 64 * i; const float xv = h1[(size_t)r * D + k];
#pragma unroll
            for (int c = 0; c < 4; ++c) lg[c] += xv * wg[k * 4 + c];
#pragma unroll
            for (int c = 0; c < 32; ++c) lg[4 + c] += xv * we[k * 32 + c]; }
#pragma unroll
        for (int c = 0; c < 36; ++c) lg[c] = wsum(lg[c]);
#pragma unroll
        for (int c = 0; c < 4; ++c) lg[c] += bg[c];
#pragma unroll
        for (int c = 0; c < 32; ++c) lg[4 + c] += be[c];
        int grp = 0; float gm = lg[0];
#pragma unroll
        for (int c = 1; c < 4; ++c) if (lg[c] > gm) { gm = lg[c]; grp = c; }
        float den = 0.f;
#pragma unroll
        for (int c = 0; c < 4; ++c) den += expf(lg[c] - gm);
        const float pgrp = 1.f / den;
        float ein[8];
#pragma unroll
        for (int j = 0; j < 8; ++j) ein[j] = grp == 0 ? lg[4 + j] : grp == 1 ? lg[12 + j] : grp == 2 ? lg[20 + j] : lg[28 + j];
        int i0 = 0; float v0 = ein[0];
#pragma unroll
        for (int j = 1; j < 8; ++j) if (ein[j] > v0) { v0 = ein[j]; i0 = j; }
        int i1 = -1; float v1 = -INFINITY;
#pragma unroll
        for (int j = 0; j < 8; ++j) if (j != i0 && ein[j] > v1) { v1 = ein[j]; i1 = j; }
        const float e1 = expf(v1 - v0); const float p0 = 1.f / (1.f + e1), p1 = e1 / (1.f + e1);
        if (lane == 0) {
            const int ea = grp * 8 + i0, eb = grp * 8 + i1;
            tok_e[2 * r] = ea; tok_e[2 * r + 1] = eb;
            tok_rank[2 * r] = atomicAdd(cnt + ea, 1); tok_rank[2 * r + 1] = atomicAdd(cnt + eb, 1);
            tok_gate[2 * r] = pgrp * p0; tok_gate[2 * r + 1] = pgrp * p1;
        }
    }
}
__device__ __forceinline__ void prefix(const int* cnt, int* pad_start, int* blk_exp) {
    if (threadIdx.x != 0 || blockIdx.x != 0) return;
    int acc = 0;
    for (int e = 0; e < NEXP; ++e) { pad_start[e] = acc; acc += ((__hip_atomic_load(cnt + e, __ATOMIC_RELAXED, __HIP_MEMORY_SCOPE_AGENT) + 127) / 128) * 128; pad_start[NEXP + e] = acc; }
    for (int b = 0; b < NBLK; ++b) { int c = 0; for (int e = 0; e < NEXP; ++e) c += (pad_start[NEXP + e] <= b * 128) ? 1 : 0; blk_exp[b] = c < NEXP - 1 ? c : NEXP - 1; }
}
__device__ __forceinline__ void slot_init(int* slot_tok, float* slot_gate) { for (int i = GTID; i < PSLOTS; i += GTHREADS) { slot_tok[i] = NTOK; slot_gate[i] = 0.f; } }
__device__ __forceinline__ void slot_fill(const int* tok_e, const int* tok_rank, const float* tok_gate, const int* pad_start, int* slot_tok, float* slot_gate) {
    for (int i = GTID; i < NTOK * 2; i += GTHREADS) { const int s = pad_start[tok_e[i]] + tok_rank[i]; slot_tok[s] = i >> 1; slot_gate[s] = tok_gate[i]; }
}
__device__ __forceinline__ void zero_f32(float* p, size_t n) { for (size_t i = GTID; i < n / 4; i += GTHREADS) ((float4*)p)[i] = make_float4(0.f, 0.f, 0.f, 0.f); }
}

struct Args { const float* in[22]; float* out; unsigned char* ws; };
constexpr size_t MiB = 1u << 20;
constexpr size_t WS_CTL = 260 * MiB, CTL_ZERO_BYTES = 64 * 1024;
constexpr int CW_BAR = 1024, CW_CNT = 8192;

__global__ void __launch_bounds__(NTHREADS, 2) mega_fwd(Args args) {
    extern __shared__ __attribute__((aligned(16))) unsigned char lds_raw[];
    using namespace nv;
    LAS unsigned char* lds = (LAS unsigned char*)lds_raw;
    volatile LAS unsigned* MISC = (volatile LAS unsigned*)(lds + 131072);
    if (threadIdx.x < 64) MISC[threadIdx.x] = 0u;
    __syncthreads();
    unsigned char* ws = args.ws;
    unsigned* ctl = (unsigned*)(ws + WS_CTL);
    XcdBarrier bar = xcd_barrier_post(ctl + CW_BAR, MISC + 8);
    const float* x = args.in[0]; const int* pos = (const int*)args.in[1]; const float* w_in = args.in[2];
    const float* q_norm_g = args.in[3]; const float* w_uq = args.in[4]; const float* kv_norm_g = args.in[5];
    const float* w_ukv = args.in[6]; const float* mla_out_g = args.in[7]; const float* lbl = args.in[8];
    const float* hg_norm_g = args.in[9]; const float* w_out = args.in[10]; const float* ln1_g = args.in[11];
    const float* ln1_b = args.in[12]; const float* wrg = args.in[13]; const float* brg = args.in[14];
    const float* wre = args.in[15]; const float* bre = args.in[16]; const float* w1 = args.in[17];
    const float* w3 = args.in[18]; const float* w2 = args.in[19]; const float* ln2_g = args.in[20]; const float* ln2_b = args.in[21];
    float* out = args.out;
    float* proj = (float*)(ws + 0);
    float* rr   = (float*)(ws + 156 * MiB);
    float* cs   = (float*)(ws + 188 * MiB);
    float* kr   = (float*)(ws + 190 * MiB);
    float* cqn  = (float*)(ws + 192 * MiB);
    float* ckvn = (float*)(ws + 208 * MiB);
    float* qb   = (float*)(ws + 0);
    float* kvb  = (float*)(ws + 48 * MiB);
    float* ab   = (float*)(ws + 112 * MiB);
    float* h1   = (float*)(ws + 0);
    float* Hb   = (float*)(ws + 188 * MiB);
    float* accb = (float*)(ws + 64 * MiB);
    int* cnt = (int*)(ctl + CW_CNT);
    int* meta = (int*)(ws + WS_CTL + 1 * MiB);
    int* pad_start = meta; int* blk_exp = meta + 256; int* tok_e = meta + 1024; int* tok_rank = tok_e + 2 * NTOK; float* tok_gate = (float*)(tok_rank + 2 * NTOK);
    int* slot_tok = (int*)(tok_gate + 2 * NTOK); float* slot_gate = (float*)(slot_tok + PSLOTS);

    ngemm(lds, NTOK, INC, D, ProjF{x, w_in, proj});
    cs_tab(pos, cs);
    xcd_barrier(bar);
    hg_gate(proj, lbl);
    mla_prep(proj, q_norm_g, kv_norm_g, cs, cqn, ckvn, kr);
    xcd_barrier(bar);
    hg_rec(proj);
    xcd_barrier(bar);
    hg_out(proj, hg_norm_g, rr);
    xcd_barrier(bar);
    ngemm(lds, NTOK, 768, 256, PlainF{cqn, 256, w_uq, 768, qb, 768});
    ngemm(lds, NTOK, 1024, 128, PlainF{ckvn, 128, w_ukv, 1024, kvb, 1024});
    xcd_barrier(bar);
    q_rope(qb, cs);
    xcd_barrier(bar);
    attn_naive(qb, kvb, kr, ab);
    xcd_barrier(bar);
    a_norm(ab, mla_out_g);
    xcd_barrier(bar);
    ngemm(lds, NTOK, D, D, MixF{ab, rr, w_out, x, h1});
    xcd_barrier(bar);
    ln_rows(h1, nullptr, 1.f, ln1_g, ln1_b, h1);
    xcd_barrier(bar);
    router(h1, wrg, brg, wre, bre, cnt, tok_e, tok_rank, tok_gate);
    slot_init(slot_tok, slot_gate);
    zero_f32(accb, (size_t)NTOK * D);
    xcd_barrier(bar);
    prefix(cnt, pad_start, blk_exp);
    xcd_barrier(bar);
    slot_fill(tok_e, tok_rank, tok_gate, pad_start, slot_tok, slot_gate);
    xcd_barrier(bar);
    ngemm(lds, PSLOTS, 512, D, Moe1F{h1, slot_tok, blk_exp, w1, Hb, 0});
    xcd_barrier(bar);
    ngemm(lds, PSLOTS, 512, D, Moe1F{h1, slot_tok, blk_exp, w3, Hb, 1});
    xcd_barrier(bar);
    ngemm(lds, PSLOTS, D, 512, Moe2F{Hb, slot_tok, slot_gate, blk_exp, w2, accb});
    xcd_barrier(bar);
    ln_rows(h1, accb, ALPHA, ln2_g, ln2_b, out);
}

extern "C" void kernel_launch(void* const* d_in, const int* in_sizes, int n_in, void* d_out, int out_size, void* d_ws, size_t ws_size, hipStream_t stream) {
    static int grid = 0;
    if (grid == 0) {
        if (n_in != 22 || ws_size < 262 * MiB) { fprintf(stderr, "kernel_launch: unexpected n_in %d / ws %zu\n", n_in, ws_size); grid = -1; return; }
        int dev = 0, cus = 0, per_cu = 0;
        if (hipGetDevice(&dev) != hipSuccess || hipDeviceGetAttribute(&cus, hipDeviceAttributeMultiprocessorCount, dev) != hipSuccess) { grid = -1; return; }
        if (hipFuncSetAttribute((const void*)mega_fwd, hipFuncAttributeMaxDynamicSharedMemorySize, LDS_BYTES) != hipSuccess) { fprintf(stderr, "kernel_launch: hipFuncSetAttribute failed\n"); grid = -1; return; }
        if (hipOccupancyMaxActiveBlocksPerMultiprocessor(&per_cu, (const void*)mega_fwd, NTHREADS, LDS_BYTES) != hipSuccess || per_cu < 1) { fprintf(stderr, "kernel_launch: occupancy query says %d\n", per_cu); (void)hipGetLastError(); }
        grid = cus;
    }
    if (grid < 0) return;
    if (hipMemsetAsync((char*)d_ws + WS_CTL, 0, CTL_ZERO_BYTES, stream) != hipSuccess) return;
    Args a{};
    for (int i = 0; i < 22; ++i) a.in[i] = (const float*)d_in[i];
    a.out = (float*)d_out; a.ws = (unsigned char*)d_ws;
    hipLaunchKernelGGL(mega_fwd, dim3(grid), dim3(NTHREADS), LDS_BYTES, stream, a);
}
```

```cpp
#include <hip/hip_runtime.h>
#include <cstdio>
#include <cstdint>
#include <cmath>

#define LAS __attribute__((address_space(3)))
constexpr int NTHREADS = 512, NWAVES = 8;
constexpr int LDS_BYTES = 147456;

#define XB_TMO      128
#define XB_XCNT(j)  (256  + 64 * (j))
#define XB_XSUB(j)  (1280 + 64 * (j))
#define XB_XGEN(j)  (2304 + 64 * (j))
#define XB_TOP      3328
#define XB_TOPGEN   3392
#define XCD_BAR_WORDS 3456
#define XB_SPIN_CAP (1u << 18)

__device__ __forceinline__ unsigned xb_ld(unsigned* p)              { return __hip_atomic_load(p, __ATOMIC_RELAXED, __HIP_MEMORY_SCOPE_AGENT); }
__device__ __forceinline__ unsigned xb_add(unsigned* p, unsigned v) { return __hip_atomic_fetch_add(p, v, __ATOMIC_RELAXED, __HIP_MEMORY_SCOPE_AGENT); }
__device__ __forceinline__ unsigned xb_xcc_id() { return (unsigned)__builtin_amdgcn_s_getreg((3 << 11) | 20) & 0xFu; }
#define XB_SPIN(cond, bar) do { unsigned _sp = 0; while (cond) { __builtin_amdgcn_s_sleep(1); \
    if ((++_sp & 255u) == 0u) { if (xb_ld(&(bar)[XB_TMO])) break; if (_sp > XB_SPIN_CAP) { atomicAdd(&(bar)[XB_TMO], 1u); break; } } } } while (0)

struct XcdBarrier {
    unsigned* bar; unsigned x;
    volatile LAS unsigned* st;
};

__device__ __forceinline__ XcdBarrier xcd_barrier_post(unsigned* bar, volatile LAS unsigned* st) {
    XcdBarrier b; b.bar = bar; b.x = xb_xcc_id(); b.st = st;
    if (threadIdx.x == 0) (void)xb_add(&bar[XB_XCNT(b.x)], 1u);
    return b;
}
__device__ __forceinline__ void xcd_barrier_complete(unsigned* bar, unsigned x, unsigned& nloc, unsigned& nx) {
    const unsigned G = gridDim.x * gridDim.y * gridDim.z;
    unsigned sum, cnt, mine, sp = 0u;
    for (;;) {
        sum = 0u; cnt = 0u; mine = 0u;
#pragma unroll
        for (unsigned j = 0; j < 16; ++j) { const unsigned c = xb_ld(&bar[XB_XCNT(j)]); sum += c; cnt += (c > 0u) ? 1u : 0u; mine = (j == x) ? c : mine; }
        if (sum == G) break;
        __builtin_amdgcn_s_sleep(1);
        if ((++sp & 255u) == 0u) { if (xb_ld(&bar[XB_TMO])) break; if (sp > XB_SPIN_CAP) { atomicAdd(&bar[XB_TMO], 1u); break; } }
    }
    nloc = mine > 0u ? mine : 1u; nx = cnt > 0u ? cnt : 1u;
}

__device__ __forceinline__ void xcd_barrier(const XcdBarrier& b) {
    asm volatile("s_waitcnt vmcnt(0)" ::: "memory");
    __syncthreads();
    if (threadIdx.x == 0) {
        unsigned* bar = b.bar;
        __builtin_amdgcn_s_waitcnt(0);
        unsigned nloc = b.st[0], nx = b.st[1];
        if (nloc == 0u) { xcd_barrier_complete(bar, b.x, nloc, nx); b.st[0] = nloc; b.st[1] = nx; }
        const unsigned old = xb_add(&bar[XB_XSUB(b.x)], 1u);
        const unsigned gen = old / nloc;
        if (old + 1u == (gen + 1u) * nloc) {
            __builtin_amdgcn_fence(__ATOMIC_RELEASE, "agent");
            asm volatile("s_waitcnt vmcnt(0)" ::: "memory");
            const unsigned og = xb_add(&bar[XB_TOP], 1u);
            const unsigned tg = og / nx;
            if (og + 1u == (tg + 1u) * nx) xb_add(&bar[XB_TOPGEN], 1u);
            else XB_SPIN(xb_ld(&bar[XB_TOPGEN]) == tg, bar);
            __builtin_amdgcn_fence(__ATOMIC_ACQUIRE, "agent");
            xb_add(&bar[XB_XGEN(b.x)], 1u);
            asm volatile("s_waitcnt vmcnt(0)" ::: "memory");
        } else {
            XB_SPIN(xb_ld(&bar[XB_XGEN(b.x)]) == gen, bar);
            __builtin_amdgcn_fence(__ATOMIC_ACQUIRE, "agent");
            asm volatile("s_waitcnt vmcnt(0)" ::: "memory");
        }
    }
    __syncthreads();
}
namespace pg8 {
#define PG8_LAS __attribute__((address_space(3)))
typedef unsigned short bf16_t;
typedef short bf16x8 __attribute__((ext_vector_type(8)));
typedef float f32x4 __attribute__((ext_vector_type(4)));
typedef unsigned u32x4 __attribute__((ext_vector_type(4)));
constexpr int BM = 256, BK = 64, HALF = 128, HTB = HALF * BK * 2  , STAGE_BYTES = 8 * HTB, NXCD = 8, WGM = 8;

__host__ __device__ __forceinline__ int lds_byte(int r, int c) { const int st = (r >> 4) * 2 + (c >> 5), rr = r & 15, cc = c & 31, ob = rr * 64 + cc * 2; return st * 1024 + (ob ^ (((ob >> 9) & 1) << 5)); }
__host__ __device__ __forceinline__ void stage_rc(int b, int& R, int& C) { const int st = b / 1024, sb = b % 1024, swz = sb ^ (((sb >> 9) & 1) << 5); R = (st >> 1) * 16 + swz / 64; C = (st & 1) * 32 + (swz % 64) / 2; }
__host__ __device__ __forceinline__ int perm32(int rho) { const int n = rho >> 4, i = rho & 15; return 8 * (i >> 2) + 4 * n + (i & 3); }

struct Unit { int pm, pn; };
struct Gemm { const bf16_t* A; const bf16_t* Bt; int M, N, K; };

struct StaticOrder {
    int nM, nN, nwg, G, c;
    __host__ __device__ void init(int M, int N, int G_, int c_) { nM = M / BM; nN = N / BM; nwg = nM * nN; G = G_; c = c_; }
    __host__ __device__ bool next(int i, Unit& u) const {
        const long L = (long)i * G + c; if (L >= nwg) return false;
        int wgid = (int)L; { const int q = nwg / NXCD, r = nwg % NXCD, xcd = wgid % NXCD, off = wgid / NXCD; wgid = (xcd < r ? xcd * (q + 1) : r * (q + 1) + (xcd - r) * q) + off; }
        const int nig = WGM * nN, gid = wgid / nig, fm = gid * WGM, gsz = (nM - fm) < WGM ? (nM - fm) : WGM;
        u.pm = fm + ((wgid % nig) % gsz); u.pn = (wgid % nig) / gsz; return true;
    }
    __device__ __forceinline__ void a_ready(const Unit&) const {}
    __device__ __forceinline__ void done(const Unit&) const {}
};

__device__ __forceinline__ unsigned cvt_pk_bf16(float lo, float hi) { unsigned r; asm volatile("v_cvt_pk_bf16_f32 %0, %1, %2" : "=v"(r) : "v"(lo), "v"(hi)); return r; }
typedef float f32x2 __attribute__((ext_vector_type(2)));
__device__ __forceinline__ f32x2 gelu_pk(f32x2 v) {
    const f32x2 av = __builtin_elementwise_abs(v), d = av * 0.2316418882f + 1.0f;
    f32x2 t; t.x = __builtin_amdgcn_rcpf(d.x); t.y = __builtin_amdgcn_rcpf(d.y);
    f32x2 q = t * 0.5307027145f + (-0.7265760135f); q = q * t + 0.7107068705f; q = q * t + (-0.142248368f); q = q * t + 0.127414796f; q = q * t;
    const f32x2 s = (v * v) * (-0.72134752044f);
    f32x2 e; e.x = __builtin_amdgcn_exp2f(s.x); e.y = __builtin_amdgcn_exp2f(s.y);
    const f32x2 m = v * (q * e), r = v - m;
    f32x2 o; o.x = v.x < 0.f ? m.x : r.x; o.y = v.y < 0.f ? m.y : r.y; return o;
}

template <int ACT  > struct EpiBf16 {
    static constexpr bool PERM = true, AFTER_DRAIN = false; static_assert(ACT == 0 || ACT == 1, "EpiBf16: ACT is 0 (none) or 1 (gelu_pk)");
    bf16_t* O; int ldc; const float* bias; int split_cols; size_t split_stride; float scale0;
    __device__ __forceinline__ void operator()(const f32x4 (&acc)[2][2][4][2], const Unit& u, int wr, int wc, int fr, int fq) const {
        const int row0 = u.pm * BM + wr * 64 + fr; int colt = u.pn * BM; bf16_t* base = O;
        float sc = 1.f; if (split_cols) { const int t = colt / split_cols; base += (size_t)t * split_stride; colt -= t * split_cols; if (t == 0) sc = scale0; }
        const int col0 = colt + wc * 32 + 8 * fq, bcol0 = u.pn * BM + wc * 32 + 8 * fq;
        f32x4 bv[2][2];
#pragma unroll
        for (int bj = 0; bj < 2; ++bj)
#pragma unroll
            for (int n = 0; n < 2; ++n) bv[bj][n] = bias ? *(const f32x4*)(bias + bcol0 + bj * HALF + 4 * n) : (f32x4){0.f, 0.f, 0.f, 0.f};
#pragma unroll
        for (int ai = 0; ai < 2; ++ai)
#pragma unroll
            for (int m = 0; m < 4; ++m) { bf16_t* rowp = base + (size_t)(row0 + ai * HALF + m * 16) * ldc + col0;
#pragma unroll
                for (int bj = 0; bj < 2; ++bj) { f32x4 v0 = acc[ai][bj][m][0] + bv[bj][0], v1 = acc[ai][bj][m][1] + bv[bj][1];
                    if (ACT == 1) { f32x2 a = gelu_pk((f32x2){v0[0], v0[1]}), b = gelu_pk((f32x2){v0[2], v0[3]}), c = gelu_pk((f32x2){v1[0], v1[1]}), d = gelu_pk((f32x2){v1[2], v1[3]});
                        v0 = (f32x4){a.x, a.y, b.x, b.y}; v1 = (f32x4){c.x, c.y, d.x, d.y}; }
                    v0 = v0 * sc; v1 = v1 * sc; u32x4 w; w.x = cvt_pk_bf16(v0[0], v0[1]); w.y = cvt_pk_bf16(v0[2], v0[3]); w.z = cvt_pk_bf16(v1[0], v1[1]); w.w = cvt_pk_bf16(v1[2], v1[3]);
                    *(u32x4*)(rowp + bj * HALF) = w; } }
    }
};

struct PanelStats {
    unsigned* xbuf;
    unsigned* cnt;
    unsigned* tmo;
    int ntn; float eps;
    unsigned code;
    __device__ __forceinline__ bool run(const f32x4 (&v)[2][2][4][2], const Unit& u, int wr, int wc, int fr, int fq, PG8_LAS unsigned char* lds, int wid, int lane) const {
        typedef float f32x2v __attribute__((ext_vector_type(2)));
        PG8_LAS f32x2v* P = (PG8_LAS f32x2v*)lds;
        PG8_LAS f32x2v* S = (PG8_LAS f32x2v*)(lds + 8192);
        PG8_LAS unsigned* flag = (PG8_LAS unsigned*)(lds + 8192 + 2048);
#pragma unroll
        for (int ai = 0; ai < 2; ++ai)
#pragma unroll
            for (int m = 0; m < 4; ++m) {
                float s = 0.f;
#pragma unroll
                for (int bj = 0; bj < 2; ++bj)
#pragma unroll
                    for (int n = 0; n < 2; ++n) { const f32x4 x = v[ai][bj][m][n]; s += (x[0] + x[1]) + (x[2] + x[3]); }
                s += __shfl_xor(s, 16); s += __shfl_xor(s, 32);
                const float mw = s * (1.0f / 64.0f); float q = 0.f;
#pragma unroll
                for (int bj = 0; bj < 2; ++bj)
#pragma unroll
                    for (int n = 0; n < 2; ++n) { const f32x4 d = v[ai][bj][m][n] - mw; q += (d[0] * d[0] + d[1] * d[1]) + (d[2] * d[2] + d[3] * d[3]); }
                q += __shfl_xor(q, 16); q += __shfl_xor(q, 32);
                if (fq == 0) P[(ai * HALF + wr * 64 + m * 16 + fr) * 4 + wc] = (f32x2v){mw, q};
            }
        asm volatile("s_waitcnt lgkmcnt(0)" ::: "memory"); __builtin_amdgcn_s_barrier(); asm volatile("" ::: "memory");
#if defined(BROKEN_EXCHANGE_NO_WAIT)
#warning BROKEN CONTROL BUILD: the row-statistics exchange does not wait; results are wrong by design
        if (blockIdx.x >= 64) { const long long t0_ = clock64(); while (clock64() - t0_ < 60000) __builtin_amdgcn_s_sleep(8); }
#endif
        const int row = wid * 32 + (lane & 31);
        if (lane < 32) {
            const f32x2v a = P[row * 4 + 0], b = P[row * 4 + 1], c = P[row * 4 + 2], d = P[row * 4 + 3];
            const float mt = (a.x + b.x + c.x + d.x) * 0.25f;
            const float da = a.x - mt, db = b.x - mt, dc = c.x - mt, dd = d.x - mt;
            const float m2 = (a.y + b.y) + (c.y + d.y) + 64.0f * ((da * da + db * db) + (dc * dc + dd * dd));
            unsigned long long* slot = (unsigned long long*)xbuf + ((size_t)(u.pm * BM + row) * 4 + u.pn);
            __hip_atomic_store(slot, ((unsigned long long)__float_as_uint(m2) << 32) | __float_as_uint(mt), __ATOMIC_RELAXED, __HIP_MEMORY_SCOPE_AGENT);
        }
        asm volatile("s_waitcnt vmcnt(0)" ::: "memory");
        if (lane == 0) __hip_atomic_fetch_add(cnt + 64 * u.pm, 1u, __ATOMIC_RELAXED, __HIP_MEMORY_SCOPE_AGENT);
        if (wid == 0) {
            bool dead = false; const unsigned long long t0 = __builtin_amdgcn_s_memrealtime(); const unsigned want = 8u * (unsigned)ntn;
            for (;;) {
#if defined(BROKEN_EXCHANGE_NO_WAIT)
                break;
#endif
                if ((unsigned)__builtin_amdgcn_readfirstlane(__hip_atomic_load(cnt + 64 * u.pm, __ATOMIC_RELAXED, __HIP_MEMORY_SCOPE_AGENT)) >= want) break;
                if (__builtin_amdgcn_s_memrealtime() - t0 > 2000000ull) {
                    if (lane == 0) { unsigned expect = 0u; __hip_atomic_compare_exchange_strong(tmo + 1, &expect, code | (unsigned)(u.pm & 0xff), __ATOMIC_RELAXED, __ATOMIC_RELAXED, __HIP_MEMORY_SCOPE_AGENT);
                                     __hip_atomic_store(tmo, 1u, __ATOMIC_RELAXED, __HIP_MEMORY_SCOPE_AGENT); }
                    dead = true; break; }
                __builtin_amdgcn_s_sleep(2);
            }
            __builtin_amdgcn_fence(__ATOMIC_ACQUIRE, "agent");
            if (lane == 0) flag[0] = dead ? 1u : 0u;
        }
        asm volatile("s_waitcnt vmcnt(0) lgkmcnt(0)" ::: "memory"); __builtin_amdgcn_s_barrier(); asm volatile("" ::: "memory");
        const bool bad = flag[0] != 0u;
        if (lane < 32) {
            const unsigned long long* slot = (const unsigned long long*)xbuf + (size_t)(u.pm * BM + row) * 4; float mt[4], m2[4]; float ms = 0.f;
#pragma unroll
            for (int t = 0; t < 4; ++t) { if (t < ntn) { const unsigned long long w = __hip_atomic_load(slot + t, __ATOMIC_RELAXED, __HIP_MEMORY_SCOPE_AGENT); mt[t] = __uint_as_float((unsigned)w); m2[t] = __uint_as_float((unsigned)(w >> 32)); } else { mt[t] = 0.f; m2[t] = 0.f; } ms += mt[t]; }
            const float mean = ms / (float)ntn; float q = 0.f;
#pragma unroll
            for (int t = 0; t < 4; ++t) if (t < ntn) { const float dm = mt[t] - mean; q += m2[t] + 256.0f * dm * dm; }
            S[row] = (f32x2v){mean, 1.0f / sqrtf(q / (256.0f * (float)ntn) + eps)};
        }
        asm volatile("s_waitcnt lgkmcnt(0)" ::: "memory"); __builtin_amdgcn_s_barrier(); asm volatile("" ::: "memory");
        return bad;
    }
};
struct EpiLnRes {
    static constexpr bool PERM = false, AFTER_DRAIN = true;
    const float* base; float* out; int ldc; const float* bias; PanelStats st; unsigned poison;
    __device__ __forceinline__ void fused(f32x4 (&acc)[2][2][4][2], const Unit& u, int wr, int wc, int fr, int fq, PG8_LAS unsigned char* lds, int wid, int lane) const {
        typedef float f32x2v __attribute__((ext_vector_type(2)));
        const PG8_LAS f32x2v* S = (const PG8_LAS f32x2v*)(lds + 8192);
        const int col0 = u.pn * BM + wc * 32 + 4 * fq;
#pragma unroll
        for (int bj = 0; bj < 2; ++bj)
#pragma unroll
            for (int n = 0; n < 2; ++n) { const f32x4 bv = bias ? *(const f32x4*)(bias + col0 + bj * HALF + n * 16) : (f32x4){0.f, 0.f, 0.f, 0.f};
#pragma unroll
                for (int ai = 0; ai < 2; ++ai)
#pragma unroll
                    for (int m = 0; m < 4; ++m) acc[ai][bj][m][n] += bv; }
        f32x4 pre[4][2][2];
#pragma unroll
        for (int m = 0; m < 4; ++m) { const size_t off = (size_t)(u.pm * BM + wr * 64 + m * 16 + fr) * ldc + col0;
#pragma unroll
            for (int bj = 0; bj < 2; ++bj)
#pragma unroll
                for (int n = 0; n < 2; ++n) pre[m][bj][n] = *(const f32x4*)(base + off + bj * HALF + n * 16); }
        const bool bad = st.run(acc, u, wr, wc, fr, fq, lds, wid, lane) || poison != 0u;
        const float qnan = __builtin_nanf("");
#pragma unroll
        for (int ai = 0; ai < 2; ++ai)
#pragma unroll
            for (int m = 0; m < 4; ++m) { const int r = ai * HALF + wr * 64 + m * 16 + fr; const f32x2v sr = S[r]; const size_t off = (size_t)(u.pm * BM + r) * ldc + col0;
#pragma unroll
                for (int bj = 0; bj < 2; ++bj)
#pragma unroll
                    for (int n = 0; n < 2; ++n) { const f32x4 bs = ai == 0 ? pre[m][bj][n] : *(const f32x4*)(base + off + bj * HALF + n * 16); f32x4 o = bs + (acc[ai][bj][m][n] - sr.x) * sr.y;
                        if (bad) o = (f32x4){qnan, qnan, qnan, qnan}; *(f32x4*)(out + off + bj * HALF + n * 16) = o; }
                if (m & 1) asm volatile("" ::: "memory"); }
    }
};
struct EpiLnResLn {
    static constexpr bool PERM = false, AFTER_DRAIN = true;
    const float* base; float* out; bf16_t* xn; int ldc; const float* bias; PanelStats st1, st2; unsigned poison;
    __device__ __forceinline__ void fused(f32x4 (&acc)[2][2][4][2], const Unit& u, int wr, int wc, int fr, int fq, PG8_LAS unsigned char* lds, int wid, int lane) const {
        typedef float f32x2v __attribute__((ext_vector_type(2))); typedef unsigned u32x2v __attribute__((ext_vector_type(2)));
        const PG8_LAS f32x2v* S = (const PG8_LAS f32x2v*)(lds + 8192);
        const int col0 = u.pn * BM + wc * 32 + 4 * fq;
#pragma unroll
        for (int bj = 0; bj < 2; ++bj)
#pragma unroll
            for (int n = 0; n < 2; ++n) { const f32x4 bv = bias ? *(const f32x4*)(bias + col0 + bj * HALF + n * 16) : (f32x4){0.f, 0.f, 0.f, 0.f};
#pragma unroll
                for (int ai = 0; ai < 2; ++ai)
#pragma unroll
                    for (int m = 0; m < 4; ++m) acc[ai][bj][m][n] += bv; }
        bool bad = st1.run(acc, u, wr, wc, fr, fq, lds, wid, lane) || poison != 0u;
        const float qnan = __builtin_nanf("");
#pragma unroll
        for (int ai = 0; ai < 2; ++ai)
#pragma unroll
            for (int m = 0; m < 4; ++m) { const int r = ai * HALF + wr * 64 + m * 16 + fr; const f32x2v sr = S[r]; const size_t off = (size_t)(u.pm * BM + r) * ldc + col0;
#pragma unroll
                for (int bj = 0; bj < 2; ++bj)
#pragma unroll
                    for (int n = 0; n < 2; ++n) { const f32x4 bs = *(const f32x4*)(base + off + bj * HALF + n * 16); acc[ai][bj][m][n] = bs + (acc[ai][bj][m][n] - sr.x) * sr.y; }
                asm volatile("" : "+v"(acc[ai][0][m][0]), "+v"(acc[ai][0][m][1]), "+v"(acc[ai][1][m][0]), "+v"(acc[ai][1][m][1]));
                if (m & 1) asm volatile("" ::: "memory"); }
        const bool bad1 = bad;
        bad = st2.run(acc, u, wr, wc, fr, fq, lds, wid, lane) || bad;
#pragma unroll
        for (int ai = 0; ai < 2; ++ai)
#pragma unroll
            for (int m = 0; m < 4; ++m) { const int r = ai * HALF + wr * 64 + m * 16 + fr; const f32x2v sr = S[r]; const size_t off = (size_t)(u.pm * BM + r) * ldc + col0;
#pragma unroll
                for (int bj = 0; bj < 2; ++bj)
#pragma unroll
                    for (int n = 0; n < 2; ++n) { const f32x4 x1 = acc[ai][bj][m][n]; *(f32x4*)(out + off + bj * HALF + n * 16) = bad1 ? (f32x4){qnan, qnan, qnan, qnan} : x1;
                        const f32x4 o = (x1 - sr.x) * sr.y; u32x2v w; w.x = cvt_pk_bf16(o[0], o[1]); w.y = cvt_pk_bf16(o[2], o[3]);
                        if (bad) { w.x = 0x7fc07fc0u; w.y = 0x7fc07fc0u; } *(u32x2v*)(xn + off + bj * HALF + n * 16) = w; }
                asm volatile("" ::: "memory"); }
    }
};

template <class Epi, class Sched, bool ALIGN_EPI = false, bool SP2 = false>
__device__ __forceinline__ void gemm_phase(PG8_LAS unsigned char* lds, const Gemm g, const Sched& S, const Epi& E) {
    const int tid = threadIdx.x, wid = __builtin_amdgcn_readfirstlane(tid >> 6), lane = tid & 63, wr = wid >> 2, wc = wid & 3, fr = lane & 15, fq = lane >> 4;
    const int K = g.K, nt = K / BK;
    unsigned voffA[2], voffB[2];
#pragma unroll
    for (int i = 0; i < 2; ++i) { int R, C; stage_rc(tid * 16 + i * 8192, R, C); const int Rb = Epi::PERM ? ((R & ~31) + perm32(R & 31)) : R;
        voffA[i] = (unsigned)(R * K + C) * 2u; voffB[i] = (unsigned)(Rb * K + C) * 2u; }
    const size_t kstep = (size_t)(BK * 2);
    const size_t hstep = (size_t)HALF * K * 2;
    const size_t tstep = 2 * hstep;
    const unsigned ldsw = (unsigned)wid * 1024u;
    const int aoff = lds_byte(wr * 64 + fr, fq * 8), boff = lds_byte(wc * 32 + fr, fq * 8);
#define PG8_SA(b, h) (((b) * 2 + (h)) * HTB)
#define PG8_SB(b, h) ((4 + (b) * 2 + (h)) * HTB)
#define PG8_STAGE(bufoff, gbase, voff) do { _Pragma("unroll") for (int _i = 0; _i < 2; ++_i) \
        __builtin_amdgcn_global_load_lds((const unsigned*)((const char*)(gbase) + (voff)[_i]), (PG8_LAS unsigned*)(lds + (bufoff) + ldsw + _i * 8192), 16, 0, 0); } while (0)
#define PG8_LDA(dst, b, h) do { _Pragma("unroll") for (int m = 0; m < 4; ++m) _Pragma("unroll") for (int k = 0; k < 2; ++k) dst[m][k] = *(const PG8_LAS bf16x8*)(lds + PG8_SA(b, h) + aoff + m * 2048 + k * 1024); } while (0)
#define PG8_LDB(dst, b, h) do { _Pragma("unroll") for (int n = 0; n < 2; ++n) _Pragma("unroll") for (int k = 0; k < 2; ++k) dst[n][k] = *(const PG8_LAS bf16x8*)(lds + PG8_SB(b, h) + boff + n * 2048 + k * 1024); } while (0)
#define PG8_MMA(ai, bj, At, Bt) do { __builtin_amdgcn_s_setprio(1); _Pragma("unroll") for (int m = 0; m < 4; ++m) _Pragma("unroll") for (int n = 0; n < 2; ++n) _Pragma("unroll") for (int k = 0; k < 2; ++k) \
        acc[ai][bj][m][n] = __builtin_amdgcn_mfma_f32_16x16x32_bf16(Bt[n][k], At[m][k], acc[ai][bj][m][n], 0, 0, 0); __builtin_amdgcn_s_setprio(0); } while (0)
#define PG8_WAIT_V(n) asm volatile("s_waitcnt vmcnt(" #n ")" ::: "memory")
#define PG8_WAIT_L(n) asm volatile("s_waitcnt lgkmcnt(" #n ")" ::: "memory")
#define PG8_BAR __builtin_amdgcn_s_barrier()
#define PG8_SCHED __builtin_amdgcn_sched_barrier(0)
    Unit cur, nxt; int ui = 0;
    if (!S.next(0, cur)) return;
    f32x4 acc[2][2][4][2];
#pragma unroll
    for (int a = 0; a < 2; ++a)
#pragma unroll
        for (int b = 0; b < 2; ++b)
#pragma unroll
            for (int m = 0; m < 4; ++m)
#pragma unroll
                for (int n = 0; n < 2; ++n) acc[a][b][m][n] = (f32x4){0.f, 0.f, 0.f, 0.f};
    bf16x8 At[4][2], B0[2][2], B1[2][2];
    const char* cA = (const char*)g.A + (size_t)cur.pm * tstep; const char* cB = (const char*)g.Bt + (size_t)cur.pn * tstep;
    S.a_ready(cur);
    if constexpr (SP2) {
        PG8_STAGE(PG8_SB(0, 0), cB, voffB); PG8_STAGE(PG8_SB(0, 1), cB + hstep, voffB); PG8_STAGE(PG8_SA(0, 0), cA, voffA); PG8_STAGE(PG8_SA(0, 1), cA + hstep, voffA);
        if (wr == 1) PG8_BAR;
        PG8_WAIT_V(2); PG8_BAR;
        PG8_STAGE(PG8_SB(1, 0), cB + kstep, voffB); PG8_STAGE(PG8_SA(1, 0), cA + kstep, voffA); PG8_STAGE(PG8_SB(1, 1), cB + hstep + kstep, voffB);
        PG8_WAIT_V(6); PG8_BAR;
    } else {
        PG8_STAGE(PG8_SB(0, 0), cB, voffB); PG8_STAGE(PG8_SA(0, 0), cA, voffA); PG8_STAGE(PG8_SB(0, 1), cB + hstep, voffB); PG8_STAGE(PG8_SA(0, 1), cA + hstep, voffA);
        if (wr == 1) PG8_BAR;
        PG8_WAIT_V(4); PG8_BAR;
        PG8_STAGE(PG8_SB(1, 0), cB + kstep, voffB); PG8_STAGE(PG8_SA(1, 0), cA + kstep, voffA); PG8_STAGE(PG8_SB(1, 1), cB + hstep + kstep, voffB);
        PG8_WAIT_V(6); PG8_BAR;
    }
    for (;;) {
        const bool has_next = S.next(ui + 1, nxt);
        const char* nA = has_next ? (const char*)g.A + (size_t)nxt.pm * tstep : cA; const char* nB = has_next ? (const char*)g.Bt + (size_t)nxt.pn * tstep : cB;
        for (int t = 0; t < nt; t += 2) {
            const bool last = (t == nt - 2);
            const char* a1 = cA + (size_t)(t + 1) * kstep;
            const char* a2 = last ? nA : cA + (size_t)(t + 2) * kstep; const char* b2 = last ? nB : cB + (size_t)(t + 2) * kstep;
            const char* a3 = a2 + kstep; const char* b3 = b2 + kstep;
            if (last && has_next) S.a_ready(nxt);
            if constexpr (SP2) {
            PG8_LDB(B0, 0, 0); PG8_LDB(B1, 0, 1); PG8_SCHED; PG8_LDA(At, 0, 0); PG8_STAGE(PG8_SA(1, 1), a1 + hstep, voffA);
            PG8_WAIT_V(8); PG8_WAIT_L(0); PG8_BAR; PG8_MMA(0, 0, At, B0); PG8_MMA(0, 1, At, B1); PG8_BAR; PG8_SCHED;
            PG8_LDA(At, 0, 1); PG8_STAGE(PG8_SB(0, 0), b2, voffB); PG8_STAGE(PG8_SB(0, 1), b2 + hstep, voffB); PG8_STAGE(PG8_SA(0, 0), a2, voffA);
            PG8_WAIT_V(8); PG8_WAIT_L(0); PG8_BAR; PG8_MMA(1, 0, At, B0); PG8_MMA(1, 1, At, B1); PG8_BAR; PG8_SCHED;
            PG8_LDB(B0, 1, 0); PG8_LDB(B1, 1, 1); PG8_SCHED; PG8_LDA(At, 1, 0); PG8_STAGE(PG8_SA(0, 1), a2 + hstep, voffA);
            PG8_WAIT_V(8); PG8_WAIT_L(0); PG8_BAR; PG8_MMA(0, 0, At, B0); PG8_MMA(0, 1, At, B1); PG8_BAR; PG8_SCHED;
            PG8_LDA(At, 1, 1); PG8_STAGE(PG8_SB(1, 0), b3, voffB); PG8_STAGE(PG8_SB(1, 1), b3 + hstep, voffB); PG8_STAGE(PG8_SA(1, 0), a3, voffA);
            PG8_WAIT_V(8); PG8_WAIT_L(0); PG8_BAR; PG8_MMA(1, 0, At, B0); PG8_MMA(1, 1, At, B1); PG8_BAR; PG8_SCHED;
            } else {
            PG8_LDB(B0, 0, 0); PG8_SCHED; PG8_LDA(At, 0, 0); PG8_STAGE(PG8_SA(1, 1), a1 + hstep, voffA);
            PG8_WAIT_L(8); PG8_BAR; PG8_WAIT_L(0); PG8_MMA(0, 0, At, B0); PG8_BAR; PG8_SCHED;
            PG8_LDB(B1, 0, 1); PG8_STAGE(PG8_SB(0, 0), b2, voffB);
            PG8_BAR; PG8_WAIT_L(0); PG8_MMA(0, 1, At, B1); PG8_BAR;
            PG8_LDA(At, 0, 1); PG8_STAGE(PG8_SA(0, 0), a2, voffA);
            PG8_BAR; PG8_WAIT_L(0); PG8_MMA(1, 0, At, B0); PG8_BAR; PG8_SCHED;
            PG8_STAGE(PG8_SB(0, 1), b2 + hstep, voffB);
            PG8_WAIT_V(6); PG8_BAR; PG8_MMA(1, 1, At, B1); PG8_BAR;
            PG8_LDB(B0, 1, 0); PG8_SCHED; PG8_LDA(At, 1, 0); PG8_STAGE(PG8_SA(0, 1), a2 + hstep, voffA);
            PG8_WAIT_L(8); PG8_BAR; PG8_WAIT_L(0); PG8_MMA(0, 0, At, B0); PG8_BAR; PG8_SCHED;
            PG8_LDB(B1, 1, 1); PG8_STAGE(PG8_SB(1, 0), b3, voffB);
            PG8_BAR; PG8_WAIT_L(0); PG8_MMA(0, 1, At, B1); PG8_BAR;
            PG8_LDA(At, 1, 1); PG8_STAGE(PG8_SA(1, 0), a3, voffA);
            PG8_BAR; PG8_WAIT_L(0); PG8_MMA(1, 0, At, B0); PG8_BAR; PG8_SCHED;
            PG8_STAGE(PG8_SB(1, 1), b3 + hstep, voffB);
            PG8_WAIT_V(6); PG8_BAR; PG8_MMA(1, 1, At, B1); PG8_BAR;
            }
        }
        if constexpr (ALIGN_EPI) { if (wr == 0) PG8_BAR; }
        if constexpr (!Epi::AFTER_DRAIN) { E(acc, cur, wr, wc, fr, fq); S.done(cur); }
        if (!has_next) break;
#pragma unroll
        for (int a = 0; a < 2; ++a)
#pragma unroll
            for (int b = 0; b < 2; ++b)
#pragma unroll
                for (int m = 0; m < 4; ++m)
#pragma unroll
                    for (int n = 0; n < 2; ++n) acc[a][b][m][n] = (f32x4){0.f, 0.f, 0.f, 0.f};
        cur = nxt; cA = nA; cB = nB; ++ui;
        if constexpr (ALIGN_EPI) { if (wr == 1) PG8_BAR; }
    }
    PG8_WAIT_V(0);
    if constexpr (!ALIGN_EPI) { if (wr == 0) PG8_BAR; }
    PG8_BAR;
    if constexpr (Epi::AFTER_DRAIN) { E.fused(acc, cur, wr, wc, fr, fq, lds, wid, lane); S.done(cur); }
#undef PG8_SA
#undef PG8_SB
#undef PG8_STAGE
#undef PG8_LDA
#undef PG8_LDB
#undef PG8_MMA
#undef PG8_WAIT_V
#undef PG8_WAIT_L
#undef PG8_BAR
#undef PG8_SCHED
}
}

#ifndef PG8_SP2
#define PG8_SP2 true
#endif
#ifndef PG8_ALIGN
#define PG8_ALIGN true
#endif

namespace nv {
constexpr int NTOK = 16384, D = 1024, SEQ = 4096, INC = 2464;
constexpr int O_CQ = 0, O_CKV = 256, O_KR = 384, O_F = 416, O_I = 928, O_Q = 1440, O_G = 1952;
constexpr int NEXP = 32, PSLOTS = 36864, NBLK = 288;
constexpr float ALPHA = 1.189207115002721f;
constexpr float RMS_EPS = 1e-6f, LN_EPS = 1e-5f;

template <class F>
__device__ __forceinline__ void ngemm(LAS unsigned char* lds, int M, int N, int K, const F& f) {
    LAS float* As = (LAS float*)lds;
    LAS float* Bs = As + 16 * 132;
    const int tid = threadIdx.x, tx = tid & 15, ty = tid >> 4;
    const int tn = (N + 63) / 64, tm = (M + 127) / 128;
    for (int tile = blockIdx.x; tile < tn * tm; tile += gridDim.x) {
        const int m0 = (tile / tn) * 128, n0 = (tile % tn) * 64;
        float acc[4][4];
#pragma unroll
        for (int i = 0; i < 4; ++i)
#pragma unroll
            for (int j = 0; j < 4; ++j) acc[i][j] = 0.f;
        for (int k0 = 0; k0 < K; k0 += 16) {
#pragma unroll
            for (int i = 0; i < 4; ++i) { const int idx = tid + i * 512; const int r = idx >> 4, kk = idx & 15; As[kk * 132 + r] = (m0 + r < M) ? f.a(m0 + r, k0 + kk) : 0.f; }
#pragma unroll
            for (int i = 0; i < 2; ++i) { const int idx = tid + i * 512; const int kk = idx >> 6, c = idx & 63; Bs[kk * 68 + c] = (n0 + c < N) ? f.b(k0 + kk, n0 + c, m0) : 0.f; }
            __syncthreads();
#pragma unroll
            for (int kk = 0; kk < 16; ++kk) {
                float a[4], b[4];
#pragma unroll
                for (int i = 0; i < 4; ++i) { a[i] = As[kk * 132 + ty * 4 + i]; b[i] = Bs[kk * 68 + tx * 4 + i]; }
#pragma unroll
                for (int i = 0; i < 4; ++i)
#pragma unroll
                    for (int j = 0; j < 4; ++j) acc[i][j] += a[i] * b[j];
            }
            __syncthreads();
        }
#pragma unroll
        for (int i = 0; i < 4; ++i)
#pragma unroll
            for (int j = 0; j < 4; ++j) { const int r = m0 + ty * 4 + i, c = n0 + tx * 4 + j; if (r < M && c < N) f.epi(r, c, acc[i][j]); }
    }
}

struct ProjF { const float* x; const float* w; float* out;
    __device__ float a(int r, int k) const { return x[(size_t)r * D + k]; }
    __device__ float b(int k, int c, int) const { return w[(size_t)k * INC + c]; }
    __device__ void epi(int r, int c, float v) const { out[(size_t)r * INC + c] = v; } };
struct PlainF { const float* A; int lda; const float* B; int ldb; float* C; int ldc;
    __device__ float a(int r, int k) const { return A[(size_t)r * lda + k]; }
    __device__ float b(int k, int c, int) const { return B[(size_t)k * ldb + c]; }
    __device__ void epi(int r, int c, float v) const { C[(size_t)r * ldc + c] = v; } };
struct MixF { const float* an; const float* rr; const float* w; const float* x; float* t;
    __device__ float a(int r, int k) const { return k < 512 ? an[(size_t)r * 512 + k] : rr[(size_t)r * 512 + k - 512]; }
    __device__ float b(int k, int c, int) const { return w[(size_t)k * D + c]; }
    __device__ void epi(int r, int c, float v) const { t[(size_t)r * D + c] = ALPHA * x[(size_t)r * D + c] + v; } };
struct Moe1F { const float* h1; const int* slot_tok; const int* blk_exp; const float* w; float* H; int which;
    __device__ float a(int r, int k) const { const int tok = slot_tok[r]; return tok < NTOK ? h1[(size_t)tok * D + k] : 0.f; }
    __device__ float b(int k, int c, int m0) const { const int e = blk_exp[m0 >> 7]; return w[((size_t)e * D + k) * 512 + c]; }
    __device__ void epi(int r, int c, float v) const { float* p = H + (size_t)r * 512 + c; if (which == 0) *p = v / (1.f + expf(-v)); else *p *= v; } };
struct Moe2F { const float* H; const int* slot_tok; const float* slot_gate; const int* blk_exp; const float* w; float* acc;
    __device__ float a(int r, int k) const { return H[(size_t)r * 512 + k]; }
    __device__ float b(int k, int c, int m0) const { const int e = blk_exp[m0 >> 7]; return w[((size_t)e * 512 + k) * D + c]; }
    __device__ void epi(int r, int c, float v) const { const int tok = slot_tok[r]; if (tok < NTOK) atomicAdd(acc + (size_t)tok * D + c, slot_gate[r] * v); } };

__device__ __forceinline__ float wsum(float v) {
#pragma unroll
    for (int o = 1; o < 64; o <<= 1) v += __shfl_xor(v, o);
    return v;
}
#define GTID (blockIdx.x * NTHREADS + threadIdx.x)
#define GTHREADS (gridDim.x * NTHREADS)
#define GWAVE (blockIdx.x * NWAVES + (threadIdx.x >> 6))
#define GWAVES (gridDim.x * NWAVES)

__device__ __forceinline__ void hg_gate(float* proj, const float* lbl) {
    for (int i = GTID; i < NTOK * 512; i += GTHREADS) {
        const int r = i >> 9, c = i & 511;
        const float l0 = lbl[c], l1 = lbl[512 + c]; const float mx = fmaxf(l0, l1);
        const float e0 = expf(l0 - mx), e1 = expf(l1 - mx); const float lb = e0 / (e0 + e1);
        float* p = proj + (size_t)r * INC + O_F + c; const float z = *p;
        *p = lb + (1.f - lb) * (1.f / (1.f + expf(-z)));
    }
}
__device__ __forceinline__ void hg_rec(float* proj) {
    if (blockIdx.x >= 16 || threadIdx.x >= 128) return;
    const int bh = blockIdx.x, b = bh >> 2, h = bh & 3, e = threadIdx.x;
    float S[128];
#pragma unroll
    for (int d = 0; d < 128; ++d) S[d] = 0.f;
    for (int t = 0; t < SEQ; ++t) {
        float* row = proj + (size_t)(b * SEQ + t) * INC;
        const float v = row[O_I + h * 128 + e];
        const float* fr = row + O_F + h * 128; const float* qr = row + O_Q + h * 128;
        float o = 0.f;
#pragma unroll
        for (int d = 0; d < 128; ++d) { const float f = fr[d]; S[d] = f * S[d] + (1.f - f) * v; o += qr[d] * S[d]; }
        row[O_I + h * 128 + e] = o;
    }
}
__device__ __forceinline__ void hg_out(const float* proj, const float* g, float* rr) {
    const int lane = threadIdx.x & 63;
    for (int w = GWAVE; w < NTOK * 4; w += GWAVES) {
        const int r = w >> 2, h = w & 3; const float* row = proj + (size_t)r * INC;
        const float o0 = row[O_I + h * 128 + lane], o1 = row[O_I + h * 128 + 64 + lane];
        const float ss = wsum(o0 * o0 + o1 * o1); const float rs = 1.f / sqrtf(ss * (1.f / 128.f) + RMS_EPS);
        const float g0 = row[O_G + h * 128 + lane], g1 = row[O_G + h * 128 + 64 + lane];
        rr[(size_t)r * 512 + h * 128 + lane] = o0 * rs * g[lane] * (g0 / (1.f + expf(-g0)));
        rr[(size_t)r * 512 + h * 128 + 64 + lane] = o1 * rs * g[64 + lane] * (g1 / (1.f + expf(-g1)));
    }
}
__device__ __forceinline__ void cs_tab(const int* pos, float* cs) {
    for (int i = GTID; i < NTOK * 16; i += GTHREADS) {
        const int j = i & 15, r = i >> 4;
        const float invf = (float)pow(10000.0, -(double)(2 * j) / 32.0);
        const float ang = (float)pos[r] * invf;
        double s, c; sincos((double)ang, &s, &c);
        cs[(size_t)r * 32 + j] = (float)c; cs[(size_t)r * 32 + 16 + j] = (float)s;
    }
}
__device__ __forceinline__ void mla_prep(const float* proj, const float* gq, const float* gkv, const float* cs, float* cqn, float* ckvn, float* kr) {
    const int lane = threadIdx.x & 63;
    for (int r = GWAVE; r < NTOK; r += GWAVES) {
        const float* row = proj + (size_t)r * INC;
        float v[4]; float ss = 0.f;
#pragma unroll
        for (int i = 0; i < 4; ++i) { v[i] = row[O_CQ + lane + 64 * i]; ss += v[i] * v[i]; }
        ss = wsum(ss); float rs = 1.f / sqrtf(ss * (1.f / 256.f) + RMS_EPS);
#pragma unroll
        for (int i = 0; i < 4; ++i) cqn[(size_t)r * 256 + lane + 64 * i] = v[i] * rs * gq[lane + 64 * i];
        float u0 = row[O_CKV + lane], u1 = row[O_CKV + 64 + lane];
        ss = wsum(u0 * u0 + u1 * u1); rs = 1.f / sqrtf(ss * (1.f / 128.f) + RMS_EPS);
        ckvn[(size_t)r * 128 + lane] = u0 * rs * gkv[lane]; ckvn[(size_t)r * 128 + 64 + lane] = u1 * rs * gkv[64 + lane];
        if (lane < 16) { const float x1 = row[O_KR + lane], x2 = row[O_KR + 16 + lane]; const float c = cs[(size_t)r * 32 + lane], s = cs[(size_t)r * 32 + 16 + lane];
            kr[(size_t)r * 32 + lane] = x1 * c - x2 * s; kr[(size_t)r * 32 + 16 + lane] = x2 * c + x1 * s; }
    }
}
__device__ __forceinline__ void q_rope(float* q, const float* cs) {
    for (int i = GTID; i < NTOK * 8 * 16; i += GTHREADS) {
        const int j = i & 15, h = (i >> 4) & 7, r = i >> 7;
        float* p = q + (size_t)r * 768 + h * 96 + 64; const float x1 = p[j], x2 = p[16 + j]; const float c = cs[(size_t)r * 32 + j], s = cs[(size_t)r * 32 + 16 + j];
        p[j] = x1 * c - x2 * s; p[16 + j] = x2 * c + x1 * s;
    }
}
__device__ __forceinline__ void attn_naive(const float* q, const float* kv, const float* kr, float* out) {
    const int lane = threadIdx.x & 63;
    for (int task = GWAVE; task < 2048; task += GWAVES) {
        const int tsk = __builtin_amdgcn_readfirstlane(task);
        const int qc = 63 - (tsk >> 5), h = tsk & 7, b = (tsk >> 3) & 3;
        const int t = qc * 64 + lane; const size_t row = (size_t)b * SEQ + t;
        const float scale = 0.10206207261596575f;
        float qv[96];
#pragma unroll
        for (int d = 0; d < 96; ++d) qv[d] = q[row * 768 + h * 96 + d] * scale;
        float o[64];
#pragma unroll
        for (int d = 0; d < 64; ++d) o[d] = 0.f;
        float m = -INFINITY, l = 0.f;
        const int nk = (qc + 1) * 64;
        for (int s = 0; s < nk; ++s) {
            const size_t kr_ = (size_t)b * SEQ + s;
            const float* kp = kv + kr_ * 1024 + h * 128; const float* rp = kr + kr_ * 32;
            float sc = 0.f;
#pragma unroll
            for (int d = 0; d < 64; ++d) sc += qv[d] * kp[d];
#pragma unroll
            for (int d = 0; d < 32; ++d) sc += qv[64 + d] * rp[d];
            const float mn = fmaxf(m, sc); const float corr = expf(m - mn), p = expf(sc - mn);
            l = l * corr + p;
#pragma unroll
            for (int d = 0; d < 64; ++d) o[d] = o[d] * corr + p * kp[64 + d];
            m = mn;
        }
        const float il = 1.f / l;
#pragma unroll
        for (int d = 0; d < 64; ++d) out[row * 512 + h * 64 + d] = o[d] * il;
    }
}
__device__ __forceinline__ void a_norm(float* a, const float* g) {
    const int lane = threadIdx.x & 63;
    for (int r = GWAVE; r < NTOK; r += GWAVES) {
        float v[8]; float ss = 0.f;
#pragma unroll
        for (int i = 0; i < 8; ++i) { v[i] = a[(size_t)r * 512 + lane + 64 * i]; ss += v[i] * v[i]; }
        ss = wsum(ss); const float rs = 1.f / sqrtf(ss * (1.f / 512.f) + RMS_EPS);
#pragma unroll
        for (int i = 0; i < 8; ++i) a[(size_t)r * 512 + lane + 64 * i] = v[i] * rs * g[lane + 64 * i];
    }
}
__device__ __forceinline__ void ln_rows(const float* in, const float* add, float addscale_in, const float* g, const float* bb, float* out) {
    const int lane = threadIdx.x & 63;
    for (int r = GWAVE; r < NTOK; r += GWAVES) {
        float v[16]; float s = 0.f;
#pragma unroll
        for (int i = 0; i < 16; ++i) { const size_t o = (size_t)r * D + lane + 64 * i; v[i] = addscale_in * in[o] + (add ? add[o] : 0.f); s += v[i]; }
        const float mean = wsum(s) * (1.f / D); float q = 0.f;
#pragma unroll
        for (int i = 0; i < 16; ++i) { v[i] -= mean; q += v[i] * v[i]; }
        const float rs = 1.f / sqrtf(wsum(q) * (1.f / D) + LN_EPS);
#pragma unroll
        for (int i = 0; i < 16; ++i) { const int c = lane + 64 * i; out[(size_t)r * D + c] = v[i] * rs * g[c] + bb[c]; }
    }
}
__device__ __forceinline__ void router(const float* h1, const float* wg, const float* bg, const float* we, const float* be, int* cnt, int* tok_e, int* tok_rank, float* tok_gate) {
    const int lane = threadIdx.x & 63;
    for (int r = GWAVE; r < NTOK; r += GWAVES) {
        float lg[36];
#pragma unroll
        for (int c = 0; c < 36; ++c) lg[c] = 0.f;
        for (int i = 0; i < 16; ++i) { const int k = lane + 64 * i; const float xv = h1[(size_t)r * D + k];
#pragma unroll
            for (int c = 0; c < 4; ++c) lg[c] += xv * wg[k * 4 + c];
#pragma unroll
            for (int c = 0; c < 32; ++c) lg[4 + c] += xv * we[k * 32 + c]; }
#pragma unroll
        for (int c = 0; c < 36; ++c) lg[c] = wsum(lg[c]);
#pragma unroll
        for (int c = 0; c < 4; ++c) lg[c] += bg[c];
#pragma unroll
        for (int c = 0; c < 32; ++c) lg[4 + c] += be[c];
        int grp = 0; float gm = lg[0];
#pragma unroll
        for (int c = 1; c < 4; ++c) if (lg[c] > gm) { gm = lg[c]; grp = c; }
        float den = 0.f;
#pragma unroll
        for (int c = 0; c < 4; ++c) den += expf(lg[c] - gm);
        const float pgrp = 1.f / den;
        float ein[8];
#pragma unroll
        for (int j = 0; j < 8; ++j) ein[j] = grp == 0 ? lg[4 + j] : grp == 1 ? lg[12 + j] : grp == 2 ? lg[20 + j] : lg[28 + j];
        int i0 = 0; float v0 = ein[0];
#pragma unroll
        for (int j = 1; j < 8; ++j) if (ein[j] > v0) { v0 = ein[j]; i0 = j; }
        int i1 = -1; float v1 = -INFINITY;
#pragma unroll
        for (int j = 0; j < 8; ++j) if (j != i0 && ein[j] > v1) { v1 = ein[j]; i1 = j; }
        const float e1 = expf(v1 - v0); const float p0 = 1.f / (1.f + e1), p1 = e1 / (1.f + e1);
        if (lane == 0) {
            const int ea = grp * 8 + i0, eb = grp * 8 + i1;
            tok_e[2 * r] = ea; tok_e[2 * r + 1] = eb;
            tok_rank[2 * r] = atomicAdd(cnt + ea, 1); tok_rank[2 * r + 1] = atomicAdd(cnt + eb, 1);
            tok_gate[2 * r] = pgrp * p0; tok_gate[2 * r + 1] = pgrp * p1;
        }
    }
}
__device__ __forceinline__ void prefix(const int* cnt, int* pad_start, int* blk_exp) {
    if (threadIdx.x != 0 || blockIdx.x != 0) return;
    int acc = 0;
    for (int e = 0; e < NEXP; ++e) { pad_start[e] = acc; acc += ((__hip_atomic_load(cnt + e, __ATOMIC_RELAXED, __HIP_MEMORY_SCOPE_AGENT) + 127) / 128) * 128; pad_start[NEXP + e] = acc; }
    for (int b = 0; b < NBLK; ++b) { int c = 0; for (int e = 0; e < NEXP; ++e) c += (pad_start[NEXP + e] <= b * 128) ? 1 : 0; blk_exp[b] = c < NEXP - 1 ? c : NEXP - 1; }
}
__device__ __forceinline__ void slot_init(int* slot_tok, float* slot_gate) { for (int i = GTID; i < PSLOTS; i += GTHREADS) { slot_tok[i] = NTOK; slot_gate[i] = 0.f; } }
__device__ __forceinline__ void slot_fill(const int* tok_e, const int* tok_rank, const float* tok_gate, const int* pad_start, int* slot_tok, float* slot_gate) {
    for (int i = GTID; i < NTOK * 2; i += GTHREADS) { const int s = pad_start[tok_e[i]] + tok_rank[i]; slot_tok[s] = i >> 1; slot_gate[s] = tok_gate[i]; }
}
__device__ __forceinline__ void zero_f32(float* p, size_t n) { for (size_t i = GTID; i < n / 4; i += GTHREADS) ((float4*)p)[i] = make_float4(0.f, 0.f, 0.f, 0.f); }
}


namespace op {
using pg8::f32x4; using pg8::Unit; using pg8::bf16_t;
typedef unsigned v4u __attribute__((ext_vector_type(4)));
#define GAS __attribute__((address_space(1)))
__device__ __forceinline__ unsigned f2bf(float f) { unsigned u = __builtin_bit_cast(unsigned, f); return (u + 0x7fffu + ((u >> 16) & 1u)) >> 16; }
__device__ __forceinline__ unsigned pk2(float lo, float hi) { return f2bf(lo) | (f2bf(hi) << 16); }
__device__ __forceinline__ float bf2f(unsigned short b) { return __builtin_bit_cast(float, (unsigned)b << 16); }

template <class RowMap>
__device__ __forceinline__ void transpose_item(const float* W, int K, int N, bf16_t* WT, LAS float* scr, int item, int lane, const RowMap& rm) {
    const int nblk = N / 32, kb = item / nblk, nb = item % nblk, k0 = 64 * kb, n0 = 32 * nb;
#pragma unroll 8
    for (int i = 0; i < 32; ++i) { const int kk = 2 * i + (lane >> 5); scr[kk * 33 + (lane & 31)] = rm.scale(n0 + (lane & 31), k0 + kk) * W[(size_t)(k0 + kk) * N + n0 + (lane & 31)]; }
    asm volatile("s_waitcnt lgkmcnt(0)" ::: "memory");
    const int c = lane & 7;
#pragma unroll
    for (int j = 0; j < 4; ++j) { const int n = (lane >> 3) + 8 * j; const LAS float* s = scr + (8 * c) * 33 + n;
        v4u o; o.x = pk2(s[0 * 33], s[1 * 33]); o.y = pk2(s[2 * 33], s[3 * 33]); o.z = pk2(s[4 * 33], s[5 * 33]); o.w = pk2(s[6 * 33], s[7 * 33]);
        *(GAS v4u*)(WT + (size_t)rm.row(n0 + n) * K + k0 + 8 * c) = o; }
    asm volatile("s_waitcnt lgkmcnt(0)" ::: "memory");
}
struct RowId { __device__ __forceinline__ int row(int n) const { return n; } __device__ __forceinline__ float scale(int, int) const { return 1.f; } };

__device__ __forceinline__ void cvt_rows_bf16(const float* src, bf16_t* dst, size_t n) {
    for (size_t i = GTID; i < n / 8; i += GTHREADS) { const float4 a = ((const float4*)src)[2 * i], b = ((const float4*)src)[2 * i + 1];
        v4u o; o.x = pk2(a.x, a.y); o.y = pk2(a.z, a.w); o.z = pk2(b.x, b.y); o.w = pk2(b.z, b.w); ((v4u*)dst)[i] = o; }
}

struct EpiF32Nat { static constexpr bool PERM = false, AFTER_DRAIN = false;
    float* C; int ldc; int ncols;
    __device__ __forceinline__ void operator()(const f32x4 (&acc)[2][2][4][2], const Unit& u, int wr, int wc, int fr, int fq) const {
        const int row0 = u.pm * 256 + wr * 64 + fr, col0 = u.pn * 256 + wc * 32 + 4 * fq;
#pragma unroll
        for (int ai = 0; ai < 2; ++ai)
#pragma unroll
            for (int m = 0; m < 4; ++m) { float* rowp = C + (size_t)(row0 + ai * 128 + m * 16) * ldc;
#pragma unroll
                for (int bj = 0; bj < 2; ++bj)
#pragma unroll
                    for (int n = 0; n < 2; ++n) { const int c = col0 + bj * 128 + n * 16; if (c < ncols) *(f32x4*)(rowp + c) = acc[ai][bj][m][n]; } }
    }
};
}
struct Args { const float* in[22]; float* out; unsigned char* ws; };
constexpr size_t MiB = 1u << 20;
constexpr size_t WS_CTL = 260 * MiB, CTL_ZERO_BYTES = 64 * 1024;
constexpr int CW_BAR = 1024, CW_CNT = 8192;

__global__ void __launch_bounds__(NTHREADS, 2) mega_fwd(Args args) {
    extern __shared__ __attribute__((aligned(16))) unsigned char lds_raw[];
    using namespace nv;
    LAS unsigned char* lds = (LAS unsigned char*)lds_raw;
    volatile LAS unsigned* MISC = (volatile LAS unsigned*)(lds + 131072);
    if (threadIdx.x < 64) MISC[threadIdx.x] = 0u;
    __syncthreads();
    unsigned char* ws = args.ws;
    unsigned* ctl = (unsigned*)(ws + WS_CTL);
    XcdBarrier bar = xcd_barrier_post(ctl + CW_BAR, MISC + 8);
    const float* x = args.in[0]; const int* pos = (const int*)args.in[1]; const float* w_in = args.in[2];
    const float* q_norm_g = args.in[3]; const float* w_uq = args.in[4]; const float* kv_norm_g = args.in[5];
    const float* w_ukv = args.in[6]; const float* mla_out_g = args.in[7]; const float* lbl = args.in[8];
    const float* hg_norm_g = args.in[9]; const float* w_out = args.in[10]; const float* ln1_g = args.in[11];
    const float* ln1_b = args.in[12]; const float* wrg = args.in[13]; const float* brg = args.in[14];
    const float* wre = args.in[15]; const float* bre = args.in[16]; const float* w1 = args.in[17];
    const float* w3 = args.in[18]; const float* w2 = args.in[19]; const float* ln2_g = args.in[20]; const float* ln2_b = args.in[21];
    float* out = args.out;
    float* proj = (float*)(ws + 0);
    float* rr   = (float*)(ws + 156 * MiB);
    float* cs   = (float*)(ws + 188 * MiB);
    float* kr   = (float*)(ws + 190 * MiB);
    float* cqn  = (float*)(ws + 192 * MiB);
    float* ckvn = (float*)(ws + 208 * MiB);
    float* qb   = (float*)(ws + 0);
    float* kvb  = (float*)(ws + 48 * MiB);
    float* ab   = (float*)(ws + 112 * MiB);
    float* h1   = (float*)(ws + 0);
    float* Hb   = (float*)(ws + 188 * MiB);
    float* accb = (float*)(ws + 64 * MiB);
    int* cnt = (int*)(ctl + CW_CNT);
    int* meta = (int*)(ws + WS_CTL + 1 * MiB);
    int* pad_start = meta; int* blk_exp = meta + 256; int* tok_e = meta + 1024; int* tok_rank = tok_e + 2 * NTOK; float* tok_gate = (float*)(tok_rank + 2 * NTOK);
    int* slot_tok = (int*)(tok_gate + 2 * NTOK); float* slot_gate = (float*)(slot_tok + PSLOTS);

    op::bf16_t* xb = (op::bf16_t*)(ws + 216 * MiB);
    op::bf16_t* Win_t = (op::bf16_t*)(ws + 248 * MiB);
    const int wave = __builtin_amdgcn_readfirstlane(threadIdx.x >> 6), lane = threadIdx.x & 63;
    {
        LAS float* scr = (LAS float*)(lds + wave * 16384);
        for (int it = GWAVE; it < (D / 64) * (INC / 32); it += GWAVES) op::transpose_item(w_in, D, INC, Win_t, scr, it, lane, op::RowId{});
        op::cvt_rows_bf16(x, xb, (size_t)NTOK * D);
        cs_tab(pos, cs);
    }
    xcd_barrier(bar);
    {
        pg8::Gemm g{xb, Win_t, NTOK, 2560, D}; pg8::StaticOrder S; S.init(NTOK, 2560, (int)gridDim.x, (int)blockIdx.x);
        op::EpiF32Nat E{proj, INC, INC};
        pg8::gemm_phase<op::EpiF32Nat, pg8::StaticOrder, true, true>(lds, g, S, E);
    }
    xcd_barrier(bar);
    hg_gate(proj, lbl);
    mla_prep(proj, q_norm_g, kv_norm_g, cs, cqn, ckvn, kr);
    xcd_barrier(bar);
    hg_rec(proj);
    xcd_barrier(bar);
    hg_out(proj, hg_norm_g, rr);
    xcd_barrier(bar);
    ngemm(lds, NTOK, 768, 256, PlainF{cqn, 256, w_uq, 768, qb, 768});
    ngemm(lds, NTOK, 1024, 128, PlainF{ckvn, 128, w_ukv, 1024, kvb, 1024});
    xcd_barrier(bar);
    q_rope(qb, cs);
    xcd_barrier(bar);
    attn_naive(qb, kvb, kr, ab);
    xcd_barrier(bar);
    a_norm(ab, mla_out_g);
    xcd_barrier(bar);
    ngemm(lds, NTOK, D, D, MixF{ab, rr, w_out, x, h1});
    xcd_barrier(bar);
    ln_rows(h1, nullptr, 1.f, ln1_g, ln1_b, h1);
    xcd_barrier(bar);
    router(h1, wrg, brg, wre, bre, cnt, tok_e, tok_rank, tok_gate);
    slot_init(slot_tok, slot_gate);
    zero_f32(accb, (size_t)NTOK * D);
    xcd_barrier(bar);
    prefix(cnt, pad_start, blk_exp);
    xcd_barrier(bar);
    slot_fill(tok_e, tok_rank, tok_gate, pad_start, slot_tok, slot_gate);
    xcd_barrier(bar);
    ngemm(lds, PSLOTS, 512, D, Moe1F{h1, slot_tok, blk_exp, w1, Hb, 0});
    xcd_barrier(bar);
    ngemm(lds, PSLOTS, 512, D, Moe1F{h1, slot_tok, blk_exp, w3, Hb, 1});
    xcd_barrier(bar);
    ngemm(lds, PSLOTS, D, 512, Moe2F{Hb, slot_tok, slot_gate, blk_exp, w2, accb});
    xcd_barrier(bar);
    ln_rows(h1, accb, ALPHA, ln2_g, ln2_b, out);
}

extern "C" void kernel_launch(void* const* d_in, const int* in_sizes, int n_in, void* d_out, int out_size, void* d_ws, size_t ws_size, hipStream_t stream) {
    static int grid = 0;
    if (grid == 0) {
        if (n_in != 22 || ws_size < 262 * MiB) { fprintf(stderr, "kernel_launch: unexpected n_in %d / ws %zu\n", n_in, ws_size); grid = -1; return; }
        int dev = 0, cus = 0, per_cu = 0;
        if (hipGetDevice(&dev) != hipSuccess || hipDeviceGetAttribute(&cus, hipDeviceAttributeMultiprocessorCount, dev) != hipSuccess) { grid = -1; return; }
        if (hipFuncSetAttribute((const void*)mega_fwd, hipFuncAttributeMaxDynamicSharedMemorySize, LDS_BYTES) != hipSuccess) { fprintf(stderr, "kernel_launch: hipFuncSetAttribute failed\n"); grid = -1; return; }
        if (hipOccupancyMaxActiveBlocksPerMultiprocessor(&per_cu, (const void*)mega_fwd, NTHREADS, LDS_BYTES) != hipSuccess || per_cu < 1) { fprintf(stderr, "kernel_launch: occupancy query says %d\n", per_cu); (void)hipGetLastError(); }
        grid = cus;
    }
    if (grid < 0) return;
    if (hipMemsetAsync((char*)d_ws + WS_CTL, 0, CTL_ZERO_BYTES, stream) != hipSuccess) return;
    Args a{};
    for (int i = 0; i < 22; ++i) a.in[i] = (const float*)d_in[i];
    a.out = (float*)d_out; a.ws = (unsigned char*)d_ws;
    hipLaunchKernelGGL(mega_fwd, dim3(grid), dim3(NTHREADS), LDS_BYTES, stream, a);
}
```

```cpp
#include <hip/hip_runtime.h>
#include <cstdio>
#include <cstdint>
#include <cmath>

#define LAS __attribute__((address_space(3)))
constexpr int NTHREADS = 512, NWAVES = 8;
constexpr int LDS_BYTES = 147456;

#define XB_TMO      128
#define XB_XCNT(j)  (256  + 64 * (j))
#define XB_XSUB(j)  (1280 + 64 * (j))
#define XB_XGEN(j)  (2304 + 64 * (j))
#define XB_TOP      3328
#define XB_TOPGEN   3392
#define XCD_BAR_WORDS 3456
#define XB_SPIN_CAP (1u << 18)

__device__ __forceinline__ unsigned xb_ld(unsigned* p)              { return __hip_atomic_load(p, __ATOMIC_RELAXED, __HIP_MEMORY_SCOPE_AGENT); }
__device__ __forceinline__ unsigned xb_add(unsigned* p, unsigned v) { return __hip_atomic_fetch_add(p, v, __ATOMIC_RELAXED, __HIP_MEMORY_SCOPE_AGENT); }
__device__ __forceinline__ unsigned xb_xcc_id() { return (unsigned)__builtin_amdgcn_s_getreg((3 << 11) | 20) & 0xFu; }
#define XB_SPIN(cond, bar) do { unsigned _sp = 0; while (cond) { __builtin_amdgcn_s_sleep(1); \
    if ((++_sp & 255u) == 0u) { if (xb_ld(&(bar)[XB_TMO])) break; if (_sp > XB_SPIN_CAP) { atomicAdd(&(bar)[XB_TMO], 1u); break; } } } } while (0)

struct XcdBarrier {
    unsigned* bar; unsigned x;
    volatile LAS unsigned* st;
};

__device__ __forceinline__ XcdBarrier xcd_barrier_post(unsigned* bar, volatile LAS unsigned* st) {
    XcdBarrier b; b.bar = bar; b.x = xb_xcc_id(); b.st = st;
    if (threadIdx.x == 0) (void)xb_add(&bar[XB_XCNT(b.x)], 1u);
    return b;
}
__device__ __forceinline__ void xcd_barrier_complete(unsigned* bar, unsigned x, unsigned& nloc, unsigned& nx) {
    const unsigned G = gridDim.x * gridDim.y * gridDim.z;
    unsigned sum, cnt, mine, sp = 0u;
    for (;;) {
        sum = 0u; cnt = 0u; mine = 0u;
#pragma unroll
        for (unsigned j = 0; j < 16; ++j) { const unsigned c = xb_ld(&bar[XB_XCNT(j)]); sum += c; cnt += (c > 0u) ? 1u : 0u; mine = (j == x) ? c : mine; }
        if (sum == G) break;
        __builtin_amdgcn_s_sleep(1);
        if ((++sp & 255u) == 0u) { if (xb_ld(&bar[XB_TMO])) break; if (sp > XB_SPIN_CAP) { atomicAdd(&bar[XB_TMO], 1u); break; } }
    }
    nloc = mine > 0u ? mine : 1u; nx = cnt > 0u ? cnt : 1u;
}

__device__ __forceinline__ void xcd_barrier(const XcdBarrier& b) {
    asm volatile("s_waitcnt vmcnt(0)" ::: "memory");
    __syncthreads();
    if (threadIdx.x == 0) {
        unsigned* bar = b.bar;
        __builtin_amdgcn_s_waitcnt(0);
        unsigned nloc = b.st[0], nx = b.st[1];
        if (nloc == 0u) { xcd_barrier_complete(bar, b.x, nloc, nx); b.st[0] = nloc; b.st[1] = nx; }
        const unsigned old = xb_add(&bar[XB_XSUB(b.x)], 1u);
        const unsigned gen = old / nloc;
        if (old + 1u == (gen + 1u) * nloc) {
            __builtin_amdgcn_fence(__ATOMIC_RELEASE, "agent");
            asm volatile("s_waitcnt vmcnt(0)" ::: "memory");
            const unsigned og = xb_add(&bar[XB_TOP], 1u);
            const unsigned tg = og / nx;
            if (og + 1u == (tg + 1u) * nx) xb_add(&bar[XB_TOPGEN], 1u);
            else XB_SPIN(xb_ld(&bar[XB_TOPGEN]) == tg, bar);
            __builtin_amdgcn_fence(__ATOMIC_ACQUIRE, "agent");
            xb_add(&bar[XB_XGEN(b.x)], 1u);
            asm volatile("s_waitcnt vmcnt(0)" ::: "memory");
        } else {
            XB_SPIN(xb_ld(&bar[XB_XGEN(b.x)]) == gen, bar);
            __builtin_amdgcn_fence(__ATOMIC_ACQUIRE, "agent");
            asm volatile("s_waitcnt vmcnt(0)" ::: "memory");
        }
    }
    __syncthreads();
}
namespace pg8 {
#define PG8_LAS __attribute__((address_space(3)))
typedef unsigned short bf16_t;
typedef short bf16x8 __attribute__((ext_vector_type(8)));
typedef float f32x4 __attribute__((ext_vector_type(4)));
typedef unsigned u32x4 __attribute__((ext_vector_type(4)));
constexpr int BM = 256, BK = 64, HALF = 128, HTB = HALF * BK * 2  , STAGE_BYTES = 8 * HTB, NXCD = 8, WGM = 8;

__host__ __device__ __forceinline__ int lds_byte(int r, int c) { const int st = (r >> 4) * 2 + (c >> 5), rr = r & 15, cc = c & 31, ob = rr * 64 + cc * 2; return st * 1024 + (ob ^ (((ob >> 9) & 1) << 5)); }
__host__ __device__ __forceinline__ void stage_rc(int b, int& R, int& C) { const int st = b / 1024, sb = b % 1024, swz = sb ^ (((sb >> 9) & 1) << 5); R = (st >> 1) * 16 + swz / 64; C = (st & 1) * 32 + (swz % 64) / 2; }
__host__ __device__ __forceinline__ int perm32(int rho) { const int n = rho >> 4, i = rho & 15; return 8 * (i >> 2) + 4 * n + (i & 3); }

struct Unit { int pm, pn; };
struct Gemm { const bf16_t* A; const bf16_t* Bt; int M, N, K; };

struct StaticOrder {
    int nM, nN, nwg, G, c;
    __host__ __device__ void init(int M, int N, int G_, int c_) { nM = M / BM; nN = N / BM; nwg = nM * nN; G = G_; c = c_; }
    __host__ __device__ bool next(int i, Unit& u) const {
        const long L = (long)i * G + c; if (L >= nwg) return false;
        int wgid = (int)L; { const int q = nwg / NXCD, r = nwg % NXCD, xcd = wgid % NXCD, off = wgid / NXCD; wgid = (xcd < r ? xcd * (q + 1) : r * (q + 1) + (xcd - r) * q) + off; }
        const int nig = WGM * nN, gid = wgid / nig, fm = gid * WGM, gsz = (nM - fm) < WGM ? (nM - fm) : WGM;
        u.pm = fm + ((wgid % nig) % gsz); u.pn = (wgid % nig) / gsz; return true;
    }
    __device__ __forceinline__ void a_ready(const Unit&) const {}
    __device__ __forceinline__ void done(const Unit&) const {}
};

__device__ __forceinline__ unsigned cvt_pk_bf16(float lo, float hi) { unsigned r; asm volatile("v_cvt_pk_bf16_f32 %0, %1, %2" : "=v"(r) : "v"(lo), "v"(hi)); return r; }
typedef float f32x2 __attribute__((ext_vector_type(2)));
__device__ __forceinline__ f32x2 gelu_pk(f32x2 v) {
    const f32x2 av = __builtin_elementwise_abs(v), d = av * 0.2316418882f + 1.0f;
    f32x2 t; t.x = __builtin_amdgcn_rcpf(d.x); t.y = __builtin_amdgcn_rcpf(d.y);
    f32x2 q = t * 0.5307027145f + (-0.7265760135f); q = q * t + 0.7107068705f; q = q * t + (-0.142248368f); q = q * t + 0.127414796f; q = q * t;
    const f32x2 s = (v * v) * (-0.72134752044f);
    f32x2 e; e.x = __builtin_amdgcn_exp2f(s.x); e.y = __builtin_amdgcn_exp2f(s.y);
    const f32x2 m = v * (q * e), r = v - m;
    f32x2 o; o.x = v.x < 0.f ? m.x : r.x; o.y = v.y < 0.f ? m.y : r.y; return o;
}

template <int ACT  > struct EpiBf16 {
    static constexpr bool PERM = true, AFTER_DRAIN = false; static_assert(ACT == 0 || ACT == 1, "EpiBf16: ACT is 0 (none) or 1 (gelu_pk)");
    bf16_t* O; int ldc; const float* bias; int split_cols; size_t split_stride; float scale0;
    __device__ __forceinline__ void operator()(const f32x4 (&acc)[2][2][4][2], const Unit& u, int wr, int wc, int fr, int fq) const {
        const int row0 = u.pm * BM + wr * 64 + fr; int colt = u.pn * BM; bf16_t* base = O;
        float sc = 1.f; if (split_cols) { const int t = colt / split_cols; base += (size_t)t * split_stride; colt -= t * split_cols; if (t == 0) sc = scale0; }
        const int col0 = colt + wc * 32 + 8 * fq, bcol0 = u.pn * BM + wc * 32 + 8 * fq;
        f32x4 bv[2][2];
#pragma unroll
        for (int bj = 0; bj < 2; ++bj)
#pragma unroll
            for (int n = 0; n < 2; ++n) bv[bj][n] = bias ? *(const f32x4*)(bias + bcol0 + bj * HALF + 4 * n) : (f32x4){0.f, 0.f, 0.f, 0.f};
#pragma unroll
        for (int ai = 0; ai < 2; ++ai)
#pragma unroll
            for (int m = 0; m < 4; ++m) { bf16_t* rowp = base + (size_t)(row0 + ai * HALF + m * 16) * ldc + col0;
#pragma unroll
                for (int bj = 0; bj < 2; ++bj) { f32x4 v0 = acc[ai][bj][m][0] + bv[bj][0], v1 = acc[ai][bj][m][1] + bv[bj][1];
                    if (ACT == 1) { f32x2 a = gelu_pk((f32x2){v0[0], v0[1]}), b = gelu_pk((f32x2){v0[2], v0[3]}), c = gelu_pk((f32x2){v1[0], v1[1]}), d = gelu_pk((f32x2){v1[2], v1[3]});
                        v0 = (f32x4){a.x, a.y, b.x, b.y}; v1 = (f32x4){c.x, c.y, d.x, d.y}; }
                    v0 = v0 * sc; v1 = v1 * sc; u32x4 w; w.x = cvt_pk_bf16(v0[0], v0[1]); w.y = cvt_pk_bf16(v0[2], v0[3]); w.z = cvt_pk_bf16(v1[0], v1[1]); w.w = cvt_pk_bf16(v1[2], v1[3]);
                    *(u32x4*)(rowp + bj * HALF) = w; } }
    }
};

struct PanelStats {
    unsigned* xbuf;
    unsigned* cnt;
    unsigned* tmo;
    int ntn; float eps;
    unsigned code;
    __device__ __forceinline__ bool run(const f32x4 (&v)[2][2][4][2], const Unit& u, int wr, int wc, int fr, int fq, PG8_LAS unsigned char* lds, int wid, int lane) const {
        typedef float f32x2v __attribute__((ext_vector_type(2)));
        PG8_LAS f32x2v* P = (PG8_LAS f32x2v*)lds;
        PG8_LAS f32x2v* S = (PG8_LAS f32x2v*)(lds + 8192);
        PG8_LAS unsigned* flag = (PG8_LAS unsigned*)(lds + 8192 + 2048);
#pragma unroll
        for (int ai = 0; ai < 2; ++ai)
#pragma unroll
            for (int m = 0; m < 4; ++m) {
                float s = 0.f;
#pragma unroll
                for (int bj = 0; bj < 2; ++bj)
#pragma unroll
                    for (int n = 0; n < 2; ++n) { const f32x4 x = v[ai][bj][m][n]; s += (x[0] + x[1]) + (x[2] + x[3]); }
                s += __shfl_xor(s, 16); s += __shfl_xor(s, 32);
                const float mw = s * (1.0f / 64.0f); float q = 0.f;
#pragma unroll
                for (int bj = 0; bj < 2; ++bj)
#pragma unroll
                    for (int n = 0; n < 2; ++n) { const f32x4 d = v[ai][bj][m][n] - mw; q += (d[0] * d[0] + d[1] * d[1]) + (d[2] * d[2] + d[3] * d[3]); }
                q += __shfl_xor(q, 16); q += __shfl_xor(q, 32);
                if (fq == 0) P[(ai * HALF + wr * 64 + m * 16 + fr) * 4 + wc] = (f32x2v){mw, q};
            }
        asm volatile("s_waitcnt lgkmcnt(0)" ::: "memory"); __builtin_amdgcn_s_barrier(); asm volatile("" ::: "memory");
#if defined(BROKEN_EXCHANGE_NO_WAIT)
#warning BROKEN CONTROL BUILD: the row-statistics exchange does not wait; results are wrong by design
        if (blockIdx.x >= 64) { const long long t0_ = clock64(); while (clock64() - t0_ < 60000) __builtin_amdgcn_s_sleep(8); }
#endif
        const int row = wid * 32 + (lane & 31);
        if (lane < 32) {
            const f32x2v a = P[row * 4 + 0], b = P[row * 4 + 1], c = P[row * 4 + 2], d = P[row * 4 + 3];
            const float mt = (a.x + b.x + c.x + d.x) * 0.25f;
            const float da = a.x - mt, db = b.x - mt, dc = c.x - mt, dd = d.x - mt;
            const float m2 = (a.y + b.y) + (c.y + d.y) + 64.0f * ((da * da + db * db) + (dc * dc + dd * dd));
            unsigned long long* slot = (unsigned long long*)xbuf + ((size_t)(u.pm * BM + row) * 4 + u.pn);
            __hip_atomic_store(slot, ((unsigned long long)__float_as_uint(m2) << 32) | __float_as_uint(mt), __ATOMIC_RELAXED, __HIP_MEMORY_SCOPE_AGENT);
        }
        asm volatile("s_waitcnt vmcnt(0)" ::: "memory");
        if (lane == 0) __hip_atomic_fetch_add(cnt + 64 * u.pm, 1u, __ATOMIC_RELAXED, __HIP_MEMORY_SCOPE_AGENT);
        if (wid == 0) {
            bool dead = false; const unsigned long long t0 = __builtin_amdgcn_s_memrealtime(); const unsigned want = 8u * (unsigned)ntn;
            for (;;) {
#if defined(BROKEN_EXCHANGE_NO_WAIT)
                break;
#endif
                if ((unsigned)__builtin_amdgcn_readfirstlane(__hip_atomic_load(cnt + 64 * u.pm, __ATOMIC_RELAXED, __HIP_MEMORY_SCOPE_AGENT)) >= want) break;
                if (__builtin_amdgcn_s_memrealtime() - t0 > 2000000ull) {
                    if (lane == 0) { unsigned expect = 0u; __hip_atomic_compare_exchange_strong(tmo + 1, &expect, code | (unsigned)(u.pm & 0xff), __ATOMIC_RELAXED, __ATOMIC_RELAXED, __HIP_MEMORY_SCOPE_AGENT);
                                     __hip_atomic_store(tmo, 1u, __ATOMIC_RELAXED, __HIP_MEMORY_SCOPE_AGENT); }
                    dead = true; break; }
                __builtin_amdgcn_s_sleep(2);
            }
            __builtin_amdgcn_fence(__ATOMIC_ACQUIRE, "agent");
            if (lane == 0) flag[0] = dead ? 1u : 0u;
        }
        asm volatile("s_waitcnt vmcnt(0) lgkmcnt(0)" ::: "memory"); __builtin_amdgcn_s_barrier(); asm volatile("" ::: "memory");
        const bool bad = flag[0] != 0u;
        if (lane < 32) {
            const unsigned long long* slot = (const unsigned long long*)xbuf + (size_t)(u.pm * BM + row) * 4; float mt[4], m2[4]; float ms = 0.f;
#pragma unroll
            for (int t = 0; t < 4; ++t) { if (t < ntn) { const unsigned long long w = __hip_atomic_load(slot + t, __ATOMIC_RELAXED, __HIP_MEMORY_SCOPE_AGENT); mt[t] = __uint_as_float((unsigned)w); m2[t] = __uint_as_float((unsigned)(w >> 32)); } else { mt[t] = 0.f; m2[t] = 0.f; } ms += mt[t]; }
            const float mean = ms / (float)ntn; float q = 0.f;
#pragma unroll
            for (int t = 0; t < 4; ++t) if (t < ntn) { const float dm = mt[t] - mean; q += m2[t] + 256.0f * dm * dm; }
            S[row] = (f32x2v){mean, 1.0f / sqrtf(q / (256.0f * (float)ntn) + eps)};
        }
        asm volatile("s_waitcnt lgkmcnt(0)" ::: "memory"); __builtin_amdgcn_s_barrier(); asm volatile("" ::: "memory");
        return bad;
    }
};
struct EpiLnRes {
    static constexpr bool PERM = false, AFTER_DRAIN = true;
    const float* base; float* out; int ldc; const float* bias; PanelStats st; unsigned poison;
    __device__ __forceinline__ void fused(f32x4 (&acc)[2][2][4][2], const Unit& u, int wr, int wc, int fr, int fq, PG8_LAS unsigned char* lds, int wid, int lane) const {
        typedef float f32x2v __attribute__((ext_vector_type(2)));
        const PG8_LAS f32x2v* S = (const PG8_LAS f32x2v*)(lds + 8192);
        const int col0 = u.pn * BM + wc * 32 + 4 * fq;
#pragma unroll
        for (int bj = 0; bj < 2; ++bj)
#pragma unroll
            for (int n = 0; n < 2; ++n) { const f32x4 bv = bias ? *(const f32x4*)(bias + col0 + bj * HALF + n * 16) : (f32x4){0.f, 0.f, 0.f, 0.f};
#pragma unroll
                for (int ai = 0; ai < 2; ++ai)
#pragma unroll
                    for (int m = 0; m < 4; ++m) acc[ai][bj][m][n] += bv; }
        f32x4 pre[4][2][2];
#pragma unroll
        for (int m = 0; m < 4; ++m) { const size_t off = (size_t)(u.pm * BM + wr * 64 + m * 16 + fr) * ldc + col0;
#pragma unroll
            for (int bj = 0; bj < 2; ++bj)
#pragma unroll
                for (int n = 0; n < 2; ++n) pre[m][bj][n] = *(const f32x4*)(base + off + bj * HALF + n * 16); }
        const bool bad = st.run(acc, u, wr, wc, fr, fq, lds, wid, lane) || poison != 0u;
        const float qnan = __builtin_nanf("");
#pragma unroll
        for (int ai = 0; ai < 2; ++ai)
#pragma unroll
            for (int m = 0; m < 4; ++m) { const int r = ai * HALF + wr * 64 + m * 16 + fr; const f32x2v sr = S[r]; const size_t off = (size_t)(u.pm * BM + r) * ldc + col0;
#pragma unroll
                for (int bj = 0; bj < 2; ++bj)
#pragma unroll
                    for (int n = 0; n < 2; ++n) { const f32x4 bs = ai == 0 ? pre[m][bj][n] : *(const f32x4*)(base + off + bj * HALF + n * 16); f32x4 o = bs + (acc[ai][bj][m][n] - sr.x) * sr.y;
                        if (bad) o = (f32x4){qnan, qnan, qnan, qnan}; *(f32x4*)(out + off + bj * HALF + n * 16) = o; }
                if (m & 1) asm volatile("" ::: "memory"); }
    }
};
struct EpiLnResLn {
    static constexpr bool PERM = false, AFTER_DRAIN = true;
    const float* base; float* out; bf16_t* xn; int ldc; const float* bias; PanelStats st1, st2; unsigned poison;
    __device__ __forceinline__ void fused(f32x4 (&acc)[2][2][4][2], const Unit& u, int wr, int wc, int fr, int fq, PG8_LAS unsigned char* lds, int wid, int lane) const {
        typedef float f32x2v __attribute__((ext_vector_type(2))); typedef unsigned u32x2v __attribute__((ext_vector_type(2)));
        const PG8_LAS f32x2v* S = (const PG8_LAS f32x2v*)(lds + 8192);
        const int col0 = u.pn * BM + wc * 32 + 4 * fq;
#pragma unroll
        for (int bj = 0; bj < 2; ++bj)
#pragma unroll
            for (int n = 0; n < 2; ++n) { const f32x4 bv = bias ? *(const f32x4*)(bias + col0 + bj * HALF + n * 16) : (f32x4){0.f, 0.f, 0.f, 0.f};
#pragma unroll
                for (int ai = 0; ai < 2; ++ai)
#pragma unroll
                    for (int m = 0; m < 4; ++m) acc[ai][bj][m][n] += bv; }
        bool bad = st1.run(acc, u, wr, wc, fr, fq, lds, wid, lane) || poison != 0u;
        const float qnan = __builtin_nanf("");
#pragma unroll
        for (int ai = 0; ai < 2; ++ai)
#pragma unroll
            for (int m = 0; m < 4; ++m) { const int r = ai * HALF + wr * 64 + m * 16 + fr; const f32x2v sr = S[r]; const size_t off = (size_t)(u.pm * BM + r) * ldc + col0;
#pragma unroll
                for (int bj = 0; bj < 2; ++bj)
#pragma unroll
                    for (int n = 0; n < 2; ++n) { const f32x4 bs = *(const f32x4*)(base + off + bj * HALF + n * 16); acc[ai][bj][m][n] = bs + (acc[ai][bj][m][n] - sr.x) * sr.y; }
                asm volatile("" : "+v"(acc[ai][0][m][0]), "+v"(acc[ai][0][m][1]), "+v"(acc[ai][1][m][0]), "+v"(acc[ai][1][m][1]));
                if (m & 1) asm volatile("" ::: "memory"); }
        const bool bad1 = bad;
        bad = st2.run(acc, u, wr, wc, fr, fq, lds, wid, lane) || bad;
#pragma unroll
        for (int ai = 0; ai < 2; ++ai)
#pragma unroll
            for (int m = 0; m < 4; ++m) { const int r = ai * HALF + wr * 64 + m * 16 + fr; const f32x2v sr = S[r]; const size_t off = (size_t)(u.pm * BM + r) * ldc + col0;
#pragma unroll
                for (int bj = 0; bj < 2; ++bj)
#pragma unroll
                    for (int n = 0; n < 2; ++n) { const f32x4 x1 = acc[ai][bj][m][n]; *(f32x4*)(out + off + bj * HALF + n * 16) = bad1 ? (f32x4){qnan, qnan, qnan, qnan} : x1;
                        const f32x4 o = (x1 - sr.x) * sr.y; u32x2v w; w.x = cvt_pk_bf16(o[0], o[1]); w.y = cvt_pk_bf16(o[2], o[3]);
                        if (bad) { w.x = 0x7fc07fc0u; w.y = 0x7fc07fc0u; } *(u32x2v*)(xn + off + bj * HALF + n * 16) = w; }
                asm volatile("" ::: "memory"); }
    }
};

template <class Epi, class Sched, bool ALIGN_EPI = false, bool SP2 = false>
__device__ __forceinline__ void gemm_phase(PG8_LAS unsigned char* lds, const Gemm g, const Sched& S, const Epi& E) {
    const int tid = threadIdx.x, wid = __builtin_amdgcn_readfirstlane(tid >> 6), lane = tid & 63, wr = wid >> 2, wc = wid & 3, fr = lane & 15, fq = lane >> 4;
    const int K = g.K, nt = K / BK;
    unsigned voffA[2], voffB[2];
#pragma unroll
    for (int i = 0; i < 2; ++i) { int R, C; stage_rc(tid * 16 + i * 8192, R, C); const int Rb = Epi::PERM ? ((R & ~31) + perm32(R & 31)) : R;
        voffA[i] = (unsigned)(R * K + C) * 2u; voffB[i] = (unsigned)(Rb * K + C) * 2u; }
    const size_t kstep = (size_t)(BK * 2);
    const size_t hstep = (size_t)HALF * K * 2;
    const size_t tstep = 2 * hstep;
    const unsigned ldsw = (unsigned)wid * 1024u;
    const int aoff = lds_byte(wr * 64 + fr, fq * 8), boff = lds_byte(wc * 32 + fr, fq * 8);
#define PG8_SA(b, h) (((b) * 2 + (h)) * HTB)
#define PG8_SB(b, h) ((4 + (b) * 2 + (h)) * HTB)
#define PG8_STAGE(bufoff, gbase, voff) do { _Pragma("unroll") for (int _i = 0; _i < 2; ++_i) \
        __builtin_amdgcn_global_load_lds((const unsigned*)((const char*)(gbase) + (voff)[_i]), (PG8_LAS unsigned*)(lds + (bufoff) + ldsw + _i * 8192), 16, 0, 0); } while (0)
#define PG8_LDA(dst, b, h) do { _Pragma("unroll") for (int m = 0; m < 4; ++m) _Pragma("unroll") for (int k = 0; k < 2; ++k) dst[m][k] = *(const PG8_LAS bf16x8*)(lds + PG8_SA(b, h) + aoff + m * 2048 + k * 1024); } while (0)
#define PG8_LDB(dst, b, h) do { _Pragma("unroll") for (int n = 0; n < 2; ++n) _Pragma("unroll") for (int k = 0; k < 2; ++k) dst[n][k] = *(const PG8_LAS bf16x8*)(lds + PG8_SB(b, h) + boff + n * 2048 + k * 1024); } while (0)
#define PG8_MMA(ai, bj, At, Bt) do { __builtin_amdgcn_s_setprio(1); _Pragma("unroll") for (int m = 0; m < 4; ++m) _Pragma("unroll") for (int n = 0; n < 2; ++n) _Pragma("unroll") for (int k = 0; k < 2; ++k) \
        acc[ai][bj][m][n] = __builtin_amdgcn_mfma_f32_16x16x32_bf16(Bt[n][k], At[m][k], acc[ai][bj][m][n], 0, 0, 0); __builtin_amdgcn_s_setprio(0); } while (0)
#define PG8_WAIT_V(n) asm volatile("s_waitcnt vmcnt(" #n ")" ::: "memory")
#define PG8_WAIT_L(n) asm volatile("s_waitcnt lgkmcnt(" #n ")" ::: "memory")
#define PG8_BAR __builtin_amdgcn_s_barrier()
#define PG8_SCHED __builtin_amdgcn_sched_barrier(0)
    Unit cur, nxt; int ui = 0;
    if (!S.next(0, cur)) return;
    f32x4 acc[2][2][4][2];
#pragma unroll
    for (int a = 0; a < 2; ++a)
#pragma unroll
        for (int b = 0; b < 2; ++b)
#pragma unroll
            for (int m = 0; m < 4; ++m)
#pragma unroll
                for (int n = 0; n < 2; ++n) acc[a][b][m][n] = (f32x4){0.f, 0.f, 0.f, 0.f};
    bf16x8 At[4][2], B0[2][2], B1[2][2];
    const char* cA = (const char*)g.A + (size_t)cur.pm * tstep; const char* cB = (const char*)g.Bt + (size_t)cur.pn * tstep;
    S.a_ready(cur);
    if constexpr (SP2) {
        PG8_STAGE(PG8_SB(0, 0), cB, voffB); PG8_STAGE(PG8_SB(0, 1), cB + hstep, voffB); PG8_STAGE(PG8_SA(0, 0), cA, voffA); PG8_STAGE(PG8_SA(0, 1), cA + hstep, voffA);
        if (wr == 1) PG8_BAR;
        PG8_WAIT_V(2); PG8_BAR;
        PG8_STAGE(PG8_SB(1, 0), cB + kstep, voffB); PG8_STAGE(PG8_SA(1, 0), cA + kstep, voffA); PG8_STAGE(PG8_SB(1, 1), cB + hstep + kstep, voffB);
        PG8_WAIT_V(6); PG8_BAR;
    } else {
        PG8_STAGE(PG8_SB(0, 0), cB, voffB); PG8_STAGE(PG8_SA(0, 0), cA, voffA); PG8_STAGE(PG8_SB(0, 1), cB + hstep, voffB); PG8_STAGE(PG8_SA(0, 1), cA + hstep, voffA);
        if (wr == 1) PG8_BAR;
        PG8_WAIT_V(4); PG8_BAR;
        PG8_STAGE(PG8_SB(1, 0), cB + kstep, voffB); PG8_STAGE(PG8_SA(1, 0), cA + kstep, voffA); PG8_STAGE(PG8_SB(1, 1), cB + hstep + kstep, voffB);
        PG8_WAIT_V(6); PG8_BAR;
    }
    for (;;) {
        const bool has_next = S.next(ui + 1, nxt);
        const char* nA = has_next ? (const char*)g.A + (size_t)nxt.pm * tstep : cA; const char* nB = has_next ? (const char*)g.Bt + (size_t)nxt.pn * tstep : cB;
        for (int t = 0; t < nt; t += 2) {
            const bool last = (t == nt - 2);
            const char* a1 = cA + (size_t)(t + 1) * kstep;
            const char* a2 = last ? nA : cA + (size_t)(t + 2) * kstep; const char* b2 = last ? nB : cB + (size_t)(t + 2) * kstep;
            const char* a3 = a2 + kstep; const char* b3 = b2 + kstep;
            if (last && has_next) S.a_ready(nxt);
            if constexpr (SP2) {
            PG8_LDB(B0, 0, 0); PG8_LDB(B1, 0, 1); PG8_SCHED; PG8_LDA(At, 0, 0); PG8_STAGE(PG8_SA(1, 1), a1 + hstep, voffA);
            PG8_WAIT_V(8); PG8_WAIT_L(0); PG8_BAR; PG8_MMA(0, 0, At, B0); PG8_MMA(0, 1, At, B1); PG8_BAR; PG8_SCHED;
            PG8_LDA(At, 0, 1); PG8_STAGE(PG8_SB(0, 0), b2, voffB); PG8_STAGE(PG8_SB(0, 1), b2 + hstep, voffB); PG8_STAGE(PG8_SA(0, 0), a2, voffA);
            PG8_WAIT_V(8); PG8_WAIT_L(0); PG8_BAR; PG8_MMA(1, 0, At, B0); PG8_MMA(1, 1, At, B1); PG8_BAR; PG8_SCHED;
            PG8_LDB(B0, 1, 0); PG8_LDB(B1, 1, 1); PG8_SCHED; PG8_LDA(At, 1, 0); PG8_STAGE(PG8_SA(0, 1), a2 + hstep, voffA);
            PG8_WAIT_V(8); PG8_WAIT_L(0); PG8_BAR; PG8_MMA(0, 0, At, B0); PG8_MMA(0, 1, At, B1); PG8_BAR; PG8_SCHED;
            PG8_LDA(At, 1, 1); PG8_STAGE(PG8_SB(1, 0), b3, voffB); PG8_STAGE(PG8_SB(1, 1), b3 + hstep, voffB); PG8_STAGE(PG8_SA(1, 0), a3, voffA);
            PG8_WAIT_V(8); PG8_WAIT_L(0); PG8_BAR; PG8_MMA(1, 0, At, B0); PG8_MMA(1, 1, At, B1); PG8_BAR; PG8_SCHED;
            } else {
            PG8_LDB(B0, 0, 0); PG8_SCHED; PG8_LDA(At, 0, 0); PG8_STAGE(PG8_SA(1, 1), a1 + hstep, voffA);
            PG8_WAIT_L(8); PG8_BAR; PG8_WAIT_L(0); PG8_MMA(0, 0, At, B0); PG8_BAR; PG8_SCHED;
            PG8_LDB(B1, 0, 1); PG8_STAGE(PG8_SB(0, 0), b2, voffB);
            PG8_BAR; PG8_WAIT_L(0); PG8_MMA(0, 1, At, B1); PG8_BAR;
            PG8_LDA(At, 0, 1); PG8_STAGE(PG8_SA(0, 0), a2, voffA);
            PG8_BAR; PG8_WAIT_L(0); PG8_MMA(1, 0, At, B0); PG8_BAR; PG8_SCHED;
            PG8_STAGE(PG8_SB(0, 1), b2 + hstep, voffB);
            PG8_WAIT_V(6); PG8_BAR; PG8_MMA(1, 1, At, B1); PG8_BAR;
            PG8_LDB(B0, 1, 0); PG8_SCHED; PG8_LDA(At, 1, 0); PG8_STAGE(PG8_SA(0, 1), a2 + hstep, voffA);
            PG8_WAIT_L(8); PG8_BAR; PG8_WAIT_L(0); PG8_MMA(0, 0, At, B0); PG8_BAR; PG8_SCHED;
            PG8_LDB(B1, 1, 1); PG8_STAGE(PG8_SB(1, 0), b3, voffB);
            PG8_BAR; PG8_WAIT_L(0); PG8_MMA(0, 1, At, B1); PG8_BAR;
            PG8_LDA(At, 1, 1); PG8_STAGE(PG8_SA(1, 0), a3, voffA);
            PG8_BAR; PG8_WAIT_L(0); PG8_MMA(1, 0, At, B0); PG8_BAR; PG8_SCHED;
            PG8_STAGE(PG8_SB(1, 1), b3 + hstep, voffB);
            PG8_WAIT_V(6); PG8_BAR; PG8_MMA(1, 1, At, B1); PG8_BAR;
            }
        }
        if constexpr (ALIGN_EPI) { if (wr == 0) PG8_BAR; }
        if constexpr (!Epi::AFTER_DRAIN) { E(acc, cur, wr, wc, fr, fq); S.done(cur); }
        if (!has_next) break;
#pragma unroll
        for (int a = 0; a < 2; ++a)
#pragma unroll
            for (int b = 0; b < 2; ++b)
#pragma unroll
                for (int m = 0; m < 4; ++m)
#pragma unroll
                    for (int n = 0; n < 2; ++n) acc[a][b][m][n] = (f32x4){0.f, 0.f, 0.f, 0.f};
        cur = nxt; cA = nA; cB = nB; ++ui;
        if constexpr (ALIGN_EPI) { if (wr == 1) PG8_BAR; }
    }
    PG8_WAIT_V(0);
    if constexpr (!ALIGN_EPI) { if (wr == 0) PG8_BAR; }
    PG8_BAR;
    if constexpr (Epi::AFTER_DRAIN) { E.fused(acc, cur, wr, wc, fr, fq, lds, wid, lane); S.done(cur); }
#undef PG8_SA
#undef PG8_SB
#undef PG8_STAGE
#undef PG8_LDA
#undef PG8_LDB
#undef PG8_MMA
#undef PG8_WAIT_V
#undef PG8_WAIT_L
#undef PG8_BAR
#undef PG8_SCHED
}
}

#ifndef PG8_SP2
#define PG8_SP2 true
#endif
#ifndef PG8_ALIGN
#define PG8_ALIGN true
#endif

namespace nv {
constexpr int NTOK = 16384, D = 1024, SEQ = 4096, INC = 2464;
constexpr int O_CQ = 0, O_CKV = 256, O_KR = 384, O_F = 416, O_I = 928, O_Q = 1440, O_G = 1952;
constexpr int NEXP = 32, PSLOTS = 36864, NBLK = 288;
constexpr float ALPHA = 1.189207115002721f;
constexpr float RMS_EPS = 1e-6f, LN_EPS = 1e-5f;

template <class F>
__device__ __forceinline__ void ngemm(LAS unsigned char* lds, int M, int N, int K, const F& f) {
    LAS float* As = (LAS float*)lds;
    LAS float* Bs = As + 16 * 132;
    const int tid = threadIdx.x, tx = tid & 15, ty = tid >> 4;
    const int tn = (N + 63) / 64, tm = (M + 127) / 128;
    for (int tile = blockIdx.x; tile < tn * tm; tile += gridDim.x) {
        const int m0 = (tile / tn) * 128, n0 = (tile % tn) * 64;
        float acc[4][4];
#pragma unroll
        for (int i = 0; i < 4; ++i)
#pragma unroll
            for (int j = 0; j < 4; ++j) acc[i][j] = 0.f;
        for (int k0 = 0; k0 < K; k0 += 16) {
#pragma unroll
            for (int i = 0; i < 4; ++i) { const int idx = tid + i * 512; const int r = idx >> 4, kk = idx & 15; As[kk * 132 + r] = (m0 + r < M) ? f.a(m0 + r, k0 + kk) : 0.f; }
#pragma unroll
            for (int i = 0; i < 2; ++i) { const int idx = tid + i * 512; const int kk = idx >> 6, c = idx & 63; Bs[kk * 68 + c] = (n0 + c < N) ? f.b(k0 + kk, n0 + c, m0) : 0.f; }
            __syncthreads();
#pragma unroll
            for (int kk = 0; kk < 16; ++kk) {
                float a[4], b[4];
#pragma unroll
                for (int i = 0; i < 4; ++i) { a[i] = As[kk * 132 + ty * 4 + i]; b[i] = Bs[kk * 68 + tx * 4 + i]; }
#pragma unroll
                for (int i = 0; i < 4; ++i)
#pragma unroll
                    for (int j = 0; j < 4; ++j) acc[i][j] += a[i] * b[j];
            }
            __syncthreads();
        }
#pragma unroll
        for (int i = 0; i < 4; ++i)
#pragma unroll
            for (int j = 0; j < 4; ++j) { const int r = m0 + ty * 4 + i, c = n0 + tx * 4 + j; if (r < M && c < N) f.epi(r, c, acc[i][j]); }
    }
}

struct ProjF { const float* x; const float* w; float* out;
    __device__ float a(int r, int k) const { return x[(size_t)r * D + k]; }
    __device__ float b(int k, int c, int) const { return w[(size_t)k * INC + c]; }
    __device__ void epi(int r, int c, float v) const { out[(size_t)r * INC + c] = v; } };
struct PlainF { const float* A; int lda; const float* B; int ldb; float* C; int ldc;
    __device__ float a(int r, int k) const { return A[(size_t)r * lda + k]; }
    __device__ float b(int k, int c, int) const { return B[(size_t)k * ldb + c]; }
    __device__ void epi(int r, int c, float v) const { C[(size_t)r * ldc + c] = v; } };
struct MixF { const float* an; const float* rr; const float* w; const float* x; float* t;
    __device__ float a(int r, int k) const { return k < 512 ? an[(size_t)r * 512 + k] : rr[(size_t)r * 512 + k - 512]; }
    __device__ float b(int k, int c, int) const { return w[(size_t)k * D + c]; }
    __device__ void epi(int r, int c, float v) const { t[(size_t)r * D + c] = ALPHA * x[(size_t)r * D + c] + v; } };
struct Moe1F { const float* h1; const int* slot_tok; const int* blk_exp; const float* w; float* H; int which;
    __device__ float a(int r, int k) const { const int tok = slot_tok[r]; return tok < NTOK ? h1[(size_t)tok * D + k] : 0.f; }
    __device__ float b(int k, int c, int m0) const { const int e = blk_exp[m0 >> 7]; return w[((size_t)e * D + k) * 512 + c]; }
    __device__ void epi(int r, int c, float v) const { float* p = H + (size_t)r * 512 + c; if (which == 0) *p = v / (1.f + expf(-v)); else *p *= v; } };
struct Moe2F { const float* H; const int* slot_tok; const float* slot_gate; const int* blk_exp; const float* w; float* acc;
    __device__ float a(int r, int k) const { return H[(size_t)r * 512 + k]; }
    __device__ float b(int k, int c, int m0) const { const int e = blk_exp[m0 >> 7]; return w[((size_t)e * 512 + k) * D + c]; }
    __device__ void epi(int r, int c, float v) const { const int tok = slot_tok[r]; if (tok < NTOK) atomicAdd(acc + (size_t)tok * D + c, slot_gate[r] * v); } };

__device__ __forceinline__ float wsum(float v) {
#pragma unroll
    for (int o = 1; o < 64; o <<= 1) v += __shfl_xor(v, o);
    return v;
}
#define GTID (blockIdx.x * NTHREADS + threadIdx.x)
#define GTHREADS (gridDim.x * NTHREADS)
#define GWAVE (blockIdx.x * NWAVES + (threadIdx.x >> 6))
#define GWAVES (gridDim.x * NWAVES)

__device__ __forceinline__ void hg_gate(float* proj, const float* lbl) {
    for (int i = GTID; i < NTOK * 512; i += GTHREADS) {
        const int r = i >> 9, c = i & 511;
        const float l0 = lbl[c], l1 = lbl[512 + c]; const float mx = fmaxf(l0, l1);
        const float e0 = expf(l0 - mx), e1 = expf(l1 - mx); const float lb = e0 / (e0 + e1);
        float* p = proj + (size_t)r * INC + O_F + c; const float z = *p;
        *p = lb + (1.f - lb) * (1.f / (1.f + expf(-z)));
    }
}
__device__ __forceinline__ void hg_rec(float* proj) {
    if (blockIdx.x >= 16 || threadIdx.x >= 128) return;
    const int bh = blockIdx.x, b = bh >> 2, h = bh & 3, e = threadIdx.x;
    float S[128];
#pragma unroll
    for (int d = 0; d < 128; ++d) S[d] = 0.f;
    for (int t = 0; t < SEQ; ++t) {
        float* row = proj + (size_t)(b * SEQ + t) * INC;
        const float v = row[O_I + h * 128 + e];
        const float* fr = row + O_F + h * 128; const float* qr = row + O_Q + h * 128;
        float o = 0.f;
#pragma unroll
        for (int d = 0; d < 128; ++d) { const float f = fr[d]; S[d] = f * S[d] + (1.f - f) * v; o += qr[d] * S[d]; }
        row[O_I + h * 128 + e] = o;
    }
}
__device__ __forceinline__ void hg_out(const float* proj, const float* g, float* rr) {
    const int lane = threadIdx.x & 63;
    for (int w = GWAVE; w < NTOK * 4; w += GWAVES) {
        const int r = w >> 2, h = w & 3; const float* row = proj + (size_t)r * INC;
        const float o0 = row[O_I + h * 128 + lane], o1 = row[O_I + h * 128 + 64 + lane];
        const float ss = wsum(o0 * o0 + o1 * o1); const float rs = 1.f / sqrtf(ss * (1.f / 128.f) + RMS_EPS);
        const float g0 = row[O_G + h * 128 + lane], g1 = row[O_G + h * 128 + 64 + lane];
        rr[(size_t)r * 512 + h * 128 + lane] = o0 * rs * g[lane] * (g0 / (1.f + expf(-g0)));
        rr[(size_t)r * 512 + h * 128 + 64 + lane] = o1 * rs * g[64 + lane] * (g1 / (1.f + expf(-g1)));
    }
}
__device__ __forceinline__ void cs_tab(const int* pos, float* cs) {
    for (int i = GTID; i < NTOK * 16; i += GTHREADS) {
        const int j = i & 15, r = i >> 4;
        const float invf = (float)pow(10000.0, -(double)(2 * j) / 32.0);
        const float ang = (float)pos[r] * invf;
        double s, c; sincos((double)ang, &s, &c);
        cs[(size_t)r * 32 + j] = (float)c; cs[(size_t)r * 32 + 16 + j] = (float)s;
    }
}
__device__ __forceinline__ void mla_prep(const float* proj, const float* gq, const float* gkv, const float* cs, float* cqn, float* ckvn, float* kr) {
    const int lane = threadIdx.x & 63;
    for (int r = GWAVE; r < NTOK; r += GWAVES) {
        const float* row = proj + (size_t)r * INC;
        float v[4]; float ss = 0.f;
#pragma unroll
        for (int i = 0; i < 4; ++i) { v[i] = row[O_CQ + lane + 64 * i]; ss += v[i] * v[i]; }
        ss = wsum(ss); float rs = 1.f / sqrtf(ss * (1.f / 256.f) + RMS_EPS);
#pragma unroll
        for (int i = 0; i < 4; ++i) cqn[(size_t)r * 256 + lane + 64 * i] = v[i] * rs * gq[lane + 64 * i];
        float u0 = row[O_CKV + lane], u1 = row[O_CKV + 64 + lane];
        ss = wsum(u0 * u0 + u1 * u1); rs = 1.f / sqrtf(ss * (1.f / 128.f) + RMS_EPS);
        ckvn[(size_t)r * 128 + lane] = u0 * rs * gkv[lane]; ckvn[(size_t)r * 128 + 64 + lane] = u1 * rs * gkv[64 + lane];
        if (lane < 16) { const float x1 = row[O_KR + lane], x2 = row[O_KR + 16 + lane]; const float c = cs[(size_t)r * 32 + lane], s = cs[(size_t)r * 32 + 16 + lane];
            kr[(size_t)r * 32 + lane] = x1 * c - x2 * s; kr[(size_t)r * 32 + 16 + lane] = x2 * c + x1 * s; }
    }
}
__device__ __forceinline__ void q_rope(float* q, const float* cs) {
    for (int i = GTID; i < NTOK * 8 * 16; i += GTHREADS) {
        const int j = i & 15, h = (i >> 4) & 7, r = i >> 7;
        float* p = q + (size_t)r * 768 + h * 96 + 64; const float x1 = p[j], x2 = p[16 + j]; const float c = cs[(size_t)r * 32 + j], s = cs[(size_t)r * 32 + 16 + j];
        p[j] = x1 * c - x2 * s; p[16 + j] = x2 * c + x1 * s;
    }
}
__device__ __forceinline__ void attn_naive(const float* q, const float* kv, const float* kr, float* out) {
    const int lane = threadIdx.x & 63;
    for (int task = GWAVE; task < 2048; task += GWAVES) {
        const int tsk = __builtin_amdgcn_readfirstlane(task);
        const int qc = 63 - (tsk >> 5), h = tsk & 7, b = (tsk >> 3) & 3;
        const int t = qc * 64 + lane; const size_t row = (size_t)b * SEQ + t;
        const float scale = 0.10206207261596575f;
        float qv[96];
#pragma unroll
        for (int d = 0; d < 96; ++d) qv[d] = q[row * 768 + h * 96 + d] * scale;
        float o[64];
#pragma unroll
        for (int d = 0; d < 64; ++d) o[d] = 0.f;
        float m = -INFINITY, l = 0.f;
        const int nk = (qc + 1) * 64;
        for (int s = 0; s < nk; ++s) {
            const size_t kr_ = (size_t)b * SEQ + s;
            const float* kp = kv + kr_ * 1024 + h * 128; const float* rp = kr + kr_ * 32;
            float sc = 0.f;
#pragma unroll
            for (int d = 0; d < 64; ++d) sc += qv[d] * kp[d];
#pragma unroll
            for (int d = 0; d < 32; ++d) sc += qv[64 + d] * rp[d];
            const float mn = fmaxf(m, sc); const float corr = expf(m - mn), p = expf(sc - mn);
            l = l * corr + p;
#pragma unroll
            for (int d = 0; d < 64; ++d) o[d] = o[d] * corr + p * kp[64 + d];
            m = mn;
        }
        const float il = 1.f / l;
#pragma unroll
        for (int d = 0; d < 64; ++d) out[row * 512 + h * 64 + d] = o[d] * il;
    }
}
__device__ __forceinline__ void a_norm(float* a, const float* g) {
    const int lane = threadIdx.x & 63;
    for (int r = GWAVE; r < NTOK; r += GWAVES) {
        float v[8]; float ss = 0.f;
#pragma unroll
        for (int i = 0; i < 8; ++i) { v[i] = a[(size_t)r * 512 + lane + 64 * i]; ss += v[i] * v[i]; }
        ss = wsum(ss); const float rs = 1.f / sqrtf(ss * (1.f / 512.f) + RMS_EPS);
#pragma unroll
        for (int i = 0; i < 8; ++i) a[(size_t)r * 512 + lane + 64 * i] = v[i] * rs * g[lane + 64 * i];
    }
}
__device__ __forceinline__ void ln_rows(const float* in, const float* add, float addscale_in, const float* g, const float* bb, float* out) {
    const int lane = threadIdx.x & 63;
    for (int r = GWAVE; r < NTOK; r += GWAVES) {
        float v[16]; float s = 0.f;
#pragma unroll
        for (int i = 0; i < 16; ++i) { const size_t o = (size_t)r * D + lane + 64 * i; v[i] = addscale_in * in[o] + (add ? add[o] : 0.f); s += v[i]; }
        const float mean = wsum(s) * (1.f / D); float q = 0.f;
#pragma unroll
        for (int i = 0; i < 16; ++i) { v[i] -= mean; q += v[i] * v[i]; }
        const float rs = 1.f / sqrtf(wsum(q) * (1.f / D) + LN_EPS);
#pragma unroll
        for (int i = 0; i < 16; ++i) { const int c = lane + 64 * i; out[(size_t)r * D + c] = v[i] * rs * g[c] + bb[c]; }
    }
}
__device__ __forceinline__ void router(const float* h1, const float* wg, const float* bg, const float* we, const float* be, int* cnt, int* tok_e, int* tok_rank, float* tok_gate) {
    const int lane = threadIdx.x & 63;
    for (int r = GWAVE; r < NTOK; r += GWAVES) {
        float lg[36];
#pragma unroll
        for (int c = 0; c < 36; ++c) lg[c] = 0.f;
        for (int i = 0; i < 16; ++i) { const int k = lane + 64 * i; const float xv = h1[(size_t)r * D + k];
#pragma unroll
            for (int c = 0; c < 4; ++c) lg[c] += xv * wg[k * 4 + c];
#pragma unroll
            for (int c = 0; c < 32; ++c) lg[4 + c] += xv * we[k * 32 + c]; }
#pragma unroll
        for (int c = 0; c < 36; ++c) lg[c] = wsum(lg[c]);
#pragma unroll
        for (int c = 0; c < 4; ++c) lg[c] += bg[c];
#pragma unroll
        for (int c = 0; c < 32; ++c) lg[4 + c] += be[c];
        int grp = 0; float gm = lg[0];
#pragma unroll
        for (int c = 1; c < 4; ++c) if (lg[c] > gm) { gm = lg[c]; grp = c; }
        float den = 0.f;
#pragma unroll
        for (int c = 0; c < 4; ++c) den += expf(lg[c] - gm);
        const float pgrp = 1.f / den;
        float ein[8];
#pragma unroll
        for (int j = 0; j < 8; ++j) ein[j] = grp == 0 ? lg[4 + j] : grp == 1 ? lg[12 + j] : grp == 2 ? lg[20 + j] : lg[28 + j];
        int i0 = 0; float v0 = ein[0];
#pragma unroll
        for (int j = 1; j < 8; ++j) if (ein[j] > v0) { v0 = ein[j]; i0 = j; }
        int i1 = -1; float v1 = -INFINITY;
#pragma unroll
        for (int j = 0; j < 8; ++j) if (j != i0 && ein[j] > v1) { v1 = ein[j]; i1 = j; }
        const float e1 = expf(v1 - v0); const float p0 = 1.f / (1.f + e1), p1 = e1 / (1.f + e1);
        if (lane == 0) {
            const int ea = grp * 8 + i0, eb = grp * 8 + i1;
            tok_e[2 * r] = ea; tok_e[2 * r + 1] = eb;
            tok_rank[2 * r] = atomicAdd(cnt + ea, 1); tok_rank[2 * r + 1] = atomicAdd(cnt + eb, 1);
            tok_gate[2 * r] = pgrp * p0; tok_gate[2 * r + 1] = pgrp * p1;
        }
    }
}
__device__ __forceinline__ void prefix(const int* cnt, int* pad_start, int* blk_exp) {
    if (threadIdx.x != 0 || blockIdx.x != 0) return;
    int acc = 0;
    for (int e = 0; e < NEXP; ++e) { pad_start[e] = acc; acc += ((__hip_atomic_load(cnt + e, __ATOMIC_RELAXED, __HIP_MEMORY_SCOPE_AGENT) + 127) / 128) * 128; pad_start[NEXP + e] = acc; }
    for (int b = 0; b < NBLK; ++b) { int c = 0; for (int e = 0; e < NEXP; ++e) c += (pad_start[NEXP + e] <= b * 128) ? 1 : 0; blk_exp[b] = c < NEXP - 1 ? c : NEXP - 1; }
}
__device__ __forceinline__ void slot_init(int* slot_tok, float* slot_gate) { for (int i = GTID; i < PSLOTS; i += GTHREADS) { slot_tok[i] = NTOK; slot_gate[i] = 0.f; } }
__device__ __forceinline__ void slot_fill(const int* tok_e, const int* tok_rank, const float* tok_gate, const int* pad_start, int* slot_tok, float* slot_gate) {
    for (int i = GTID; i < NTOK * 2; i += GTHREADS) { const int s = pad_start[tok_e[i]] + tok_rank[i]; slot_tok[s] = i >> 1; slot_gate[s] = tok_gate[i]; }
}
__device__ __forceinline__ void zero_f32(float* p, size_t n) { for (size_t i = GTID; i < n / 4; i += GTHREADS) ((float4*)p)[i] = make_float4(0.f, 0.f, 0.f, 0.f); }
}


namespace op {
using pg8::f32x4; using pg8::Unit; using pg8::bf16_t;
typedef unsigned v4u __attribute__((ext_vector_type(4)));
#define GAS __attribute__((address_space(1)))
__device__ __forceinline__ unsigned f2bf(float f) { unsigned u = __builtin_bit_cast(unsigned, f); return (u + 0x7fffu + ((u >> 16) & 1u)) >> 16; }
__device__ __forceinline__ unsigned pk2(float lo, float hi) { return f2bf(lo) | (f2bf(hi) << 16); }
__device__ __forceinline__ float bf2f(unsigned short b) { return __builtin_bit_cast(float, (unsigned)b << 16); }

template <class RowMap>
__device__ __forceinline__ void transpose_item(const float* W, int K, int N, bf16_t* WT, LAS float* scr, int item, int lane, const RowMap& rm) {
    const int nblk = N / 32, kb = item / nblk, nb = item % nblk, k0 = 64 * kb, n0 = 32 * nb;
#pragma unroll 8
    for (int i = 0; i < 32; ++i) { const int kk = 2 * i + (lane >> 5); scr[kk * 33 + (lane & 31)] = rm.scale(n0 + (lane & 31), k0 + kk) * W[(size_t)(k0 + kk) * N + n0 + (lane & 31)]; }
    asm volatile("s_waitcnt lgkmcnt(0)" ::: "memory");
    const int c = lane & 7;
#pragma unroll
    for (int j = 0; j < 4; ++j) { const int n = (lane >> 3) + 8 * j; const LAS float* s = scr + (8 * c) * 33 + n;
        v4u o; o.x = pk2(s[0 * 33], s[1 * 33]); o.y = pk2(s[2 * 33], s[3 * 33]); o.z = pk2(s[4 * 33], s[5 * 33]); o.w = pk2(s[6 * 33], s[7 * 33]);
        *(GAS v4u*)(WT + (size_t)rm.row(n0 + n) * K + k0 + 8 * c) = o; }
    asm volatile("s_waitcnt lgkmcnt(0)" ::: "memory");
}
struct RowId { __device__ __forceinline__ int row(int n) const { return n; } __device__ __forceinline__ float scale(int, int) const { return 1.f; } };

__device__ __forceinline__ void cvt_rows_bf16(const float* src, bf16_t* dst, size_t n) {
    for (size_t i = GTID; i < n / 8; i += GTHREADS) { const float4 a = ((const float4*)src)[2 * i], b = ((const float4*)src)[2 * i + 1];
        v4u o; o.x = pk2(a.x, a.y); o.y = pk2(a.z, a.w); o.z = pk2(b.x, b.y); o.w = pk2(b.z, b.w); ((v4u*)dst)[i] = o; }
}

struct EpiF32Nat { static constexpr bool PERM = false, AFTER_DRAIN = false;
    float* C; int ldc; int ncols;
    __device__ __forceinline__ void operator()(const f32x4 (&acc)[2][2][4][2], const Unit& u, int wr, int wc, int fr, int fq) const {
        const int row0 = u.pm * 256 + wr * 64 + fr, col0 = u.pn * 256 + wc * 32 + 4 * fq;
#pragma unroll
        for (int ai = 0; ai < 2; ++ai)
#pragma unroll
            for (int m = 0; m < 4; ++m) { float* rowp = C + (size_t)(row0 + ai * 128 + m * 16) * ldc;
#pragma unroll
                for (int bj = 0; bj < 2; ++bj)
#pragma unroll
                    for (int n = 0; n < 2; ++n) { const int c = col0 + bj * 128 + n * 16; if (c < ncols) *(f32x4*)(rowp + c) = acc[ai][bj][m][n]; } }
    }
};
}

namespace op {
struct RowProj {
    __device__ __forceinline__ int row(int n) const {
        if (n < 384) return n;
        if (n < 416) { const int j = n - 384, jj = j & 15, a = jj >> 2, b = jj & 3; return 384 + 8 * a + b + (j >= 16 ? 4 : 0); }
        return n + 96;
    }
    __device__ __forceinline__ float scale(int, int) const { return 1.f; }
};
__device__ __forceinline__ v4u pack8(const f32x4& v0, const f32x4& v1) { v4u w; w.x = pk2(v0[0], v0[1]); w.y = pk2(v0[2], v0[3]); w.z = pk2(v1[0], v1[1]); w.w = pk2(v1[2], v1[3]); return w; }
__device__ __forceinline__ float dot4(const f32x4& v) { return (v[0] * v[0] + v[1] * v[1]) + (v[2] * v[2] + v[3] * v[3]); }

struct EpiProj { static constexpr bool PERM = true, AFTER_DRAIN = false;
    bf16_t *cq, *ckv, *kr, *kk, *vi; float* lf; float *ssq_q, *ssq_kv; const float* cs; const float* lbt;
    __device__ __forceinline__ void operator()(const f32x4 (&acc)[2][2][4][2], const Unit& u, int wr, int wc, int fr, int fq) const {
        const int pn = u.pn; const int row0 = u.pm * 256 + wr * 64 + fr; const int cl = wc * 32 + 8 * fq;
        if (pn == 0) {
#pragma unroll
            for (int ai = 0; ai < 2; ++ai)
#pragma unroll
                for (int m = 0; m < 4; ++m) { const int row = row0 + ai * 128 + m * 16; float s = 0.f;
#pragma unroll
                    for (int bj = 0; bj < 2; ++bj) { const f32x4 v0 = acc[ai][bj][m][0], v1 = acc[ai][bj][m][1]; s += dot4(v0) + dot4(v1);
                        *(v4u*)(cq + (size_t)row * 256 + bj * 128 + cl) = pack8(v0, v1); }
                    s += __shfl_xor(s, 16); s += __shfl_xor(s, 32); if (fq == 0) atomicAdd(ssq_q + row, s); }
        } else if (pn == 1) {
#pragma unroll
            for (int ai = 0; ai < 2; ++ai)
#pragma unroll
                for (int m = 0; m < 4; ++m) { const int row = row0 + ai * 128 + m * 16;
                    const f32x4 v0 = acc[ai][0][m][0], v1 = acc[ai][0][m][1]; float s = dot4(v0) + dot4(v1);
                    *(v4u*)(ckv + (size_t)row * 128 + cl) = pack8(v0, v1);
                    s += __shfl_xor(s, 16); s += __shfl_xor(s, 32); if (fq == 0) atomicAdd(ssq_kv + row, s);
                    if (wc == 0) { const f32x4 x1 = acc[ai][1][m][0], x2 = acc[ai][1][m][1];
                        const f32x4 c = *(const f32x4*)(cs + (size_t)row * 32 + 4 * fq), sn = *(const f32x4*)(cs + (size_t)row * 32 + 16 + 4 * fq);
                        *(v4u*)(kr + (size_t)row * 32 + 8 * fq) = pack8(x1 * c - x2 * sn, x2 * c + x1 * sn); } }
        } else if (pn < 4) {
            const int cb = (pn - 2) * 256;
#pragma unroll
            for (int bj = 0; bj < 2; ++bj) { const int col = cb + bj * 128 + cl;
#pragma unroll
                for (int n = 0; n < 2; ++n) { const f32x4 lb = *(const f32x4*)(lbt + col + 4 * n);
#pragma unroll
                    for (int ai = 0; ai < 2; ++ai)
#pragma unroll
                        for (int m = 0; m < 4; ++m) { const int row = row0 + ai * 128 + m * 16; f32x4 l, k;
#pragma unroll
                            for (int i = 0; i < 4; ++i) { const float e = __expf(-acc[ai][bj][m][n][i]), sg = __builtin_amdgcn_rcpf(1.f + e); const float om = 1.f - lb[i]; l[i] = __logf(lb[i] + om * sg); k[i] = om * e * sg; }
                            *(f32x4*)(lf + (size_t)row * 512 + col + 4 * n) = l;
                            typedef unsigned v2u __attribute__((ext_vector_type(2))); v2u w; w.x = pk2(k[0], k[1]); w.y = pk2(k[2], k[3]);
                            *(v2u*)(kk + (size_t)row * 512 + col + 4 * n) = w;
                            asm volatile("" ::: "memory"); } } }
        } else {
            bf16_t* dst = vi + (size_t)((pn - 4) >> 1) * ((size_t)16384 * 512); const int cb = (pn & 1) * 256;
#pragma unroll
            for (int ai = 0; ai < 2; ++ai)
#pragma unroll
                for (int m = 0; m < 4; ++m) { const int row = row0 + ai * 128 + m * 16;
#pragma unroll
                    for (int bj = 0; bj < 2; ++bj) *(v4u*)(dst + (size_t)row * 512 + cb + bj * 128 + cl) = pack8(acc[ai][bj][m][0], acc[ai][bj][m][1]); }
        }
    }
};
}

namespace nv {
using op::bf2f; typedef unsigned short bf16_t;
__device__ __forceinline__ void lb_tab(const float* lbl, float* lbt) {
    for (int c = GTID; c < 512; c += GTHREADS) { const float l0 = lbl[c], l1 = lbl[512 + c]; const float mx = fmaxf(l0, l1); const float e0 = expf(l0 - mx), e1 = expf(l1 - mx); lbt[c] = e0 / (e0 + e1); }
}
__device__ __forceinline__ void hg_f(const float* lf, float* fb) { for (size_t i = GTID; i < (size_t)NTOK * 512; i += GTHREADS) fb[i] = expf(lf[i]); }
__device__ __forceinline__ void hg_rec2(const float* fb, const bf16_t* kk, const bf16_t* vi, const bf16_t* qh, float* ob) {
    if (blockIdx.x >= 16 || threadIdx.x >= 128) return;
    const int bh = blockIdx.x, b = bh >> 2, h = bh & 3, e = threadIdx.x;
    float S[128];
#pragma unroll
    for (int d = 0; d < 128; ++d) S[d] = 0.f;
    for (int t = 0; t < SEQ; ++t) {
        const size_t base = (size_t)(b * SEQ + t) * 512 + h * 128;
        const float v = bf2f(vi[base + e]);
        float o = 0.f;
#pragma unroll
        for (int d = 0; d < 128; ++d) { const float f = fb[base + d]; S[d] = f * S[d] + bf2f(kk[base + d]) * v; o += bf2f(qh[base + d]) * S[d]; }
        ob[base + e] = o;
    }
}
__device__ __forceinline__ void hg_out2(const float* ob, const bf16_t* gh, const float* g, float* rr) {
    const int lane = threadIdx.x & 63;
    for (int w = GWAVE; w < NTOK * 4; w += GWAVES) {
        const size_t base = (size_t)(w >> 2) * 512 + (w & 3) * 128;
        const float o0 = ob[base + lane], o1 = ob[base + 64 + lane];
        const float ss = wsum(o0 * o0 + o1 * o1); const float rs = 1.f / sqrtf(ss * (1.f / 128.f) + RMS_EPS);
        const float g0 = bf2f(gh[base + lane]), g1 = bf2f(gh[base + 64 + lane]);
        rr[base + lane] = o0 * rs * g[lane] * (g0 / (1.f + expf(-g0)));
        rr[base + 64 + lane] = o1 * rs * g[64 + lane] * (g1 / (1.f + expf(-g1)));
    }
}
__device__ __forceinline__ void mla_prep2(const bf16_t* cq, const bf16_t* ckv, const float* ssq_q, const float* ssq_kv, const float* gq, const float* gkv, float* cqn, float* ckvn) {
    for (size_t i = GTID; i < (size_t)NTOK * 256; i += GTHREADS) { const int r = (int)(i >> 8), c = (int)(i & 255);
        cqn[i] = bf2f(cq[i]) * (1.f / sqrtf(__hip_atomic_load(ssq_q + r, __ATOMIC_RELAXED, __HIP_MEMORY_SCOPE_AGENT) * (1.f / 256.f) + RMS_EPS)) * gq[c]; }
    for (size_t i = GTID; i < (size_t)NTOK * 128; i += GTHREADS) { const int r = (int)(i >> 7), c = (int)(i & 127);
        ckvn[i] = bf2f(ckv[i]) * (1.f / sqrtf(__hip_atomic_load(ssq_kv + r, __ATOMIC_RELAXED, __HIP_MEMORY_SCOPE_AGENT) * (1.f / 128.f) + RMS_EPS)) * gkv[c]; }
}
__host__ __device__ constexpr int rope_nat(int p) { return ((p & 7) < 4) ? 4 * (p >> 3) + (p & 7) : 16 + 4 * (p >> 3) + (p & 7) - 4; }
__device__ __forceinline__ void attn_naive2(const float* q, const float* kv, const bf16_t* kr, float* out) {
    const int lane = threadIdx.x & 63;
    for (int task = GWAVE; task < 2048; task += GWAVES) {
        const int tsk = __builtin_amdgcn_readfirstlane(task);
        const int qc = 63 - (tsk >> 5), h = tsk & 7, b = (tsk >> 3) & 3;
        const int t = qc * 64 + lane; const size_t row = (size_t)b * SEQ + t;
        const float scale = 0.10206207261596575f;
        float qv[96];
#pragma unroll
        for (int d = 0; d < 96; ++d) qv[d] = q[row * 768 + h * 96 + d] * scale;
        float o[64];
#pragma unroll
        for (int d = 0; d < 64; ++d) o[d] = 0.f;
        float m = -INFINITY, l = 0.f;
        const int nk = (qc + 1) * 64;
        for (int s = 0; s < nk; ++s) {
            const size_t kr_ = (size_t)b * SEQ + s;
            const float* kp = kv + kr_ * 1024 + h * 128; const bf16_t* rp = kr + kr_ * 32;
            float sc = 0.f;
#pragma unroll
            for (int d = 0; d < 64; ++d) sc += qv[d] * kp[d];
#pragma unroll
            for (int p = 0; p < 32; ++p) sc += qv[64 + rope_nat(p)] * bf2f(rp[p]);
            const float mn = fmaxf(m, sc); const float corr = expf(m - mn), pe = expf(sc - mn);
            l = l * corr + pe;
#pragma unroll
            for (int d = 0; d < 64; ++d) o[d] = o[d] * corr + pe * kp[64 + d];
            m = mn;
        }
        const float il = 1.f / l;
#pragma unroll
        for (int d = 0; d < 64; ++d) out[row * 512 + h * 64 + d] = o[d] * il;
    }
}
}

struct Args { const float* in[22]; float* out; unsigned char* ws; };
constexpr size_t MiB = 1u << 20;
constexpr size_t WS_CTL = 260 * MiB, CTL_ZERO_BYTES = 1 * MiB;
constexpr int CW_BAR = 1024, CW_CNT = 8192, CW_SSQ_Q = 16384, CW_SSQ_KV = 32768, CW_SSQ_A = 49152;

__global__ void __launch_bounds__(NTHREADS, 2) mega_fwd(Args args) {
    extern __shared__ __attribute__((aligned(16))) unsigned char lds_raw[];
    using namespace nv;
    LAS unsigned char* lds = (LAS unsigned char*)lds_raw;
    volatile LAS unsigned* MISC = (volatile LAS unsigned*)(lds + 131072);
    if (threadIdx.x < 64) MISC[threadIdx.x] = 0u;
    __syncthreads();
    unsigned char* ws = args.ws;
    unsigned* ctl = (unsigned*)(ws + WS_CTL);
    XcdBarrier bar = xcd_barrier_post(ctl + CW_BAR, MISC + 8);
    const float* x = args.in[0]; const int* pos = (const int*)args.in[1]; const float* w_in = args.in[2];
    const float* q_norm_g = args.in[3]; const float* w_uq = args.in[4]; const float* kv_norm_g = args.in[5];
    const float* w_ukv = args.in[6]; const float* mla_out_g = args.in[7]; const float* lbl = args.in[8];
    const float* hg_norm_g = args.in[9]; const float* w_out = args.in[10]; const float* ln1_g = args.in[11];
    const float* ln1_b = args.in[12]; const float* wrg = args.in[13]; const float* brg = args.in[14];
    const float* wre = args.in[15]; const float* bre = args.in[16]; const float* w1 = args.in[17];
    const float* w3 = args.in[18]; const float* w2 = args.in[19]; const float* ln2_g = args.in[20]; const float* ln2_b = args.in[21];
    float* out = args.out;
    typedef op::bf16_t bf16_t;
    float*  lf   = (float*)(ws + 0);
    bf16_t* kk   = (bf16_t*)(ws + 32 * MiB);
    bf16_t* vi   = (bf16_t*)(ws + 48 * MiB);
    bf16_t* qh   = (bf16_t*)(ws + 64 * MiB);
    bf16_t* gh   = (bf16_t*)(ws + 80 * MiB);
    float*  ob   = (float*)(ws + 112 * MiB);
    float*  rr   = (float*)(ws + 144 * MiB);
    float*  cs   = (float*)(ws + 176 * MiB);
    float*  cqn  = (float*)(ws + 178 * MiB);
    float*  ckvn = (float*)(ws + 194 * MiB);
    bf16_t* xb   = (bf16_t*)(ws + 202 * MiB);
    float*  fb   = (float*)(ws + 202 * MiB);
    bf16_t* Win_t = (bf16_t*)(ws + 234 * MiB);
    bf16_t* cq   = (bf16_t*)(ws + 239 * MiB);
    bf16_t* ckv  = (bf16_t*)(ws + 247 * MiB);
    bf16_t* kr   = (bf16_t*)(ws + 251 * MiB);
    float*  qb   = (float*)(ws + 0);
    float*  kvb  = (float*)(ws + 48 * MiB);
    float*  ab   = (float*)(ws + 112 * MiB);
    float*  h1   = (float*)(ws + 0);
    float*  Hb   = (float*)(ws + 176 * MiB);
    float*  accb = (float*)(ws + 64 * MiB);
    int* cnt = (int*)(ctl + CW_CNT);
    float* ssq_q = (float*)(ctl + CW_SSQ_Q); float* ssq_kv = (float*)(ctl + CW_SSQ_KV);
    int* meta = (int*)(ws + WS_CTL + 1 * MiB);
    int* pad_start = meta; int* blk_exp = meta + 256; float* lbt = (float*)(meta + 1024); int* tok_e = meta + 2048; int* tok_rank = tok_e + 2 * NTOK; float* tok_gate = (float*)(tok_rank + 2 * NTOK);
    int* slot_tok = (int*)(tok_gate + 2 * NTOK); float* slot_gate = (float*)(slot_tok + PSLOTS);
    const int wave = __builtin_amdgcn_readfirstlane(threadIdx.x >> 6), lane = threadIdx.x & 63;

    {
        LAS float* scr = (LAS float*)(lds + wave * 16384);
        for (int it = GWAVE; it < (D / 64) * (INC / 32); it += GWAVES) op::transpose_item(w_in, D, INC, Win_t, scr, it, lane, op::RowProj{});
        op::cvt_rows_bf16(x, xb, (size_t)NTOK * D);
        cs_tab(pos, cs);
        lb_tab(lbl, lbt);
    }
    xcd_barrier(bar);
    {
        pg8::Gemm g{xb, Win_t, NTOK, 2560, D}; pg8::StaticOrder S; S.init(NTOK, 2560, (int)gridDim.x, (int)blockIdx.x);
        op::EpiProj E{cq, ckv, kr, kk, vi, lf, ssq_q, ssq_kv, cs, lbt};
        pg8::gemm_phase<op::EpiProj, pg8::StaticOrder, true, true>(lds, g, S, E);
    }
    xcd_barrier(bar);
    hg_f(lf, fb);
    mla_prep2(cq, ckv, ssq_q, ssq_kv, q_norm_g, kv_norm_g, cqn, ckvn);
    xcd_barrier(bar);
    hg_rec2(fb, kk, vi, qh, ob);
    xcd_barrier(bar);
    hg_out2(ob, gh, hg_norm_g, rr);
    xcd_barrier(bar);
    ngemm(lds, NTOK, 768, 256, PlainF{cqn, 256, w_uq, 768, qb, 768});
    ngemm(lds, NTOK, 1024, 128, PlainF{ckvn, 128, w_ukv, 1024, kvb, 1024});
    xcd_barrier(bar);
    q_rope(qb, cs);
    xcd_barrier(bar);
    attn_naive2(qb, kvb, kr, ab);
    xcd_barrier(bar);
    a_norm(ab, mla_out_g);
    xcd_barrier(bar);
    ngemm(lds, NTOK, D, D, MixF{ab, rr, w_out, x, h1});
    xcd_barrier(bar);
    ln_rows(h1, nullptr, 1.f, ln1_g, ln1_b, h1);
    xcd_barrier(bar);
    router(h1, wrg, brg, wre, bre, cnt, tok_e, tok_rank, tok_gate);
    slot_init(slot_tok, slot_gate);
    zero_f32(accb, (size_t)NTOK * D);
    xcd_barrier(bar);
    prefix(cnt, pad_start, blk_exp);
    xcd_barrier(bar);
    slot_fill(tok_e, tok_rank, tok_gate, pad_start, slot_tok, slot_gate);
    xcd_barrier(bar);
    ngemm(lds, PSLOTS, 512, D, Moe1F{h1, slot_tok, blk_exp, w1, Hb, 0});
    xcd_barrier(bar);
    ngemm(lds, PSLOTS, 512, D, Moe1F{h1, slot_tok, blk_exp, w3, Hb, 1});
    xcd_barrier(bar);
    ngemm(lds, PSLOTS, D, 512, Moe2F{Hb, slot_tok, slot_gate, blk_exp, w2, accb});
    xcd_barrier(bar);
    ln_rows(h1, accb, ALPHA, ln2_g, ln2_b, out);
}

extern "C" void kernel_launch(void* const* d_in, const int* in_sizes, int n_in, void* d_out, int out_size, void* d_ws, size_t ws_size, hipStream_t stream) {
    static int grid = 0;
    if (grid == 0) {
        if (n_in != 22 || ws_size < 264 * MiB) { fprintf(stderr, "kernel_launch: unexpected n_in %d / ws %zu\n", n_in, ws_size); grid = -1; return; }
        int dev = 0, cus = 0, per_cu = 0;
        if (hipGetDevice(&dev) != hipSuccess || hipDeviceGetAttribute(&cus, hipDeviceAttributeMultiprocessorCount, dev) != hipSuccess) { grid = -1; return; }
        if (hipFuncSetAttribute((const void*)mega_fwd, hipFuncAttributeMaxDynamicSharedMemorySize, LDS_BYTES) != hipSuccess) { fprintf(stderr, "kernel_launch: hipFuncSetAttribute failed\n"); grid = -1; return; }
        if (hipOccupancyMaxActiveBlocksPerMultiprocessor(&per_cu, (const void*)mega_fwd, NTHREADS, LDS_BYTES) != hipSuccess || per_cu < 1) { fprintf(stderr, "kernel_launch: occupancy query says %d\n", per_cu); (void)hipGetLastError(); }
        grid = cus;
    }
    if (grid < 0) return;
    if (hipMemsetAsync((char*)d_ws + WS_CTL, 0, CTL_ZERO_BYTES, stream) != hipSuccess) return;
    Args a{};
    for (int i = 0; i < 22; ++i) a.in[i] = (const float*)d_in[i];
    a.out = (float*)d_out; a.ws = (unsigned char*)d_ws;
    hipLaunchKernelGGL(mega_fwd, dim3(grid), dim3(NTHREADS), LDS_BYTES, stream, a);
}
```

```cpp
#include <hip/hip_runtime.h>
#include <cstdio>
#include <cstdint>
#include <cmath>

#define LAS __attribute__((address_space(3)))
constexpr int NTHREADS = 512, NWAVES = 8;
constexpr int LDS_BYTES = 147456;

#define XB_TMO      128
#define XB_XCNT(j)  (256  + 64 * (j))
#define XB_XSUB(j)  (1280 + 64 * (j))
#define XB_XGEN(j)  (2304 + 64 * (j))
#define XB_TOP      3328
#define XB_TOPGEN   3392
#define XCD_BAR_WORDS 3456
#define XB_SPIN_CAP (1u << 18)

__device__ __forceinline__ unsigned xb_ld(unsigned* p)              { return __hip_atomic_load(p, __ATOMIC_RELAXED, __HIP_MEMORY_SCOPE_AGENT); }
__device__ __forceinline__ unsigned xb_add(unsigned* p, unsigned v) { return __hip_atomic_fetch_add(p, v, __ATOMIC_RELAXED, __HIP_MEMORY_SCOPE_AGENT); }
__device__ __forceinline__ unsigned xb_xcc_id() { return (unsigned)__builtin_amdgcn_s_getreg((3 << 11) | 20) & 0xFu; }
#define XB_SPIN(cond, bar) do { unsigned _sp = 0; while (cond) { __builtin_amdgcn_s_sleep(1); \
    if ((++_sp & 255u) == 0u) { if (xb_ld(&(bar)[XB_TMO])) break; if (_sp > XB_SPIN_CAP) { atomicAdd(&(bar)[XB_TMO], 1u); break; } } } } while (0)

struct XcdBarrier {
    unsigned* bar; unsigned x;
    volatile LAS unsigned* st;
};

__device__ __forceinline__ XcdBarrier xcd_barrier_post(unsigned* bar, volatile LAS unsigned* st) {
    XcdBarrier b; b.bar = bar; b.x = xb_xcc_id(); b.st = st;
    if (threadIdx.x == 0) (void)xb_add(&bar[XB_XCNT(b.x)], 1u);
    return b;
}
__device__ __forceinline__ void xcd_barrier_complete(unsigned* bar, unsigned x, unsigned& nloc, unsigned& nx) {
    const unsigned G = gridDim.x * gridDim.y * gridDim.z;
    unsigned sum, cnt, mine, sp = 0u;
    for (;;) {
        sum = 0u; cnt = 0u; mine = 0u;
#pragma unroll
        for (unsigned j = 0; j < 16; ++j) { const unsigned c = xb_ld(&bar[XB_XCNT(j)]); sum += c; cnt += (c > 0u) ? 1u : 0u; mine = (j == x) ? c : mine; }
        if (sum == G) break;
        __builtin_amdgcn_s_sleep(1);
        if ((++sp & 255u) == 0u) { if (xb_ld(&bar[XB_TMO])) break; if (sp > XB_SPIN_CAP) { atomicAdd(&bar[XB_TMO], 1u); break; } }
    }
    nloc = mine > 0u ? mine : 1u; nx = cnt > 0u ? cnt : 1u;
}

__device__ __forceinline__ void xcd_barrier(const XcdBarrier& b) {
    asm volatile("s_waitcnt vmcnt(0)" ::: "memory");
    __syncthreads();
    if (threadIdx.x == 0) {
        unsigned* bar = b.bar;
        __builtin_amdgcn_s_waitcnt(0);
        unsigned nloc = b.st[0], nx = b.st[1];
        if (nloc == 0u) { xcd_barrier_complete(bar, b.x, nloc, nx); b.st[0] = nloc; b.st[1] = nx; }
        const unsigned old = xb_add(&bar[XB_XSUB(b.x)], 1u);
        const unsigned gen = old / nloc;
        if (old + 1u == (gen + 1u) * nloc) {
            __builtin_amdgcn_fence(__ATOMIC_RELEASE, "agent");
            asm volatile("s_waitcnt vmcnt(0)" ::: "memory");
            const unsigned og = xb_add(&bar[XB_TOP], 1u);
            const unsigned tg = og / nx;
            if (og + 1u == (tg + 1u) * nx) xb_add(&bar[XB_TOPGEN], 1u);
            else XB_SPIN(xb_ld(&bar[XB_TOPGEN]) == tg, bar);
            __builtin_amdgcn_fence(__ATOMIC_ACQUIRE, "agent");
            xb_add(&bar[XB_XGEN(b.x)], 1u);
            asm volatile("s_waitcnt vmcnt(0)" ::: "memory");
        } else {
            XB_SPIN(xb_ld(&bar[XB_XGEN(b.x)]) == gen, bar);
            __builtin_amdgcn_fence(__ATOMIC_ACQUIRE, "agent");
            asm volatile("s_waitcnt vmcnt(0)" ::: "memory");
        }
    }
    __syncthreads();
}
namespace pg8 {
#define PG8_LAS __attribute__((address_space(3)))
typedef unsigned short bf16_t;
typedef short bf16x8 __attribute__((ext_vector_type(8)));
typedef float f32x4 __attribute__((ext_vector_type(4)));
typedef unsigned u32x4 __attribute__((ext_vector_type(4)));
constexpr int BM = 256, BK = 64, HALF = 128, HTB = HALF * BK * 2  , STAGE_BYTES = 8 * HTB, NXCD = 8, WGM = 8;

__host__ __device__ __forceinline__ int lds_byte(int r, int c) { const int st = (r >> 4) * 2 + (c >> 5), rr = r & 15, cc = c & 31, ob = rr * 64 + cc * 2; return st * 1024 + (ob ^ (((ob >> 9) & 1) << 5)); }
__host__ __device__ __forceinline__ void stage_rc(int b, int& R, int& C) { const int st = b / 1024, sb = b % 1024, swz = sb ^ (((sb >> 9) & 1) << 5); R = (st >> 1) * 16 + swz / 64; C = (st & 1) * 32 + (swz % 64) / 2; }
__host__ __device__ __forceinline__ int perm32(int rho) { const int n = rho >> 4, i = rho & 15; return 8 * (i >> 2) + 4 * n + (i & 3); }

struct Unit { int pm, pn; };
struct Gemm { const bf16_t* A; const bf16_t* Bt; int M, N, K; };

struct StaticOrder {
    int nM, nN, nwg, G, c;
    __host__ __device__ void init(int M, int N, int G_, int c_) { nM = M / BM; nN = N / BM; nwg = nM * nN; G = G_; c = c_; }
    __host__ __device__ bool next(int i, Unit& u) const {
        const long L = (long)i * G + c; if (L >= nwg) return false;
        int wgid = (int)L; { const int q = nwg / NXCD, r = nwg % NXCD, xcd = wgid % NXCD, off = wgid / NXCD; wgid = (xcd < r ? xcd * (q + 1) : r * (q + 1) + (xcd - r) * q) + off; }
        const int nig = WGM * nN, gid = wgid / nig, fm = gid * WGM, gsz = (nM - fm) < WGM ? (nM - fm) : WGM;
        u.pm = fm + ((wgid % nig) % gsz); u.pn = (wgid % nig) / gsz; return true;
    }
    __device__ __forceinline__ void a_ready(const Unit&) const {}
    __device__ __forceinline__ void done(const Unit&) const {}
    __device__ __forceinline__ int arow(const Unit&, int) const { return 0; }
};

__device__ __forceinline__ unsigned cvt_pk_bf16(float lo, float hi) { unsigned r; asm volatile("v_cvt_pk_bf16_f32 %0, %1, %2" : "=v"(r) : "v"(lo), "v"(hi)); return r; }
typedef float f32x2 __attribute__((ext_vector_type(2)));
__device__ __forceinline__ f32x2 gelu_pk(f32x2 v) {
    const f32x2 av = __builtin_elementwise_abs(v), d = av * 0.2316418882f + 1.0f;
    f32x2 t; t.x = __builtin_amdgcn_rcpf(d.x); t.y = __builtin_amdgcn_rcpf(d.y);
    f32x2 q = t * 0.5307027145f + (-0.7265760135f); q = q * t + 0.7107068705f; q = q * t + (-0.142248368f); q = q * t + 0.127414796f; q = q * t;
    const f32x2 s = (v * v) * (-0.72134752044f);
    f32x2 e; e.x = __builtin_amdgcn_exp2f(s.x); e.y = __builtin_amdgcn_exp2f(s.y);
    const f32x2 m = v * (q * e), r = v - m;
    f32x2 o; o.x = v.x < 0.f ? m.x : r.x; o.y = v.y < 0.f ? m.y : r.y; return o;
}

template <int ACT  > struct EpiBf16 {
    static constexpr bool PERM = true, AFTER_DRAIN = false; static_assert(ACT == 0 || ACT == 1, "EpiBf16: ACT is 0 (none) or 1 (gelu_pk)");
    bf16_t* O; int ldc; const float* bias; int split_cols; size_t split_stride; float scale0;
    __device__ __forceinline__ void operator()(const f32x4 (&acc)[2][2][4][2], const Unit& u, int wr, int wc, int fr, int fq) const {
        const int row0 = u.pm * BM + wr * 64 + fr; int colt = u.pn * BM; bf16_t* base = O;
        float sc = 1.f; if (split_cols) { const int t = colt / split_cols; base += (size_t)t * split_stride; colt -= t * split_cols; if (t == 0) sc = scale0; }
        const int col0 = colt + wc * 32 + 8 * fq, bcol0 = u.pn * BM + wc * 32 + 8 * fq;
        f32x4 bv[2][2];
#pragma unroll
        for (int bj = 0; bj < 2; ++bj)
#pragma unroll
            for (int n = 0; n < 2; ++n) bv[bj][n] = bias ? *(const f32x4*)(bias + bcol0 + bj * HALF + 4 * n) : (f32x4){0.f, 0.f, 0.f, 0.f};
#pragma unroll
        for (int ai = 0; ai < 2; ++ai)
#pragma unroll
            for (int m = 0; m < 4; ++m) { bf16_t* rowp = base + (size_t)(row0 + ai * HALF + m * 16) * ldc + col0;
#pragma unroll
                for (int bj = 0; bj < 2; ++bj) { f32x4 v0 = acc[ai][bj][m][0] + bv[bj][0], v1 = acc[ai][bj][m][1] + bv[bj][1];
                    if (ACT == 1) { f32x2 a = gelu_pk((f32x2){v0[0], v0[1]}), b = gelu_pk((f32x2){v0[2], v0[3]}), c = gelu_pk((f32x2){v1[0], v1[1]}), d = gelu_pk((f32x2){v1[2], v1[3]});
                        v0 = (f32x4){a.x, a.y, b.x, b.y}; v1 = (f32x4){c.x, c.y, d.x, d.y}; }
                    v0 = v0 * sc; v1 = v1 * sc; u32x4 w; w.x = cvt_pk_bf16(v0[0], v0[1]); w.y = cvt_pk_bf16(v0[2], v0[3]); w.z = cvt_pk_bf16(v1[0], v1[1]); w.w = cvt_pk_bf16(v1[2], v1[3]);
                    *(u32x4*)(rowp + bj * HALF) = w; } }
    }
};

struct PanelStats {
    unsigned* xbuf;
    unsigned* cnt;
    unsigned* tmo;
    int ntn; float eps;
    unsigned code;
    __device__ __forceinline__ bool run(const f32x4 (&v)[2][2][4][2], const Unit& u, int wr, int wc, int fr, int fq, PG8_LAS unsigned char* lds, int wid, int lane) const {
        typedef float f32x2v __attribute__((ext_vector_type(2)));
        PG8_LAS f32x2v* P = (PG8_LAS f32x2v*)lds;
        PG8_LAS f32x2v* S = (PG8_LAS f32x2v*)(lds + 8192);
        PG8_LAS unsigned* flag = (PG8_LAS unsigned*)(lds + 8192 + 2048);
#pragma unroll
        for (int ai = 0; ai < 2; ++ai)
#pragma unroll
            for (int m = 0; m < 4; ++m) {
                float s = 0.f;
#pragma unroll
                for (int bj = 0; bj < 2; ++bj)
#pragma unroll
                    for (int n = 0; n < 2; ++n) { const f32x4 x = v[ai][bj][m][n]; s += (x[0] + x[1]) + (x[2] + x[3]); }
                s += __shfl_xor(s, 16); s += __shfl_xor(s, 32);
                const float mw = s * (1.0f / 64.0f); float q = 0.f;
#pragma unroll
                for (int bj = 0; bj < 2; ++bj)
#pragma unroll
                    for (int n = 0; n < 2; ++n) { const f32x4 d = v[ai][bj][m][n] - mw; q += (d[0] * d[0] + d[1] * d[1]) + (d[2] * d[2] + d[3] * d[3]); }
                q += __shfl_xor(q, 16); q += __shfl_xor(q, 32);
                if (fq == 0) P[(ai * HALF + wr * 64 + m * 16 + fr) * 4 + wc] = (f32x2v){mw, q};
            }
        asm volatile("s_waitcnt lgkmcnt(0)" ::: "memory"); __builtin_amdgcn_s_barrier(); asm volatile("" ::: "memory");
#if defined(BROKEN_EXCHANGE_NO_WAIT)
#warning BROKEN CONTROL BUILD: the row-statistics exchange does not wait; results are wrong by design
        if (blockIdx.x >= 64) { const long long t0_ = clock64(); while (clock64() - t0_ < 60000) __builtin_amdgcn_s_sleep(8); }
#endif
        const int row = wid * 32 + (lane & 31);
        if (lane < 32) {
            const f32x2v a = P[row * 4 + 0], b = P[row * 4 + 1], c = P[row * 4 + 2], d = P[row * 4 + 3];
            const float mt = (a.x + b.x + c.x + d.x) * 0.25f;
            const float da = a.x - mt, db = b.x - mt, dc = c.x - mt, dd = d.x - mt;
            const float m2 = (a.y + b.y) + (c.y + d.y) + 64.0f * ((da * da + db * db) + (dc * dc + dd * dd));
            unsigned long long* slot = (unsigned long long*)xbuf + ((size_t)(u.pm * BM + row) * 4 + u.pn);
            __hip_atomic_store(slot, ((unsigned long long)__float_as_uint(m2) << 32) | __float_as_uint(mt), __ATOMIC_RELAXED, __HIP_MEMORY_SCOPE_AGENT);
        }
        asm volatile("s_waitcnt vmcnt(0)" ::: "memory");
        if (lane == 0) __hip_atomic_fetch_add(cnt + 64 * u.pm, 1u, __ATOMIC_RELAXED, __HIP_MEMORY_SCOPE_AGENT);
        if (wid == 0) {
            bool dead = false; const unsigned long long t0 = __builtin_amdgcn_s_memrealtime(); const unsigned want = 8u * (unsigned)ntn;
            for (;;) {
#if defined(BROKEN_EXCHANGE_NO_WAIT)
                break;
#endif
                if ((unsigned)__builtin_amdgcn_readfirstlane(__hip_atomic_load(cnt + 64 * u.pm, __ATOMIC_RELAXED, __HIP_MEMORY_SCOPE_AGENT)) >= want) break;
                if (__builtin_amdgcn_s_memrealtime() - t0 > 2000000ull) {
                    if (lane == 0) { unsigned expect = 0u; __hip_atomic_compare_exchange_strong(tmo + 1, &expect, code | (unsigned)(u.pm & 0xff), __ATOMIC_RELAXED, __ATOMIC_RELAXED, __HIP_MEMORY_SCOPE_AGENT);
                                     __hip_atomic_store(tmo, 1u, __ATOMIC_RELAXED, __HIP_MEMORY_SCOPE_AGENT); }
                    dead = true; break; }
                __builtin_amdgcn_s_sleep(2);
            }
            __builtin_amdgcn_fence(__ATOMIC_ACQUIRE, "agent");
            if (lane == 0) flag[0] = dead ? 1u : 0u;
        }
        asm volatile("s_waitcnt vmcnt(0) lgkmcnt(0)" ::: "memory"); __builtin_amdgcn_s_barrier(); asm volatile("" ::: "memory");
        const bool bad = flag[0] != 0u;
        if (lane < 32) {
            const unsigned long long* slot = (const unsigned long long*)xbuf + (size_t)(u.pm * BM + row) * 4; float mt[4], m2[4]; float ms = 0.f;
#pragma unroll
            for (int t = 0; t < 4; ++t) { if (t < ntn) { const unsigned long long w = __hip_atomic_load(slot + t, __ATOMIC_RELAXED, __HIP_MEMORY_SCOPE_AGENT); mt[t] = __uint_as_float((unsigned)w); m2[t] = __uint_as_float((unsigned)(w >> 32)); } else { mt[t] = 0.f; m2[t] = 0.f; } ms += mt[t]; }
            const float mean = ms / (float)ntn; float q = 0.f;
#pragma unroll
            for (int t = 0; t < 4; ++t) if (t < ntn) { const float dm = mt[t] - mean; q += m2[t] + 256.0f * dm * dm; }
            S[row] = (f32x2v){mean, 1.0f / sqrtf(q / (256.0f * (float)ntn) + eps)};
        }
        asm volatile("s_waitcnt lgkmcnt(0)" ::: "memory"); __builtin_amdgcn_s_barrier(); asm volatile("" ::: "memory");
        return bad;
    }
};
struct EpiLnRes {
    static constexpr bool PERM = false, AFTER_DRAIN = true;
    const float* base; float* out; int ldc; const float* bias; PanelStats st; unsigned poison;
    __device__ __forceinline__ void fused(f32x4 (&acc)[2][2][4][2], const Unit& u, int wr, int wc, int fr, int fq, PG8_LAS unsigned char* lds, int wid, int lane) const {
        typedef float f32x2v __attribute__((ext_vector_type(2)));
        const PG8_LAS f32x2v* S = (const PG8_LAS f32x2v*)(lds + 8192);
        const int col0 = u.pn * BM + wc * 32 + 4 * fq;
#pragma unroll
        for (int bj = 0; bj < 2; ++bj)
#pragma unroll
            for (int n = 0; n < 2; ++n) { const f32x4 bv = bias ? *(const f32x4*)(bias + col0 + bj * HALF + n * 16) : (f32x4){0.f, 0.f, 0.f, 0.f};
#pragma unroll
                for (int ai = 0; ai < 2; ++ai)
#pragma unroll
                    for (int m = 0; m < 4; ++m) acc[ai][bj][m][n] += bv; }
        f32x4 pre[4][2][2];
#pragma unroll
        for (int m = 0; m < 4; ++m) { const size_t off = (size_t)(u.pm * BM + wr * 64 + m * 16 + fr) * ldc + col0;
#pragma unroll
            for (int bj = 0; bj < 2; ++bj)
#pragma unroll
                for (int n = 0; n < 2; ++n) pre[m][bj][n] = *(const f32x4*)(base + off + bj * HALF + n * 16); }
        const bool bad = st.run(acc, u, wr, wc, fr, fq, lds, wid, lane) || poison != 0u;
        const float qnan = __builtin_nanf("");
#pragma unroll
        for (int ai = 0; ai < 2; ++ai)
#pragma unroll
            for (int m = 0; m < 4; ++m) { const int r = ai * HALF + wr * 64 + m * 16 + fr; const f32x2v sr = S[r]; const size_t off = (size_t)(u.pm * BM + r) * ldc + col0;
#pragma unroll
                for (int bj = 0; bj < 2; ++bj)
#pragma unroll
                    for (int n = 0; n < 2; ++n) { const f32x4 bs = ai == 0 ? pre[m][bj][n] : *(const f32x4*)(base + off + bj * HALF + n * 16); f32x4 o = bs + (acc[ai][bj][m][n] - sr.x) * sr.y;
                        if (bad) o = (f32x4){qnan, qnan, qnan, qnan}; *(f32x4*)(out + off + bj * HALF + n * 16) = o; }
                if (m & 1) asm volatile("" ::: "memory"); }
    }
};
struct EpiLnResLn {
    static constexpr bool PERM = false, AFTER_DRAIN = true;
    const float* base; float* out; bf16_t* xn; int ldc; const float* bias; PanelStats st1, st2; unsigned poison;
    __device__ __forceinline__ void fused(f32x4 (&acc)[2][2][4][2], const Unit& u, int wr, int wc, int fr, int fq, PG8_LAS unsigned char* lds, int wid, int lane) const {
        typedef float f32x2v __attribute__((ext_vector_type(2))); typedef unsigned u32x2v __attribute__((ext_vector_type(2)));
        const PG8_LAS f32x2v* S = (const PG8_LAS f32x2v*)(lds + 8192);
        const int col0 = u.pn * BM + wc * 32 + 4 * fq;
#pragma unroll
        for (int bj = 0; bj < 2; ++bj)
#pragma unroll
            for (int n = 0; n < 2; ++n) { const f32x4 bv = bias ? *(const f32x4*)(bias + col0 + bj * HALF + n * 16) : (f32x4){0.f, 0.f, 0.f, 0.f};
#pragma unroll
                for (int ai = 0; ai < 2; ++ai)
#pragma unroll
                    for (int m = 0; m < 4; ++m) acc[ai][bj][m][n] += bv; }
        bool bad = st1.run(acc, u, wr, wc, fr, fq, lds, wid, lane) || poison != 0u;
        const float qnan = __builtin_nanf("");
#pragma unroll
        for (int ai = 0; ai < 2; ++ai)
#pragma unroll
            for (int m = 0; m < 4; ++m) { const int r = ai * HALF + wr * 64 + m * 16 + fr; const f32x2v sr = S[r]; const size_t off = (size_t)(u.pm * BM + r) * ldc + col0;
#pragma unroll
                for (int bj = 0; bj < 2; ++bj)
#pragma unroll
                    for (int n = 0; n < 2; ++n) { const f32x4 bs = *(const f32x4*)(base + off + bj * HALF + n * 16); acc[ai][bj][m][n] = bs + (acc[ai][bj][m][n] - sr.x) * sr.y; }
                asm volatile("" : "+v"(acc[ai][0][m][0]), "+v"(acc[ai][0][m][1]), "+v"(acc[ai][1][m][0]), "+v"(acc[ai][1][m][1]));
                if (m & 1) asm volatile("" ::: "memory"); }
        const bool bad1 = bad;
        bad = st2.run(acc, u, wr, wc, fr, fq, lds, wid, lane) || bad;
#pragma unroll
        for (int ai = 0; ai < 2; ++ai)
#pragma unroll
            for (int m = 0; m < 4; ++m) { const int r = ai * HALF + wr * 64 + m * 16 + fr; const f32x2v sr = S[r]; const size_t off = (size_t)(u.pm * BM + r) * ldc + col0;
#pragma unroll
                for (int bj = 0; bj < 2; ++bj)
#pragma unroll
                    for (int n = 0; n < 2; ++n) { const f32x4 x1 = acc[ai][bj][m][n]; *(f32x4*)(out + off + bj * HALF + n * 16) = bad1 ? (f32x4){qnan, qnan, qnan, qnan} : x1;
                        const f32x4 o = (x1 - sr.x) * sr.y; u32x2v w; w.x = cvt_pk_bf16(o[0], o[1]); w.y = cvt_pk_bf16(o[2], o[3]);
                        if (bad) { w.x = 0x7fc07fc0u; w.y = 0x7fc07fc0u; } *(u32x2v*)(xn + off + bj * HALF + n * 16) = w; }
                asm volatile("" ::: "memory"); }
    }
};

template <class Epi, class Sched, bool ALIGN_EPI = false, bool SP2 = false, bool GATHER = false>
__device__ __forceinline__ void gemm_phase(PG8_LAS unsigned char* lds, const Gemm g, const Sched& S, const Epi& E) {
    int tid_ = threadIdx.x; asm volatile("" : "+v"(tid_));
    const int tid = tid_, wid = __builtin_amdgcn_readfirstlane(tid >> 6), lane = tid & 63, wr = wid >> 2, wc = wid & 3, fr = lane & 15, fq = lane >> 4;
    const int K = g.K, nt = K / BK;
    unsigned voffA[2], voffB[2]; int stR[2], stC[2]; static_assert(!GATHER || SP2, "GATHER needs SP2");
#pragma unroll
    for (int i = 0; i < 2; ++i) { int R, C; stage_rc(tid * 16 + i * 8192, R, C); stR[i] = R; stC[i] = C; const int Rb = Epi::PERM ? ((R & ~31) + perm32(R & 31)) : R;
        voffA[i] = (unsigned)(R * K + C) * 2u; voffB[i] = (unsigned)(Rb * K + C) * 2u; }
    const size_t kstep = (size_t)(BK * 2);
    const size_t hstep = (size_t)HALF * K * 2;
    const size_t tstep = 2 * hstep;
    const unsigned ldsw = (unsigned)wid * 1024u;
    const int aoff = lds_byte(wr * 64 + fr, fq * 8), boff = lds_byte(wc * 32 + fr, fq * 8);
#define PG8_SA(b, h) (((b) * 2 + (h)) * HTB)
#define PG8_SB(b, h) ((4 + (b) * 2 + (h)) * HTB)
#define PG8_STAGE(bufoff, gbase, voff) do { _Pragma("unroll") for (int _i = 0; _i < 2; ++_i) \
        __builtin_amdgcn_global_load_lds((const unsigned*)((const char*)(gbase) + (voff)[_i]), (PG8_LAS unsigned*)(lds + (bufoff) + ldsw + _i * 8192), 16, 0, 0); } while (0)
#define PG8_STAGE_A(bufoff, base, h, vsel) do { if constexpr (GATHER) { _Pragma("unroll") for (int _i = 0; _i < 2; ++_i) \
        __builtin_amdgcn_global_load_lds((const unsigned*)((const char*)(base) + (vsel)[h][_i]), (PG8_LAS unsigned*)(lds + (bufoff) + ldsw + _i * 8192), 16, 0, 0); } \
        else { PG8_STAGE(bufoff, (base) + (h) * hstep, voffA); } } while (0)
#define PG8_GOFF(dst, u) do { _Pragma("unroll") for (int _h = 0; _h < 2; ++_h) _Pragma("unroll") for (int _i = 0; _i < 2; ++_i) dst[_h][_i] = (unsigned)S.arow(u, _h * HALF + stR[_i]) * (unsigned)(K * 2) + (unsigned)(stC[_i] * 2); } while (0)
#define PG8_LDA(dst, b, h) do { _Pragma("unroll") for (int m = 0; m < 4; ++m) _Pragma("unroll") for (int k = 0; k < 2; ++k) dst[m][k] = *(const PG8_LAS bf16x8*)(lds + PG8_SA(b, h) + aoff + m * 2048 + k * 1024); } while (0)
#define PG8_LDB(dst, b, h) do { _Pragma("unroll") for (int n = 0; n < 2; ++n) _Pragma("unroll") for (int k = 0; k < 2; ++k) dst[n][k] = *(const PG8_LAS bf16x8*)(lds + PG8_SB(b, h) + boff + n * 2048 + k * 1024); } while (0)
#define PG8_MMA(ai, bj, At, Bt) do { __builtin_amdgcn_s_setprio(1); _Pragma("unroll") for (int m = 0; m < 4; ++m) _Pragma("unroll") for (int n = 0; n < 2; ++n) _Pragma("unroll") for (int k = 0; k < 2; ++k) \
        acc[ai][bj][m][n] = __builtin_amdgcn_mfma_f32_16x16x32_bf16(Bt[n][k], At[m][k], acc[ai][bj][m][n], 0, 0, 0); __builtin_amdgcn_s_setprio(0); } while (0)
#define PG8_WAIT_V(n) asm volatile("s_waitcnt vmcnt(" #n ")" ::: "memory")
#define PG8_WAIT_L(n) asm volatile("s_waitcnt lgkmcnt(" #n ")" ::: "memory")
#define PG8_BAR __builtin_amdgcn_s_barrier()
#define PG8_SCHED __builtin_amdgcn_sched_barrier(0)
    Unit cur, nxt; int ui = 0;
    if (!S.next(0, cur)) return;
    f32x4 acc[2][2][4][2];
#pragma unroll
    for (int a = 0; a < 2; ++a)
#pragma unroll
        for (int b = 0; b < 2; ++b)
#pragma unroll
            for (int m = 0; m < 4; ++m)
#pragma unroll
                for (int n = 0; n < 2; ++n) acc[a][b][m][n] = (f32x4){0.f, 0.f, 0.f, 0.f};
    bf16x8 At[4][2], B0[2][2], B1[2][2];
    unsigned gC[2][2] = {{0u, 0u}, {0u, 0u}}, gN[2][2] = {{0u, 0u}, {0u, 0u}}, gS[2][2] = {{0u, 0u}, {0u, 0u}};
    if constexpr (GATHER) PG8_GOFF(gC, cur);
    const char* cA = GATHER ? (const char*)g.A : (const char*)g.A + (size_t)cur.pm * tstep; const char* cB = (const char*)g.Bt + (size_t)cur.pn * tstep;
    S.a_ready(cur);
    if constexpr (SP2) {
        PG8_STAGE(PG8_SB(0, 0), cB, voffB); PG8_STAGE(PG8_SB(0, 1), cB + hstep, voffB); PG8_STAGE_A(PG8_SA(0, 0), cA, 0, gC); PG8_STAGE_A(PG8_SA(0, 1), cA, 1, gC);
        if (wr == 1) PG8_BAR;
        PG8_WAIT_V(2); PG8_BAR;
        PG8_STAGE(PG8_SB(1, 0), cB + kstep, voffB); PG8_STAGE_A(PG8_SA(1, 0), cA + kstep, 0, gC); PG8_STAGE(PG8_SB(1, 1), cB + hstep + kstep, voffB);
        PG8_WAIT_V(6); PG8_BAR;
    } else {
        PG8_STAGE(PG8_SB(0, 0), cB, voffB); PG8_STAGE(PG8_SA(0, 0), cA, voffA); PG8_STAGE(PG8_SB(0, 1), cB + hstep, voffB); PG8_STAGE(PG8_SA(0, 1), cA + hstep, voffA);
        if (wr == 1) PG8_BAR;
        PG8_WAIT_V(4); PG8_BAR;
        PG8_STAGE(PG8_SB(1, 0), cB + kstep, voffB); PG8_STAGE(PG8_SA(1, 0), cA + kstep, voffA); PG8_STAGE(PG8_SB(1, 1), cB + hstep + kstep, voffB);
        PG8_WAIT_V(6); PG8_BAR;
    }
    for (;;) {
        const bool has_next = S.next(ui + 1, nxt);
        if constexpr (GATHER) { if (has_next) PG8_GOFF(gN, nxt); else { _Pragma("unroll") for (int _h = 0; _h < 2; ++_h) _Pragma("unroll") for (int _i = 0; _i < 2; ++_i) gN[_h][_i] = gC[_h][_i]; } }
        const char* nA = GATHER ? (const char*)g.A : (has_next ? (const char*)g.A + (size_t)nxt.pm * tstep : cA); const char* nB = has_next ? (const char*)g.Bt + (size_t)nxt.pn * tstep : cB;
        for (int t = 0; t < nt; t += 2) {
            const bool last = (t == nt - 2);
            const char* a1 = cA + (size_t)(t + 1) * kstep;
            const char* a2 = last ? nA : cA + (size_t)(t + 2) * kstep; const char* b2 = last ? nB : cB + (size_t)(t + 2) * kstep;
            const char* a3 = a2 + kstep; const char* b3 = b2 + kstep;
            if (last && has_next) S.a_ready(nxt);
            if constexpr (GATHER) { _Pragma("unroll") for (int _h = 0; _h < 2; ++_h) _Pragma("unroll") for (int _i = 0; _i < 2; ++_i) gS[_h][_i] = last ? gN[_h][_i] : gC[_h][_i]; }
            if constexpr (SP2) {
            PG8_LDB(B0, 0, 0); PG8_LDB(B1, 0, 1); PG8_SCHED; PG8_LDA(At, 0, 0); PG8_STAGE_A(PG8_SA(1, 1), a1, 1, gC);
            PG8_WAIT_V(8); PG8_WAIT_L(0); PG8_BAR; PG8_MMA(0, 0, At, B0); PG8_MMA(0, 1, At, B1); PG8_BAR; PG8_SCHED;
            PG8_LDA(At, 0, 1); PG8_STAGE(PG8_SB(0, 0), b2, voffB); PG8_STAGE(PG8_SB(0, 1), b2 + hstep, voffB); PG8_STAGE_A(PG8_SA(0, 0), a2, 0, gS);
            PG8_WAIT_V(8); PG8_WAIT_L(0); PG8_BAR; PG8_MMA(1, 0, At, B0); PG8_MMA(1, 1, At, B1); PG8_BAR; PG8_SCHED;
            PG8_LDB(B0, 1, 0); PG8_LDB(B1, 1, 1); PG8_SCHED; PG8_LDA(At, 1, 0); PG8_STAGE_A(PG8_SA(0, 1), a2, 1, gS);
            PG8_WAIT_V(8); PG8_WAIT_L(0); PG8_BAR; PG8_MMA(0, 0, At, B0); PG8_MMA(0, 1, At, B1); PG8_BAR; PG8_SCHED;
            PG8_LDA(At, 1, 1); PG8_STAGE(PG8_SB(1, 0), b3, voffB); PG8_STAGE(PG8_SB(1, 1), b3 + hstep, voffB); PG8_STAGE_A(PG8_SA(1, 0), a3, 0, gS);
            PG8_WAIT_V(8); PG8_WAIT_L(0); PG8_BAR; PG8_MMA(1, 0, At, B0); PG8_MMA(1, 1, At, B1); PG8_BAR; PG8_SCHED;
            } else {
            PG8_LDB(B0, 0, 0); PG8_SCHED; PG8_LDA(At, 0, 0); PG8_STAGE(PG8_SA(1, 1), a1 + hstep, voffA);
            PG8_WAIT_L(8); PG8_BAR; PG8_WAIT_L(0); PG8_MMA(0, 0, At, B0); PG8_BAR; PG8_SCHED;
            PG8_LDB(B1, 0, 1); PG8_STAGE(PG8_SB(0, 0), b2, voffB);
            PG8_BAR; PG8_WAIT_L(0); PG8_MMA(0, 1, At, B1); PG8_BAR;
            PG8_LDA(At, 0, 1); PG8_STAGE(PG8_SA(0, 0), a2, voffA);
            PG8_BAR; PG8_WAIT_L(0); PG8_MMA(1, 0, At, B0); PG8_BAR; PG8_SCHED;
            PG8_STAGE(PG8_SB(0, 1), b2 + hstep, voffB);
            PG8_WAIT_V(6); PG8_BAR; PG8_MMA(1, 1, At, B1); PG8_BAR;
            PG8_LDB(B0, 1, 0); PG8_SCHED; PG8_LDA(At, 1, 0); PG8_STAGE(PG8_SA(0, 1), a2 + hstep, voffA);
            PG8_WAIT_L(8); PG8_BAR; PG8_WAIT_L(0); PG8_MMA(0, 0, At, B0); PG8_BAR; PG8_SCHED;
            PG8_LDB(B1, 1, 1); PG8_STAGE(PG8_SB(1, 0), b3, voffB);
            PG8_BAR; PG8_WAIT_L(0); PG8_MMA(0, 1, At, B1); PG8_BAR;
            PG8_LDA(At, 1, 1); PG8_STAGE(PG8_SA(1, 0), a3, voffA);
            PG8_BAR; PG8_WAIT_L(0); PG8_MMA(1, 0, At, B0); PG8_BAR; PG8_SCHED;
            PG8_STAGE(PG8_SB(1, 1), b3 + hstep, voffB);
            PG8_WAIT_V(6); PG8_BAR; PG8_MMA(1, 1, At, B1); PG8_BAR;
            }
        }
        if constexpr (ALIGN_EPI) { if (wr == 0) PG8_BAR; }
        if constexpr (!Epi::AFTER_DRAIN) { E(acc, cur, wr, wc, fr, fq); S.done(cur); }
        if (!has_next) break;
#pragma unroll
        for (int a = 0; a < 2; ++a)
#pragma unroll
            for (int b = 0; b < 2; ++b)
#pragma unroll
                for (int m = 0; m < 4; ++m)
#pragma unroll
                    for (int n = 0; n < 2; ++n) acc[a][b][m][n] = (f32x4){0.f, 0.f, 0.f, 0.f};
        cur = nxt; cA = nA; cB = nB; ++ui;
        if constexpr (GATHER) { _Pragma("unroll") for (int _h = 0; _h < 2; ++_h) _Pragma("unroll") for (int _i = 0; _i < 2; ++_i) gC[_h][_i] = gN[_h][_i]; }
        if constexpr (ALIGN_EPI) { if (wr == 1) PG8_BAR; }
    }
    PG8_WAIT_V(0);
    if constexpr (!ALIGN_EPI) { if (wr == 0) PG8_BAR; }
    PG8_BAR;
    if constexpr (Epi::AFTER_DRAIN) { E.fused(acc, cur, wr, wc, fr, fq, lds, wid, lane); S.done(cur); }
#undef PG8_SA
#undef PG8_SB
#undef PG8_STAGE
#undef PG8_STAGE_A
#undef PG8_GOFF
#undef PG8_LDA
#undef PG8_LDB
#undef PG8_MMA
#undef PG8_WAIT_V
#undef PG8_WAIT_L
#undef PG8_BAR
#undef PG8_SCHED
}
}

#ifndef PG8_SP2
#define PG8_SP2 true
#endif
#ifndef PG8_ALIGN
#define PG8_ALIGN true
#endif

namespace nv {
constexpr int NTOK = 16384, D = 1024, SEQ = 4096, INC = 2464;
constexpr int O_CQ = 0, O_CKV = 256, O_KR = 384, O_F = 416, O_I = 928, O_Q = 1440, O_G = 1952;
constexpr int NEXP = 32, PSLOTS = 36864, NBLK = 288;
constexpr float ALPHA = 1.189207115002721f;
constexpr float RMS_EPS = 1e-6f, LN_EPS = 1e-5f;

template <class F>
__device__ __forceinline__ void ngemm(LAS unsigned char* lds, int M, int N, int K, const F& f) {
    LAS float* As = (LAS float*)lds;
    LAS float* Bs = As + 16 * 132;
    const int tid = threadIdx.x, tx = tid & 15, ty = tid >> 4;
    const int tn = (N + 63) / 64, tm = (M + 127) / 128;
    for (int tile = blockIdx.x; tile < tn * tm; tile += gridDim.x) {
        const int m0 = (tile / tn) * 128, n0 = (tile % tn) * 64;
        float acc[4][4];
#pragma unroll
        for (int i = 0; i < 4; ++i)
#pragma unroll
            for (int j = 0; j < 4; ++j) acc[i][j] = 0.f;
        for (int k0 = 0; k0 < K; k0 += 16) {
#pragma unroll
            for (int i = 0; i < 4; ++i) { const int idx = tid + i * 512; const int r = idx >> 4, kk = idx & 15; As[kk * 132 + r] = (m0 + r < M) ? f.a(m0 + r, k0 + kk) : 0.f; }
#pragma unroll
            for (int i = 0; i < 2; ++i) { const int idx = tid + i * 512; const int kk = idx >> 6, c = idx & 63; Bs[kk * 68 + c] = (n0 + c < N) ? f.b(k0 + kk, n0 + c, m0) : 0.f; }
            __syncthreads();
#pragma unroll
            for (int kk = 0; kk < 16; ++kk) {
                float a[4], b[4];
#pragma unroll
                for (int i = 0; i < 4; ++i) { a[i] = As[kk * 132 + ty * 4 + i]; b[i] = Bs[kk * 68 + tx * 4 + i]; }
#pragma unroll
                for (int i = 0; i < 4; ++i)
#pragma unroll
                    for (int j = 0; j < 4; ++j) acc[i][j] += a[i] * b[j];
            }
            __syncthreads();
        }
#pragma unroll
        for (int i = 0; i < 4; ++i)
#pragma unroll
            for (int j = 0; j < 4; ++j) { const int r = m0 + ty * 4 + i, c = n0 + tx * 4 + j; if (r < M && c < N) f.epi(r, c, acc[i][j]); }
    }
}

struct ProjF { const float* x; const float* w; float* out;
    __device__ float a(int r, int k) const { return x[(size_t)r * D + k]; }
    __device__ float b(int k, int c, int) const { return w[(size_t)k * INC + c]; }
    __device__ void epi(int r, int c, float v) const { out[(size_t)r * INC + c] = v; } };
struct PlainF { const float* A; int lda; const float* B; int ldb; float* C; int ldc;
    __device__ float a(int r, int k) const { return A[(size_t)r * lda + k]; }
    __device__ float b(int k, int c, int) const { return B[(size_t)k * ldb + c]; }
    __device__ void epi(int r, int c, float v) const { C[(size_t)r * ldc + c] = v; } };
struct MixF { const float* an; const float* rr; const float* w; const float* x; float* t;
    __device__ float a(int r, int k) const { return k < 512 ? an[(size_t)r * 512 + k] : rr[(size_t)r * 512 + k - 512]; }
    __device__ float b(int k, int c, int) const { return w[(size_t)k * D + c]; }
    __device__ void epi(int r, int c, float v) const { t[(size_t)r * D + c] = ALPHA * x[(size_t)r * D + c] + v; } };
struct Moe1F { const float* h1; const int* slot_tok; const int* blk_exp; const float* w; float* H; int which;
    __device__ float a(int r, int k) const { const int tok = slot_tok[r]; return tok < NTOK ? h1[(size_t)tok * D + k] : 0.f; }
    __device__ float b(int k, int c, int m0) const { const int e = blk_exp[m0 >> 7]; return w[((size_t)e * D + k) * 512 + c]; }
    __device__ void epi(int r, int c, float v) const { float* p = H + (size_t)r * 512 + c; if (which == 0) *p = v / (1.f + expf(-v)); else *p *= v; } };
struct Moe2F { const float* H; const int* slot_tok; const float* slot_gate; const int* blk_exp; const float* w; float* acc;
    __device__ float a(int r, int k) const { return H[(size_t)r * 512 + k]; }
    __device__ float b(int k, int c, int m0) const { const int e = blk_exp[m0 >> 7]; return w[((size_t)e * 512 + k) * D + c]; }
    __device__ void epi(int r, int c, float v) const { const int tok = slot_tok[r]; if (tok < NTOK) atomicAdd(acc + (size_t)tok * D + c, slot_gate[r] * v); } };

__device__ __forceinline__ float wsum(float v) {
#pragma unroll
    for (int o = 1; o < 64; o <<= 1) v += __shfl_xor(v, o);
    return v;
}
#define GTID (blockIdx.x * NTHREADS + threadIdx.x)
#define GTHREADS (gridDim.x * NTHREADS)
#define GWAVE (blockIdx.x * NWAVES + (threadIdx.x >> 6))
#define GWAVES (gridDim.x * NWAVES)

__device__ __forceinline__ void hg_gate(float* proj, const float* lbl) {
    for (int i = GTID; i < NTOK * 512; i += GTHREADS) {
        const int r = i >> 9, c = i & 511;
        const float l0 = lbl[c], l1 = lbl[512 + c]; const float mx = fmaxf(l0, l1);
        const float e0 = expf(l0 - mx), e1 = expf(l1 - mx); const float lb = e0 / (e0 + e1);
        float* p = proj + (size_t)r * INC + O_F + c; const float z = *p;
        *p = lb + (1.f - lb) * (1.f / (1.f + expf(-z)));
    }
}
__device__ __forceinline__ void hg_rec(float* proj) {
    if (blockIdx.x >= 16 || threadIdx.x >= 128) return;
    const int bh = blockIdx.x, b = bh >> 2, h = bh & 3, e = threadIdx.x;
    float S[128];
#pragma unroll
    for (int d = 0; d < 128; ++d) S[d] = 0.f;
    for (int t = 0; t < SEQ; ++t) {
        float* row = proj + (size_t)(b * SEQ + t) * INC;
        const float v = row[O_I + h * 128 + e];
        const float* fr = row + O_F + h * 128; const float* qr = row + O_Q + h * 128;
        float o = 0.f;
#pragma unroll
        for (int d = 0; d < 128; ++d) { const float f = fr[d]; S[d] = f * S[d] + (1.f - f) * v; o += qr[d] * S[d]; }
        row[O_I + h * 128 + e] = o;
    }
}
__device__ __forceinline__ void hg_out(const float* proj, const float* g, float* rr) {
    const int lane = threadIdx.x & 63;
    for (int w = GWAVE; w < NTOK * 4; w += GWAVES) {
        const int r = w >> 2, h = w & 3; const float* row = proj + (size_t)r * INC;
        const float o0 = row[O_I + h * 128 + lane], o1 = row[O_I + h * 128 + 64 + lane];
        const float ss = wsum(o0 * o0 + o1 * o1); const float rs = 1.f / sqrtf(ss * (1.f / 128.f) + RMS_EPS);
        const float g0 = row[O_G + h * 128 + lane], g1 = row[O_G + h * 128 + 64 + lane];
        rr[(size_t)r * 512 + h * 128 + lane] = o0 * rs * g[lane] * (g0 / (1.f + expf(-g0)));
        rr[(size_t)r * 512 + h * 128 + 64 + lane] = o1 * rs * g[64 + lane] * (g1 / (1.f + expf(-g1)));
    }
}
__device__ __forceinline__ void cs_tab(const int* pos, float* cs) {
    for (int i = GTID; i < NTOK * 16; i += GTHREADS) {
        const int j = i & 15, r = i >> 4;
        const float invf = (float)pow(10000.0, -(double)(2 * j) / 32.0);
        const float ang = (float)pos[r] * invf;
        double s, c; sincos((double)ang, &s, &c);
        cs[(size_t)r * 32 + j] = (float)c; cs[(size_t)r * 32 + 16 + j] = (float)s;
    }
}
__device__ __forceinline__ void mla_prep(const float* proj, const float* gq, const float* gkv, const float* cs, float* cqn, float* ckvn, float* kr) {
    const int lane = threadIdx.x & 63;
    for (int r = GWAVE; r < NTOK; r += GWAVES) {
        const float* row = proj + (size_t)r * INC;
        float v[4]; float ss = 0.f;
#pragma unroll
        for (int i = 0; i < 4; ++i) { v[i] = row[O_CQ + lane + 64 * i]; ss += v[i] * v[i]; }
        ss = wsum(ss); float rs = 1.f / sqrtf(ss * (1.f / 256.f) + RMS_EPS);
#pragma unroll
        for (int i = 0; i < 4; ++i) cqn[(size_t)r * 256 + lane + 64 * i] = v[i] * rs * gq[lane + 64 * i];
        float u0 = row[O_CKV + lane], u1 = row[O_CKV + 64 + lane];
        ss = wsum(u0 * u0 + u1 * u1); rs = 1.f / sqrtf(ss * (1.f / 128.f) + RMS_EPS);
        ckvn[(size_t)r * 128 + lane] = u0 * rs * gkv[lane]; ckvn[(size_t)r * 128 + 64 + lane] = u1 * rs * gkv[64 + lane];
        if (lane < 16) { const float x1 = row[O_KR + lane], x2 = row[O_KR + 16 + lane]; const float c = cs[(size_t)r * 32 + lane], s = cs[(size_t)r * 32 + 16 + lane];
            kr[(size_t)r * 32 + lane] = x1 * c - x2 * s; kr[(size_t)r * 32 + 16 + lane] = x2 * c + x1 * s; }
    }
}
__device__ __forceinline__ void q_rope(float* q, const float* cs) {
    for (int i = GTID; i < NTOK * 8 * 16; i += GTHREADS) {
        const int j = i & 15, h = (i >> 4) & 7, r = i >> 7;
        float* p = q + (size_t)r * 768 + h * 96 + 64; const float x1 = p[j], x2 = p[16 + j]; const float c = cs[(size_t)r * 32 + j], s = cs[(size_t)r * 32 + 16 + j];
        p[j] = x1 * c - x2 * s; p[16 + j] = x2 * c + x1 * s;
    }
}
__device__ __forceinline__ void attn_naive(const float* q, const float* kv, const float* kr, float* out) {
    const int lane = threadIdx.x & 63;
    for (int task = GWAVE; task < 2048; task += GWAVES) {
        const int tsk = __builtin_amdgcn_readfirstlane(task);
        const int qc = 63 - (tsk >> 5), h = tsk & 7, b = (tsk >> 3) & 3;
        const int t = qc * 64 + lane; const size_t row = (size_t)b * SEQ + t;
        const float scale = 0.10206207261596575f;
        float qv[96];
#pragma unroll
        for (int d = 0; d < 96; ++d) qv[d] = q[row * 768 + h * 96 + d] * scale;
        float o[64];
#pragma unroll
        for (int d = 0; d < 64; ++d) o[d] = 0.f;
        float m = -INFINITY, l = 0.f;
        const int nk = (qc + 1) * 64;
        for (int s = 0; s < nk; ++s) {
            const size_t kr_ = (size_t)b * SEQ + s;
            const float* kp = kv + kr_ * 1024 + h * 128; const float* rp = kr + kr_ * 32;
            float sc = 0.f;
#pragma unroll
            for (int d = 0; d < 64; ++d) sc += qv[d] * kp[d];
#pragma unroll
            for (int d = 0; d < 32; ++d) sc += qv[64 + d] * rp[d];
            const float mn = fmaxf(m, sc); const float corr = expf(m - mn), p = expf(sc - mn);
            l = l * corr + p;
#pragma unroll
            for (int d = 0; d < 64; ++d) o[d] = o[d] * corr + p * kp[64 + d];
            m = mn;
        }
        const float il = 1.f / l;
#pragma unroll
        for (int d = 0; d < 64; ++d) out[row * 512 + h * 64 + d] = o[d] * il;
    }
}
__device__ __forceinline__ void a_norm(float* a, const float* g) {
    const int lane = threadIdx.x & 63;
    for (int r = GWAVE; r < NTOK; r += GWAVES) {
        float v[8]; float ss = 0.f;
#pragma unroll
        for (int i = 0; i < 8; ++i) { v[i] = a[(size_t)r * 512 + lane + 64 * i]; ss += v[i] * v[i]; }
        ss = wsum(ss); const float rs = 1.f / sqrtf(ss * (1.f / 512.f) + RMS_EPS);
#pragma unroll
        for (int i = 0; i < 8; ++i) a[(size_t)r * 512 + lane + 64 * i] = v[i] * rs * g[lane + 64 * i];
    }
}
__device__ __forceinline__ void ln_rows(const float* in, const float* add, float addscale_in, const float* g, const float* bb, float* out) {
    const int lane = threadIdx.x & 63;
    for (int r = GWAVE; r < NTOK; r += GWAVES) {
        float v[16]; float s = 0.f;
#pragma unroll
        for (int i = 0; i < 16; ++i) { const size_t o = (size_t)r * D + lane + 64 * i; v[i] = addscale_in * in[o] + (add ? add[o] : 0.f); s += v[i]; }
        const float mean = wsum(s) * (1.f / D); float q = 0.f;
#pragma unroll
        for (int i = 0; i < 16; ++i) { v[i] -= mean; q += v[i] * v[i]; }
        const float rs = 1.f / sqrtf(wsum(q) * (1.f / D) + LN_EPS);
#pragma unroll
        for (int i = 0; i < 16; ++i) { const int c = lane + 64 * i; out[(size_t)r * D + c] = v[i] * rs * g[c] + bb[c]; }
    }
}
__device__ __forceinline__ void router(const float* h1, const float* wg, const float* bg, const float* we, const float* be, int* cnt, int* tok_e, int* tok_rank, float* tok_gate) {
    const int lane = threadIdx.x & 63;
    for (int r = GWAVE; r < NTOK; r += GWAVES) {
        float lg[36];
#pragma unroll
        for (int c = 0; c < 36; ++c) lg[c] = 0.f;
        for (int i = 0; i < 16; ++i) { const int k = lane + 64 * i; const float xv = h1[(size_t)r * D + k];
#pragma unroll
            for (int c = 0; c < 4; ++c) lg[c] += xv * wg[k * 4 + c];
#pragma unroll
            for (int c = 0; c < 32; ++c) lg[4 + c] += xv * we[k * 32 + c]; }
#pragma unroll
        for (int c = 0; c < 36; ++c) lg[c] = wsum(lg[c]);
#pragma unroll
        for (int c = 0; c < 4; ++c) lg[c] += bg[c];
#pragma unroll
        for (int c = 0; c < 32; ++c) lg[4 + c] += be[c];
        int grp = 0; float gm = lg[0];
#pragma unroll
        for (int c = 1; c < 4; ++c) if (lg[c] > gm) { gm = lg[c]; grp = c; }
        float den = 0.f;
#pragma unroll
        for (int c = 0; c < 4; ++c) den += expf(lg[c] - gm);
        const float pgrp = 1.f / den;
        float ein[8];
#pragma unroll
        for (int j = 0; j < 8; ++j) ein[j] = grp == 0 ? lg[4 + j] : grp == 1 ? lg[12 + j] : grp == 2 ? lg[20 + j] : lg[28 + j];
        int i0 = 0; float v0 = ein[0];
#pragma unroll
        for (int j = 1; j < 8; ++j) if (ein[j] > v0) { v0 = ein[j]; i0 = j; }
        int i1 = -1; float v1 = -INFINITY;
#pragma unroll
        for (int j = 0; j < 8; ++j) if (j != i0 && ein[j] > v1) { v1 = ein[j]; i1 = j; }
        const float e1 = expf(v1 - v0); const float p0 = 1.f / (1.f + e1), p1 = e1 / (1.f + e1);
        if (lane == 0) {
            const int ea = grp * 8 + i0, eb = grp * 8 + i1;
            tok_e[2 * r] = ea; tok_e[2 * r + 1] = eb;
            tok_rank[2 * r] = atomicAdd(cnt + ea, 1); tok_rank[2 * r + 1] = atomicAdd(cnt + eb, 1);
            tok_gate[2 * r] = pgrp * p0; tok_gate[2 * r + 1] = pgrp * p1;
        }
    }
}
__device__ __forceinline__ void prefix(const int* cnt, int* pad_start, int* blk_exp) {
    if (threadIdx.x != 0 || blockIdx.x != 0) return;
    int acc = 0;
    for (int e = 0; e < NEXP; ++e) { pad_start[e] = acc; acc += ((__hip_atomic_load(cnt + e, __ATOMIC_RELAXED, __HIP_MEMORY_SCOPE_AGENT) + 127) / 128) * 128; pad_start[NEXP + e] = acc; }
    for (int b = 0; b < NBLK; ++b) { int c = 0; for (int e = 0; e < NEXP; ++e) c += (pad_start[NEXP + e] <= b * 128) ? 1 : 0; blk_exp[b] = c < NEXP - 1 ? c : NEXP - 1; }
}
__device__ __forceinline__ void slot_init(int* slot_tok, float* slot_gate) { for (int i = GTID; i < PSLOTS; i += GTHREADS) { slot_tok[i] = NTOK; slot_gate[i] = 0.f; } }
__device__ __forceinline__ void slot_fill(const int* tok_e, const int* tok_rank, const float* tok_gate, const int* pad_start, int* slot_tok, float* slot_gate) {
    for (int i = GTID; i < NTOK * 2; i += GTHREADS) { const int s = pad_start[tok_e[i]] + tok_rank[i]; slot_tok[s] = i >> 1; slot_gate[s] = tok_gate[i]; }
}
__device__ __forceinline__ void zero_f32(float* p, size_t n) { for (size_t i = GTID; i < n / 4; i += GTHREADS) ((float4*)p)[i] = make_float4(0.f, 0.f, 0.f, 0.f); }
}


namespace op {
using pg8::f32x4; using pg8::Unit; using pg8::bf16_t;
typedef unsigned v4u __attribute__((ext_vector_type(4)));
#define GAS __attribute__((address_space(1)))
__device__ __forceinline__ unsigned f2bf(float f) { unsigned u = __builtin_bit_cast(unsigned, f); return (u + 0x7fffu + ((u >> 16) & 1u)) >> 16; }
__device__ __forceinline__ unsigned pk2(float lo, float hi) { return f2bf(lo) | (f2bf(hi) << 16); }
__device__ __forceinline__ float bf2f(unsigned short b) { return __builtin_bit_cast(float, (unsigned)b << 16); }

template <class RowMap>
__device__ __forceinline__ void transpose_item(const float* W, int K, int N, bf16_t* WT, LAS float* scr, int item, int lane, const RowMap& rm) {
    const int nblk = N / 32, kb = item / nblk, nb = item % nblk, k0 = 64 * kb, n0 = 32 * nb;
#pragma unroll 8
    for (int i = 0; i < 32; ++i) { const int kk = 2 * i + (lane >> 5); scr[kk * 33 + (lane & 31)] = rm.scale(n0 + (lane & 31), k0 + kk) * W[(size_t)(k0 + kk) * N + n0 + (lane & 31)]; }
    asm volatile("s_waitcnt lgkmcnt(0)" ::: "memory");
    const int c = lane & 7;
#pragma unroll
    for (int j = 0; j < 4; ++j) { const int n = (lane >> 3) + 8 * j; const LAS float* s = scr + (8 * c) * 33 + n;
        v4u o; o.x = pk2(s[0 * 33], s[1 * 33]); o.y = pk2(s[2 * 33], s[3 * 33]); o.z = pk2(s[4 * 33], s[5 * 33]); o.w = pk2(s[6 * 33], s[7 * 33]);
        *(GAS v4u*)(WT + (size_t)rm.row(n0 + n) * K + k0 + 8 * c) = o; }
    asm volatile("s_waitcnt lgkmcnt(0)" ::: "memory");
}
struct RowId { __device__ __forceinline__ int row(int n) const { return n; } __device__ __forceinline__ float scale(int, int) const { return 1.f; } };

__device__ __forceinline__ void cvt_rows_bf16(const float* src, bf16_t* dst, size_t n) {
    for (size_t i = GTID; i < n / 8; i += GTHREADS) { const float4 a = ((const float4*)src)[2 * i], b = ((const float4*)src)[2 * i + 1];
        v4u o; o.x = pk2(a.x, a.y); o.y = pk2(a.z, a.w); o.z = pk2(b.x, b.y); o.w = pk2(b.z, b.w); ((v4u*)dst)[i] = o; }
}

struct EpiF32Nat { static constexpr bool PERM = false, AFTER_DRAIN = false;
    float* C; int ldc; int ncols;
    __device__ __forceinline__ void operator()(const f32x4 (&acc)[2][2][4][2], const Unit& u, int wr, int wc, int fr, int fq) const {
        const int row0 = u.pm * 256 + wr * 64 + fr, col0 = u.pn * 256 + wc * 32 + 4 * fq;
#pragma unroll
        for (int ai = 0; ai < 2; ++ai)
#pragma unroll
            for (int m = 0; m < 4; ++m) { float* rowp = C + (size_t)(row0 + ai * 128 + m * 16) * ldc;
#pragma unroll
                for (int bj = 0; bj < 2; ++bj)
#pragma unroll
                    for (int n = 0; n < 2; ++n) { const int c = col0 + bj * 128 + n * 16; if (c < ncols) *(f32x4*)(rowp + c) = acc[ai][bj][m][n]; } }
    }
};
}

namespace op {
struct RowProj {
    __device__ __forceinline__ int row(int n) const {
        if (n < 384) return n;
        if (n < 416) { const int j = n - 384, jj = j & 15, a = jj >> 2, b = jj & 3; return 384 + 8 * a + b + (j >= 16 ? 4 : 0); }
        return n + 96;
    }
    __device__ __forceinline__ float scale(int, int) const { return 1.f; }
};
__device__ __forceinline__ v4u pack8(const f32x4& v0, const f32x4& v1) { v4u w; w.x = pk2(v0[0], v0[1]); w.y = pk2(v0[2], v0[3]); w.z = pk2(v1[0], v1[1]); w.w = pk2(v1[2], v1[3]); return w; }
__device__ __forceinline__ float dot4(const f32x4& v) { return (v[0] * v[0] + v[1] * v[1]) + (v[2] * v[2] + v[3] * v[3]); }

struct EpiProj { static constexpr bool PERM = true, AFTER_DRAIN = false;
    bf16_t *cq, *ckv, *kr, *kk, *vi; float* lf; float *ssq_q, *ssq_kv; const float* cs; const float* lbt;
    __device__ __forceinline__ void operator()(const f32x4 (&acc)[2][2][4][2], const Unit& u, int wr, int wc, int fr, int fq) const {
        const int pn = u.pn; const int row0 = u.pm * 256 + wr * 64 + fr; const int cl = wc * 32 + 8 * fq;
        if (pn == 0) {
#pragma unroll
            for (int ai = 0; ai < 2; ++ai)
#pragma unroll
                for (int m = 0; m < 4; ++m) { const int row = row0 + ai * 128 + m * 16; float s = 0.f;
#pragma unroll
                    for (int bj = 0; bj < 2; ++bj) { const f32x4 v0 = acc[ai][bj][m][0], v1 = acc[ai][bj][m][1]; s += dot4(v0) + dot4(v1);
                        *(v4u*)(cq + (size_t)row * 256 + bj * 128 + cl) = pack8(v0, v1); }
                    s += __shfl_xor(s, 16); s += __shfl_xor(s, 32); if (fq == 0) atomicAdd(ssq_q + row, s); }
        } else if (pn == 1) {
#pragma unroll
            for (int ai = 0; ai < 2; ++ai)
#pragma unroll
                for (int m = 0; m < 4; ++m) { const int row = row0 + ai * 128 + m * 16;
                    const f32x4 v0 = acc[ai][0][m][0], v1 = acc[ai][0][m][1]; float s = dot4(v0) + dot4(v1);
                    *(v4u*)(ckv + (size_t)row * 128 + cl) = pack8(v0, v1);
                    s += __shfl_xor(s, 16); s += __shfl_xor(s, 32); if (fq == 0) atomicAdd(ssq_kv + row, s);
                    if (wc == 0) { const f32x4 x1 = acc[ai][1][m][0], x2 = acc[ai][1][m][1];
                        const f32x4 c = *(const f32x4*)(cs + (size_t)row * 32 + 4 * fq), sn = *(const f32x4*)(cs + (size_t)row * 32 + 16 + 4 * fq);
                        *(v4u*)(kr + (size_t)row * 32 + 8 * fq) = pack8(x1 * c - x2 * sn, x2 * c + x1 * sn); } }
        } else if (pn < 4) {
            const int cb = (pn - 2) * 256;
#pragma unroll
            for (int bj = 0; bj < 2; ++bj) { const int col = cb + bj * 128 + cl;
#pragma unroll
                for (int n = 0; n < 2; ++n) { const f32x4 lb = *(const f32x4*)(lbt + col + 4 * n);
#pragma unroll
                    for (int ai = 0; ai < 2; ++ai)
#pragma unroll
                        for (int m = 0; m < 4; ++m) { const int row = row0 + ai * 128 + m * 16; f32x4 l, k;
#pragma unroll
                            for (int i = 0; i < 4; ++i) { const float e = __expf(-acc[ai][bj][m][n][i]), sg = __builtin_amdgcn_rcpf(1.f + e); const float om = 1.f - lb[i]; l[i] = __logf(lb[i] + om * sg); k[i] = om * e * sg; }
                            *(f32x4*)(lf + (size_t)row * 512 + col + 4 * n) = l;
                            typedef unsigned v2u __attribute__((ext_vector_type(2))); v2u w; w.x = pk2(k[0], k[1]); w.y = pk2(k[2], k[3]);
                            *(v2u*)(kk + (size_t)row * 512 + col + 4 * n) = w;
                            asm volatile("" ::: "memory"); } } }
        } else {
            bf16_t* dst = vi + (size_t)((pn - 4) >> 1) * ((size_t)16384 * 512); const int cb = (pn & 1) * 256;
#pragma unroll
            for (int ai = 0; ai < 2; ++ai)
#pragma unroll
                for (int m = 0; m < 4; ++m) { const int row = row0 + ai * 128 + m * 16;
#pragma unroll
                    for (int bj = 0; bj < 2; ++bj) *(v4u*)(dst + (size_t)row * 512 + cb + bj * 128 + cl) = pack8(acc[ai][bj][m][0], acc[ai][bj][m][1]); }
        }
    }
};
}

namespace nv {
using op::bf2f; typedef unsigned short bf16_t;
__device__ __forceinline__ void lb_tab(const float* lbl, float* lbt) {
    for (int c = GTID; c < 512; c += GTHREADS) { const float l0 = lbl[c], l1 = lbl[512 + c]; const float mx = fmaxf(l0, l1); const float e0 = expf(l0 - mx), e1 = expf(l1 - mx); lbt[c] = e0 / (e0 + e1); }
}
__device__ __forceinline__ void hg_f(const float* lf, float* fb) { for (size_t i = GTID; i < (size_t)NTOK * 512; i += GTHREADS) fb[i] = expf(lf[i]); }
__device__ __forceinline__ void hg_rec2(const float* fb, const bf16_t* kk, const bf16_t* vi, const bf16_t* qh, float* ob) {
    if (blockIdx.x >= 16 || threadIdx.x >= 128) return;
    const int bh = blockIdx.x, b = bh >> 2, h = bh & 3, e = threadIdx.x;
    float S[128];
#pragma unroll
    for (int d = 0; d < 128; ++d) S[d] = 0.f;
    for (int t = 0; t < SEQ; ++t) {
        const size_t base = (size_t)(b * SEQ + t) * 512 + h * 128;
        const float v = bf2f(vi[base + e]);
        float o = 0.f;
#pragma unroll
        for (int d = 0; d < 128; ++d) { const float f = fb[base + d]; S[d] = f * S[d] + bf2f(kk[base + d]) * v; o += bf2f(qh[base + d]) * S[d]; }
        ob[base + e] = o;
    }
}
__device__ __forceinline__ void hg_out2(const float* ob, const bf16_t* gh, const float* g, float* rr) {
    const int lane = threadIdx.x & 63;
    for (int w = GWAVE; w < NTOK * 4; w += GWAVES) {
        const size_t base = (size_t)(w >> 2) * 512 + (w & 3) * 128;
        const float o0 = ob[base + lane], o1 = ob[base + 64 + lane];
        const float ss = wsum(o0 * o0 + o1 * o1); const float rs = 1.f / sqrtf(ss * (1.f / 128.f) + RMS_EPS);
        const float g0 = bf2f(gh[base + lane]), g1 = bf2f(gh[base + 64 + lane]);
        rr[base + lane] = o0 * rs * g[lane] * (g0 / (1.f + expf(-g0)));
        rr[base + 64 + lane] = o1 * rs * g[64 + lane] * (g1 / (1.f + expf(-g1)));
    }
}
__device__ __forceinline__ void mla_prep2(const bf16_t* cq, const bf16_t* ckv, const float* ssq_q, const float* ssq_kv, const float* gq, const float* gkv, float* cqn, float* ckvn) {
    for (size_t i = GTID; i < (size_t)NTOK * 256; i += GTHREADS) { const int r = (int)(i >> 8), c = (int)(i & 255);
        cqn[i] = bf2f(cq[i]) * (1.f / sqrtf(__hip_atomic_load(ssq_q + r, __ATOMIC_RELAXED, __HIP_MEMORY_SCOPE_AGENT) * (1.f / 256.f) + RMS_EPS)) * gq[c]; }
    for (size_t i = GTID; i < (size_t)NTOK * 128; i += GTHREADS) { const int r = (int)(i >> 7), c = (int)(i & 127);
        ckvn[i] = bf2f(ckv[i]) * (1.f / sqrtf(__hip_atomic_load(ssq_kv + r, __ATOMIC_RELAXED, __HIP_MEMORY_SCOPE_AGENT) * (1.f / 128.f) + RMS_EPS)) * gkv[c]; }
}
__host__ __device__ constexpr int rope_nat(int p) { return ((p & 7) < 4) ? 4 * (p >> 3) + (p & 7) : 16 + 4 * (p >> 3) + (p & 7) - 4; }
__device__ __forceinline__ void attn_naive2(const float* q, const float* kv, const bf16_t* kr, float* out) {
    const int lane = threadIdx.x & 63;
    for (int task = GWAVE; task < 2048; task += GWAVES) {
        const int tsk = __builtin_amdgcn_readfirstlane(task);
        const int qc = 63 - (tsk >> 5), h = tsk & 7, b = (tsk >> 3) & 3;
        const int t = qc * 64 + lane; const size_t row = (size_t)b * SEQ + t;
        const float scale = 0.10206207261596575f;
        float qv[96];
#pragma unroll
        for (int d = 0; d < 96; ++d) qv[d] = q[row * 768 + h * 96 + d] * scale;
        float o[64];
#pragma unroll
        for (int d = 0; d < 64; ++d) o[d] = 0.f;
        float m = -INFINITY, l = 0.f;
        const int nk = (qc + 1) * 64;
        for (int s = 0; s < nk; ++s) {
            const size_t kr_ = (size_t)b * SEQ + s;
            const float* kp = kv + kr_ * 1024 + h * 128; const bf16_t* rp = kr + kr_ * 32;
            float sc = 0.f;
#pragma unroll
            for (int d = 0; d < 64; ++d) sc += qv[d] * kp[d];
#pragma unroll
            for (int p = 0; p < 32; ++p) sc += qv[64 + rope_nat(p)] * bf2f(rp[p]);
            const float mn = fmaxf(m, sc); const float corr = expf(m - mn), pe = expf(sc - mn);
            l = l * corr + pe;
#pragma unroll
            for (int d = 0; d < 64; ++d) o[d] = o[d] * corr + pe * kp[64 + d];
            m = mn;
        }
        const float il = 1.f / l;
#pragma unroll
        for (int d = 0; d < 64; ++d) out[row * 512 + h * 64 + d] = o[d] * il;
    }
}
}

namespace op {
constexpr int MOE_CAP = 16384, MOE_MAXT = 160;
__device__ __forceinline__ void moe_build_tab(LAS int* tab, const int* cnt, int* tstart_g) {
    if (threadIdx.x < 64) {
        const int e = threadIdx.x & 31; const int c = __hip_atomic_load(cnt + e, __ATOMIC_RELAXED, __HIP_MEMORY_SCOPE_AGENT); const int t = (c + 255) >> 8;
        int incl = t;
#pragma unroll
        for (int o = 1; o < 32; o <<= 1) { const int v = __shfl_up(incl, o, 32); if (e >= o) incl += v; }
        const int start = incl - t;
        if (threadIdx.x < 32) { tab[1 + e] = c; tab[33 + e] = start; if (e == 31) tab[0] = incl; for (int j = 0; j < t; ++j) tab[65 + start + j] = e;
            if (blockIdx.x == 0 && tstart_g) tstart_g[e] = start; }
    }
    __syncthreads();
}
struct MoeOrder {
    const LAS int* tab; int G, c; const int* stok;
    __device__ __forceinline__ bool next(int i, Unit& u) const { const int L = i * G + c; const int T = tab[0]; if (L >= 4 * T) return false; const int mt = L >> 2; u.pm = mt; u.pn = tab[65 + mt] * 4 + (L & 3); return true; }
    __device__ __forceinline__ void a_ready(const Unit&) const {}
    __device__ __forceinline__ void done(const Unit&) const {}
    __device__ __forceinline__ int arow(const Unit& u, int r) const { const int e = u.pn >> 2; const int idx = (u.pm - tab[33 + e]) * 256 + r; return idx < tab[1 + e] ? stok[e * MOE_CAP + idx] : 16384; }
};
struct RowW13 { int which; __device__ __forceinline__ int row(int n) const { return 8 * (n >> 2) + (n & 3) + 4 * which; } __device__ __forceinline__ float scale(int, int) const { return 1.f; } };
struct RowScaleK { const float* g; int klim; __device__ __forceinline__ int row(int n) const { return n; } __device__ __forceinline__ float scale(int, int k) const { return k < klim ? g[k] : 1.f; } };

typedef unsigned v2u __attribute__((ext_vector_type(2)));
struct EpiMoe1 { static constexpr bool PERM = true, AFTER_DRAIN = false;
    bf16_t* H;
    __device__ __forceinline__ void operator()(const f32x4 (&acc)[2][2][4][2], const Unit& u, int wr, int wc, int fr, int fq) const {
        const int row0 = u.pm * 256 + wr * 64 + fr, col0 = 128 * (u.pn & 3) + 16 * wc + 4 * fq;
#pragma unroll
        for (int ai = 0; ai < 2; ++ai)
#pragma unroll
            for (int m = 0; m < 4; ++m) { bf16_t* rowp = H + (size_t)(row0 + ai * 128 + m * 16) * 512 + col0;
#pragma unroll
                for (int bj = 0; bj < 2; ++bj) { const f32x4 a = acc[ai][bj][m][0], b = acc[ai][bj][m][1]; float h[4];
#pragma unroll
                    for (int i = 0; i < 4; ++i) h[i] = a[i] * __builtin_amdgcn_rcpf(1.f + __expf(-a[i])) * b[i];
                    v2u w; w.x = pk2(h[0], h[1]); w.y = pk2(h[2], h[3]); *(v2u*)(rowp + 64 * bj) = w; } }
    }
};
struct EpiBf16P { static constexpr bool PERM = true, AFTER_DRAIN = false;
    bf16_t* O; int ldc; int pmask;
    __device__ __forceinline__ void operator()(const f32x4 (&acc)[2][2][4][2], const Unit& u, int wr, int wc, int fr, int fq) const {
        const int row0 = u.pm * 256 + wr * 64 + fr, col0 = 256 * (u.pn & pmask) + 32 * wc + 8 * fq;
#pragma unroll
        for (int ai = 0; ai < 2; ++ai)
#pragma unroll
            for (int m = 0; m < 4; ++m) { bf16_t* rowp = O + (size_t)(row0 + ai * 128 + m * 16) * ldc + col0;
#pragma unroll
                for (int bj = 0; bj < 2; ++bj) *(v4u*)(rowp + 128 * bj) = pack8(acc[ai][bj][m][0], acc[ai][bj][m][1]); }
    }
};
struct EpiMix { static constexpr bool PERM = false, AFTER_DRAIN = false;
    const float* x; float* t; float alpha;
    __device__ __forceinline__ void operator()(const f32x4 (&acc)[2][2][4][2], const Unit& u, int wr, int wc, int fr, int fq) const {
        const int row0 = u.pm * 256 + wr * 64 + fr, col0 = u.pn * 256 + wc * 32 + 4 * fq;
#pragma unroll
        for (int ai = 0; ai < 2; ++ai)
#pragma unroll
            for (int m = 0; m < 4; ++m) { const size_t ro = (size_t)(row0 + ai * 128 + m * 16) * 1024 + col0;
#pragma unroll
                for (int bj = 0; bj < 2; ++bj)
#pragma unroll
                    for (int n = 0; n < 2; ++n) { const size_t o = ro + bj * 128 + n * 16; *(f32x4*)(t + o) = alpha * *(const f32x4*)(x + o) + acc[ai][bj][m][n]; } }
    }
};
}

namespace nv {
__device__ __forceinline__ void a_norm2(const float* a, const float* g, bf16_t* AR) {
    const int lane = threadIdx.x & 63;
    for (int r = GWAVE; r < NTOK; r += GWAVES) {
        float v[8]; float ss = 0.f;
#pragma unroll
        for (int i = 0; i < 8; ++i) { v[i] = a[(size_t)r * 512 + lane + 64 * i]; ss += v[i] * v[i]; }
        ss = wsum(ss); const float rs = 1.f / sqrtf(ss * (1.f / 512.f) + RMS_EPS);
#pragma unroll
        for (int i = 0; i < 8; ++i) AR[(size_t)r * 1024 + lane + 64 * i] = (bf16_t)op::f2bf(v[i] * rs * g[lane + 64 * i]);
    }
}
__device__ __forceinline__ void hg_out3(const float* ob, const bf16_t* gh, const float* g, bf16_t* AR) {
    const int lane = threadIdx.x & 63;
    for (int w = GWAVE; w < NTOK * 4; w += GWAVES) {
        const size_t base = (size_t)(w >> 2) * 512 + (w & 3) * 128; const size_t ob_ = (size_t)(w >> 2) * 1024 + 512 + (w & 3) * 128;
        const float o0 = ob[base + lane], o1 = ob[base + 64 + lane];
        const float ss = wsum(o0 * o0 + o1 * o1); const float rs = 1.f / sqrtf(ss * (1.f / 128.f) + RMS_EPS);
        const float g0 = bf2f(gh[base + lane]), g1 = bf2f(gh[base + 64 + lane]);
        AR[ob_ + lane] = (bf16_t)op::f2bf(o0 * rs * g[lane] * (g0 / (1.f + expf(-g0))));
        AR[ob_ + 64 + lane] = (bf16_t)op::f2bf(o1 * rs * g[64 + lane] * (g1 / (1.f + expf(-g1))));
    }
}
__device__ __forceinline__ void ln_rows2(float* h, const float* g, const float* bb, bf16_t* hb) {
    const int lane = threadIdx.x & 63;
    for (int r = GWAVE; r < NTOK; r += GWAVES) {
        float v[16]; float s = 0.f;
#pragma unroll
        for (int i = 0; i < 16; ++i) { v[i] = h[(size_t)r * D + lane + 64 * i]; s += v[i]; }
        const float mean = wsum(s) * (1.f / D); float q = 0.f;
#pragma unroll
        for (int i = 0; i < 16; ++i) { v[i] -= mean; q += v[i] * v[i]; }
        const float rs = 1.f / sqrtf(wsum(q) * (1.f / D) + LN_EPS);
#pragma unroll
        for (int i = 0; i < 16; ++i) { const int c = lane + 64 * i; const float o = v[i] * rs * g[c] + bb[c]; h[(size_t)r * D + c] = o; hb[(size_t)r * D + c] = (bf16_t)op::f2bf(o); }
    }
    if (blockIdx.x == 0) for (int c = threadIdx.x; c < D; c += NTHREADS) hb[(size_t)NTOK * D + c] = 0;
}
__device__ __forceinline__ void router2(const float* h1, const float* wg, const float* bg, const float* we, const float* be, int* cnt, int* tok_e, int* tok_rank, float* tok_gate, int* stok) {
    const int lane = threadIdx.x & 63;
    for (int r = GWAVE; r < NTOK; r += GWAVES) {
        float lg[36];
#pragma unroll
        for (int c = 0; c < 36; ++c) lg[c] = 0.f;
        for (int i = 0; i < 16; ++i) { const int k = lane + 64 * i; const float xv = h1[(size_t)r * D + k];
#pragma unroll
            for (int c = 0; c < 4; ++c) lg[c] += xv * wg[k * 4 + c];
#pragma unroll
            for (int c = 0; c < 32; ++c) lg[4 + c] += xv * we[k * 32 + c]; }
#pragma unroll
        for (int c = 0; c < 36; ++c) lg[c] = wsum(lg[c]);
#pragma unroll
        for (int c = 0; c < 4; ++c) lg[c] += bg[c];
#pragma unroll
        for (int c = 0; c < 32; ++c) lg[4 + c] += be[c];
        int grp = 0; float gm = lg[0];
#pragma unroll
        for (int c = 1; c < 4; ++c) if (lg[c] > gm) { gm = lg[c]; grp = c; }
        float den = 0.f;
#pragma unroll
        for (int c = 0; c < 4; ++c) den += expf(lg[c] - gm);
        const float pgrp = 1.f / den;
        float ein[8];
#pragma unroll
        for (int j = 0; j < 8; ++j) ein[j] = grp == 0 ? lg[4 + j] : grp == 1 ? lg[12 + j] : grp == 2 ? lg[20 + j] : lg[28 + j];
        int i0 = 0; float v0 = ein[0];
#pragma unroll
        for (int j = 1; j < 8; ++j) if (ein[j] > v0) { v0 = ein[j]; i0 = j; }
        int i1 = -1; float v1 = -INFINITY;
#pragma unroll
        for (int j = 0; j < 8; ++j) if (j != i0 && ein[j] > v1) { v1 = ein[j]; i1 = j; }
        const float e1 = expf(v1 - v0); const float p0 = 1.f / (1.f + e1), p1 = e1 / (1.f + e1);
        if (lane == 0) {
            const int ea = grp * 8 + i0, eb = grp * 8 + i1;
            const int ra = atomicAdd(cnt + ea, 1), rb = atomicAdd(cnt + eb, 1);
            tok_e[2 * r] = ea; tok_e[2 * r + 1] = eb; tok_rank[2 * r] = ra; tok_rank[2 * r + 1] = rb;
            tok_gate[2 * r] = pgrp * p0; tok_gate[2 * r + 1] = pgrp * p1;
            stok[ea * op::MOE_CAP + ra] = r; stok[eb * op::MOE_CAP + rb] = r;
        }
    }
}
__device__ __forceinline__ void ln2_rows(const float* h1, const bf16_t* Y, const int* tok_e, const int* tok_rank, const float* tok_gate, const int* tstart, const float* g, const float* bb, float* out) {
    const int lane = threadIdx.x & 63;
    for (int r = GWAVE; r < NTOK; r += GWAVES) {
        const size_t r0 = (size_t)tstart[tok_e[2 * r]] * 256 + tok_rank[2 * r], r1 = (size_t)tstart[tok_e[2 * r + 1]] * 256 + tok_rank[2 * r + 1];
        const float g0 = tok_gate[2 * r], g1 = tok_gate[2 * r + 1];
        float v[16]; float s = 0.f;
#pragma unroll
        for (int i = 0; i < 16; ++i) { const int c = lane + 64 * i; v[i] = ALPHA * h1[(size_t)r * D + c] + g0 * bf2f(Y[r0 * D + c]) + g1 * bf2f(Y[r1 * D + c]); s += v[i]; }
        const float mean = wsum(s) * (1.f / D); float q = 0.f;
#pragma unroll
        for (int i = 0; i < 16; ++i) { v[i] -= mean; q += v[i] * v[i]; }
        const float rs = 1.f / sqrtf(wsum(q) * (1.f / D) + LN_EPS);
#pragma unroll
        for (int i = 0; i < 16; ++i) { const int c = lane + 64 * i; out[(size_t)r * D + c] = v[i] * rs * g[c] + bb[c]; }
    }
}
}

struct Args { const float* in[22]; float* out; unsigned char* ws; };
constexpr size_t MiB = 1u << 20;
constexpr size_t WS_CTL = 260 * MiB, CTL_ZERO_BYTES = 1 * MiB;
constexpr int CW_BAR = 1024, CW_CNT = 8192, CW_SSQ_Q = 16384, CW_SSQ_KV = 32768, CW_SSQ_A = 49152;

__global__ void __launch_bounds__(NTHREADS, 2) mega_fwd(Args args) {
    extern __shared__ __attribute__((aligned(16))) unsigned char lds_raw[];
    using namespace nv;
    LAS unsigned char* lds = (LAS unsigned char*)lds_raw;
    volatile LAS unsigned* MISC = (volatile LAS unsigned*)(lds + 131072);
    if (threadIdx.x < 64) MISC[threadIdx.x] = 0u;
    __syncthreads();
    unsigned char* ws = args.ws;
    unsigned* ctl = (unsigned*)(ws + WS_CTL);
    XcdBarrier bar = xcd_barrier_post(ctl + CW_BAR, MISC + 8);
    const float* x = args.in[0]; const int* pos = (const int*)args.in[1]; const float* w_in = args.in[2];
    const float* q_norm_g = args.in[3]; const float* w_uq = args.in[4]; const float* kv_norm_g = args.in[5];
    const float* w_ukv = args.in[6]; const float* mla_out_g = args.in[7]; const float* lbl = args.in[8];
    const float* hg_norm_g = args.in[9]; const float* w_out = args.in[10]; const float* ln1_g = args.in[11];
    const float* ln1_b = args.in[12]; const float* wrg = args.in[13]; const float* brg = args.in[14];
    const float* wre = args.in[15]; const float* bre = args.in[16]; const float* w1 = args.in[17];
    const float* w3 = args.in[18]; const float* w2 = args.in[19]; const float* ln2_g = args.in[20]; const float* ln2_b = args.in[21];
    float* out = args.out;
    typedef op::bf16_t bf16_t;
    float*  lf   = (float*)(ws + 0);
    bf16_t* kk   = (bf16_t*)(ws + 32 * MiB);
    bf16_t* vi   = (bf16_t*)(ws + 48 * MiB);
    bf16_t* qh   = (bf16_t*)(ws + 64 * MiB);
    bf16_t* gh   = (bf16_t*)(ws + 80 * MiB);
    float*  ob   = (float*)(ws + 112 * MiB);
    bf16_t* AR   = (bf16_t*)(ws + 144 * MiB);
    float*  cs   = (float*)(ws + 176 * MiB);
    float*  cqn  = (float*)(ws + 178 * MiB);
    float*  ckvn = (float*)(ws + 194 * MiB);
    bf16_t* xb   = (bf16_t*)(ws + 202 * MiB);
    float*  fb   = (float*)(ws + 202 * MiB);
    bf16_t* Win_t = (bf16_t*)(ws + 234 * MiB);
    bf16_t* cq   = (bf16_t*)(ws + 239 * MiB);
    bf16_t* ckv  = (bf16_t*)(ws + 247 * MiB);
    bf16_t* kr   = (bf16_t*)(ws + 251 * MiB);
    bf16_t* Wout_t = (bf16_t*)(ws + 252 * MiB);
    float*  qb   = (float*)(ws + 0);
    float*  kvb  = (float*)(ws + 48 * MiB);
    float*  ab   = (float*)(ws + 112 * MiB);
    float*  h1   = (float*)(ws + 0);
    bf16_t* h1b  = (bf16_t*)(ws + 64 * MiB);
    bf16_t* W13_t = (bf16_t*)(ws + 97 * MiB);
    bf16_t* W2_t = (bf16_t*)(ws + 161 * MiB);
    bf16_t* Hb   = (bf16_t*)(ws + 193 * MiB);
    int*    stok = (int*)(ws + 233 * MiB);
    bf16_t* Yb   = (bf16_t*)(ws + 64 * MiB);
    int* cnt = (int*)(ctl + CW_CNT);
    float* ssq_q = (float*)(ctl + CW_SSQ_Q); float* ssq_kv = (float*)(ctl + CW_SSQ_KV);
    int* meta = (int*)(ws + WS_CTL + 1 * MiB);
    int* tstart_g = meta; float* lbt = (float*)(meta + 1024); int* tok_e = meta + 2048; int* tok_rank = tok_e + 2 * NTOK; float* tok_gate = (float*)(tok_rank + 2 * NTOK);
    LAS int* moetab = (LAS int*)(lds + 131072 + 1024);
    const int wave = __builtin_amdgcn_readfirstlane(threadIdx.x >> 6), lane = threadIdx.x & 63;

    {
        LAS float* scr = (LAS float*)(lds + wave * 16384);
        for (int it = GWAVE; it < (D / 64) * (INC / 32); it += GWAVES) op::transpose_item(w_in, D, INC, Win_t, scr, it, lane, op::RowProj{});
        for (int it = GWAVE; it < (D / 64) * (D / 32); it += GWAVES) op::transpose_item(w_out, D, D, Wout_t, scr, it, lane, op::RowId{});
        op::cvt_rows_bf16(x, xb, (size_t)NTOK * D);
        cs_tab(pos, cs);
        lb_tab(lbl, lbt);
    }
    xcd_barrier(bar);
    {
        pg8::Gemm g{xb, Win_t, NTOK, 2560, D}; pg8::StaticOrder S; S.init(NTOK, 2560, (int)gridDim.x, (int)blockIdx.x);
        op::EpiProj E{cq, ckv, kr, kk, vi, lf, ssq_q, ssq_kv, cs, lbt};
        pg8::gemm_phase<op::EpiProj, pg8::StaticOrder, true, true>(lds, g, S, E);
    }
    xcd_barrier(bar);
    hg_f(lf, fb);
    mla_prep2(cq, ckv, ssq_q, ssq_kv, q_norm_g, kv_norm_g, cqn, ckvn);
    xcd_barrier(bar);
    hg_rec2(fb, kk, vi, qh, ob);
    xcd_barrier(bar);
    hg_out3(ob, gh, hg_norm_g, AR);
    xcd_barrier(bar);
    ngemm(lds, NTOK, 768, 256, PlainF{cqn, 256, w_uq, 768, qb, 768});
    ngemm(lds, NTOK, 1024, 128, PlainF{ckvn, 128, w_ukv, 1024, kvb, 1024});
    xcd_barrier(bar);
    q_rope(qb, cs);
    xcd_barrier(bar);
    attn_naive2(qb, kvb, kr, ab);
    xcd_barrier(bar);
    a_norm2(ab, mla_out_g, AR);
    xcd_barrier(bar);
    {
        pg8::Gemm g{AR, Wout_t, NTOK, D, D}; pg8::StaticOrder S; S.init(NTOK, D, (int)gridDim.x, (int)blockIdx.x);
        op::EpiMix E{x, h1, ALPHA};
        pg8::gemm_phase<op::EpiMix, pg8::StaticOrder, true, true>(lds, g, S, E);
    }
    xcd_barrier(bar);
    ln_rows2(h1, ln1_g, ln1_b, h1b);
    {
        LAS float* scr = (LAS float*)(lds + wave * 16384);
        for (int it = GWAVE; it < 32 * 3 * 256; it += GWAVES) {
            const int e = it / 768, r = it % 768;
            if (r < 256) op::transpose_item(w1 + (size_t)e * D * 512, D, 512, W13_t + (size_t)e * D * D, scr, r, lane, op::RowW13{0});
            else if (r < 512) op::transpose_item(w3 + (size_t)e * D * 512, D, 512, W13_t + (size_t)e * D * D, scr, r - 256, lane, op::RowW13{1});
            else op::transpose_item(w2 + (size_t)e * 512 * D, 512, D, W2_t + (size_t)e * D * 512, scr, r - 512, lane, op::RowId{});
        }
    }
    xcd_barrier(bar);
    router2(h1, wrg, brg, wre, bre, cnt, tok_e, tok_rank, tok_gate, stok);
    xcd_barrier(bar);
    op::moe_build_tab(moetab, cnt, tstart_g);
    {
        pg8::Gemm g{h1b, W13_t, 0, 0, D}; op::MoeOrder S{moetab, (int)gridDim.x, (int)blockIdx.x, stok};
        op::EpiMoe1 E{Hb};
        pg8::gemm_phase<op::EpiMoe1, op::MoeOrder, true, true, true>(lds, g, S, E);
    }
    xcd_barrier(bar);
    {
        pg8::Gemm g{Hb, W2_t, 0, 0, 512}; op::MoeOrder S{moetab, (int)gridDim.x, (int)blockIdx.x, stok};
        op::EpiBf16P E{Yb, D, 3};
        pg8::gemm_phase<op::EpiBf16P, op::MoeOrder, true, true, false>(lds, g, S, E);
    }
    xcd_barrier(bar);
    ln2_rows(h1, Yb, tok_e, tok_rank, tok_gate, tstart_g, ln2_g, ln2_b, out);
}

extern "C" void kernel_launch(void* const* d_in, const int* in_sizes, int n_in, void* d_out, int out_size, void* d_ws, size_t ws_size, hipStream_t stream) {
    static int grid = 0;
    if (grid == 0) {
        if (n_in != 22 || ws_size < 264 * MiB) { fprintf(stderr, "kernel_launch: unexpected n_in %d / ws %zu\n", n_in, ws_size); grid = -1; return; }
        int dev = 0, cus = 0, per_cu = 0;
        if (hipGetDevice(&dev) != hipSuccess || hipDeviceGetAttribute(&cus, hipDeviceAttributeMultiprocessorCount, dev) != hipSuccess) { grid = -1; return; }
        if (hipFuncSetAttribute((const void*)mega_fwd, hipFuncAttributeMaxDynamicSharedMemorySize, LDS_BYTES) != hipSuccess) { fprintf(stderr, "kernel_launch: hipFuncSetAttribute failed\n"); grid = -1; return; }
        if (hipOccupancyMaxActiveBlocksPerMultiprocessor(&per_cu, (const void*)mega_fwd, NTHREADS, LDS_BYTES) != hipSuccess || per_cu < 1) { fprintf(stderr, "kernel_launch: occupancy query says %d\n", per_cu); (void)hipGetLastError(); }
        grid = cus;
    }
    if (grid < 0) return;
    if (hipMemsetAsync((char*)d_ws + WS_CTL, 0, CTL_ZERO_BYTES, stream) != hipSuccess) return;
    Args a{};
    for (int i = 0; i < 22; ++i) a.in[i] = (const float*)d_in[i];
    a.out = (float*)d_out; a.ws = (unsigned char*)d_ws;
    hipLaunchKernelGGL(mega_fwd, dim3(grid), dim3(NTHREADS), LDS_BYTES, stream, a);
}
```

```cpp
#include <hip/hip_runtime.h>
#include <cstdio>
#include <cstdint>
#include <cmath>

#define LAS __attribute__((address_space(3)))
constexpr int NTHREADS = 512, NWAVES = 8;
constexpr int LDS_BYTES = 147456;

#define XB_TMO      128
#define XB_XCNT(j)  (256  + 64 * (j))
#define XB_XSUB(j)  (1280 + 64 * (j))
#define XB_XGEN(j)  (2304 + 64 * (j))
#define XB_TOP      3328
#define XB_TOPGEN   3392
#define XCD_BAR_WORDS 3456
#define XB_SPIN_CAP (1u << 18)

__device__ __forceinline__ unsigned xb_ld(unsigned* p)              { return __hip_atomic_load(p, __ATOMIC_RELAXED, __HIP_MEMORY_SCOPE_AGENT); }
__device__ __forceinline__ unsigned xb_add(unsigned* p, unsigned v) { return __hip_atomic_fetch_add(p, v, __ATOMIC_RELAXED, __HIP_MEMORY_SCOPE_AGENT); }
__device__ __forceinline__ unsigned xb_xcc_id() { return (unsigned)__builtin_amdgcn_s_getreg((3 << 11) | 20) & 0xFu; }
#define XB_SPIN(cond, bar) do { unsigned _sp = 0; while (cond) { __builtin_amdgcn_s_sleep(1); \
    if ((++_sp & 255u) == 0u) { if (xb_ld(&(bar)[XB_TMO])) break; if (_sp > XB_SPIN_CAP) { atomicAdd(&(bar)[XB_TMO], 1u); break; } } } } while (0)

struct XcdBarrier {
    unsigned* bar; unsigned x;
    volatile LAS unsigned* st;
};

__device__ __forceinline__ XcdBarrier xcd_barrier_post(unsigned* bar, volatile LAS unsigned* st) {
    XcdBarrier b; b.bar = bar; b.x = xb_xcc_id(); b.st = st;
    if (threadIdx.x == 0) (void)xb_add(&bar[XB_XCNT(b.x)], 1u);
    return b;
}
__device__ __forceinline__ void xcd_barrier_complete(unsigned* bar, unsigned x, unsigned& nloc, unsigned& nx) {
    const unsigned G = gridDim.x * gridDim.y * gridDim.z;
    unsigned sum, cnt, mine, sp = 0u;
    for (;;) {
        sum = 0u; cnt = 0u; mine = 0u;
#pragma unroll
        for (unsigned j = 0; j < 16; ++j) { const unsigned c = xb_ld(&bar[XB_XCNT(j)]); sum += c; cnt += (c > 0u) ? 1u : 0u; mine = (j == x) ? c : mine; }
        if (sum == G) break;
        __builtin_amdgcn_s_sleep(1);
        if ((++sp & 255u) == 0u) { if (xb_ld(&bar[XB_TMO])) break; if (sp > XB_SPIN_CAP) { atomicAdd(&bar[XB_TMO], 1u); break; } }
    }
    nloc = mine > 0u ? mine : 1u; nx = cnt > 0u ? cnt : 1u;
}

__device__ __forceinline__ void xcd_barrier(const XcdBarrier& b) {
    asm volatile("s_waitcnt vmcnt(0)" ::: "memory");
    __syncthreads();
    if (threadIdx.x == 0) {
        unsigned* bar = b.bar;
        __builtin_amdgcn_s_waitcnt(0);
        unsigned nloc = b.st[0], nx = b.st[1];
        if (nloc == 0u) { xcd_barrier_complete(bar, b.x, nloc, nx); b.st[0] = nloc; b.st[1] = nx; }
        const unsigned old = xb_add(&bar[XB_XSUB(b.x)], 1u);
        const unsigned gen = old / nloc;
        if (old + 1u == (gen + 1u) * nloc) {
            __builtin_amdgcn_fence(__ATOMIC_RELEASE, "agent");
            asm volatile("s_waitcnt vmcnt(0)" ::: "memory");
            const unsigned og = xb_add(&bar[XB_TOP], 1u);
            const unsigned tg = og / nx;
            if (og + 1u == (tg + 1u) * nx) xb_add(&bar[XB_TOPGEN], 1u);
            else XB_SPIN(xb_ld(&bar[XB_TOPGEN]) == tg, bar);
            __builtin_amdgcn_fence(__ATOMIC_ACQUIRE, "agent");
            xb_add(&bar[XB_XGEN(b.x)], 1u);
            asm volatile("s_waitcnt vmcnt(0)" ::: "memory");
        } else {
            XB_SPIN(xb_ld(&bar[XB_XGEN(b.x)]) == gen, bar);
            __builtin_amdgcn_fence(__ATOMIC_ACQUIRE, "agent");
            asm volatile("s_waitcnt vmcnt(0)" ::: "memory");
        }
    }
    __syncthreads();
}
namespace pg8 {
#define PG8_LAS __attribute__((address_space(3)))
typedef unsigned short bf16_t;
typedef short bf16x8 __attribute__((ext_vector_type(8)));
typedef float f32x4 __attribute__((ext_vector_type(4)));
typedef unsigned u32x4 __attribute__((ext_vector_type(4)));
constexpr int BM = 256, BK = 64, HALF = 128, HTB = HALF * BK * 2  , STAGE_BYTES = 8 * HTB, NXCD = 8, WGM = 8;

__host__ __device__ __forceinline__ int lds_byte(int r, int c) { const int st = (r >> 4) * 2 + (c >> 5), rr = r & 15, cc = c & 31, ob = rr * 64 + cc * 2; return st * 1024 + (ob ^ (((ob >> 9) & 1) << 5)); }
__host__ __device__ __forceinline__ void stage_rc(int b, int& R, int& C) { const int st = b / 1024, sb = b % 1024, swz = sb ^ (((sb >> 9) & 1) << 5); R = (st >> 1) * 16 + swz / 64; C = (st & 1) * 32 + (swz % 64) / 2; }
__host__ __device__ __forceinline__ int perm32(int rho) { const int n = rho >> 4, i = rho & 15; return 8 * (i >> 2) + 4 * n + (i & 3); }

struct Unit { int pm, pn; };
struct Gemm { const bf16_t* A; const bf16_t* Bt; int M, N, K; };

struct StaticOrder {
    int nM, nN, nwg, G, c;
    __host__ __device__ void init(int M, int N, int G_, int c_) { nM = M / BM; nN = N / BM; nwg = nM * nN; G = G_; c = c_; }
    __host__ __device__ bool next(int i, Unit& u) const {
        const long L = (long)i * G + c; if (L >= nwg) return false;
        int wgid = (int)L; { const int q = nwg / NXCD, r = nwg % NXCD, xcd = wgid % NXCD, off = wgid / NXCD; wgid = (xcd < r ? xcd * (q + 1) : r * (q + 1) + (xcd - r) * q) + off; }
        const int nig = WGM * nN, gid = wgid / nig, fm = gid * WGM, gsz = (nM - fm) < WGM ? (nM - fm) : WGM;
        u.pm = fm + ((wgid % nig) % gsz); u.pn = (wgid % nig) / gsz; return true;
    }
    __device__ __forceinline__ void a_ready(const Unit&) const {}
    __device__ __forceinline__ void done(const Unit&) const {}
    __device__ __forceinline__ int arow(const Unit&, int) const { return 0; }
};

__device__ __forceinline__ unsigned cvt_pk_bf16(float lo, float hi) { unsigned r; asm volatile("v_cvt_pk_bf16_f32 %0, %1, %2" : "=v"(r) : "v"(lo), "v"(hi)); return r; }
typedef float f32x2 __attribute__((ext_vector_type(2)));
__device__ __forceinline__ f32x2 gelu_pk(f32x2 v) {
    const f32x2 av = __builtin_elementwise_abs(v), d = av * 0.2316418882f + 1.0f;
    f32x2 t; t.x = __builtin_amdgcn_rcpf(d.x); t.y = __builtin_amdgcn_rcpf(d.y);
    f32x2 q = t * 0.5307027145f + (-0.7265760135f); q = q * t + 0.7107068705f; q = q * t + (-0.142248368f); q = q * t + 0.127414796f; q = q * t;
    const f32x2 s = (v * v) * (-0.72134752044f);
    f32x2 e; e.x = __builtin_amdgcn_exp2f(s.x); e.y = __builtin_amdgcn_exp2f(s.y);
    const f32x2 m = v * (q * e), r = v - m;
    f32x2 o; o.x = v.x < 0.f ? m.x : r.x; o.y = v.y < 0.f ? m.y : r.y; return o;
}

template <int ACT  > struct EpiBf16 {
    static constexpr bool PERM = true, AFTER_DRAIN = false; static_assert(ACT == 0 || ACT == 1, "EpiBf16: ACT is 0 (none) or 1 (gelu_pk)");
    bf16_t* O; int ldc; const float* bias; int split_cols; size_t split_stride; float scale0;
    __device__ __forceinline__ void operator()(const f32x4 (&acc)[2][2][4][2], const Unit& u, int wr, int wc, int fr, int fq) const {
        const int row0 = u.pm * BM + wr * 64 + fr; int colt = u.pn * BM; bf16_t* base = O;
        float sc = 1.f; if (split_cols) { const int t = colt / split_cols; base += (size_t)t * split_stride; colt -= t * split_cols; if (t == 0) sc = scale0; }
        const int col0 = colt + wc * 32 + 8 * fq, bcol0 = u.pn * BM + wc * 32 + 8 * fq;
        f32x4 bv[2][2];
#pragma unroll
        for (int bj = 0; bj < 2; ++bj)
#pragma unroll
            for (int n = 0; n < 2; ++n) bv[bj][n] = bias ? *(const f32x4*)(bias + bcol0 + bj * HALF + 4 * n) : (f32x4){0.f, 0.f, 0.f, 0.f};
#pragma unroll
        for (int ai = 0; ai < 2; ++ai)
#pragma unroll
            for (int m = 0; m < 4; ++m) { bf16_t* rowp = base + (size_t)(row0 + ai * HALF + m * 16) * ldc + col0;
#pragma unroll
                for (int bj = 0; bj < 2; ++bj) { f32x4 v0 = acc[ai][bj][m][0] + bv[bj][0], v1 = acc[ai][bj][m][1] + bv[bj][1];
                    if (ACT == 1) { f32x2 a = gelu_pk((f32x2){v0[0], v0[1]}), b = gelu_pk((f32x2){v0[2], v0[3]}), c = gelu_pk((f32x2){v1[0], v1[1]}), d = gelu_pk((f32x2){v1[2], v1[3]});
                        v0 = (f32x4){a.x, a.y, b.x, b.y}; v1 = (f32x4){c.x, c.y, d.x, d.y}; }
                    v0 = v0 * sc; v1 = v1 * sc; u32x4 w; w.x = cvt_pk_bf16(v0[0], v0[1]); w.y = cvt_pk_bf16(v0[2], v0[3]); w.z = cvt_pk_bf16(v1[0], v1[1]); w.w = cvt_pk_bf16(v1[2], v1[3]);
                    *(u32x4*)(rowp + bj * HALF) = w; } }
    }
};

struct PanelStats {
    unsigned* xbuf;
    unsigned* cnt;
    unsigned* tmo;
    int ntn; float eps;
    unsigned code;
    __device__ __forceinline__ bool run(const f32x4 (&v)[2][2][4][2], const Unit& u, int wr, int wc, int fr, int fq, PG8_LAS unsigned char* lds, int wid, int lane) const {
        typedef float f32x2v __attribute__((ext_vector_type(2)));
        PG8_LAS f32x2v* P = (PG8_LAS f32x2v*)lds;
        PG8_LAS f32x2v* S = (PG8_LAS f32x2v*)(lds + 8192);
        PG8_LAS unsigned* flag = (PG8_LAS unsigned*)(lds + 8192 + 2048);
#pragma unroll
        for (int ai = 0; ai < 2; ++ai)
#pragma unroll
            for (int m = 0; m < 4; ++m) {
                float s = 0.f;
#pragma unroll
                for (int bj = 0; bj < 2; ++bj)
#pragma unroll
                    for (int n = 0; n < 2; ++n) { const f32x4 x = v[ai][bj][m][n]; s += (x[0] + x[1]) + (x[2] + x[3]); }
                s += __shfl_xor(s, 16); s += __shfl_xor(s, 32);
                const float mw = s * (1.0f / 64.0f); float q = 0.f;
#pragma unroll
                for (int bj = 0; bj < 2; ++bj)
#pragma unroll
                    for (int n = 0; n < 2; ++n) { const f32x4 d = v[ai][bj][m][n] - mw; q += (d[0] * d[0] + d[1] * d[1]) + (d[2] * d[2] + d[3] * d[3]); }
                q += __shfl_xor(q, 16); q += __shfl_xor(q, 32);
                if (fq == 0) P[(ai * HALF + wr * 64 + m * 16 + fr) * 4 + wc] = (f32x2v){mw, q};
            }
        asm volatile("s_waitcnt lgkmcnt(0)" ::: "memory"); __builtin_amdgcn_s_barrier(); asm volatile("" ::: "memory");
#if defined(BROKEN_EXCHANGE_NO_WAIT)
#warning BROKEN CONTROL BUILD: the row-statistics exchange does not wait; results are wrong by design
        if (blockIdx.x >= 64) { const long long t0_ = clock64(); while (clock64() - t0_ < 60000) __builtin_amdgcn_s_sleep(8); }
#endif
        const int row = wid * 32 + (lane & 31);
        if (lane < 32) {
            const f32x2v a = P[row * 4 + 0], b = P[row * 4 + 1], c = P[row * 4 + 2], d = P[row * 4 + 3];
            const float mt = (a.x + b.x + c.x + d.x) * 0.25f;
            const float da = a.x - mt, db = b.x - mt, dc = c.x - mt, dd = d.x - mt;
            const float m2 = (a.y + b.y) + (c.y + d.y) + 64.0f * ((da * da + db * db) + (dc * dc + dd * dd));
            unsigned long long* slot = (unsigned long long*)xbuf + ((size_t)(u.pm * BM + row) * 4 + u.pn);
            __hip_atomic_store(slot, ((unsigned long long)__float_as_uint(m2) << 32) | __float_as_uint(mt), __ATOMIC_RELAXED, __HIP_MEMORY_SCOPE_AGENT);
        }
        asm volatile("s_waitcnt vmcnt(0)" ::: "memory");
        if (lane == 0) __hip_atomic_fetch_add(cnt + 64 * u.pm, 1u, __ATOMIC_RELAXED, __HIP_MEMORY_SCOPE_AGENT);
        if (wid == 0) {
            bool dead = false; const unsigned long long t0 = __builtin_amdgcn_s_memrealtime(); const unsigned want = 8u * (unsigned)ntn;
            for (;;) {
#if defined(BROKEN_EXCHANGE_NO_WAIT)
                break;
#endif
                if ((unsigned)__builtin_amdgcn_readfirstlane(__hip_atomic_load(cnt + 64 * u.pm, __ATOMIC_RELAXED, __HIP_MEMORY_SCOPE_AGENT)) >= want) break;
                if (__builtin_amdgcn_s_memrealtime() - t0 > 2000000ull) {
                    if (lane == 0) { unsigned expect = 0u; __hip_atomic_compare_exchange_strong(tmo + 1, &expect, code | (unsigned)(u.pm & 0xff), __ATOMIC_RELAXED, __ATOMIC_RELAXED, __HIP_MEMORY_SCOPE_AGENT);
                                     __hip_atomic_store(tmo, 1u, __ATOMIC_RELAXED, __HIP_MEMORY_SCOPE_AGENT); }
                    dead = true; break; }
                __builtin_amdgcn_s_sleep(2);
            }
            __builtin_amdgcn_fence(__ATOMIC_ACQUIRE, "agent");
            if (lane == 0) flag[0] = dead ? 1u : 0u;
        }
        asm volatile("s_waitcnt vmcnt(0) lgkmcnt(0)" ::: "memory"); __builtin_amdgcn_s_barrier(); asm volatile("" ::: "memory");
        const bool bad = flag[0] != 0u;
        if (lane < 32) {
            const unsigned long long* slot = (const unsigned long long*)xbuf + (size_t)(u.pm * BM + row) * 4; float mt[4], m2[4]; float ms = 0.f;
#pragma unroll
            for (int t = 0; t < 4; ++t) { if (t < ntn) { const unsigned long long w = __hip_atomic_load(slot + t, __ATOMIC_RELAXED, __HIP_MEMORY_SCOPE_AGENT); mt[t] = __uint_as_float((unsigned)w); m2[t] = __uint_as_float((unsigned)(w >> 32)); } else { mt[t] = 0.f; m2[t] = 0.f; } ms += mt[t]; }
            const float mean = ms / (float)ntn; float q = 0.f;
#pragma unroll
            for (int t = 0; t < 4; ++t) if (t < ntn) { const float dm = mt[t] - mean; q += m2[t] + 256.0f * dm * dm; }
            S[row] = (f32x2v){mean, 1.0f / sqrtf(q / (256.0f * (float)ntn) + eps)};
        }
        asm volatile("s_waitcnt lgkmcnt(0)" ::: "memory"); __builtin_amdgcn_s_barrier(); asm volatile("" ::: "memory");
        return bad;
    }
};
struct EpiLnRes {
    static constexpr bool PERM = false, AFTER_DRAIN = true;
    const float* base; float* out; int ldc; const float* bias; PanelStats st; unsigned poison;
    __device__ __forceinline__ void fused(f32x4 (&acc)[2][2][4][2], const Unit& u, int wr, int wc, int fr, int fq, PG8_LAS unsigned char* lds, int wid, int lane) const {
        typedef float f32x2v __attribute__((ext_vector_type(2)));
        const PG8_LAS f32x2v* S = (const PG8_LAS f32x2v*)(lds + 8192);
        const int col0 = u.pn * BM + wc * 32 + 4 * fq;
#pragma unroll
        for (int bj = 0; bj < 2; ++bj)
#pragma unroll
            for (int n = 0; n < 2; ++n) { const f32x4 bv = bias ? *(const f32x4*)(bias + col0 + bj * HALF + n * 16) : (f32x4){0.f, 0.f, 0.f, 0.f};
#pragma unroll
                for (int ai = 0; ai < 2; ++ai)
#pragma unroll
                    for (int m = 0; m < 4; ++m) acc[ai][bj][m][n] += bv; }
        f32x4 pre[4][2][2];
#pragma unroll
        for (int m = 0; m < 4; ++m) { const size_t off = (size_t)(u.pm * BM + wr * 64 + m * 16 + fr) * ldc + col0;
#pragma unroll
            for (int bj = 0; bj < 2; ++bj)
#pragma unroll
                for (int n = 0; n < 2; ++n) pre[m][bj][n] = *(const f32x4*)(base + off + bj * HALF + n * 16); }
        const bool bad = st.run(acc, u, wr, wc, fr, fq, lds, wid, lane) || poison != 0u;
        const float qnan = __builtin_nanf("");
#pragma unroll
        for (int ai = 0; ai < 2; ++ai)
#pragma unroll
            for (int m = 0; m < 4; ++m) { const int r = ai * HALF + wr * 64 + m * 16 + fr; const f32x2v sr = S[r]; const size_t off = (size_t)(u.pm * BM + r) * ldc + col0;
#pragma unroll
                for (int bj = 0; bj < 2; ++bj)
#pragma unroll
                    for (int n = 0; n < 2; ++n) { const f32x4 bs = ai == 0 ? pre[m][bj][n] : *(const f32x4*)(base + off + bj * HALF + n * 16); f32x4 o = bs + (acc[ai][bj][m][n] - sr.x) * sr.y;
                        if (bad) o = (f32x4){qnan, qnan, qnan, qnan}; *(f32x4*)(out + off + bj * HALF + n * 16) = o; }
                if (m & 1) asm volatile("" ::: "memory"); }
    }
};
struct EpiLnResLn {
    static constexpr bool PERM = false, AFTER_DRAIN = true;
    const float* base; float* out; bf16_t* xn; int ldc; const float* bias; PanelStats st1, st2; unsigned poison;
    __device__ __forceinline__ void fused(f32x4 (&acc)[2][2][4][2], const Unit& u, int wr, int wc, int fr, int fq, PG8_LAS unsigned char* lds, int wid, int lane) const {
        typedef float f32x2v __attribute__((ext_vector_type(2))); typedef unsigned u32x2v __attribute__((ext_vector_type(2)));
        const PG8_LAS f32x2v* S = (const PG8_LAS f32x2v*)(lds + 8192);
        const int col0 = u.pn * BM + wc * 32 + 4 * fq;
#pragma unroll
        for (int bj = 0; bj < 2; ++bj)
#pragma unroll
            for (int n = 0; n < 2; ++n) { const f32x4 bv = bias ? *(const f32x4*)(bias + col0 + bj * HALF + n * 16) : (f32x4){0.f, 0.f, 0.f, 0.f};
#pragma unroll
                for (int ai = 0; ai < 2; ++ai)
#pragma unroll
                    for (int m = 0; m < 4; ++m) acc[ai][bj][m][n] += bv; }
        bool bad = st1.run(acc, u, wr, wc, fr, fq, lds, wid, lane) || poison != 0u;
        const float qnan = __builtin_nanf("");
#pragma unroll
        for (int ai = 0; ai < 2; ++ai)
#pragma unroll
            for (int m = 0; m < 4; ++m) { const int r = ai * HALF + wr * 64 + m * 16 + fr; const f32x2v sr = S[r]; const size_t off = (size_t)(u.pm * BM + r) * ldc + col0;
#pragma unroll
                for (int bj = 0; bj < 2; ++bj)
#pragma unroll
                    for (int n = 0; n < 2; ++n) { const f32x4 bs = *(const f32x4*)(base + off + bj * HALF + n * 16); acc[ai][bj][m][n] = bs + (acc[ai][bj][m][n] - sr.x) * sr.y; }
                asm volatile("" : "+v"(acc[ai][0][m][0]), "+v"(acc[ai][0][m][1]), "+v"(acc[ai][1][m][0]), "+v"(acc[ai][1][m][1]));
                if (m & 1) asm volatile("" ::: "memory"); }
        const bool bad1 = bad;
        bad = st2.run(acc, u, wr, wc, fr, fq, lds, wid, lane) || bad;
#pragma unroll
        for (int ai = 0; ai < 2; ++ai)
#pragma unroll
            for (int m = 0; m < 4; ++m) { const int r = ai * HALF + wr * 64 + m * 16 + fr; const f32x2v sr = S[r]; const size_t off = (size_t)(u.pm * BM + r) * ldc + col0;
#pragma unroll
                for (int bj = 0; bj < 2; ++bj)
#pragma unroll
                    for (int n = 0; n < 2; ++n) { const f32x4 x1 = acc[ai][bj][m][n]; *(f32x4*)(out + off + bj * HALF + n * 16) = bad1 ? (f32x4){qnan, qnan, qnan, qnan} : x1;
                        const f32x4 o = (x1 - sr.x) * sr.y; u32x2v w; w.x = cvt_pk_bf16(o[0], o[1]); w.y = cvt_pk_bf16(o[2], o[3]);
                        if (bad) { w.x = 0x7fc07fc0u; w.y = 0x7fc07fc0u; } *(u32x2v*)(xn + off + bj * HALF + n * 16) = w; }
                asm volatile("" ::: "memory"); }
    }
};

template <class Epi, class Sched, bool ALIGN_EPI = false, bool SP2 = false, bool GATHER = false>
__device__ __forceinline__ void gemm_phase(PG8_LAS unsigned char* lds, const Gemm g, const Sched& S, const Epi& E) {
    int tid_ = threadIdx.x; asm volatile("" : "+v"(tid_));
    const int tid = tid_, wid = __builtin_amdgcn_readfirstlane(tid >> 6), lane = tid & 63, wr = wid >> 2, wc = wid & 3, fr = lane & 15, fq = lane >> 4;
    const int K = g.K, nt = K / BK;
    unsigned voffA[2], voffB[2]; int stR[2], stC[2]; static_assert(!GATHER || SP2, "GATHER needs SP2");
#pragma unroll
    for (int i = 0; i < 2; ++i) { int R, C; stage_rc(tid * 16 + i * 8192, R, C); stR[i] = R; stC[i] = C; const int Rb = Epi::PERM ? ((R & ~31) + perm32(R & 31)) : R;
        voffA[i] = (unsigned)(R * K + C) * 2u; voffB[i] = (unsigned)(Rb * K + C) * 2u; }
    const size_t kstep = (size_t)(BK * 2);
    const size_t hstep = (size_t)HALF * K * 2;
    const size_t tstep = 2 * hstep;
    const unsigned ldsw = (unsigned)wid * 1024u;
    const int aoff = lds_byte(wr * 64 + fr, fq * 8), boff = lds_byte(wc * 32 + fr, fq * 8);
#define PG8_SA(b, h) (((b) * 2 + (h)) * HTB)
#define PG8_SB(b, h) ((4 + (b) * 2 + (h)) * HTB)
#define PG8_STAGE(bufoff, gbase, voff) do { _Pragma("unroll") for (int _i = 0; _i < 2; ++_i) \
        __builtin_amdgcn_global_load_lds((const unsigned*)((const char*)(gbase) + (voff)[_i]), (PG8_LAS unsigned*)(lds + (bufoff) + ldsw + _i * 8192), 16, 0, 0); } while (0)
#define PG8_STAGE_A(bufoff, base, h, vsel) do { if constexpr (GATHER) { _Pragma("unroll") for (int _i = 0; _i < 2; ++_i) \
        __builtin_amdgcn_global_load_lds((const unsigned*)((const char*)(base) + (vsel)[h][_i]), (PG8_LAS unsigned*)(lds + (bufoff) + ldsw + _i * 8192), 16, 0, 0); } \
        else { PG8_STAGE(bufoff, (base) + (h) * hstep, voffA); } } while (0)
#define PG8_GOFF(dst, u) do { _Pragma("unroll") for (int _h = 0; _h < 2; ++_h) _Pragma("unroll") for (int _i = 0; _i < 2; ++_i) dst[_h][_i] = (unsigned)S.arow(u, _h * HALF + stR[_i]) * (unsigned)(K * 2) + (unsigned)(stC[_i] * 2); } while (0)
#define PG8_LDA(dst, b, h) do { _Pragma("unroll") for (int m = 0; m < 4; ++m) _Pragma("unroll") for (int k = 0; k < 2; ++k) dst[m][k] = *(const PG8_LAS bf16x8*)(lds + PG8_SA(b, h) + aoff + m * 2048 + k * 1024); } while (0)
#define PG8_LDB(dst, b, h) do { _Pragma("unroll") for (int n = 0; n < 2; ++n) _Pragma("unroll") for (int k = 0; k < 2; ++k) dst[n][k] = *(const PG8_LAS bf16x8*)(lds + PG8_SB(b, h) + boff + n * 2048 + k * 1024); } while (0)
#define PG8_MMA(ai, bj, At, Bt) do { __builtin_amdgcn_s_setprio(1); _Pragma("unroll") for (int m = 0; m < 4; ++m) _Pragma("unroll") for (int n = 0; n < 2; ++n) _Pragma("unroll") for (int k = 0; k < 2; ++k) \
        acc[ai][bj][m][n] = __builtin_amdgcn_mfma_f32_16x16x32_bf16(Bt[n][k], At[m][k], acc[ai][bj][m][n], 0, 0, 0); __builtin_amdgcn_s_setprio(0); } while (0)
#define PG8_WAIT_V(n) asm volatile("s_waitcnt vmcnt(" #n ")" ::: "memory")
#define PG8_WAIT_L(n) asm volatile("s_waitcnt lgkmcnt(" #n ")" ::: "memory")
#define PG8_BAR __builtin_amdgcn_s_barrier()
#define PG8_SCHED __builtin_amdgcn_sched_barrier(0)
    Unit cur, nxt; int ui = 0;
    if (!S.next(0, cur)) return;
    f32x4 acc[2][2][4][2];
#pragma unroll
    for (int a = 0; a < 2; ++a)
#pragma unroll
        for (int b = 0; b < 2; ++b)
#pragma unroll
            for (int m = 0; m < 4; ++m)
#pragma unroll
                for (int n = 0; n < 2; ++n) acc[a][b][m][n] = (f32x4){0.f, 0.f, 0.f, 0.f};
    bf16x8 At[4][2], B0[2][2], B1[2][2];
    unsigned gC[2][2] = {{0u, 0u}, {0u, 0u}}, gN[2][2] = {{0u, 0u}, {0u, 0u}}, gS[2][2] = {{0u, 0u}, {0u, 0u}};
    if constexpr (GATHER) PG8_GOFF(gC, cur);
    const char* cA = GATHER ? (const char*)g.A : (const char*)g.A + (size_t)cur.pm * tstep; const char* cB = (const char*)g.Bt + (size_t)cur.pn * tstep;
    S.a_ready(cur);
    if constexpr (SP2) {
        PG8_STAGE(PG8_SB(0, 0), cB, voffB); PG8_STAGE(PG8_SB(0, 1), cB + hstep, voffB); PG8_STAGE_A(PG8_SA(0, 0), cA, 0, gC); PG8_STAGE_A(PG8_SA(0, 1), cA, 1, gC);
        if (wr == 1) PG8_BAR;
        PG8_WAIT_V(2); PG8_BAR;
        PG8_STAGE(PG8_SB(1, 0), cB + kstep, voffB); PG8_STAGE_A(PG8_SA(1, 0), cA + kstep, 0, gC); PG8_STAGE(PG8_SB(1, 1), cB + hstep + kstep, voffB);
        PG8_WAIT_V(6); PG8_BAR;
    } else {
        PG8_STAGE(PG8_SB(0, 0), cB, voffB); PG8_STAGE(PG8_SA(0, 0), cA, voffA); PG8_STAGE(PG8_SB(0, 1), cB + hstep, voffB); PG8_STAGE(PG8_SA(0, 1), cA + hstep, voffA);
        if (wr == 1) PG8_BAR;
        PG8_WAIT_V(4); PG8_BAR;
        PG8_STAGE(PG8_SB(1, 0), cB + kstep, voffB); PG8_STAGE(PG8_SA(1, 0), cA + kstep, voffA); PG8_STAGE(PG8_SB(1, 1), cB + hstep + kstep, voffB);
        PG8_WAIT_V(6); PG8_BAR;
    }
    for (;;) {
        const bool has_next = S.next(ui + 1, nxt);
        if constexpr (GATHER) { if (has_next) PG8_GOFF(gN, nxt); else { _Pragma("unroll") for (int _h = 0; _h < 2; ++_h) _Pragma("unroll") for (int _i = 0; _i < 2; ++_i) gN[_h][_i] = gC[_h][_i]; } }
        const char* nA = GATHER ? (const char*)g.A : (has_next ? (const char*)g.A + (size_t)nxt.pm * tstep : cA); const char* nB = has_next ? (const char*)g.Bt + (size_t)nxt.pn * tstep : cB;
        for (int t = 0; t < nt; t += 2) {
            const bool last = (t == nt - 2);
            const char* a1 = cA + (size_t)(t + 1) * kstep;
            const char* a2 = last ? nA : cA + (size_t)(t + 2) * kstep; const char* b2 = last ? nB : cB + (size_t)(t + 2) * kstep;
            const char* a3 = a2 + kstep; const char* b3 = b2 + kstep;
            if (last && has_next) S.a_ready(nxt);
            if constexpr (GATHER) { _Pragma("unroll") for (int _h = 0; _h < 2; ++_h) _Pragma("unroll") for (int _i = 0; _i < 2; ++_i) gS[_h][_i] = last ? gN[_h][_i] : gC[_h][_i]; }
            if constexpr (SP2) {
            PG8_LDB(B0, 0, 0); PG8_LDB(B1, 0, 1); PG8_SCHED; PG8_LDA(At, 0, 0); PG8_STAGE_A(PG8_SA(1, 1), a1, 1, gC);
            PG8_WAIT_V(8); PG8_WAIT_L(0); PG8_BAR; PG8_MMA(0, 0, At, B0); PG8_MMA(0, 1, At, B1); PG8_BAR; PG8_SCHED;
            PG8_LDA(At, 0, 1); PG8_STAGE(PG8_SB(0, 0), b2, voffB); PG8_STAGE(PG8_SB(0, 1), b2 + hstep, voffB); PG8_STAGE_A(PG8_SA(0, 0), a2, 0, gS);
            PG8_WAIT_V(8); PG8_WAIT_L(0); PG8_BAR; PG8_MMA(1, 0, At, B0); PG8_MMA(1, 1, At, B1); PG8_BAR; PG8_SCHED;
            PG8_LDB(B0, 1, 0); PG8_LDB(B1, 1, 1); PG8_SCHED; PG8_LDA(At, 1, 0); PG8_STAGE_A(PG8_SA(0, 1), a2, 1, gS);
            PG8_WAIT_V(8); PG8_WAIT_L(0); PG8_BAR; PG8_MMA(0, 0, At, B0); PG8_MMA(0, 1, At, B1); PG8_BAR; PG8_SCHED;
            PG8_LDA(At, 1, 1); PG8_STAGE(PG8_SB(1, 0), b3, voffB); PG8_STAGE(PG8_SB(1, 1), b3 + hstep, voffB); PG8_STAGE_A(PG8_SA(1, 0), a3, 0, gS);
            PG8_WAIT_V(8); PG8_WAIT_L(0); PG8_BAR; PG8_MMA(1, 0, At, B0); PG8_MMA(1, 1, At, B1); PG8_BAR; PG8_SCHED;
            } else {
            PG8_LDB(B0, 0, 0); PG8_SCHED; PG8_LDA(At, 0, 0); PG8_STAGE(PG8_SA(1, 1), a1 + hstep, voffA);
            PG8_WAIT_L(8); PG8_BAR; PG8_WAIT_L(0); PG8_MMA(0, 0, At, B0); PG8_BAR; PG8_SCHED;
            PG8_LDB(B1, 0, 1); PG8_STAGE(PG8_SB(0, 0), b2, voffB);
            PG8_BAR; PG8_WAIT_L(0); PG8_MMA(0, 1, At, B1); PG8_BAR;
            PG8_LDA(At, 0, 1); PG8_STAGE(PG8_SA(0, 0), a2, voffA);
            PG8_BAR; PG8_WAIT_L(0); PG8_MMA(1, 0, At, B0); PG8_BAR; PG8_SCHED;
            PG8_STAGE(PG8_SB(0, 1), b2 + hstep, voffB);
            PG8_WAIT_V(6); PG8_BAR; PG8_MMA(1, 1, At, B1); PG8_BAR;
            PG8_LDB(B0, 1, 0); PG8_SCHED; PG8_LDA(At, 1, 0); PG8_STAGE(PG8_SA(0, 1), a2 + hstep, voffA);
            PG8_WAIT_L(8); PG8_BAR; PG8_WAIT_L(0); PG8_MMA(0, 0, At, B0); PG8_BAR; PG8_SCHED;
            PG8_LDB(B1, 1, 1); PG8_STAGE(PG8_SB(1, 0), b3, voffB);
            PG8_BAR; PG8_WAIT_L(0); PG8_MMA(0, 1, At, B1); PG8_BAR;
            PG8_LDA(At, 1, 1); PG8_STAGE(PG8_SA(1, 0), a3, voffA);
            PG8_BAR; PG8_WAIT_L(0); PG8_MMA(1, 0, At, B0); PG8_BAR; PG8_SCHED;
            PG8_STAGE(PG8_SB(1, 1), b3 + hstep, voffB);
            PG8_WAIT_V(6); PG8_BAR; PG8_MMA(1, 1, At, B1); PG8_BAR;
            }
        }
        if constexpr (ALIGN_EPI) { if (wr == 0) PG8_BAR; }
        if constexpr (!Epi::AFTER_DRAIN) { E(acc, cur, wr, wc, fr, fq); S.done(cur); }
        if (!has_next) break;
#pragma unroll
        for (int a = 0; a < 2; ++a)
#pragma unroll
            for (int b = 0; b < 2; ++b)
#pragma unroll
                for (int m = 0; m < 4; ++m)
#pragma unroll
                    for (int n = 0; n < 2; ++n) acc[a][b][m][n] = (f32x4){0.f, 0.f, 0.f, 0.f};
        cur = nxt; cA = nA; cB = nB; ++ui;
        if constexpr (GATHER) { _Pragma("unroll") for (int _h = 0; _h < 2; ++_h) _Pragma("unroll") for (int _i = 0; _i < 2; ++_i) gC[_h][_i] = gN[_h][_i]; }
        if constexpr (ALIGN_EPI) { if (wr == 1) PG8_BAR; }
    }
    PG8_WAIT_V(0);
    if constexpr (!ALIGN_EPI) { if (wr == 0) PG8_BAR; }
    PG8_BAR;
    if constexpr (Epi::AFTER_DRAIN) { E.fused(acc, cur, wr, wc, fr, fq, lds, wid, lane); S.done(cur); }
#undef PG8_SA
#undef PG8_SB
#undef PG8_STAGE
#undef PG8_STAGE_A
#undef PG8_GOFF
#undef PG8_LDA
#undef PG8_LDB
#undef PG8_MMA
#undef PG8_WAIT_V
#undef PG8_WAIT_L
#undef PG8_BAR
#undef PG8_SCHED
}
}

#ifndef PG8_SP2
#define PG8_SP2 true
#endif
#ifndef PG8_ALIGN
#define PG8_ALIGN true
#endif

namespace nv {
constexpr int NTOK = 16384, D = 1024, SEQ = 4096, INC = 2464;
constexpr int O_CQ = 0, O_CKV = 256, O_KR = 384, O_F = 416, O_I = 928, O_Q = 1440, O_G = 1952;
constexpr int NEXP = 32, PSLOTS = 36864, NBLK = 288;
constexpr float ALPHA = 1.189207115002721f;
constexpr float RMS_EPS = 1e-6f, LN_EPS = 1e-5f;

template <class F>
__device__ __forceinline__ void ngemm(LAS unsigned char* lds, int M, int N, int K, const F& f) {
    LAS float* As = (LAS float*)lds;
    LAS float* Bs = As + 16 * 132;
    const int tid = threadIdx.x, tx = tid & 15, ty = tid >> 4;
    const int tn = (N + 63) / 64, tm = (M + 127) / 128;
    for (int tile = blockIdx.x; tile < tn * tm; tile += gridDim.x) {
        const int m0 = (tile / tn) * 128, n0 = (tile % tn) * 64;
        float acc[4][4];
#pragma unroll
        for (int i = 0; i < 4; ++i)
#pragma unroll
            for (int j = 0; j < 4; ++j) acc[i][j] = 0.f;
        for (int k0 = 0; k0 < K; k0 += 16) {
#pragma unroll
            for (int i = 0; i < 4; ++i) { const int idx = tid + i * 512; const int r = idx >> 4, kk = idx & 15; As[kk * 132 + r] = (m0 + r < M) ? f.a(m0 + r, k0 + kk) : 0.f; }
#pragma unroll
            for (int i = 0; i < 2; ++i) { const int idx = tid + i * 512; const int kk = idx >> 6, c = idx & 63; Bs[kk * 68 + c] = (n0 + c < N) ? f.b(k0 + kk, n0 + c, m0) : 0.f; }
            __syncthreads();
#pragma unroll
            for (int kk = 0; kk < 16; ++kk) {
                float a[4], b[4];
#pragma unroll
                for (int i = 0; i < 4; ++i) { a[i] = As[kk * 132 + ty * 4 + i]; b[i] = Bs[kk * 68 + tx * 4 + i]; }
#pragma unroll
                for (int i = 0; i < 4; ++i)
#pragma unroll
                    for (int j = 0; j < 4; ++j) acc[i][j] += a[i] * b[j];
            }
            __syncthreads();
        }
#pragma unroll
        for (int i = 0; i < 4; ++i)
#pragma unroll
            for (int j = 0; j < 4; ++j) { const int r = m0 + ty * 4 + i, c = n0 + tx * 4 + j; if (r < M && c < N) f.epi(r, c, acc[i][j]); }
    }
}

struct ProjF { const float* x; const float* w; float* out;
    __device__ float a(int r, int k) const { return x[(size_t)r * D + k]; }
    __device__ float b(int k, int c, int) const { return w[(size_t)k * INC + c]; }
    __device__ void epi(int r, int c, float v) const { out[(size_t)r * INC + c] = v; } };
struct PlainF { const float* A; int lda; const float* B; int ldb; float* C; int ldc;
    __device__ float a(int r, int k) const { return A[(size_t)r * lda + k]; }
    __device__ float b(int k, int c, int) const { return B[(size_t)k * ldb + c]; }
    __device__ void epi(int r, int c, float v) const { C[(size_t)r * ldc + c] = v; } };
struct MixF { const float* an; const float* rr; const float* w; const float* x; float* t;
    __device__ float a(int r, int k) const { return k < 512 ? an[(size_t)r * 512 + k] : rr[(size_t)r * 512 + k - 512]; }
    __device__ float b(int k, int c, int) const { return w[(size_t)k * D + c]; }
    __device__ void epi(int r, int c, float v) const { t[(size_t)r * D + c] = ALPHA * x[(size_t)r * D + c] + v; } };
struct Moe1F { const float* h1; const int* slot_tok; const int* blk_exp; const float* w; float* H; int which;
    __device__ float a(int r, int k) const { const int tok = slot_tok[r]; return tok < NTOK ? h1[(size_t)tok * D + k] : 0.f; }
    __device__ float b(int k, int c, int m0) const { const int e = blk_exp[m0 >> 7]; return w[((size_t)e * D + k) * 512 + c]; }
    __device__ void epi(int r, int c, float v) const { float* p = H + (size_t)r * 512 + c; if (which == 0) *p = v / (1.f + expf(-v)); else *p *= v; } };
struct Moe2F { const float* H; const int* slot_tok; const float* slot_gate; const int* blk_exp; const float* w; float* acc;
    __device__ float a(int r, int k) const { return H[(size_t)r * 512 + k]; }
    __device__ float b(int k, int c, int m0) const { const int e = blk_exp[m0 >> 7]; return w[((size_t)e * 512 + k) * D + c]; }
    __device__ void epi(int r, int c, float v) const { const int tok = slot_tok[r]; if (tok < NTOK) atomicAdd(acc + (size_t)tok * D + c, slot_gate[r] * v); } };

__device__ __forceinline__ float wsum(float v) {
#pragma unroll
    for (int o = 1; o < 64; o <<= 1) v += __shfl_xor(v, o);
    return v;
}
#define GTID (blockIdx.x * NTHREADS + threadIdx.x)
#define GTHREADS (gridDim.x * NTHREADS)
#define GWAVE (blockIdx.x * NWAVES + (threadIdx.x >> 6))
#define GWAVES (gridDim.x * NWAVES)

__device__ __forceinline__ void hg_gate(float* proj, const float* lbl) {
    for (int i = GTID; i < NTOK * 512; i += GTHREADS) {
        const int r = i >> 9, c = i & 511;
        const float l0 = lbl[c], l1 = lbl[512 + c]; const float mx = fmaxf(l0, l1);
        const float e0 = expf(l0 - mx), e1 = expf(l1 - mx); const float lb = e0 / (e0 + e1);
        float* p = proj + (size_t)r * INC + O_F + c; const float z = *p;
        *p = lb + (1.f - lb) * (1.f / (1.f + expf(-z)));
    }
}
__device__ __forceinline__ void hg_rec(float* proj) {
    if (blockIdx.x >= 16 || threadIdx.x >= 128) return;
    const int bh = blockIdx.x, b = bh >> 2, h = bh & 3, e = threadIdx.x;
    float S[128];
#pragma unroll
    for (int d = 0; d < 128; ++d) S[d] = 0.f;
    for (int t = 0; t < SEQ; ++t) {
        float* row = proj + (size_t)(b * SEQ + t) * INC;
        const float v = row[O_I + h * 128 + e];
        const float* fr = row + O_F + h * 128; const float* qr = row + O_Q + h * 128;
        float o = 0.f;
#pragma unroll
        for (int d = 0; d < 128; ++d) { const float f = fr[d]; S[d] = f * S[d] + (1.f - f) * v; o += qr[d] * S[d]; }
        row[O_I + h * 128 + e] = o;
    }
}
__device__ __forceinline__ void hg_out(const float* proj, const float* g, float* rr) {
    const int lane = threadIdx.x & 63;
    for (int w = GWAVE; w < NTOK * 4; w += GWAVES) {
        const int r = w >> 2, h = w & 3; const float* row = proj + (size_t)r * INC;
        const float o0 = row[O_I + h * 128 + lane], o1 = row[O_I + h * 128 + 64 + lane];
        const float ss = wsum(o0 * o0 + o1 * o1); const float rs = 1.f / sqrtf(ss * (1.f / 128.f) + RMS_EPS);
        const float g0 = row[O_G + h * 128 + lane], g1 = row[O_G + h * 128 + 64 + lane];
        rr[(size_t)r * 512 + h * 128 + lane] = o0 * rs * g[lane] * (g0 / (1.f + expf(-g0)));
        rr[(size_t)r * 512 + h * 128 + 64 + lane] = o1 * rs * g[64 + lane] * (g1 / (1.f + expf(-g1)));
    }
}
__device__ __forceinline__ void cs_tab(const int* pos, float* cs) {
    for (int i = GTID; i < NTOK * 16; i += GTHREADS) {
        const int j = i & 15, r = i >> 4;
        const float invf = (float)pow(10000.0, -(double)(2 * j) / 32.0);
        const float ang = (float)pos[r] * invf;
        double s, c; sincos((double)ang, &s, &c);
        cs[(size_t)r * 32 + j] = (float)c; cs[(size_t)r * 32 + 16 + j] = (float)s;
    }
}
__device__ __forceinline__ void mla_prep(const float* proj, const float* gq, const float* gkv, const float* cs, float* cqn, float* ckvn, float* kr) {
    const int lane = threadIdx.x & 63;
    for (int r = GWAVE; r < NTOK; r += GWAVES) {
        const float* row = proj + (size_t)r * INC;
        float v[4]; float ss = 0.f;
#pragma unroll
        for (int i = 0; i < 4; ++i) { v[i] = row[O_CQ + lane + 64 * i]; ss += v[i] * v[i]; }
        ss = wsum(ss); float rs = 1.f / sqrtf(ss * (1.f / 256.f) + RMS_EPS);
#pragma unroll
        for (int i = 0; i < 4; ++i) cqn[(size_t)r * 256 + lane + 64 * i] = v[i] * rs * gq[lane + 64 * i];
        float u0 = row[O_CKV + lane], u1 = row[O_CKV + 64 + lane];
        ss = wsum(u0 * u0 + u1 * u1); rs = 1.f / sqrtf(ss * (1.f / 128.f) + RMS_EPS);
        ckvn[(size_t)r * 128 + lane] = u0 * rs * gkv[lane]; ckvn[(size_t)r * 128 + 64 + lane] = u1 * rs * gkv[64 + lane];
        if (lane < 16) { const float x1 = row[O_KR + lane], x2 = row[O_KR + 16 + lane]; const float c = cs[(size_t)r * 32 + lane], s = cs[(size_t)r * 32 + 16 + lane];
            kr[(size_t)r * 32 + lane] = x1 * c - x2 * s; kr[(size_t)r * 32 + 16 + lane] = x2 * c + x1 * s; }
    }
}
__device__ __forceinline__ void q_rope(float* q, const float* cs) {
    for (int i = GTID; i < NTOK * 8 * 16; i += GTHREADS) {
        const int j = i & 15, h = (i >> 4) & 7, r = i >> 7;
        float* p = q + (size_t)r * 768 + h * 96 + 64; const float x1 = p[j], x2 = p[16 + j]; const float c = cs[(size_t)r * 32 + j], s = cs[(size_t)r * 32 + 16 + j];
        p[j] = x1 * c - x2 * s; p[16 + j] = x2 * c + x1 * s;
    }
}
__device__ __forceinline__ void attn_naive(const float* q, const float* kv, const float* kr, float* out) {
    const int lane = threadIdx.x & 63;
    for (int task = GWAVE; task < 2048; task += GWAVES) {
        const int tsk = __builtin_amdgcn_readfirstlane(task);
        const int qc = 63 - (tsk >> 5), h = tsk & 7, b = (tsk >> 3) & 3;
        const int t = qc * 64 + lane; const size_t row = (size_t)b * SEQ + t;
        const float scale = 0.10206207261596575f;
        float qv[96];
#pragma unroll
        for (int d = 0; d < 96; ++d) qv[d] = q[row * 768 + h * 96 + d] * scale;
        float o[64];
#pragma unroll
        for (int d = 0; d < 64; ++d) o[d] = 0.f;
        float m = -INFINITY, l = 0.f;
        const int nk = (qc + 1) * 64;
        for (int s = 0; s < nk; ++s) {
            const size_t kr_ = (size_t)b * SEQ + s;
            const float* kp = kv + kr_ * 1024 + h * 128; const float* rp = kr + kr_ * 32;
            float sc = 0.f;
#pragma unroll
            for (int d = 0; d < 64; ++d) sc += qv[d] * kp[d];
#pragma unroll
            for (int d = 0; d < 32; ++d) sc += qv[64 + d] * rp[d];
            const float mn = fmaxf(m, sc); const float corr = expf(m - mn), p = expf(sc - mn);
            l = l * corr + p;
#pragma unroll
            for (int d = 0; d < 64; ++d) o[d] = o[d] * corr + p * kp[64 + d];
            m = mn;
        }
        const float il = 1.f / l;
#pragma unroll
        for (int d = 0; d < 64; ++d) out[row * 512 + h * 64 + d] = o[d] * il;
    }
}
__device__ __forceinline__ void a_norm(float* a, const float* g) {
    const int lane = threadIdx.x & 63;
    for (int r = GWAVE; r < NTOK; r += GWAVES) {
        float v[8]; float ss = 0.f;
#pragma unroll
        for (int i = 0; i < 8; ++i) { v[i] = a[(size_t)r * 512 + lane + 64 * i]; ss += v[i] * v[i]; }
        ss = wsum(ss); const float rs = 1.f / sqrtf(ss * (1.f / 512.f) + RMS_EPS);
#pragma unroll
        for (int i = 0; i < 8; ++i) a[(size_t)r * 512 + lane + 64 * i] = v[i] * rs * g[lane + 64 * i];
    }
}
__device__ __forceinline__ void ln_rows(const float* in, const float* add, float addscale_in, const float* g, const float* bb, float* out) {
    const int lane = threadIdx.x & 63;
    for (int r = GWAVE; r < NTOK; r += GWAVES) {
        float v[16]; float s = 0.f;
#pragma unroll
        for (int i = 0; i < 16; ++i) { const size_t o = (size_t)r * D + lane + 64 * i; v[i] = addscale_in * in[o] + (add ? add[o] : 0.f); s += v[i]; }
        const float mean = wsum(s) * (1.f / D); float q = 0.f;
#pragma unroll
        for (int i = 0; i < 16; ++i) { v[i] -= mean; q += v[i] * v[i]; }
        const float rs = 1.f / sqrtf(wsum(q) * (1.f / D) + LN_EPS);
#pragma unroll
        for (int i = 0; i < 16; ++i) { const int c = lane + 64 * i; out[(size_t)r * D + c] = v[i] * rs * g[c] + bb[c]; }
    }
}
__device__ __forceinline__ void router(const float* h1, const float* wg, const float* bg, const float* we, const float* be, int* cnt, int* tok_e, int* tok_rank, float* tok_gate) {
    const int lane = threadIdx.x & 63;
    for (int r = GWAVE; r < NTOK; r += GWAVES) {
        float lg[36];
#pragma unroll
        for (int c = 0; c < 36; ++c) lg[c] = 0.f;
        for (int i = 0; i < 16; ++i) { const int k = lane + 64 * i; const float xv = h1[(size_t)r * D + k];
#pragma unroll
            for (int c = 0; c < 4; ++c) lg[c] += xv * wg[k * 4 + c];
#pragma unroll
            for (int c = 0; c < 32; ++c) lg[4 + c] += xv * we[k * 32 + c]; }
#pragma unroll
        for (int c = 0; c < 36; ++c) lg[c] = wsum(lg[c]);
#pragma unroll
        for (int c = 0; c < 4; ++c) lg[c] += bg[c];
#pragma unroll
        for (int c = 0; c < 32; ++c) lg[4 + c] += be[c];
        int grp = 0; float gm = lg[0];
#pragma unroll
        for (int c = 1; c < 4; ++c) if (lg[c] > gm) { gm = lg[c]; grp = c; }
        float den = 0.f;
#pragma unroll
        for (int c = 0; c < 4; ++c) den += expf(lg[c] - gm);
        const float pgrp = 1.f / den;
        float ein[8];
#pragma unroll
        for (int j = 0; j < 8; ++j) ein[j] = grp == 0 ? lg[4 + j] : grp == 1 ? lg[12 + j] : grp == 2 ? lg[20 + j] : lg[28 + j];
        int i0 = 0; float v0 = ein[0];
#pragma unroll
        for (int j = 1; j < 8; ++j) if (ein[j] > v0) { v0 = ein[j]; i0 = j; }
        int i1 = -1; float v1 = -INFINITY;
#pragma unroll
        for (int j = 0; j < 8; ++j) if (j != i0 && ein[j] > v1) { v1 = ein[j]; i1 = j; }
        const float e1 = expf(v1 - v0); const float p0 = 1.f / (1.f + e1), p1 = e1 / (1.f + e1);
        if (lane == 0) {
            const int ea = grp * 8 + i0, eb = grp * 8 + i1;
            tok_e[2 * r] = ea; tok_e[2 * r + 1] = eb;
            tok_rank[2 * r] = atomicAdd(cnt + ea, 1); tok_rank[2 * r + 1] = atomicAdd(cnt + eb, 1);
            tok_gate[2 * r] = pgrp * p0; tok_gate[2 * r + 1] = pgrp * p1;
        }
    }
}
__device__ __forceinline__ void prefix(const int* cnt, int* pad_start, int* blk_exp) {
    if (threadIdx.x != 0 || blockIdx.x != 0) return;
    int acc = 0;
    for (int e = 0; e < NEXP; ++e) { pad_start[e] = acc; acc += ((__hip_atomic_load(cnt + e, __ATOMIC_RELAXED, __HIP_MEMORY_SCOPE_AGENT) + 127) / 128) * 128; pad_start[NEXP + e] = acc; }
    for (int b = 0; b < NBLK; ++b) { int c = 0; for (int e = 0; e < NEXP; ++e) c += (pad_start[NEXP + e] <= b * 128) ? 1 : 0; blk_exp[b] = c < NEXP - 1 ? c : NEXP - 1; }
}
__device__ __forceinline__ void slot_init(int* slot_tok, float* slot_gate) { for (int i = GTID; i < PSLOTS; i += GTHREADS) { slot_tok[i] = NTOK; slot_gate[i] = 0.f; } }
__device__ __forceinline__ void slot_fill(const int* tok_e, const int* tok_rank, const float* tok_gate, const int* pad_start, int* slot_tok, float* slot_gate) {
    for (int i = GTID; i < NTOK * 2; i += GTHREADS) { const int s = pad_start[tok_e[i]] + tok_rank[i]; slot_tok[s] = i >> 1; slot_gate[s] = tok_gate[i]; }
}
__device__ __forceinline__ void zero_f32(float* p, size_t n) { for (size_t i = GTID; i < n / 4; i += GTHREADS) ((float4*)p)[i] = make_float4(0.f, 0.f, 0.f, 0.f); }
}


namespace op {
using pg8::f32x4; using pg8::Unit; using pg8::bf16_t;
typedef unsigned v4u __attribute__((ext_vector_type(4)));
#define GAS __attribute__((address_space(1)))
__device__ __forceinline__ unsigned f2bf(float f) { unsigned u = __builtin_bit_cast(unsigned, f); return (u + 0x7fffu + ((u >> 16) & 1u)) >> 16; }
__device__ __forceinline__ unsigned pk2(float lo, float hi) { return f2bf(lo) | (f2bf(hi) << 16); }
__device__ __forceinline__ float bf2f(unsigned short b) { return __builtin_bit_cast(float, (unsigned)b << 16); }

template <class RowMap>
__device__ __forceinline__ void transpose_item(const float* W, int K, int N, bf16_t* WT, LAS float* scr, int item, int lane, const RowMap& rm) {
    const int nblk = N / 32, kb = item / nblk, nb = item % nblk, k0 = 64 * kb, n0 = 32 * nb;
#pragma unroll 8
    for (int i = 0; i < 32; ++i) { const int kk = 2 * i + (lane >> 5); scr[kk * 33 + (lane & 31)] = rm.scale(n0 + (lane & 31), k0 + kk) * W[(size_t)(k0 + kk) * N + n0 + (lane & 31)]; }
    asm volatile("s_waitcnt lgkmcnt(0)" ::: "memory");
    const int c = lane & 7;
#pragma unroll
    for (int j = 0; j < 4; ++j) { const int n = (lane >> 3) + 8 * j; const LAS float* s = scr + (8 * c) * 33 + n;
        v4u o; o.x = pk2(s[0 * 33], s[1 * 33]); o.y = pk2(s[2 * 33], s[3 * 33]); o.z = pk2(s[4 * 33], s[5 * 33]); o.w = pk2(s[6 * 33], s[7 * 33]);
        *(GAS v4u*)(WT + (size_t)rm.row(n0 + n) * K + k0 + 8 * c) = o; }
    asm volatile("s_waitcnt lgkmcnt(0)" ::: "memory");
}
struct RowId { __device__ __forceinline__ int row(int n) const { return n; } __device__ __forceinline__ float scale(int, int) const { return 1.f; } };

__device__ __forceinline__ void cvt_rows_bf16(const float* src, bf16_t* dst, size_t n) {
    for (size_t i = GTID; i < n / 8; i += GTHREADS) { const float4 a = ((const float4*)src)[2 * i], b = ((const float4*)src)[2 * i + 1];
        v4u o; o.x = pk2(a.x, a.y); o.y = pk2(a.z, a.w); o.z = pk2(b.x, b.y); o.w = pk2(b.z, b.w); ((v4u*)dst)[i] = o; }
}

struct EpiF32Nat { static constexpr bool PERM = false, AFTER_DRAIN = false;
    float* C; int ldc; int ncols;
    __device__ __forceinline__ void operator()(const f32x4 (&acc)[2][2][4][2], const Unit& u, int wr, int wc, int fr, int fq) const {
        const int row0 = u.pm * 256 + wr * 64 + fr, col0 = u.pn * 256 + wc * 32 + 4 * fq;
#pragma unroll
        for (int ai = 0; ai < 2; ++ai)
#pragma unroll
            for (int m = 0; m < 4; ++m) { float* rowp = C + (size_t)(row0 + ai * 128 + m * 16) * ldc;
#pragma unroll
                for (int bj = 0; bj < 2; ++bj)
#pragma unroll
                    for (int n = 0; n < 2; ++n) { const int c = col0 + bj * 128 + n * 16; if (c < ncols) *(f32x4*)(rowp + c) = acc[ai][bj][m][n]; } }
    }
};
}

namespace op {
struct RowProj {
    __device__ __forceinline__ int row(int n) const {
        if (n < 384) return n;
        if (n < 416) { const int j = n - 384, jj = j & 15, a = jj >> 2, b = jj & 3; return 384 + 8 * a + b + (j >= 16 ? 4 : 0); }
        return n + 96;
    }
    __device__ __forceinline__ float scale(int, int) const { return 1.f; }
};
__device__ __forceinline__ v4u pack8(const f32x4& v0, const f32x4& v1) { v4u w; w.x = pk2(v0[0], v0[1]); w.y = pk2(v0[2], v0[3]); w.z = pk2(v1[0], v1[1]); w.w = pk2(v1[2], v1[3]); return w; }
__device__ __forceinline__ float dot4(const f32x4& v) { return (v[0] * v[0] + v[1] * v[1]) + (v[2] * v[2] + v[3] * v[3]); }

struct EpiProj { static constexpr bool PERM = true, AFTER_DRAIN = false;
    bf16_t *cq, *ckv, *kr, *kk, *vi; float* lf; float *ssq_q, *ssq_kv; const float* cs; const float* lbt;
    __device__ __forceinline__ void operator()(const f32x4 (&acc)[2][2][4][2], const Unit& u, int wr, int wc, int fr, int fq) const {
        const int pn = u.pn; const int row0 = u.pm * 256 + wr * 64 + fr; const int cl = wc * 32 + 8 * fq;
        if (pn == 0) {
#pragma unroll
            for (int ai = 0; ai < 2; ++ai)
#pragma unroll
                for (int m = 0; m < 4; ++m) { const int row = row0 + ai * 128 + m * 16; float s = 0.f;
#pragma unroll
                    for (int bj = 0; bj < 2; ++bj) { const f32x4 v0 = acc[ai][bj][m][0], v1 = acc[ai][bj][m][1]; s += dot4(v0) + dot4(v1);
                        *(v4u*)(cq + (size_t)row * 256 + bj * 128 + cl) = pack8(v0, v1); }
                    s += __shfl_xor(s, 16); s += __shfl_xor(s, 32); if (fq == 0) atomicAdd(ssq_q + row, s); }
        } else if (pn == 1) {
#pragma unroll
            for (int ai = 0; ai < 2; ++ai)
#pragma unroll
                for (int m = 0; m < 4; ++m) { const int row = row0 + ai * 128 + m * 16;
                    const f32x4 v0 = acc[ai][0][m][0], v1 = acc[ai][0][m][1]; float s = dot4(v0) + dot4(v1);
                    *(v4u*)(ckv + (size_t)row * 128 + cl) = pack8(v0, v1);
                    s += __shfl_xor(s, 16); s += __shfl_xor(s, 32); if (fq == 0) atomicAdd(ssq_kv + row, s);
                    if (wc == 0) { const f32x4 x1 = acc[ai][1][m][0], x2 = acc[ai][1][m][1];
                        const f32x4 c = *(const f32x4*)(cs + (size_t)row * 32 + 4 * fq), sn = *(const f32x4*)(cs + (size_t)row * 32 + 16 + 4 * fq);
                        *(v4u*)(kr + (size_t)row * 32 + 8 * fq) = pack8(x1 * c - x2 * sn, x2 * c + x1 * sn); } }
        } else if (pn < 4) {
            const int cb = (pn - 2) * 256;
#pragma unroll
            for (int bj = 0; bj < 2; ++bj) { const int col = cb + bj * 128 + cl;
#pragma unroll
                for (int n = 0; n < 2; ++n) { const f32x4 lb = *(const f32x4*)(lbt + col + 4 * n);
#pragma unroll
                    for (int ai = 0; ai < 2; ++ai)
#pragma unroll
                        for (int m = 0; m < 4; ++m) { const int row = row0 + ai * 128 + m * 16; f32x4 l, k;
#pragma unroll
                            for (int i = 0; i < 4; ++i) { const float e = __expf(-acc[ai][bj][m][n][i]), sg = __builtin_amdgcn_rcpf(1.f + e); const float om = 1.f - lb[i]; l[i] = __logf(lb[i] + om * sg); k[i] = om * e * sg; }
                            *(f32x4*)(lf + (size_t)row * 512 + col + 4 * n) = l;
                            typedef unsigned v2u __attribute__((ext_vector_type(2))); v2u w; w.x = pk2(k[0], k[1]); w.y = pk2(k[2], k[3]);
                            *(v2u*)(kk + (size_t)row * 512 + col + 4 * n) = w;
                            asm volatile("" ::: "memory"); } } }
        } else {
            bf16_t* dst = vi + (size_t)((pn - 4) >> 1) * ((size_t)16384 * 512); const int cb = (pn & 1) * 256;
#pragma unroll
            for (int ai = 0; ai < 2; ++ai)
#pragma unroll
                for (int m = 0; m < 4; ++m) { const int row = row0 + ai * 128 + m * 16;
#pragma unroll
                    for (int bj = 0; bj < 2; ++bj) *(v4u*)(dst + (size_t)row * 512 + cb + bj * 128 + cl) = pack8(acc[ai][bj][m][0], acc[ai][bj][m][1]); }
        }
    }
};
}

namespace nv {
using op::bf2f; typedef unsigned short bf16_t;
__device__ __forceinline__ void lb_tab(const float* lbl, float* lbt) {
    for (int c = GTID; c < 512; c += GTHREADS) { const float l0 = lbl[c], l1 = lbl[512 + c]; const float mx = fmaxf(l0, l1); const float e0 = expf(l0 - mx), e1 = expf(l1 - mx); lbt[c] = e0 / (e0 + e1); }
}
__device__ __forceinline__ void hg_f(const float* lf, float* fb) { for (size_t i = GTID; i < (size_t)NTOK * 512; i += GTHREADS) fb[i] = expf(lf[i]); }
__device__ __forceinline__ void hg_rec2(const float* fb, const bf16_t* kk, const bf16_t* vi, const bf16_t* qh, float* ob) {
    if (blockIdx.x >= 16 || threadIdx.x >= 128) return;
    const int bh = blockIdx.x, b = bh >> 2, h = bh & 3, e = threadIdx.x;
    float S[128];
#pragma unroll
    for (int d = 0; d < 128; ++d) S[d] = 0.f;
    for (int t = 0; t < SEQ; ++t) {
        const size_t base = (size_t)(b * SEQ + t) * 512 + h * 128;
        const float v = bf2f(vi[base + e]);
        float o = 0.f;
#pragma unroll
        for (int d = 0; d < 128; ++d) { const float f = fb[base + d]; S[d] = f * S[d] + bf2f(kk[base + d]) * v; o += bf2f(qh[base + d]) * S[d]; }
        ob[base + e] = o;
    }
}
__device__ __forceinline__ void hg_out2(const float* ob, const bf16_t* gh, const float* g, float* rr) {
    const int lane = threadIdx.x & 63;
    for (int w = GWAVE; w < NTOK * 4; w += GWAVES) {
        const size_t base = (size_t)(w >> 2) * 512 + (w & 3) * 128;
        const float o0 = ob[base + lane], o1 = ob[base + 64 + lane];
        const float ss = wsum(o0 * o0 + o1 * o1); const float rs = 1.f / sqrtf(ss * (1.f / 128.f) + RMS_EPS);
        const float g0 = bf2f(gh[base + lane]), g1 = bf2f(gh[base + 64 + lane]);
        rr[base + lane] = o0 * rs * g[lane] * (g0 / (1.f + expf(-g0)));
        rr[base + 64 + lane] = o1 * rs * g[64 + lane] * (g1 / (1.f + expf(-g1)));
    }
}
__device__ __forceinline__ void mla_prep2(const bf16_t* cq, const bf16_t* ckv, const float* ssq_q, const float* ssq_kv, const float* gq, const float* gkv, float* cqn, float* ckvn) {
    for (size_t i = GTID; i < (size_t)NTOK * 256; i += GTHREADS) { const int r = (int)(i >> 8), c = (int)(i & 255);
        cqn[i] = bf2f(cq[i]) * (1.f / sqrtf(__hip_atomic_load(ssq_q + r, __ATOMIC_RELAXED, __HIP_MEMORY_SCOPE_AGENT) * (1.f / 256.f) + RMS_EPS)) * gq[c]; }
    for (size_t i = GTID; i < (size_t)NTOK * 128; i += GTHREADS) { const int r = (int)(i >> 7), c = (int)(i & 127);
        ckvn[i] = bf2f(ckv[i]) * (1.f / sqrtf(__hip_atomic_load(ssq_kv + r, __ATOMIC_RELAXED, __HIP_MEMORY_SCOPE_AGENT) * (1.f / 128.f) + RMS_EPS)) * gkv[c]; }
}
__host__ __device__ constexpr int rope_nat(int p) { return ((p & 7) < 4) ? 4 * (p >> 3) + (p & 7) : 16 + 4 * (p >> 3) + (p & 7) - 4; }
__device__ __forceinline__ void attn_naive2(const float* q, const float* kv, const bf16_t* kr, float* out) {
    const int lane = threadIdx.x & 63;
    for (int task = GWAVE; task < 2048; task += GWAVES) {
        const int tsk = __builtin_amdgcn_readfirstlane(task);
        const int qc = 63 - (tsk >> 5), h = tsk & 7, b = (tsk >> 3) & 3;
        const int t = qc * 64 + lane; const size_t row = (size_t)b * SEQ + t;
        const float scale = 0.10206207261596575f;
        float qv[96];
#pragma unroll
        for (int d = 0; d < 96; ++d) qv[d] = q[row * 768 + h * 96 + d] * scale;
        float o[64];
#pragma unroll
        for (int d = 0; d < 64; ++d) o[d] = 0.f;
        float m = -INFINITY, l = 0.f;
        const int nk = (qc + 1) * 64;
        for (int s = 0; s < nk; ++s) {
            const size_t kr_ = (size_t)b * SEQ + s;
            const float* kp = kv + kr_ * 1024 + h * 128; const bf16_t* rp = kr + kr_ * 32;
            float sc = 0.f;
#pragma unroll
            for (int d = 0; d < 64; ++d) sc += qv[d] * kp[d];
#pragma unroll
            for (int p = 0; p < 32; ++p) sc += qv[64 + rope_nat(p)] * bf2f(rp[p]);
            const float mn = fmaxf(m, sc); const float corr = expf(m - mn), pe = expf(sc - mn);
            l = l * corr + pe;
#pragma unroll
            for (int d = 0; d < 64; ++d) o[d] = o[d] * corr + pe * kp[64 + d];
            m = mn;
        }
        const float il = 1.f / l;
#pragma unroll
        for (int d = 0; d < 64; ++d) out[row * 512 + h * 64 + d] = o[d] * il;
    }
}
}

namespace op {
constexpr int MOE_CAP = 16384, MOE_MAXT = 160;
__device__ __forceinline__ void moe_build_tab(LAS int* tab, const int* cnt, int* tstart_g) {
    if (threadIdx.x < 64) {
        const int e = threadIdx.x & 31; const int c = __hip_atomic_load(cnt + e, __ATOMIC_RELAXED, __HIP_MEMORY_SCOPE_AGENT); const int t = (c + 255) >> 8;
        int incl = t;
#pragma unroll
        for (int o = 1; o < 32; o <<= 1) { const int v = __shfl_up(incl, o, 32); if (e >= o) incl += v; }
        const int start = incl - t;
        if (threadIdx.x < 32) { tab[1 + e] = c; tab[33 + e] = start; if (e == 31) tab[0] = incl; for (int j = 0; j < t; ++j) tab[65 + start + j] = e;
            if (blockIdx.x == 0 && tstart_g) tstart_g[e] = start; }
    }
    __syncthreads();
}
struct MoeOrder {
    const LAS int* tab; int G, c; const int* stok;
    __device__ __forceinline__ bool next(int i, Unit& u) const { const int L = i * G + c; const int T = tab[0]; if (L >= 4 * T) return false; const int mt = L >> 2; u.pm = mt; u.pn = tab[65 + mt] * 4 + (L & 3); return true; }
    __device__ __forceinline__ void a_ready(const Unit&) const {}
    __device__ __forceinline__ void done(const Unit&) const {}
    __device__ __forceinline__ int arow(const Unit& u, int r) const { const int e = u.pn >> 2; const int idx = (u.pm - tab[33 + e]) * 256 + r; return idx < tab[1 + e] ? stok[e * MOE_CAP + idx] : 16384; }
};
struct RowW13 { int which; __device__ __forceinline__ int row(int n) const { return 8 * (n >> 2) + (n & 3) + 4 * which; } __device__ __forceinline__ float scale(int, int) const { return 1.f; } };
struct RowScaleK { const float* g; int klim; __device__ __forceinline__ int row(int n) const { return n; } __device__ __forceinline__ float scale(int, int k) const { return k < klim ? g[k] : 1.f; } };

typedef unsigned v2u __attribute__((ext_vector_type(2)));
struct EpiMoe1 { static constexpr bool PERM = true, AFTER_DRAIN = false;
    bf16_t* H;
    __device__ __forceinline__ void operator()(const f32x4 (&acc)[2][2][4][2], const Unit& u, int wr, int wc, int fr, int fq) const {
        const int row0 = u.pm * 256 + wr * 64 + fr, col0 = 128 * (u.pn & 3) + 16 * wc + 4 * fq;
#pragma unroll
        for (int ai = 0; ai < 2; ++ai)
#pragma unroll
            for (int m = 0; m < 4; ++m) { bf16_t* rowp = H + (size_t)(row0 + ai * 128 + m * 16) * 512 + col0;
#pragma unroll
                for (int bj = 0; bj < 2; ++bj) { const f32x4 a = acc[ai][bj][m][0], b = acc[ai][bj][m][1]; float h[4];
#pragma unroll
                    for (int i = 0; i < 4; ++i) h[i] = a[i] * __builtin_amdgcn_rcpf(1.f + __expf(-a[i])) * b[i];
                    v2u w; w.x = pk2(h[0], h[1]); w.y = pk2(h[2], h[3]); *(v2u*)(rowp + 64 * bj) = w; } }
    }
};
struct EpiBf16P { static constexpr bool PERM = true, AFTER_DRAIN = false;
    bf16_t* O; int ldc; int pmask;
    __device__ __forceinline__ void operator()(const f32x4 (&acc)[2][2][4][2], const Unit& u, int wr, int wc, int fr, int fq) const {
        const int row0 = u.pm * 256 + wr * 64 + fr, col0 = 256 * (u.pn & pmask) + 32 * wc + 8 * fq;
#pragma unroll
        for (int ai = 0; ai < 2; ++ai)
#pragma unroll
            for (int m = 0; m < 4; ++m) { bf16_t* rowp = O + (size_t)(row0 + ai * 128 + m * 16) * ldc + col0;
#pragma unroll
                for (int bj = 0; bj < 2; ++bj) *(v4u*)(rowp + 128 * bj) = pack8(acc[ai][bj][m][0], acc[ai][bj][m][1]); }
    }
};
struct EpiMix { static constexpr bool PERM = false, AFTER_DRAIN = false;
    const float* x; float* t; float alpha;
    __device__ __forceinline__ void operator()(const f32x4 (&acc)[2][2][4][2], const Unit& u, int wr, int wc, int fr, int fq) const {
        const int row0 = u.pm * 256 + wr * 64 + fr, col0 = u.pn * 256 + wc * 32 + 4 * fq;
#pragma unroll
        for (int ai = 0; ai < 2; ++ai)
#pragma unroll
            for (int m = 0; m < 4; ++m) { const size_t ro = (size_t)(row0 + ai * 128 + m * 16) * 1024 + col0;
#pragma unroll
                for (int bj = 0; bj < 2; ++bj)
#pragma unroll
                    for (int n = 0; n < 2; ++n) { const size_t o = ro + bj * 128 + n * 16; *(f32x4*)(t + o) = alpha * *(const f32x4*)(x + o) + acc[ai][bj][m][n]; } }
    }
};
}

namespace nv {
__device__ __forceinline__ void a_norm2(const float* a, const float* g, bf16_t* AR) {
    const int lane = threadIdx.x & 63;
    for (int r = GWAVE; r < NTOK; r += GWAVES) {
        float v[8]; float ss = 0.f;
#pragma unroll
        for (int i = 0; i < 8; ++i) { v[i] = a[(size_t)r * 512 + lane + 64 * i]; ss += v[i] * v[i]; }
        ss = wsum(ss); const float rs = 1.f / sqrtf(ss * (1.f / 512.f) + RMS_EPS);
#pragma unroll
        for (int i = 0; i < 8; ++i) AR[(size_t)r * 1024 + lane + 64 * i] = (bf16_t)op::f2bf(v[i] * rs * g[lane + 64 * i]);
    }
}
__device__ __forceinline__ void hg_out3(const float* ob, const bf16_t* gh, const float* g, bf16_t* AR) {
    const int lane = threadIdx.x & 63;
    for (int w = GWAVE; w < NTOK * 4; w += GWAVES) {
        const size_t base = (size_t)(w >> 2) * 512 + (w & 3) * 128; const size_t ob_ = (size_t)(w >> 2) * 1024 + 512 + (w & 3) * 128;
        const float o0 = ob[base + lane], o1 = ob[base + 64 + lane];
        const float ss = wsum(o0 * o0 + o1 * o1); const float rs = 1.f / sqrtf(ss * (1.f / 128.f) + RMS_EPS);
        const float g0 = bf2f(gh[base + lane]), g1 = bf2f(gh[base + 64 + lane]);
        AR[ob_ + lane] = (bf16_t)op::f2bf(o0 * rs * g[lane] * (g0 / (1.f + expf(-g0))));
        AR[ob_ + 64 + lane] = (bf16_t)op::f2bf(o1 * rs * g[64 + lane] * (g1 / (1.f + expf(-g1))));
    }
}
__device__ __forceinline__ void ln_rows2(float* h, const float* g, const float* bb, bf16_t* hb) {
    const int lane = threadIdx.x & 63;
    for (int r = GWAVE; r < NTOK; r += GWAVES) {
        float v[16]; float s = 0.f;
#pragma unroll
        for (int i = 0; i < 16; ++i) { v[i] = h[(size_t)r * D + lane + 64 * i]; s += v[i]; }
        const float mean = wsum(s) * (1.f / D); float q = 0.f;
#pragma unroll
        for (int i = 0; i < 16; ++i) { v[i] -= mean; q += v[i] * v[i]; }
        const float rs = 1.f / sqrtf(wsum(q) * (1.f / D) + LN_EPS);
#pragma unroll
        for (int i = 0; i < 16; ++i) { const int c = lane + 64 * i; const float o = v[i] * rs * g[c] + bb[c]; h[(size_t)r * D + c] = o; hb[(size_t)r * D + c] = (bf16_t)op::f2bf(o); }
    }
    if (blockIdx.x == 0) for (int c = threadIdx.x; c < D; c += NTHREADS) hb[(size_t)NTOK * D + c] = 0;
}
__device__ __forceinline__ void router2(const float* h1, const float* wg, const float* bg, const float* we, const float* be, int* cnt, int* tok_e, int* tok_rank, float* tok_gate, int* stok) {
    const int lane = threadIdx.x & 63;
    for (int r = GWAVE; r < NTOK; r += GWAVES) {
        float lg[36];
#pragma unroll
        for (int c = 0; c < 36; ++c) lg[c] = 0.f;
        for (int i = 0; i < 16; ++i) { const int k = lane + 64 * i; const float xv = h1[(size_t)r * D + k];
#pragma unroll
            for (int c = 0; c < 4; ++c) lg[c] += xv * wg[k * 4 + c];
#pragma unroll
            for (int c = 0; c < 32; ++c) lg[4 + c] += xv * we[k * 32 + c]; }
#pragma unroll
        for (int c = 0; c < 36; ++c) lg[c] = wsum(lg[c]);
#pragma unroll
        for (int c = 0; c < 4; ++c) lg[c] += bg[c];
#pragma unroll
        for (int c = 0; c < 32; ++c) lg[4 + c] += be[c];
        int grp = 0; float gm = lg[0];
#pragma unroll
        for (int c = 1; c < 4; ++c) if (lg[c] > gm) { gm = lg[c]; grp = c; }
        float den = 0.f;
#pragma unroll
        for (int c = 0; c < 4; ++c) den += expf(lg[c] - gm);
        const float pgrp = 1.f / den;
        float ein[8];
#pragma unroll
        for (int j = 0; j < 8; ++j) ein[j] = grp == 0 ? lg[4 + j] : grp == 1 ? lg[12 + j] : grp == 2 ? lg[20 + j] : lg[28 + j];
        int i0 = 0; float v0 = ein[0];
#pragma unroll
        for (int j = 1; j < 8; ++j) if (ein[j] > v0) { v0 = ein[j]; i0 = j; }
        int i1 = -1; float v1 = -INFINITY;
#pragma unroll
        for (int j = 0; j < 8; ++j) if (j != i0 && ein[j] > v1) { v1 = ein[j]; i1 = j; }
        const float e1 = expf(v1 - v0); const float p0 = 1.f / (1.f + e1), p1 = e1 / (1.f + e1);
        if (lane == 0) {
            const int ea = grp * 8 + i0, eb = grp * 8 + i1;
            const int ra = atomicAdd(cnt + ea, 1), rb = atomicAdd(cnt + eb, 1);
            tok_e[2 * r] = ea; tok_e[2 * r + 1] = eb; tok_rank[2 * r] = ra; tok_rank[2 * r + 1] = rb;
            tok_gate[2 * r] = pgrp * p0; tok_gate[2 * r + 1] = pgrp * p1;
            stok[ea * op::MOE_CAP + ra] = r; stok[eb * op::MOE_CAP + rb] = r;
        }
    }
}
__device__ __forceinline__ void ln2_rows(const float* h1, const bf16_t* Y, const int* tok_e, const int* tok_rank, const float* tok_gate, const int* tstart, const float* g, const float* bb, float* out) {
    const int lane = threadIdx.x & 63;
    for (int r = GWAVE; r < NTOK; r += GWAVES) {
        const size_t r0 = (size_t)tstart[tok_e[2 * r]] * 256 + tok_rank[2 * r], r1 = (size_t)tstart[tok_e[2 * r + 1]] * 256 + tok_rank[2 * r + 1];
        const float g0 = tok_gate[2 * r], g1 = tok_gate[2 * r + 1];
        float v[16]; float s = 0.f;
#pragma unroll
        for (int i = 0; i < 16; ++i) { const int c = lane + 64 * i; v[i] = ALPHA * h1[(size_t)r * D + c] + g0 * bf2f(Y[r0 * D + c]) + g1 * bf2f(Y[r1 * D + c]); s += v[i]; }
        const float mean = wsum(s) * (1.f / D); float q = 0.f;
#pragma unroll
        for (int i = 0; i < 16; ++i) { v[i] -= mean; q += v[i] * v[i]; }
        const float rs = 1.f / sqrtf(wsum(q) * (1.f / D) + LN_EPS);
#pragma unroll
        for (int i = 0; i < 16; ++i) { const int c = lane + 64 * i; out[(size_t)r * D + c] = v[i] * rs * g[c] + bb[c]; }
    }
}
}

namespace hg {
using op::bf16_t; using op::bf2f; using op::f2bf; using op::pk2; using op::v4u; using op::v2u;
typedef short bf16x8 __attribute__((ext_vector_type(8)));
typedef float f32x4 __attribute__((ext_vector_type(4)));
constexpr int SEQ = 4096, NU = 1024;
constexpr int LDV = 72 * 2, LDK = 72 * 2, LDQ = 136 * 2, LDS_ = 136 * 2, LDA = 72 * 2;
__device__ __forceinline__ bf16x8 ldfrag(const LAS unsigned char* base, int row, int stride, int kbyte) { return *(const LAS bf16x8*)(base + row * stride + kbyte); }

__device__ __forceinline__ void stage_vT(LAS unsigned char* vT, const bf16_t* vsrc, int tid) {
#pragma unroll
    for (int j = 0; j < 2; ++j) { const int p = tid + 512 * j, s = p >> 4, e0 = (p & 15) * 8;
        const v4u w = *(const v4u*)(vsrc + (size_t)s * 512 + e0);
        const unsigned ww[4] = {w.x, w.y, w.z, w.w};
#pragma unroll
        for (int i = 0; i < 4; ++i) { *(LAS unsigned short*)(vT + (e0 + 2 * i) * LDV + s * 2) = (unsigned short)(ww[i] & 0xffffu); *(LAS unsigned short*)(vT + (e0 + 2 * i + 1) * LDV + s * 2) = (unsigned short)(ww[i] >> 16); } }
}
__device__ __forceinline__ void pass1(LAS unsigned char* lds, const float* lf, const bf16_t* kk, const bf16_t* vi, bf16_t* U, float* dl) {
    int tid_ = threadIdx.x; asm volatile("" : "+v"(tid_)); const int tid = tid_, lane = tid & 63, w = __builtin_amdgcn_readfirstlane(tid >> 6);
    LAS unsigned char* vT = lds; LAS unsigned char* kdT = lds + 128 * LDV; LAS float* segtot = (LAS float*)(lds + 128 * LDV + 128 * LDK);
    const int d = tid & 127, seg = tid >> 7, t0 = seg * 16;
    for (int u = blockIdx.x; u < NU; u += gridDim.x) {
        const int c = u & 63, bh = u >> 6, b = bh >> 2, h = bh & 3; const size_t row0 = (size_t)b * SEQ + c * 64;
        float cs[16]; float kv[16]; float run = 0.f;
#pragma unroll
        for (int i = 0; i < 16; ++i) { const size_t o = (row0 + t0 + i) * 512 + h * 128 + d; cs[i] = lf[o]; kv[i] = bf2f(kk[o]); }
        stage_vT(vT, vi + row0 * 512 + h * 128, tid);
#pragma unroll
        for (int i = 0; i < 16; ++i) { run += cs[i]; cs[i] = run; }
        segtot[seg * 128 + d] = run;
        __syncthreads();
        float off = 0.f, tot = 0.f;
#pragma unroll
        for (int s = 0; s < 4; ++s) { const float v = segtot[s * 128 + d]; tot += v; if (s < seg) off += v; }
        unsigned pk[8];
#pragma unroll
        for (int i = 0; i < 8; ++i) pk[i] = pk2(kv[2 * i] * __expf(tot - off - cs[2 * i]), kv[2 * i + 1] * __expf(tot - off - cs[2 * i + 1]));
        *(LAS v4u*)(kdT + d * LDK + t0 * 2) = (v4u){pk[0], pk[1], pk[2], pk[3]}; *(LAS v4u*)(kdT + d * LDK + t0 * 2 + 16) = (v4u){pk[4], pk[5], pk[6], pk[7]};
        if (seg == 0) dl[(size_t)u * 128 + d] = __expf(tot);
        __syncthreads();
        f32x4 acc[8];
#pragma unroll
        for (int j = 0; j < 8; ++j) acc[j] = (f32x4){0.f, 0.f, 0.f, 0.f};
#pragma unroll
        for (int ks = 0; ks < 2; ++ks) { const bf16x8 a = ldfrag(kdT, w * 16 + (lane & 15), LDK, ks * 64 + (lane >> 4) * 16);
#pragma unroll
            for (int j = 0; j < 8; ++j) { const bf16x8 bb = ldfrag(vT, j * 16 + (lane & 15), LDV, ks * 64 + (lane >> 4) * 16); acc[j] = __builtin_amdgcn_mfma_f32_16x16x32_bf16(a, bb, acc[j], 0, 0, 0); } }
        bf16_t* Uu = U + (size_t)u * 16384;
#pragma unroll
        for (int j = 0; j < 8; ++j) { v2u o; o.x = pk2(acc[j][0], acc[j][1]); o.y = pk2(acc[j][2], acc[j][3]); *(v2u*)(Uu + (j * 16 + (lane & 15)) * 128 + w * 16 + 4 * (lane >> 4)) = o; }
        __syncthreads();
    }
}
__device__ __forceinline__ void scan(const bf16_t* U, const float* dl, bf16_t* ST) {
    for (int gid = blockIdx.x * NTHREADS + threadIdx.x; gid < 16 * 128 * 64; gid += gridDim.x * NTHREADS) {
        const int dp = gid & 63, e = (gid >> 6) & 127, bh = gid >> 13;
        float s0 = 0.f, s1 = 0.f;
        for (int c0 = 0; c0 < 64; c0 += 16) {
            unsigned uv[16]; float2 dv[16];
#pragma unroll
            for (int i = 0; i < 16; ++i) { const size_t un = (size_t)bh * 64 + c0 + i; uv[i] = *(const unsigned*)(U + un * 16384 + e * 128 + 2 * dp); dv[i] = *(const float2*)(dl + un * 128 + 2 * dp); }
#pragma unroll
            for (int i = 0; i < 16; ++i) { const size_t un = (size_t)bh * 64 + c0 + i; *(unsigned*)(ST + un * 16384 + e * 128 + 2 * dp) = pk2(s0, s1);
                s0 = dv[i].x * s0 + __builtin_bit_cast(float, uv[i] << 16); s1 = dv[i].y * s1 + __builtin_bit_cast(float, uv[i] & 0xffff0000u); }
        }
    }
}
__device__ __forceinline__ void pass3(LAS unsigned char* lds, const float* lf, const bf16_t* kk, const bf16_t* vi, const bf16_t* qh, const bf16_t* gh, const bf16_t* ST, const float* gnorm, bf16_t* AR) {
    int tid_ = threadIdx.x; asm volatile("" : "+v"(tid_)); const int tid = tid_, lane = tid & 63, w = __builtin_amdgcn_readfirstlane(tid >> 6);
    LAS unsigned char* qeL = lds; LAS unsigned char* keL = qeL + 64 * LDQ; LAS unsigned char* qsL = keL + 64 * LDQ; LAS unsigned char* vT = qsL + 64 * LDQ;
    LAS unsigned char* STl = vT + 128 * LDV; LAS unsigned char* aL = STl + 128 * LDS_; LAS float* segtot = (LAS float*)(aL + 64 * LDA); LAS float* ssqL = segtot + 512;
    const int d = tid & 127, seg = tid >> 7, t0 = seg * 16;
    const int tt = w & 3, eg = w >> 2;
    for (int u = blockIdx.x; u < NU; u += gridDim.x) {
        const int c = u & 63, bh = u >> 6, b = bh >> 2, h = bh & 3; const size_t row0 = (size_t)b * SEQ + c * 64;
        float cs[16]; float kv[16], qv[16]; float run = 0.f;
#pragma unroll
        for (int i = 0; i < 16; ++i) { const size_t o = (row0 + t0 + i) * 512 + h * 128 + d; cs[i] = lf[o]; kv[i] = bf2f(kk[o]); qv[i] = bf2f(qh[o]); }
        stage_vT(vT, vi + row0 * 512 + h * 128, tid);
        { const bf16_t* Su = ST + (size_t)u * 16384;
#pragma unroll
            for (int j = 0; j < 4; ++j) { const int p = tid + 512 * j, e = p >> 4, d0 = (p & 15) * 8; *(LAS v4u*)(STl + e * LDS_ + d0 * 2) = *(const v4u*)(Su + e * 128 + d0); } }
#pragma unroll
        for (int i = 0; i < 16; ++i) { run += cs[i]; cs[i] = run; }
        segtot[seg * 128 + d] = run;
        __syncthreads();
        float off = 0.f;
#pragma unroll
        for (int s = 0; s < 3; ++s) { const float v = segtot[s * 128 + d]; if (s < seg) off += v; }
        const float bm = segtot[d] + segtot[128 + d];
#pragma unroll
        for (int i = 0; i < 16; ++i) { const float bt = off + cs[i]; const int t = t0 + i;
            *(LAS unsigned short*)(qeL + t * LDQ + d * 2) = (unsigned short)f2bf(qv[i] * __expf(fminf(bt - bm, 80.f)));
            *(LAS unsigned short*)(keL + t * LDQ + d * 2) = (unsigned short)f2bf(kv[i] * __expf(fminf(bm - bt, 80.f)));
            *(LAS unsigned short*)(qsL + t * LDQ + d * 2) = (unsigned short)f2bf(qv[i] * __expf(bt)); }
        __syncthreads();
#pragma unroll
        for (int j = 0; j < 2; ++j) { const int st = 2 * eg + j; f32x4 a = (f32x4){0.f, 0.f, 0.f, 0.f};
            if (st <= tt) {
#pragma unroll
                for (int ks = 0; ks < 4; ++ks) a = __builtin_amdgcn_mfma_f32_16x16x32_bf16(ldfrag(qeL, tt * 16 + (lane & 15), LDQ, ks * 64 + (lane >> 4) * 16), ldfrag(keL, st * 16 + (lane & 15), LDQ, ks * 64 + (lane >> 4) * 16), a, 0, 0, 0);
            }
            const int sI = st * 16 + (lane & 15);
#pragma unroll
            for (int r = 0; r < 4; ++r) { const int tI = tt * 16 + 4 * (lane >> 4) + r; *(LAS unsigned short*)(aL + tI * LDA + sI * 2) = (unsigned short)f2bf(sI <= tI ? a[r] : 0.f); } }
        float gv[4][4];
#pragma unroll
        for (int r = 0; r < 4; ++r)
#pragma unroll
            for (int j = 0; j < 4; ++j) gv[r][j] = bf2f(gh[(row0 + tt * 16 + 4 * (lane >> 4) + r) * 512 + h * 128 + (4 * eg + j) * 16 + (lane & 15)]);
        __syncthreads();
        f32x4 o[4];
#pragma unroll
        for (int j = 0; j < 4; ++j) o[j] = (f32x4){0.f, 0.f, 0.f, 0.f};
#pragma unroll
        for (int ks = 0; ks < 2; ++ks) { const bf16x8 a = ldfrag(aL, tt * 16 + (lane & 15), LDA, ks * 64 + (lane >> 4) * 16);
#pragma unroll
            for (int j = 0; j < 4; ++j) o[j] = __builtin_amdgcn_mfma_f32_16x16x32_bf16(a, ldfrag(vT, (4 * eg + j) * 16 + (lane & 15), LDV, ks * 64 + (lane >> 4) * 16), o[j], 0, 0, 0); }
#pragma unroll
        for (int ks = 0; ks < 4; ++ks) { const bf16x8 a = ldfrag(qsL, tt * 16 + (lane & 15), LDQ, ks * 64 + (lane >> 4) * 16);
#pragma unroll
            for (int j = 0; j < 4; ++j) o[j] = __builtin_amdgcn_mfma_f32_16x16x32_bf16(a, ldfrag(STl, (4 * eg + j) * 16 + (lane & 15), LDS_, ks * 64 + (lane >> 4) * 16), o[j], 0, 0, 0); }
        float ss[4];
#pragma unroll
        for (int r = 0; r < 4; ++r) { float s = 0.f;
#pragma unroll
            for (int j = 0; j < 4; ++j) s += o[j][r] * o[j][r];
            s += __shfl_xor(s, 1); s += __shfl_xor(s, 2); s += __shfl_xor(s, 4); s += __shfl_xor(s, 8); ss[r] = s; }
        if ((lane & 15) == 0) {
#pragma unroll
            for (int r = 0; r < 4; ++r) ssqL[eg * 64 + tt * 16 + 4 * (lane >> 4) + r] = ss[r]; }
        __syncthreads();
#pragma unroll
        for (int r = 0; r < 4; ++r) { const int tI = tt * 16 + 4 * (lane >> 4) + r; const float rs = 1.f / sqrtf((ssqL[tI] + ssqL[64 + tI]) * (1.f / 128.f) + 1e-6f);
#pragma unroll
            for (int j = 0; j < 4; ++j) { const int e = (4 * eg + j) * 16 + (lane & 15); const float g = gv[r][j];
                AR[(row0 + tI) * 1024 + 512 + h * 128 + e] = (bf16_t)f2bf(o[j][r] * rs * gnorm[e] * g * __builtin_amdgcn_rcpf(1.f + __expf(-g))); } }
        __syncthreads();
    }
}
}

struct Args { const float* in[22]; float* out; unsigned char* ws; };
constexpr size_t MiB = 1u << 20;
constexpr size_t WS_CTL = 260 * MiB, CTL_ZERO_BYTES = 1 * MiB;
constexpr int CW_BAR = 1024, CW_CNT = 8192, CW_SSQ_Q = 16384, CW_SSQ_KV = 32768, CW_SSQ_A = 49152;

__global__ void __launch_bounds__(NTHREADS, 2) mega_fwd(Args args) {
    extern __shared__ __attribute__((aligned(16))) unsigned char lds_raw[];
    using namespace nv;
    LAS unsigned char* lds = (LAS unsigned char*)lds_raw;
    volatile LAS unsigned* MISC = (volatile LAS unsigned*)(lds + 131072);
    if (threadIdx.x < 64) MISC[threadIdx.x] = 0u;
    __syncthreads();
    unsigned char* ws = args.ws;
    unsigned* ctl = (unsigned*)(ws + WS_CTL);
    XcdBarrier bar = xcd_barrier_post(ctl + CW_BAR, MISC + 8);
    const float* x = args.in[0]; const int* pos = (const int*)args.in[1]; const float* w_in = args.in[2];
    const float* q_norm_g = args.in[3]; const float* w_uq = args.in[4]; const float* kv_norm_g = args.in[5];
    const float* w_ukv = args.in[6]; const float* mla_out_g = args.in[7]; const float* lbl = args.in[8];
    const float* hg_norm_g = args.in[9]; const float* w_out = args.in[10]; const float* ln1_g = args.in[11];
    const float* ln1_b = args.in[12]; const float* wrg = args.in[13]; const float* brg = args.in[14];
    const float* wre = args.in[15]; const float* bre = args.in[16]; const float* w1 = args.in[17];
    const float* w3 = args.in[18]; const float* w2 = args.in[19]; const float* ln2_g = args.in[20]; const float* ln2_b = args.in[21];
    float* out = args.out;
    typedef op::bf16_t bf16_t;
    float*  lf   = (float*)(ws + 0);
    bf16_t* kk   = (bf16_t*)(ws + 32 * MiB);
    bf16_t* vi   = (bf16_t*)(ws + 48 * MiB);
    bf16_t* qh   = (bf16_t*)(ws + 64 * MiB);
    bf16_t* gh   = (bf16_t*)(ws + 80 * MiB);
    bf16_t* Ub   = (bf16_t*)(ws + 96 * MiB);
    float*  dlb  = (float*)(ws + 128 * MiB);
    bf16_t* AR   = (bf16_t*)(ws + 144 * MiB);
    float*  cs   = (float*)(ws + 176 * MiB);
    float*  cqn  = (float*)(ws + 178 * MiB);
    float*  ckvn = (float*)(ws + 194 * MiB);
    bf16_t* xb   = (bf16_t*)(ws + 202 * MiB);
    bf16_t* STb  = (bf16_t*)(ws + 202 * MiB);
    bf16_t* Win_t = (bf16_t*)(ws + 234 * MiB);
    bf16_t* cq   = (bf16_t*)(ws + 239 * MiB);
    bf16_t* ckv  = (bf16_t*)(ws + 247 * MiB);
    bf16_t* kr   = (bf16_t*)(ws + 251 * MiB);
    bf16_t* Wout_t = (bf16_t*)(ws + 252 * MiB);
    float*  qb   = (float*)(ws + 0);
    float*  kvb  = (float*)(ws + 48 * MiB);
    float*  ab   = (float*)(ws + 112 * MiB);
    float*  h1   = (float*)(ws + 0);
    bf16_t* h1b  = (bf16_t*)(ws + 64 * MiB);
    bf16_t* W13_t = (bf16_t*)(ws + 97 * MiB);
    bf16_t* W2_t = (bf16_t*)(ws + 161 * MiB);
    bf16_t* Hb   = (bf16_t*)(ws + 193 * MiB);
    int*    stok = (int*)(ws + 233 * MiB);
    bf16_t* Yb   = (bf16_t*)(ws + 64 * MiB);
    int* cnt = (int*)(ctl + CW_CNT);
    float* ssq_q = (float*)(ctl + CW_SSQ_Q); float* ssq_kv = (float*)(ctl + CW_SSQ_KV);
    int* meta = (int*)(ws + WS_CTL + 1 * MiB);
    int* tstart_g = meta; float* lbt = (float*)(meta + 1024); int* tok_e = meta + 2048; int* tok_rank = tok_e + 2 * NTOK; float* tok_gate = (float*)(tok_rank + 2 * NTOK);
    LAS int* moetab = (LAS int*)(lds + 131072 + 1024);
    const int wave = __builtin_amdgcn_readfirstlane(threadIdx.x >> 6), lane = threadIdx.x & 63;

    {
        LAS float* scr = (LAS float*)(lds + wave * 16384);
        for (int it = GWAVE; it < (D / 64) * (INC / 32); it += GWAVES) op::transpose_item(w_in, D, INC, Win_t, scr, it, lane, op::RowProj{});
        for (int it = GWAVE; it < (D / 64) * (D / 32); it += GWAVES) op::transpose_item(w_out, D, D, Wout_t, scr, it, lane, op::RowId{});
        op::cvt_rows_bf16(x, xb, (size_t)NTOK * D);
        cs_tab(pos, cs);
        lb_tab(lbl, lbt);
    }
    xcd_barrier(bar);
    {
        pg8::Gemm g{xb, Win_t, NTOK, 2560, D}; pg8::StaticOrder S; S.init(NTOK, 2560, (int)gridDim.x, (int)blockIdx.x);
        op::EpiProj E{cq, ckv, kr, kk, vi, lf, ssq_q, ssq_kv, cs, lbt};
        pg8::gemm_phase<op::EpiProj, pg8::StaticOrder, true, true>(lds, g, S, E);
    }
    xcd_barrier(bar);
    hg::pass1(lds, lf, kk, vi, Ub, dlb);
    mla_prep2(cq, ckv, ssq_q, ssq_kv, q_norm_g, kv_norm_g, cqn, ckvn);
    xcd_barrier(bar);
    hg::scan(Ub, dlb, STb);
    xcd_barrier(bar);
    hg::pass3(lds, lf, kk, vi, qh, gh, STb, hg_norm_g, AR);
    xcd_barrier(bar);
    ngemm(lds, NTOK, 768, 256, PlainF{cqn, 256, w_uq, 768, qb, 768});
    ngemm(lds, NTOK, 1024, 128, PlainF{ckvn, 128, w_ukv, 1024, kvb, 1024});
    xcd_barrier(bar);
    q_rope(qb, cs);
    xcd_barrier(bar);
    attn_naive2(qb, kvb, kr, ab);
    xcd_barrier(bar);
    a_norm2(ab, mla_out_g, AR);
    xcd_barrier(bar);
    {
        pg8::Gemm g{AR, Wout_t, NTOK, D, D}; pg8::StaticOrder S; S.init(NTOK, D, (int)gridDim.x, (int)blockIdx.x);
        op::EpiMix E{x, h1, ALPHA};
        pg8::gemm_phase<op::EpiMix, pg8::StaticOrder, true, true>(lds, g, S, E);
    }
    xcd_barrier(bar);
    ln_rows2(h1, ln1_g, ln1_b, h1b);
    {
        LAS float* scr = (LAS float*)(lds + wave * 16384);
        for (int it = GWAVE; it < 32 * 3 * 256; it += GWAVES) {
            const int e = it / 768, r = it % 768;
            if (r < 256) op::transpose_item(w1 + (size_t)e * D * 512, D, 512, W13_t + (size_t)e * D * D, scr, r, lane, op::RowW13{0});
            else if (r < 512) op::transpose_item(w3 + (size_t)e * D * 512, D, 512, W13_t + (size_t)e * D * D, scr, r - 256, lane, op::RowW13{1});
            else op::transpose_item(w2 + (size_t)e * 512 * D, 512, D, W2_t + (size_t)e * D * 512, scr, r - 512, lane, op::RowId{});
        }
    }
    xcd_barrier(bar);
    router2(h1, wrg, brg, wre, bre, cnt, tok_e, tok_rank, tok_gate, stok);
    xcd_barrier(bar);
    op::moe_build_tab(moetab, cnt, tstart_g);
    {
        pg8::Gemm g{h1b, W13_t, 0, 0, D}; op::MoeOrder S{moetab, (int)gridDim.x, (int)blockIdx.x, stok};
        op::EpiMoe1 E{Hb};
        pg8::gemm_phase<op::EpiMoe1, op::MoeOrder, true, true, true>(lds, g, S, E);
    }
    xcd_barrier(bar);
    {
        pg8::Gemm g{Hb, W2_t, 0, 0, 512}; op::MoeOrder S{moetab, (int)gridDim.x, (int)blockIdx.x, stok};
        op::EpiBf16P E{Yb, D, 3};
        pg8::gemm_phase<op::EpiBf16P, op::MoeOrder, true, true, false>(lds, g, S, E);
    }
    xcd_barrier(bar);
    ln2_rows(h1, Yb, tok_e, tok_rank, tok_gate, tstart_g, ln2_g, ln2_b, out);
}

extern "C" void kernel_launch(void* const* d_in, const int* in_sizes, int n_in, void* d_out, int out_size, void* d_ws, size_t ws_size, hipStream_t stream) {
    static int grid = 0;
    if (grid == 0) {
        if (n_in != 22 || ws_size < 264 * MiB) { fprintf(stderr, "kernel_launch: unexpected n_in %d / ws %zu\n", n_in, ws_size); grid = -1; return; }
        int dev = 0, cus = 0, per_cu = 0;
        if (hipGetDevice(&dev) != hipSuccess || hipDeviceGetAttribute(&cus, hipDeviceAttributeMultiprocessorCount, dev) != hipSuccess) { grid = -1; return; }
        if (hipFuncSetAttribute((const void*)mega_fwd, hipFuncAttributeMaxDynamicSharedMemorySize, LDS_BYTES) != hipSuccess) { fprintf(stderr, "kernel_launch: hipFuncSetAttribute failed\n"); grid = -1; return; }
        if (hipOccupancyMaxActiveBlocksPerMultiprocessor(&per_cu, (const void*)mega_fwd, NTHREADS, LDS_BYTES) != hipSuccess || per_cu < 1) { fprintf(stderr, "kernel_launch: occupancy query says %d\n", per_cu); (void)hipGetLastError(); }
        grid = cus;
    }
    if (grid < 0) return;
    if (hipMemsetAsync((char*)d_ws + WS_CTL, 0, CTL_ZERO_BYTES, stream) != hipSuccess) return;
    Args a{};
    for (int i = 0; i < 22; ++i) a.in[i] = (const float*)d_in[i];
    a.out = (float*)d_out; a.ws = (unsigned char*)d_ws;
    hipLaunchKernelGGL(mega_fwd, dim3(grid), dim3(NTHREADS), LDS_BYTES, stream, a);
}
```

```cpp
#include <hip/hip_runtime.h>
#include <cstdio>
#include <cstdint>
#include <cmath>

#define LAS __attribute__((address_space(3)))
constexpr int NTHREADS = 512, NWAVES = 8;
constexpr int LDS_BYTES = 147456;

#define XB_TMO      128
#define XB_XCNT(j)  (256  + 64 * (j))
#define XB_XSUB(j)  (1280 + 64 * (j))
#define XB_XGEN(j)  (2304 + 64 * (j))
#define XB_TOP      3328
#define XB_TOPGEN   3392
#define XCD_BAR_WORDS 3456
#define XB_SPIN_CAP (1u << 18)

__device__ __forceinline__ unsigned xb_ld(unsigned* p)              { return __hip_atomic_load(p, __ATOMIC_RELAXED, __HIP_MEMORY_SCOPE_AGENT); }
__device__ __forceinline__ unsigned xb_add(unsigned* p, unsigned v) { return __hip_atomic_fetch_add(p, v, __ATOMIC_RELAXED, __HIP_MEMORY_SCOPE_AGENT); }
__device__ __forceinline__ unsigned xb_xcc_id() { return (unsigned)__builtin_amdgcn_s_getreg((3 << 11) | 20) & 0xFu; }
#define XB_SPIN(cond, bar) do { unsigned _sp = 0; while (cond) { __builtin_amdgcn_s_sleep(1); \
    if ((++_sp & 255u) == 0u) { if (xb_ld(&(bar)[XB_TMO])) break; if (_sp > XB_SPIN_CAP) { atomicAdd(&(bar)[XB_TMO], 1u); break; } } } } while (0)

struct XcdBarrier {
    unsigned* bar; unsigned x;
    volatile LAS unsigned* st;
};

__device__ __forceinline__ XcdBarrier xcd_barrier_post(unsigned* bar, volatile LAS unsigned* st) {
    XcdBarrier b; b.bar = bar; b.x = xb_xcc_id(); b.st = st;
    if (threadIdx.x == 0) (void)xb_add(&bar[XB_XCNT(b.x)], 1u);
    return b;
}
__device__ __forceinline__ void xcd_barrier_complete(unsigned* bar, unsigned x, unsigned& nloc, unsigned& nx) {
    const unsigned G = gridDim.x * gridDim.y * gridDim.z;
    unsigned sum, cnt, mine, sp = 0u;
    for (;;) {
        sum = 0u; cnt = 0u; mine = 0u;
#pragma unroll
        for (unsigned j = 0; j < 16; ++j) { const unsigned c = xb_ld(&bar[XB_XCNT(j)]); sum += c; cnt += (c > 0u) ? 1u : 0u; mine = (j == x) ? c : mine; }
        if (sum == G) break;
        __builtin_amdgcn_s_sleep(1);
        if ((++sp & 255u) == 0u) { if (xb_ld(&bar[XB_TMO])) break; if (sp > XB_SPIN_CAP) { atomicAdd(&bar[XB_TMO], 1u); break; } }
    }
    nloc = mine > 0u ? mine : 1u; nx = cnt > 0u ? cnt : 1u;
}

__device__ __forceinline__ void xcd_barrier(const XcdBarrier& b) {
    asm volatile("s_waitcnt vmcnt(0)" ::: "memory");
    __syncthreads();
    if (threadIdx.x == 0) {
        unsigned* bar = b.bar;
        __builtin_amdgcn_s_waitcnt(0);
        unsigned nloc = b.st[0], nx = b.st[1];
        if (nloc == 0u) { xcd_barrier_complete(bar, b.x, nloc, nx); b.st[0] = nloc; b.st[1] = nx; }
        const unsigned old = xb_add(&bar[XB_XSUB(b.x)], 1u);
        const unsigned gen = old / nloc;
        if (old + 1u == (gen + 1u) * nloc) {
            __builtin_amdgcn_fence(__ATOMIC_RELEASE, "agent");
            asm volatile("s_waitcnt vmcnt(0)" ::: "memory");
            const unsigned og = xb_add(&bar[XB_TOP], 1u);
            const unsigned tg = og / nx;
            if (og + 1u == (tg + 1u) * nx) xb_add(&bar[XB_TOPGEN], 1u);
            else XB_SPIN(xb_ld(&bar[XB_TOPGEN]) == tg, bar);
            __builtin_amdgcn_fence(__ATOMIC_ACQUIRE, "agent");
            xb_add(&bar[XB_XGEN(b.x)], 1u);
            asm volatile("s_waitcnt vmcnt(0)" ::: "memory");
        } else {
            XB_SPIN(xb_ld(&bar[XB_XGEN(b.x)]) == gen, bar);
            __builtin_amdgcn_fence(__ATOMIC_ACQUIRE, "agent");
            asm volatile("s_waitcnt vmcnt(0)" ::: "memory");
        }
    }
    __syncthreads();
}
namespace pg8 {
#define PG8_LAS __attribute__((address_space(3)))
typedef unsigned short bf16_t;
typedef short bf16x8 __attribute__((ext_vector_type(8)));
typedef float f32x4 __attribute__((ext_vector_type(4)));
typedef unsigned u32x4 __attribute__((ext_vector_type(4)));
constexpr int BM = 256, BK = 64, HALF = 128, HTB = HALF * BK * 2  , STAGE_BYTES = 8 * HTB, NXCD = 8, WGM = 8;

__host__ __device__ __forceinline__ int lds_byte(int r, int c) { const int st = (r >> 4) * 2 + (c >> 5), rr = r & 15, cc = c & 31, ob = rr * 64 + cc * 2; return st * 1024 + (ob ^ (((ob >> 9) & 1) << 5)); }
__host__ __device__ __forceinline__ void stage_rc(int b, int& R, int& C) { const int st = b / 1024, sb = b % 1024, swz = sb ^ (((sb >> 9) & 1) << 5); R = (st >> 1) * 16 + swz / 64; C = (st & 1) * 32 + (swz % 64) / 2; }
__host__ __device__ __forceinline__ int perm32(int rho) { const int n = rho >> 4, i = rho & 15; return 8 * (i >> 2) + 4 * n + (i & 3); }

struct Unit { int pm, pn; };
struct Gemm { const bf16_t* A; const bf16_t* Bt; int M, N, K; };

struct StaticOrder {
    int nM, nN, nwg, G, c;
    __host__ __device__ void init(int M, int N, int G_, int c_) { nM = M / BM; nN = N / BM; nwg = nM * nN; G = G_; c = c_; }
    __host__ __device__ bool next(int i, Unit& u) const {
        const long L = (long)i * G + c; if (L >= nwg) return false;
        int wgid = (int)L; { const int q = nwg / NXCD, r = nwg % NXCD, xcd = wgid % NXCD, off = wgid / NXCD; wgid = (xcd < r ? xcd * (q + 1) : r * (q + 1) + (xcd - r) * q) + off; }
        const int nig = WGM * nN, gid = wgid / nig, fm = gid * WGM, gsz = (nM - fm) < WGM ? (nM - fm) : WGM;
        u.pm = fm + ((wgid % nig) % gsz); u.pn = (wgid % nig) / gsz; return true;
    }
    __device__ __forceinline__ void a_ready(const Unit&) const {}
    __device__ __forceinline__ void done(const Unit&) const {}
    __device__ __forceinline__ int arow(const Unit&, int) const { return 0; }
};

__device__ __forceinline__ unsigned cvt_pk_bf16(float lo, float hi) { unsigned r; asm volatile("v_cvt_pk_bf16_f32 %0, %1, %2" : "=v"(r) : "v"(lo), "v"(hi)); return r; }
typedef float f32x2 __attribute__((ext_vector_type(2)));
__device__ __forceinline__ f32x2 gelu_pk(f32x2 v) {
    const f32x2 av = __builtin_elementwise_abs(v), d = av * 0.2316418882f + 1.0f;
    f32x2 t; t.x = __builtin_amdgcn_rcpf(d.x); t.y = __builtin_amdgcn_rcpf(d.y);
    f32x2 q = t * 0.5307027145f + (-0.7265760135f); q = q * t + 0.7107068705f; q = q * t + (-0.142248368f); q = q * t + 0.127414796f; q = q * t;
    const f32x2 s = (v * v) * (-0.72134752044f);
    f32x2 e; e.x = __builtin_amdgcn_exp2f(s.x); e.y = __builtin_amdgcn_exp2f(s.y);
    const f32x2 m = v * (q * e), r = v - m;
    f32x2 o; o.x = v.x < 0.f ? m.x : r.x; o.y = v.y < 0.f ? m.y : r.y; return o;
}

template <int ACT  > struct EpiBf16 {
    static constexpr bool PERM = true, AFTER_DRAIN = false; static_assert(ACT == 0 || ACT == 1, "EpiBf16: ACT is 0 (none) or 1 (gelu_pk)");
    bf16_t* O; int ldc; const float* bias; int split_cols; size_t split_stride; float scale0;
    __device__ __forceinline__ void operator()(const f32x4 (&acc)[2][2][4][2], const Unit& u, int wr, int wc, int fr, int fq) const {
        const int row0 = u.pm * BM + wr * 64 + fr; int colt = u.pn * BM; bf16_t* base = O;
        float sc = 1.f; if (split_cols) { const int t = colt / split_cols; base += (size_t)t * split_stride; colt -= t * split_cols; if (t == 0) sc = scale0; }
        const int col0 = colt + wc * 32 + 8 * fq, bcol0 = u.pn * BM + wc * 32 + 8 * fq;
        f32x4 bv[2][2];
#pragma unroll
        for (int bj = 0; bj < 2; ++bj)
#pragma unroll
            for (int n = 0; n < 2; ++n) bv[bj][n] = bias ? *(const f32x4*)(bias + bcol0 + bj * HALF + 4 * n) : (f32x4){0.f, 0.f, 0.f, 0.f};
#pragma unroll
        for (int ai = 0; ai < 2; ++ai)
#pragma unroll
            for (int m = 0; m < 4; ++m) { bf16_t* rowp = base + (size_t)(row0 + ai * HALF + m * 16) * ldc + col0;
#pragma unroll
                for (int bj = 0; bj < 2; ++bj) { f32x4 v0 = acc[ai][bj][m][0] + bv[bj][0], v1 = acc[ai][bj][m][1] + bv[bj][1];
                    if (ACT == 1) { f32x2 a = gelu_pk((f32x2){v0[0], v0[1]}), b = gelu_pk((f32x2){v0[2], v0[3]}), c = gelu_pk((f32x2){v1[0], v1[1]}), d = gelu_pk((f32x2){v1[2], v1[3]});
                        v0 = (f32x4){a.x, a.y, b.x, b.y}; v1 = (f32x4){c.x, c.y, d.x, d.y}; }
                    v0 = v0 * sc; v1 = v1 * sc; u32x4 w; w.x = cvt_pk_bf16(v0[0], v0[1]); w.y = cvt_pk_bf16(v0[2], v0[3]); w.z = cvt_pk_bf16(v1[0], v1[1]); w.w = cvt_pk_bf16(v1[2], v1[3]);
                    *(u32x4*)(rowp + bj * HALF) = w; } }
    }
};

struct PanelStats {
    unsigned* xbuf;
    unsigned* cnt;
    unsigned* tmo;
    int ntn; float eps;
    unsigned code;
    __device__ __forceinline__ bool run(const f32x4 (&v)[2][2][4][2], const Unit& u, int wr, int wc, int fr, int fq, PG8_LAS unsigned char* lds, int wid, int lane) const {
        typedef float f32x2v __attribute__((ext_vector_type(2)));
        PG8_LAS f32x2v* P = (PG8_LAS f32x2v*)lds;
        PG8_LAS f32x2v* S = (PG8_LAS f32x2v*)(lds + 8192);
        PG8_LAS unsigned* flag = (PG8_LAS unsigned*)(lds + 8192 + 2048);
#pragma unroll
        for (int ai = 0; ai < 2; ++ai)
#pragma unroll
            for (int m = 0; m < 4; ++m) {
                float s = 0.f;
#pragma unroll
                for (int bj = 0; bj < 2; ++bj)
#pragma unroll
                    for (int n = 0; n < 2; ++n) { const f32x4 x = v[ai][bj][m][n]; s += (x[0] + x[1]) + (x[2] + x[3]); }
                s += __shfl_xor(s, 16); s += __shfl_xor(s, 32);
                const float mw = s * (1.0f / 64.0f); float q = 0.f;
#pragma unroll
                for (int bj = 0; bj < 2; ++bj)
#pragma unroll
                    for (int n = 0; n < 2; ++n) { const f32x4 d = v[ai][bj][m][n] - mw; q += (d[0] * d[0] + d[1] * d[1]) + (d[2] * d[2] + d[3] * d[3]); }
                q += __shfl_xor(q, 16); q += __shfl_xor(q, 32);
                if (fq == 0) P[(ai * HALF + wr * 64 + m * 16 + fr) * 4 + wc] = (f32x2v){mw, q};
            }
        asm volatile("s_waitcnt lgkmcnt(0)" ::: "memory"); __builtin_amdgcn_s_barrier(); asm volatile("" ::: "memory");
#if defined(BROKEN_EXCHANGE_NO_WAIT)
#warning BROKEN CONTROL BUILD: the row-statistics exchange does not wait; results are wrong by design
        if (blockIdx.x >= 64) { const long long t0_ = clock64(); while (clock64() - t0_ < 60000) __builtin_amdgcn_s_sleep(8); }
#endif
        const int row = wid * 32 + (lane & 31);
        if (lane < 32) {
            const f32x2v a = P[row * 4 + 0], b = P[row * 4 + 1], c = P[row * 4 + 2], d = P[row * 4 + 3];
            const float mt = (a.x + b.x + c.x + d.x) * 0.25f;
            const float da = a.x - mt, db = b.x - mt, dc = c.x - mt, dd = d.x - mt;
            const float m2 = (a.y + b.y) + (c.y + d.y) + 64.0f * ((da * da + db * db) + (dc * dc + dd * dd));
            unsigned long long* slot = (unsigned long long*)xbuf + ((size_t)(u.pm * BM + row) * 4 + u.pn);
            __hip_atomic_store(slot, ((unsigned long long)__float_as_uint(m2) << 32) | __float_as_uint(mt), __ATOMIC_RELAXED, __HIP_MEMORY_SCOPE_AGENT);
        }
        asm volatile("s_waitcnt vmcnt(0)" ::: "memory");
        if (lane == 0) __hip_atomic_fetch_add(cnt + 64 * u.pm, 1u, __ATOMIC_RELAXED, __HIP_MEMORY_SCOPE_AGENT);
        if (wid == 0) {
            bool dead = false; const unsigned long long t0 = __builtin_amdgcn_s_memrealtime(); const unsigned want = 8u * (unsigned)ntn;
            for (;;) {
#if defined(BROKEN_EXCHANGE_NO_WAIT)
                break;
#endif
                if ((unsigned)__builtin_amdgcn_readfirstlane(__hip_atomic_load(cnt + 64 * u.pm, __ATOMIC_RELAXED, __HIP_MEMORY_SCOPE_AGENT)) >= want) break;
                if (__builtin_amdgcn_s_memrealtime() - t0 > 2000000ull) {
                    if (lane == 0) { unsigned expect = 0u; __hip_atomic_compare_exchange_strong(tmo + 1, &expect, code | (unsigned)(u.pm & 0xff), __ATOMIC_RELAXED, __ATOMIC_RELAXED, __HIP_MEMORY_SCOPE_AGENT);
                                     __hip_atomic_store(tmo, 1u, __ATOMIC_RELAXED, __HIP_MEMORY_SCOPE_AGENT); }
                    dead = true; break; }
                __builtin_amdgcn_s_sleep(2);
            }
            __builtin_amdgcn_fence(__ATOMIC_ACQUIRE, "agent");
            if (lane == 0) flag[0] = dead ? 1u : 0u;
        }
        asm volatile("s_waitcnt vmcnt(0) lgkmcnt(0)" ::: "memory"); __builtin_amdgcn_s_barrier(); asm volatile("" ::: "memory");
        const bool bad = flag[0] != 0u;
        if (lane < 32) {
            const unsigned long long* slot = (const unsigned long long*)xbuf + (size_t)(u.pm * BM + row) * 4; float mt[4], m2[4]; float ms = 0.f;
#pragma unroll
            for (int t = 0; t < 4; ++t) { if (t < ntn) { const unsigned long long w = __hip_atomic_load(slot + t, __ATOMIC_RELAXED, __HIP_MEMORY_SCOPE_AGENT); mt[t] = __uint_as_float((unsigned)w); m2[t] = __uint_as_float((unsigned)(w >> 32)); } else { mt[t] = 0.f; m2[t] = 0.f; } ms += mt[t]; }
            const float mean = ms / (float)ntn; float q = 0.f;
#pragma unroll
            for (int t = 0; t < 4; ++t) if (t < ntn) { const float dm = mt[t] - mean; q += m2[t] + 256.0f * dm * dm; }
            S[row] = (f32x2v){mean, 1.0f / sqrtf(q / (256.0f * (float)ntn) + eps)};
        }
        asm volatile("s_waitcnt lgkmcnt(0)" ::: "memory"); __builtin_amdgcn_s_barrier(); asm volatile("" ::: "memory");
        return bad;
    }
};
struct EpiLnRes {
    static constexpr bool PERM = false, AFTER_DRAIN = true;
    const float* base; float* out; int ldc; const float* bias; PanelStats st; unsigned poison;
    __device__ __forceinline__ void fused(f32x4 (&acc)[2][2][4][2], const Unit& u, int wr, int wc, int fr, int fq, PG8_LAS unsigned char* lds, int wid, int lane) const {
        typedef float f32x2v __attribute__((ext_vector_type(2)));
        const PG8_LAS f32x2v* S = (const PG8_LAS f32x2v*)(lds + 8192);
        const int col0 = u.pn * BM + wc * 32 + 4 * fq;
#pragma unroll
        for (int bj = 0; bj < 2; ++bj)
#pragma unroll
            for (int n = 0; n < 2; ++n) { const f32x4 bv = bias ? *(const f32x4*)(bias + col0 + bj * HALF + n * 16) : (f32x4){0.f, 0.f, 0.f, 0.f};
#pragma unroll
                for (int ai = 0; ai < 2; ++ai)
#pragma unroll
                    for (int m = 0; m < 4; ++m) acc[ai][bj][m][n] += bv; }
        f32x4 pre[4][2][2];
#pragma unroll
        for (int m = 0; m < 4; ++m) { const size_t off = (size_t)(u.pm * BM + wr * 64 + m * 16 + fr) * ldc + col0;
#pragma unroll
            for (int bj = 0; bj < 2; ++bj)
#pragma unroll
                for (int n = 0; n < 2; ++n) pre[m][bj][n] = *(const f32x4*)(base + off + bj * HALF + n * 16); }
        const bool bad = st.run(acc, u, wr, wc, fr, fq, lds, wid, lane) || poison != 0u;
        const float qnan = __builtin_nanf("");
#pragma unroll
        for (int ai = 0; ai < 2; ++ai)
#pragma unroll
            for (int m = 0; m < 4; ++m) { const int r = ai * HALF + wr * 64 + m * 16 + fr; const f32x2v sr = S[r]; const size_t off = (size_t)(u.pm * BM + r) * ldc + col0;
#pragma unroll
                for (int bj = 0; bj < 2; ++bj)
#pragma unroll
                    for (int n = 0; n < 2; ++n) { const f32x4 bs = ai == 0 ? pre[m][bj][n] : *(const f32x4*)(base + off + bj * HALF + n * 16); f32x4 o = bs + (acc[ai][bj][m][n] - sr.x) * sr.y;
                        if (bad) o = (f32x4){qnan, qnan, qnan, qnan}; *(f32x4*)(out + off + bj * HALF + n * 16) = o; }
                if (m & 1) asm volatile("" ::: "memory"); }
    }
};
struct EpiLnResLn {
    static constexpr bool PERM = false, AFTER_DRAIN = true;
    const float* base; float* out; bf16_t* xn; int ldc; const float* bias; PanelStats st1, st2; unsigned poison;
    __device__ __forceinline__ void fused(f32x4 (&acc)[2][2][4][2], const Unit& u, int wr, int wc, int fr, int fq, PG8_LAS unsigned char* lds, int wid, int lane) const {
        typedef float f32x2v __attribute__((ext_vector_type(2))); typedef unsigned u32x2v __attribute__((ext_vector_type(2)));
        const PG8_LAS f32x2v* S = (const PG8_LAS f32x2v*)(lds + 8192);
        const int col0 = u.pn * BM + wc * 32 + 4 * fq;
#pragma unroll
        for (int bj = 0; bj < 2; ++bj)
#pragma unroll
            for (int n = 0; n < 2; ++n) { const f32x4 bv = bias ? *(const f32x4*)(bias + col0 + bj * HALF + n * 16) : (f32x4){0.f, 0.f, 0.f, 0.f};
#pragma unroll
                for (int ai = 0; ai < 2; ++ai)
#pragma unroll
                    for (int m = 0; m < 4; ++m) acc[ai][bj][m][n] += bv; }
        bool bad = st1.run(acc, u, wr, wc, fr, fq, lds, wid, lane) || poison != 0u;
        const float qnan = __builtin_nanf("");
#pragma unroll
        for (int ai = 0; ai < 2; ++ai)
#pragma unroll
            for (int m = 0; m < 4; ++m) { const int r = ai * HALF + wr * 64 + m * 16 + fr; const f32x2v sr = S[r]; const size_t off = (size_t)(u.pm * BM + r) * ldc + col0;
#pragma unroll
                for (int bj = 0; bj < 2; ++bj)
#pragma unroll
                    for (int n = 0; n < 2; ++n) { const f32x4 bs = *(const f32x4*)(base + off + bj * HALF + n * 16); acc[ai][bj][m][n] = bs + (acc[ai][bj][m][n] - sr.x) * sr.y; }
                asm volatile("" : "+v"(acc[ai][0][m][0]), "+v"(acc[ai][0][m][1]), "+v"(acc[ai][1][m][0]), "+v"(acc[ai][1][m][1]));
                if (m & 1) asm volatile("" ::: "memory"); }
        const bool bad1 = bad;
        bad = st2.run(acc, u, wr, wc, fr, fq, lds, wid, lane) || bad;
#pragma unroll
        for (int ai = 0; ai < 2; ++ai)
#pragma unroll
            for (int m = 0; m < 4; ++m) { const int r = ai * HALF + wr * 64 + m * 16 + fr; const f32x2v sr = S[r]; const size_t off = (size_t)(u.pm * BM + r) * ldc + col0;
#pragma unroll
                for (int bj = 0; bj < 2; ++bj)
#pragma unroll
                    for (int n = 0; n < 2; ++n) { const f32x4 x1 = acc[ai][bj][m][n]; *(f32x4*)(out + off + bj * HALF + n * 16) = bad1 ? (f32x4){qnan, qnan, qnan, qnan} : x1;
                        const f32x4 o = (x1 - sr.x) * sr.y; u32x2v w; w.x = cvt_pk_bf16(o[0], o[1]); w.y = cvt_pk_bf16(o[2], o[3]);
                        if (bad) { w.x = 0x7fc07fc0u; w.y = 0x7fc07fc0u; } *(u32x2v*)(xn + off + bj * HALF + n * 16) = w; }
                asm volatile("" ::: "memory"); }
    }
};

template <class E, class = void> struct has_mid { static constexpr bool value = false; };
template <class E> struct has_mid<E, decltype((void)E::MID_T)> { static constexpr bool value = true; };
template <class Epi, class Sched, bool ALIGN_EPI = false, bool SP2 = false, bool GATHER = false>
__device__ __forceinline__ void gemm_phase(PG8_LAS unsigned char* lds, const Gemm g, const Sched& S, const Epi& E) {
    int tid_ = threadIdx.x; asm volatile("" : "+v"(tid_));
    const int tid = tid_, wid = __builtin_amdgcn_readfirstlane(tid >> 6), lane = tid & 63, wr = wid >> 2, wc = wid & 3, fr = lane & 15, fq = lane >> 4;
    int K_ = g.K; asm volatile("" : "+s"(K_));
    const int K = K_, nt = K / BK;
    unsigned voffA[2], voffB[2]; int stR[2], stC[2]; static_assert(!GATHER || SP2, "GATHER needs SP2");
#pragma unroll
    for (int i = 0; i < 2; ++i) { int R, C; stage_rc(tid * 16 + i * 8192, R, C); stR[i] = R; stC[i] = C; const int Rb = Epi::PERM ? ((R & ~31) + perm32(R & 31)) : R;
        voffA[i] = (unsigned)(R * K + C) * 2u; voffB[i] = (unsigned)(Rb * K + C) * 2u; }
    const size_t kstep = (size_t)(BK * 2);
    const size_t hstep = (size_t)HALF * K * 2;
    const size_t tstep = 2 * hstep;
    const unsigned ldsw = (unsigned)wid * 1024u;
    const int aoff = lds_byte(wr * 64 + fr, fq * 8), boff = lds_byte(wc * 32 + fr, fq * 8);
#define PG8_SA(b, h) (((b) * 2 + (h)) * HTB)
#define PG8_SB(b, h) ((4 + (b) * 2 + (h)) * HTB)
#define PG8_STAGE(bufoff, gbase, voff) do { _Pragma("unroll") for (int _i = 0; _i < 2; ++_i) \
        __builtin_amdgcn_global_load_lds((const unsigned*)((const char*)(gbase) + (voff)[_i]), (PG8_LAS unsigned*)(lds + (bufoff) + ldsw + _i * 8192), 16, 0, 0); } while (0)
#define PG8_STAGE_A(bufoff, base, h, vsel) do { if constexpr (GATHER) { _Pragma("unroll") for (int _i = 0; _i < 2; ++_i) \
        __builtin_amdgcn_global_load_lds((const unsigned*)((const char*)(base) + (vsel)[h][_i]), (PG8_LAS unsigned*)(lds + (bufoff) + ldsw + _i * 8192), 16, 0, 0); } \
        else { PG8_STAGE(bufoff, (base) + (h) * hstep, voffA); } } while (0)
#define PG8_GOFF(dst, u) do { _Pragma("unroll") for (int _h = 0; _h < 2; ++_h) _Pragma("unroll") for (int _i = 0; _i < 2; ++_i) dst[_h][_i] = (unsigned)S.arow(u, _h * HALF + stR[_i]) * (unsigned)(K * 2) + (unsigned)(stC[_i] * 2); } while (0)
#define PG8_LDA(dst, b, h) do { _Pragma("unroll") for (int m = 0; m < 4; ++m) _Pragma("unroll") for (int k = 0; k < 2; ++k) dst[m][k] = *(const PG8_LAS bf16x8*)(lds + PG8_SA(b, h) + aoff + m * 2048 + k * 1024); } while (0)
#define PG8_LDB(dst, b, h) do { _Pragma("unroll") for (int n = 0; n < 2; ++n) _Pragma("unroll") for (int k = 0; k < 2; ++k) dst[n][k] = *(const PG8_LAS bf16x8*)(lds + PG8_SB(b, h) + boff + n * 2048 + k * 1024); } while (0)
#define PG8_MMA(ai, bj, At, Bt) do { __builtin_amdgcn_s_setprio(1); _Pragma("unroll") for (int m = 0; m < 4; ++m) _Pragma("unroll") for (int n = 0; n < 2; ++n) _Pragma("unroll") for (int k = 0; k < 2; ++k) \
        acc[ai][bj][m][n] = __builtin_amdgcn_mfma_f32_16x16x32_bf16(Bt[n][k], At[m][k], acc[ai][bj][m][n], 0, 0, 0); __builtin_amdgcn_s_setprio(0); } while (0)
#define PG8_WAIT_V(n) asm volatile("s_waitcnt vmcnt(" #n ")" ::: "memory")
#define PG8_WAIT_L(n) asm volatile("s_waitcnt lgkmcnt(" #n ")" ::: "memory")
#define PG8_BAR __builtin_amdgcn_s_barrier()
#define PG8_SCHED __builtin_amdgcn_sched_barrier(0)
    Unit cur, nxt; int ui = 0;
    if (!S.next(0, cur)) return;
    f32x4 acc[2][2][4][2];
#pragma unroll
    for (int a = 0; a < 2; ++a)
#pragma unroll
        for (int b = 0; b < 2; ++b)
#pragma unroll
            for (int m = 0; m < 4; ++m)
#pragma unroll
                for (int n = 0; n < 2; ++n) acc[a][b][m][n] = (f32x4){0.f, 0.f, 0.f, 0.f};
    bf16x8 At[4][2], B0[2][2], B1[2][2];
    unsigned gC[2][2] = {{0u, 0u}, {0u, 0u}}, gN[2][2] = {{0u, 0u}, {0u, 0u}}, gS[2][2] = {{0u, 0u}, {0u, 0u}};
    if constexpr (GATHER) PG8_GOFF(gC, cur);
    const char* cA = GATHER ? (const char*)g.A : (const char*)g.A + (size_t)cur.pm * tstep; const char* cB = (const char*)g.Bt + (size_t)cur.pn * tstep;
    S.a_ready(cur);
    if constexpr (SP2) {
        PG8_STAGE(PG8_SB(0, 0), cB, voffB); PG8_STAGE(PG8_SB(0, 1), cB + hstep, voffB); PG8_STAGE_A(PG8_SA(0, 0), cA, 0, gC); PG8_STAGE_A(PG8_SA(0, 1), cA, 1, gC);
        if (wr == 1) PG8_BAR;
        PG8_WAIT_V(2); PG8_BAR;
        PG8_STAGE(PG8_SB(1, 0), cB + kstep, voffB); PG8_STAGE_A(PG8_SA(1, 0), cA + kstep, 0, gC); PG8_STAGE(PG8_SB(1, 1), cB + hstep + kstep, voffB);
        PG8_WAIT_V(6); PG8_BAR;
    } else {
        PG8_STAGE(PG8_SB(0, 0), cB, voffB); PG8_STAGE(PG8_SA(0, 0), cA, voffA); PG8_STAGE(PG8_SB(0, 1), cB + hstep, voffB); PG8_STAGE(PG8_SA(0, 1), cA + hstep, voffA);
        if (wr == 1) PG8_BAR;
        PG8_WAIT_V(4); PG8_BAR;
        PG8_STAGE(PG8_SB(1, 0), cB + kstep, voffB); PG8_STAGE(PG8_SA(1, 0), cA + kstep, voffA); PG8_STAGE(PG8_SB(1, 1), cB + hstep + kstep, voffB);
        PG8_WAIT_V(6); PG8_BAR;
    }
    for (;;) {
        const bool has_next = S.next(ui + 1, nxt);
        if constexpr (GATHER) { if (has_next) PG8_GOFF(gN, nxt); else { _Pragma("unroll") for (int _h = 0; _h < 2; ++_h) _Pragma("unroll") for (int _i = 0; _i < 2; ++_i) gN[_h][_i] = gC[_h][_i]; } }
        const char* nA = GATHER ? (const char*)g.A : (has_next ? (const char*)g.A + (size_t)nxt.pm * tstep : cA); const char* nB = has_next ? (const char*)g.Bt + (size_t)nxt.pn * tstep : cB;
        for (int t = 0; t < nt; t += 2) {
            const bool last = (t == nt - 2);
            const char* a1 = cA + (size_t)(t + 1) * kstep;
            const char* a2 = last ? nA : cA + (size_t)(t + 2) * kstep; const char* b2 = last ? nB : cB + (size_t)(t + 2) * kstep;
            const char* a3 = a2 + kstep; const char* b3 = b2 + kstep;
            if (last && has_next) S.a_ready(nxt);
            if constexpr (has_mid<Epi>::value) { if (t == Epi::MID_T) E.mid(acc, cur, wr, wc, fr, fq); }
            if constexpr (GATHER) { _Pragma("unroll") for (int _h = 0; _h < 2; ++_h) _Pragma("unroll") for (int _i = 0; _i < 2; ++_i) gS[_h][_i] = last ? gN[_h][_i] : gC[_h][_i]; }
            if constexpr (SP2) {
            PG8_LDB(B0, 0, 0); PG8_LDB(B1, 0, 1); PG8_SCHED; PG8_LDA(At, 0, 0); PG8_STAGE_A(PG8_SA(1, 1), a1, 1, gC);
            PG8_WAIT_V(8); PG8_WAIT_L(0); PG8_BAR; PG8_MMA(0, 0, At, B0); PG8_MMA(0, 1, At, B1); PG8_BAR; PG8_SCHED;
            PG8_LDA(At, 0, 1); PG8_STAGE(PG8_SB(0, 0), b2, voffB); PG8_STAGE(PG8_SB(0, 1), b2 + hstep, voffB); PG8_STAGE_A(PG8_SA(0, 0), a2, 0, gS);
            PG8_WAIT_V(8); PG8_WAIT_L(0); PG8_BAR; PG8_MMA(1, 0, At, B0); PG8_MMA(1, 1, At, B1); PG8_BAR; PG8_SCHED;
            PG8_LDB(B0, 1, 0); PG8_LDB(B1, 1, 1); PG8_SCHED; PG8_LDA(At, 1, 0); PG8_STAGE_A(PG8_SA(0, 1), a2, 1, gS);
            PG8_WAIT_V(8); PG8_WAIT_L(0); PG8_BAR; PG8_MMA(0, 0, At, B0); PG8_MMA(0, 1, At, B1); PG8_BAR; PG8_SCHED;
            PG8_LDA(At, 1, 1); PG8_STAGE(PG8_SB(1, 0), b3, voffB); PG8_STAGE(PG8_SB(1, 1), b3 + hstep, voffB); PG8_STAGE_A(PG8_SA(1, 0), a3, 0, gS);
            PG8_WAIT_V(8); PG8_WAIT_L(0); PG8_BAR; PG8_MMA(1, 0, At, B0); PG8_MMA(1, 1, At, B1); PG8_BAR; PG8_SCHED;
            } else {
            PG8_LDB(B0, 0, 0); PG8_SCHED; PG8_LDA(At, 0, 0); PG8_STAGE(PG8_SA(1, 1), a1 + hstep, voffA);
            PG8_WAIT_L(8); PG8_BAR; PG8_WAIT_L(0); PG8_MMA(0, 0, At, B0); PG8_BAR; PG8_SCHED;
            PG8_LDB(B1, 0, 1); PG8_STAGE(PG8_SB(0, 0), b2, voffB);
            PG8_BAR; PG8_WAIT_L(0); PG8_MMA(0, 1, At, B1); PG8_BAR;
            PG8_LDA(At, 0, 1); PG8_STAGE(PG8_SA(0, 0), a2, voffA);
            PG8_BAR; PG8_WAIT_L(0); PG8_MMA(1, 0, At, B0); PG8_BAR; PG8_SCHED;
            PG8_STAGE(PG8_SB(0, 1), b2 + hstep, voffB);
            PG8_WAIT_V(6); PG8_BAR; PG8_MMA(1, 1, At, B1); PG8_BAR;
            PG8_LDB(B0, 1, 0); PG8_SCHED; PG8_LDA(At, 1, 0); PG8_STAGE(PG8_SA(0, 1), a2 + hstep, voffA);
            PG8_WAIT_L(8); PG8_BAR; PG8_WAIT_L(0); PG8_MMA(0, 0, At, B0); PG8_BAR; PG8_SCHED;
            PG8_LDB(B1, 1, 1); PG8_STAGE(PG8_SB(1, 0), b3, voffB);
            PG8_BAR; PG8_WAIT_L(0); PG8_MMA(0, 1, At, B1); PG8_BAR;
            PG8_LDA(At, 1, 1); PG8_STAGE(PG8_SA(1, 0), a3, voffA);
            PG8_BAR; PG8_WAIT_L(0); PG8_MMA(1, 0, At, B0); PG8_BAR; PG8_SCHED;
            PG8_STAGE(PG8_SB(1, 1), b3 + hstep, voffB);
            PG8_WAIT_V(6); PG8_BAR; PG8_MMA(1, 1, At, B1); PG8_BAR;
            }
        }
        if constexpr (ALIGN_EPI) { if (wr == 0) PG8_BAR; }
        if constexpr (!Epi::AFTER_DRAIN) { E(acc, cur, wr, wc, fr, fq); S.done(cur); }
        if (!has_next) break;
#pragma unroll
        for (int a = 0; a < 2; ++a)
#pragma unroll
            for (int b = 0; b < 2; ++b)
#pragma unroll
                for (int m = 0; m < 4; ++m)
#pragma unroll
                    for (int n = 0; n < 2; ++n) acc[a][b][m][n] = (f32x4){0.f, 0.f, 0.f, 0.f};
        cur = nxt; cA = nA; cB = nB; ++ui;
        if constexpr (GATHER) { _Pragma("unroll") for (int _h = 0; _h < 2; ++_h) _Pragma("unroll") for (int _i = 0; _i < 2; ++_i) gC[_h][_i] = gN[_h][_i]; }
        if constexpr (ALIGN_EPI) { if (wr == 1) PG8_BAR; }
    }
    PG8_WAIT_V(0);
    if constexpr (!ALIGN_EPI) { if (wr == 0) PG8_BAR; }
    PG8_BAR;
    if constexpr (Epi::AFTER_DRAIN) { E.fused(acc, cur, wr, wc, fr, fq, lds, wid, lane); S.done(cur); }
#undef PG8_SA
#undef PG8_SB
#undef PG8_STAGE
#undef PG8_STAGE_A
#undef PG8_GOFF
#undef PG8_LDA
#undef PG8_LDB
#undef PG8_MMA
#undef PG8_WAIT_V
#undef PG8_WAIT_L
#undef PG8_BAR
#undef PG8_SCHED
}
}

#ifndef PG8_SP2
#define PG8_SP2 true
#endif
#ifndef PG8_ALIGN
#define PG8_ALIGN true
#endif

namespace nv {
constexpr int NTOK = 16384, D = 1024, SEQ = 4096, INC = 2464;
constexpr int O_CQ = 0, O_CKV = 256, O_KR = 384, O_F = 416, O_I = 928, O_Q = 1440, O_G = 1952;
constexpr int NEXP = 32, PSLOTS = 36864, NBLK = 288;
constexpr float ALPHA = 1.189207115002721f;
constexpr float RMS_EPS = 1e-6f, LN_EPS = 1e-5f;

template <class F>
__device__ __forceinline__ void ngemm(LAS unsigned char* lds, int M, int N, int K, const F& f) {
    LAS float* As = (LAS float*)lds;
    LAS float* Bs = As + 16 * 132;
    const int tid = threadIdx.x, tx = tid & 15, ty = tid >> 4;
    const int tn = (N + 63) / 64, tm = (M + 127) / 128;
    for (int tile = blockIdx.x; tile < tn * tm; tile += gridDim.x) {
        const int m0 = (tile / tn) * 128, n0 = (tile % tn) * 64;
        float acc[4][4];
#pragma unroll
        for (int i = 0; i < 4; ++i)
#pragma unroll
            for (int j = 0; j < 4; ++j) acc[i][j] = 0.f;
        for (int k0 = 0; k0 < K; k0 += 16) {
#pragma unroll
            for (int i = 0; i < 4; ++i) { const int idx = tid + i * 512; const int r = idx >> 4, kk = idx & 15; As[kk * 132 + r] = (m0 + r < M) ? f.a(m0 + r, k0 + kk) : 0.f; }
#pragma unroll
            for (int i = 0; i < 2; ++i) { const int idx = tid + i * 512; const int kk = idx >> 6, c = idx & 63; Bs[kk * 68 + c] = (n0 + c < N) ? f.b(k0 + kk, n0 + c, m0) : 0.f; }
            __syncthreads();
#pragma unroll
            for (int kk = 0; kk < 16; ++kk) {
                float a[4], b[4];
#pragma unroll
                for (int i = 0; i < 4; ++i) { a[i] = As[kk * 132 + ty * 4 + i]; b[i] = Bs[kk * 68 + tx * 4 + i]; }
#pragma unroll
                for (int i = 0; i < 4; ++i)
#pragma unroll
                    for (int j = 0; j < 4; ++j) acc[i][j] += a[i] * b[j];
            }
            __syncthreads();
        }
#pragma unroll
        for (int i = 0; i < 4; ++i)
#pragma unroll
            for (int j = 0; j < 4; ++j) { const int r = m0 + ty * 4 + i, c = n0 + tx * 4 + j; if (r < M && c < N) f.epi(r, c, acc[i][j]); }
    }
}

struct ProjF { const float* x; const float* w; float* out;
    __device__ float a(int r, int k) const { return x[(size_t)r * D + k]; }
    __device__ float b(int k, int c, int) const { return w[(size_t)k * INC + c]; }
    __device__ void epi(int r, int c, float v) const { out[(size_t)r * INC + c] = v; } };
struct PlainF { const float* A; int lda; const float* B; int ldb; float* C; int ldc;
    __device__ float a(int r, int k) const { return A[(size_t)r * lda + k]; }
    __device__ float b(int k, int c, int) const { return B[(size_t)k * ldb + c]; }
    __device__ void epi(int r, int c, float v) const { C[(size_t)r * ldc + c] = v; } };
struct MixF { const float* an; const float* rr; const float* w; const float* x; float* t;
    __device__ float a(int r, int k) const { return k < 512 ? an[(size_t)r * 512 + k] : rr[(size_t)r * 512 + k - 512]; }
    __device__ float b(int k, int c, int) const { return w[(size_t)k * D + c]; }
    __device__ void epi(int r, int c, float v) const { t[(size_t)r * D + c] = ALPHA * x[(size_t)r * D + c] + v; } };
struct Moe1F { const float* h1; const int* slot_tok; const int* blk_exp; const float* w; float* H; int which;
    __device__ float a(int r, int k) const { const int tok = slot_tok[r]; return tok < NTOK ? h1[(size_t)tok * D + k] : 0.f; }
    __device__ float b(int k, int c, int m0) const { const int e = blk_exp[m0 >> 7]; return w[((size_t)e * D + k) * 512 + c]; }
    __device__ void epi(int r, int c, float v) const { float* p = H + (size_t)r * 512 + c; if (which == 0) *p = v / (1.f + expf(-v)); else *p *= v; } };
struct Moe2F { const float* H; const int* slot_tok; const float* slot_gate; const int* blk_exp; const float* w; float* acc;
    __device__ float a(int r, int k) const { return H[(size_t)r * 512 + k]; }
    __device__ float b(int k, int c, int m0) const { const int e = blk_exp[m0 >> 7]; return w[((size_t)e * 512 + k) * D + c]; }
    __device__ void epi(int r, int c, float v) const { const int tok = slot_tok[r]; if (tok < NTOK) atomicAdd(acc + (size_t)tok * D + c, slot_gate[r] * v); } };

__device__ __forceinline__ float wsum(float v) {
#pragma unroll
    for (int o = 1; o < 64; o <<= 1) v += __shfl_xor(v, o);
    return v;
}
__device__ __forceinline__ int tidx() { int t = threadIdx.x; asm volatile("" : "+v"(t)); return t; }
#define GTID (blockIdx.x * NTHREADS + nv::tidx())
#define GTHREADS (gridDim.x * NTHREADS)
#define GWAVE (blockIdx.x * NWAVES + (nv::tidx() >> 6))
#define GWAVES (gridDim.x * NWAVES)

__device__ __forceinline__ void hg_gate(float* proj, const float* lbl) {
    for (int i = GTID; i < NTOK * 512; i += GTHREADS) {
        const int r = i >> 9, c = i & 511;
        const float l0 = lbl[c], l1 = lbl[512 + c]; const float mx = fmaxf(l0, l1);
        const float e0 = expf(l0 - mx), e1 = expf(l1 - mx); const float lb = e0 / (e0 + e1);
        float* p = proj + (size_t)r * INC + O_F + c; const float z = *p;
        *p = lb + (1.f - lb) * (1.f / (1.f + expf(-z)));
    }
}
__device__ __forceinline__ void hg_rec(float* proj) {
    if (blockIdx.x >= 16 || threadIdx.x >= 128) return;
    const int bh = blockIdx.x, b = bh >> 2, h = bh & 3, e = threadIdx.x;
    float S[128];
#pragma unroll
    for (int d = 0; d < 128; ++d) S[d] = 0.f;
    for (int t = 0; t < SEQ; ++t) {
        float* row = proj + (size_t)(b * SEQ + t) * INC;
        const float v = row[O_I + h * 128 + e];
        const float* fr = row + O_F + h * 128; const float* qr = row + O_Q + h * 128;
        float o = 0.f;
#pragma unroll
        for (int d = 0; d < 128; ++d) { const float f = fr[d]; S[d] = f * S[d] + (1.f - f) * v; o += qr[d] * S[d]; }
        row[O_I + h * 128 + e] = o;
    }
}
__device__ __forceinline__ void hg_out(const float* proj, const float* g, float* rr) {
    const int lane = nv::tidx() & 63;
    for (int w = GWAVE; w < NTOK * 4; w += GWAVES) {
        const int r = w >> 2, h = w & 3; const float* row = proj + (size_t)r * INC;
        const float o0 = row[O_I + h * 128 + lane], o1 = row[O_I + h * 128 + 64 + lane];
        const float ss = wsum(o0 * o0 + o1 * o1); const float rs = 1.f / sqrtf(ss * (1.f / 128.f) + RMS_EPS);
        const float g0 = row[O_G + h * 128 + lane], g1 = row[O_G + h * 128 + 64 + lane];
        rr[(size_t)r * 512 + h * 128 + lane] = o0 * rs * g[lane] * (g0 / (1.f + expf(-g0)));
        rr[(size_t)r * 512 + h * 128 + 64 + lane] = o1 * rs * g[64 + lane] * (g1 / (1.f + expf(-g1)));
    }
}
__device__ __forceinline__ void cs_tab(const int* pos, float* cs) {
    for (int i = GTID; i < NTOK * 16; i += GTHREADS) {
        const int j = i & 15, r = i >> 4;
        const float invf = (float)pow(10000.0, -(double)(2 * j) / 32.0);
        const float ang = (float)pos[r] * invf;
        double s, c; sincos((double)ang, &s, &c);
        cs[(size_t)r * 32 + j] = (float)c; cs[(size_t)r * 32 + 16 + j] = (float)s;
    }
}
__device__ __forceinline__ void mla_prep(const float* proj, const float* gq, const float* gkv, const float* cs, float* cqn, float* ckvn, float* kr) {
    const int lane = nv::tidx() & 63;
    for (int r = GWAVE; r < NTOK; r += GWAVES) {
        const float* row = proj + (size_t)r * INC;
        float v[4]; float ss = 0.f;
#pragma unroll
        for (int i = 0; i < 4; ++i) { v[i] = row[O_CQ + lane + 64 * i]; ss += v[i] * v[i]; }
        ss = wsum(ss); float rs = 1.f / sqrtf(ss * (1.f / 256.f) + RMS_EPS);
#pragma unroll
        for (int i = 0; i < 4; ++i) cqn[(size_t)r * 256 + lane + 64 * i] = v[i] * rs * gq[lane + 64 * i];
        float u0 = row[O_CKV + lane], u1 = row[O_CKV + 64 + lane];
        ss = wsum(u0 * u0 + u1 * u1); rs = 1.f / sqrtf(ss * (1.f / 128.f) + RMS_EPS);
        ckvn[(size_t)r * 128 + lane] = u0 * rs * gkv[lane]; ckvn[(size_t)r * 128 + 64 + lane] = u1 * rs * gkv[64 + lane];
        if (lane < 16) { const float x1 = row[O_KR + lane], x2 = row[O_KR + 16 + lane]; const float c = cs[(size_t)r * 32 + lane], s = cs[(size_t)r * 32 + 16 + lane];
            kr[(size_t)r * 32 + lane] = x1 * c - x2 * s; kr[(size_t)r * 32 + 16 + lane] = x2 * c + x1 * s; }
    }
}
__device__ __forceinline__ void q_rope(float* q, const float* cs) {
    for (int i = GTID; i < NTOK * 8 * 16; i += GTHREADS) {
        const int j = i & 15, h = (i >> 4) & 7, r = i >> 7;
        float* p = q + (size_t)r * 768 + h * 96 + 64; const float x1 = p[j], x2 = p[16 + j]; const float c = cs[(size_t)r * 32 + j], s = cs[(size_t)r * 32 + 16 + j];
        p[j] = x1 * c - x2 * s; p[16 + j] = x2 * c + x1 * s;
    }
}
__device__ __forceinline__ void attn_naive(const float* q, const float* kv, const float* kr, float* out) {
    const int lane = nv::tidx() & 63;
    for (int task = GWAVE; task < 2048; task += GWAVES) {
        const int tsk = __builtin_amdgcn_readfirstlane(task);
        const int qc = 63 - (tsk >> 5), h = tsk & 7, b = (tsk >> 3) & 3;
        const int t = qc * 64 + lane; const size_t row = (size_t)b * SEQ + t;
        const float scale = 0.10206207261596575f;
        float qv[96];
#pragma unroll
        for (int d = 0; d < 96; ++d) qv[d] = q[row * 768 + h * 96 + d] * scale;
        float o[64];
#pragma unroll
        for (int d = 0; d < 64; ++d) o[d] = 0.f;
        float m = -INFINITY, l = 0.f;
        const int nk = (qc + 1) * 64;
        for (int s = 0; s < nk; ++s) {
            const size_t kr_ = (size_t)b * SEQ + s;
            const float* kp = kv + kr_ * 1024 + h * 128; const float* rp = kr + kr_ * 32;
            float sc = 0.f;
#pragma unroll
            for (int d = 0; d < 64; ++d) sc += qv[d] * kp[d];
#pragma unroll
            for (int d = 0; d < 32; ++d) sc += qv[64 + d] * rp[d];
            const float mn = fmaxf(m, sc); const float corr = expf(m - mn), p = expf(sc - mn);
            l = l * corr + p;
#pragma unroll
            for (int d = 0; d < 64; ++d) o[d] = o[d] * corr + p * kp[64 + d];
            m = mn;
        }
        const float il = 1.f / l;
#pragma unroll
        for (int d = 0; d < 64; ++d) out[row * 512 + h * 64 + d] = o[d] * il;
    }
}
__device__ __forceinline__ void a_norm(float* a, const float* g) {
    const int lane = nv::tidx() & 63;
    for (int r = GWAVE; r < NTOK; r += GWAVES) {
        float v[8]; float ss = 0.f;
#pragma unroll
        for (int i = 0; i < 8; ++i) { v[i] = a[(size_t)r * 512 + lane + 64 * i]; ss += v[i] * v[i]; }
        ss = wsum(ss); const float rs = 1.f / sqrtf(ss * (1.f / 512.f) + RMS_EPS);
#pragma unroll
        for (int i = 0; i < 8; ++i) a[(size_t)r * 512 + lane + 64 * i] = v[i] * rs * g[lane + 64 * i];
    }
}
__device__ __forceinline__ void ln_rows(const float* in, const float* add, float addscale_in, const float* g, const float* bb, float* out) {
    const int lane = nv::tidx() & 63;
    for (int r = GWAVE; r < NTOK; r += GWAVES) {
        float v[16]; float s = 0.f;
#pragma unroll
        for (int i = 0; i < 16; ++i) { const size_t o = (size_t)r * D + lane + 64 * i; v[i] = addscale_in * in[o] + (add ? add[o] : 0.f); s += v[i]; }
        const float mean = wsum(s) * (1.f / D); float q = 0.f;
#pragma unroll
        for (int i = 0; i < 16; ++i) { v[i] -= mean; q += v[i] * v[i]; }
        const float rs = 1.f / sqrtf(wsum(q) * (1.f / D) + LN_EPS);
#pragma unroll
        for (int i = 0; i < 16; ++i) { const int c = lane + 64 * i; out[(size_t)r * D + c] = v[i] * rs * g[c] + bb[c]; }
    }
}
__device__ __forceinline__ void router(const float* h1, const float* wg, const float* bg, const float* we, const float* be, int* cnt, int* tok_e, int* tok_rank, float* tok_gate) {
    const int lane = nv::tidx() & 63;
    for (int r = GWAVE; r < NTOK; r += GWAVES) {
        float lg[36];
#pragma unroll
        for (int c = 0; c < 36; ++c) lg[c] = 0.f;
        for (int i = 0; i < 16; ++i) { const int k = lane + 64 * i; const float xv = h1[(size_t)r * D + k];
#pragma unroll
            for (int c = 0; c < 4; ++c) lg[c] += xv * wg[k * 4 + c];
#pragma unroll
            for (int c = 0; c < 32; ++c) lg[4 + c] += xv * we[k * 32 + c]; }
#pragma unroll
        for (int c = 0; c < 36; ++c) lg[c] = wsum(lg[c]);
#pragma unroll
        for (int c = 0; c < 4; ++c) lg[c] += bg[c];
#pragma unroll
        for (int c = 0; c < 32; ++c) lg[4 + c] += be[c];
        int grp = 0; float gm = lg[0];
#pragma unroll
        for (int c = 1; c < 4; ++c) if (lg[c] > gm) { gm = lg[c]; grp = c; }
        float den = 0.f;
#pragma unroll
        for (int c = 0; c < 4; ++c) den += expf(lg[c] - gm);
        const float pgrp = 1.f / den;
        float ein[8];
#pragma unroll
        for (int j = 0; j < 8; ++j) ein[j] = grp == 0 ? lg[4 + j] : grp == 1 ? lg[12 + j] : grp == 2 ? lg[20 + j] : lg[28 + j];
        int i0 = 0; float v0 = ein[0];
#pragma unroll
        for (int j = 1; j < 8; ++j) if (ein[j] > v0) { v0 = ein[j]; i0 = j; }
        int i1 = -1; float v1 = -INFINITY;
#pragma unroll
        for (int j = 0; j < 8; ++j) if (j != i0 && ein[j] > v1) { v1 = ein[j]; i1 = j; }
        const float e1 = expf(v1 - v0); const float p0 = 1.f / (1.f + e1), p1 = e1 / (1.f + e1);
        if (lane == 0) {
            const int ea = grp * 8 + i0, eb = grp * 8 + i1;
            tok_e[2 * r] = ea; tok_e[2 * r + 1] = eb;
            tok_rank[2 * r] = atomicAdd(cnt + ea, 1); tok_rank[2 * r + 1] = atomicAdd(cnt + eb, 1);
            tok_gate[2 * r] = pgrp * p0; tok_gate[2 * r + 1] = pgrp * p1;
        }
    }
}
__device__ __forceinline__ void prefix(const int* cnt, int* pad_start, int* blk_exp) {
    if (threadIdx.x != 0 || blockIdx.x != 0) return;
    int acc = 0;
    for (int e = 0; e < NEXP; ++e) { pad_start[e] = acc; acc += ((__hip_atomic_load(cnt + e, __ATOMIC_RELAXED, __HIP_MEMORY_SCOPE_AGENT) + 127) / 128) * 128; pad_start[NEXP + e] = acc; }
    for (int b = 0; b < NBLK; ++b) { int c = 0; for (int e = 0; e < NEXP; ++e) c += (pad_start[NEXP + e] <= b * 128) ? 1 : 0; blk_exp[b] = c < NEXP - 1 ? c : NEXP - 1; }
}
__device__ __forceinline__ void slot_init(int* slot_tok, float* slot_gate) { for (int i = GTID; i < PSLOTS; i += GTHREADS) { slot_tok[i] = NTOK; slot_gate[i] = 0.f; } }
__device__ __forceinline__ void slot_fill(const int* tok_e, const int* tok_rank, const float* tok_gate, const int* pad_start, int* slot_tok, float* slot_gate) {
    for (int i = GTID; i < NTOK * 2; i += GTHREADS) { const int s = pad_start[tok_e[i]] + tok_rank[i]; slot_tok[s] = i >> 1; slot_gate[s] = tok_gate[i]; }
}
__device__ __forceinline__ void zero_f32(float* p, size_t n) { for (size_t i = GTID; i < n / 4; i += GTHREADS) ((float4*)p)[i] = make_float4(0.f, 0.f, 0.f, 0.f); }
}


namespace op {
using pg8::f32x4; using pg8::Unit; using pg8::bf16_t;
typedef unsigned v4u __attribute__((ext_vector_type(4)));
#define GAS __attribute__((address_space(1)))
__device__ __forceinline__ unsigned f2bf(float f) { unsigned u = __builtin_bit_cast(unsigned, f); return (u + 0x7fffu + ((u >> 16) & 1u)) >> 16; }
__device__ __forceinline__ unsigned pk2(float lo, float hi) { return f2bf(lo) | (f2bf(hi) << 16); }
__device__ __forceinline__ float bf2f(unsigned short b) { return __builtin_bit_cast(float, (unsigned)b << 16); }

template <class RowMap>
__device__ __forceinline__ void transpose_item(const float* W, int K, int N, bf16_t* WT, LAS float* scr, int item, int lane, const RowMap& rm) {
    const int nblk = N / 32, kb = item / nblk, nb = item % nblk, k0 = 64 * kb, n0 = 32 * nb;
#pragma unroll 8
    for (int i = 0; i < 32; ++i) { const int kk = 2 * i + (lane >> 5); scr[kk * 33 + (lane & 31)] = rm.scale(n0 + (lane & 31), k0 + kk) * W[(size_t)(k0 + kk) * N + n0 + (lane & 31)]; }
    asm volatile("s_waitcnt lgkmcnt(0)" ::: "memory");
    const int c = lane & 7;
#pragma unroll
    for (int j = 0; j < 4; ++j) { const int n = (lane >> 3) + 8 * j; const LAS float* s = scr + (8 * c) * 33 + n;
        v4u o; o.x = pk2(s[0 * 33], s[1 * 33]); o.y = pk2(s[2 * 33], s[3 * 33]); o.z = pk2(s[4 * 33], s[5 * 33]); o.w = pk2(s[6 * 33], s[7 * 33]);
        *(GAS v4u*)(WT + (size_t)rm.row(n0 + n) * K + k0 + 8 * c) = o; }
    asm volatile("s_waitcnt lgkmcnt(0)" ::: "memory");
}
struct RowId { __device__ __forceinline__ int row(int n) const { return n; } __device__ __forceinline__ float scale(int, int) const { return 1.f; } };

__device__ __forceinline__ void cvt_rows_bf16(const float* src, bf16_t* dst, size_t n) {
    for (size_t i = GTID; i < n / 8; i += GTHREADS) { const float4 a = ((const float4*)src)[2 * i], b = ((const float4*)src)[2 * i + 1];
        v4u o; o.x = pk2(a.x, a.y); o.y = pk2(a.z, a.w); o.z = pk2(b.x, b.y); o.w = pk2(b.z, b.w); ((v4u*)dst)[i] = o; }
}

struct EpiF32Nat { static constexpr bool PERM = false, AFTER_DRAIN = false;
    float* C; int ldc; int ncols;
    __device__ __forceinline__ void operator()(const f32x4 (&acc)[2][2][4][2], const Unit& u, int wr, int wc, int fr, int fq) const {
        const int row0 = u.pm * 256 + wr * 64 + fr, col0 = u.pn * 256 + wc * 32 + 4 * fq;
#pragma unroll
        for (int ai = 0; ai < 2; ++ai)
#pragma unroll
            for (int m = 0; m < 4; ++m) { float* rowp = C + (size_t)(row0 + ai * 128 + m * 16) * ldc;
#pragma unroll
                for (int bj = 0; bj < 2; ++bj)
#pragma unroll
                    for (int n = 0; n < 2; ++n) { const int c = col0 + bj * 128 + n * 16; if (c < ncols) *(f32x4*)(rowp + c) = acc[ai][bj][m][n]; } }
    }
};
}

namespace op {
struct RowProj {
    __device__ __forceinline__ int row(int n) const {
        if (n < 384) return n;
        if (n < 416) { const int j = n - 384, jj = j & 15, a = jj >> 2, b = jj & 3; return 384 + 8 * a + b + (j >= 16 ? 4 : 0); }
        return n + 96;
    }
    __device__ __forceinline__ float scale(int, int) const { return 1.f; }
};
__device__ __forceinline__ v4u pack8(const f32x4& v0, const f32x4& v1) { v4u w; w.x = pk2(v0[0], v0[1]); w.y = pk2(v0[2], v0[3]); w.z = pk2(v1[0], v1[1]); w.w = pk2(v1[2], v1[3]); return w; }
__device__ __forceinline__ float dot4(const f32x4& v) { return (v[0] * v[0] + v[1] * v[1]) + (v[2] * v[2] + v[3] * v[3]); }

struct EpiProj { static constexpr bool PERM = true, AFTER_DRAIN = false;
    bf16_t *cq, *ckv, *kr, *kk, *vi; float* lf; float *ssq_q, *ssq_kv; const float* cs; const float* lbt;
    __device__ __forceinline__ void operator()(const f32x4 (&acc)[2][2][4][2], const Unit& u, int wr, int wc, int fr, int fq) const {
        const int pn = u.pn; const int row0 = u.pm * 256 + wr * 64 + fr; const int cl = wc * 32 + 8 * fq;
        if (pn == 0) {
#pragma unroll
            for (int ai = 0; ai < 2; ++ai)
#pragma unroll
                for (int m = 0; m < 4; ++m) { const int row = row0 + ai * 128 + m * 16; float s = 0.f;
#pragma unroll
                    for (int bj = 0; bj < 2; ++bj) { const f32x4 v0 = acc[ai][bj][m][0], v1 = acc[ai][bj][m][1]; s += dot4(v0) + dot4(v1);
                        *(v4u*)(cq + (size_t)row * 256 + bj * 128 + cl) = pack8(v0, v1); }
                    s += __shfl_xor(s, 16); s += __shfl_xor(s, 32); if (fq == 0) atomicAdd(ssq_q + row, s); }
        } else if (pn == 1) {
#pragma unroll
            for (int ai = 0; ai < 2; ++ai)
#pragma unroll
                for (int m = 0; m < 4; ++m) { const int row = row0 + ai * 128 + m * 16;
                    const f32x4 v0 = acc[ai][0][m][0], v1 = acc[ai][0][m][1]; float s = dot4(v0) + dot4(v1);
                    *(v4u*)(ckv + (size_t)row * 128 + cl) = pack8(v0, v1);
                    s += __shfl_xor(s, 16); s += __shfl_xor(s, 32); if (fq == 0) atomicAdd(ssq_kv + row, s);
                    if (wc == 0) { const f32x4 x1 = acc[ai][1][m][0], x2 = acc[ai][1][m][1];
                        const f32x4 c = *(const f32x4*)(cs + (size_t)row * 32 + 4 * fq), sn = *(const f32x4*)(cs + (size_t)row * 32 + 16 + 4 * fq);
                        *(v4u*)(kr + (size_t)row * 32 + 8 * fq) = pack8(x1 * c - x2 * sn, x2 * c + x1 * sn); } }
        } else if (pn < 4) {
            const int cb = (pn - 2) * 256;
#pragma unroll
            for (int bj = 0; bj < 2; ++bj) { const int col = cb + bj * 128 + cl;
#pragma unroll
                for (int n = 0; n < 2; ++n) { const f32x4 lb = *(const f32x4*)(lbt + col + 4 * n);
#pragma unroll
                    for (int ai = 0; ai < 2; ++ai)
#pragma unroll
                        for (int m = 0; m < 4; ++m) { const int row = row0 + ai * 128 + m * 16; f32x4 l, k;
#pragma unroll
                            for (int i = 0; i < 4; ++i) { const float e = __expf(-acc[ai][bj][m][n][i]), sg = __builtin_amdgcn_rcpf(1.f + e); const float om = 1.f - lb[i]; l[i] = __logf(lb[i] + om * sg); k[i] = om * e * sg; }
                            *(f32x4*)(lf + (size_t)row * 512 + col + 4 * n) = l;
                            typedef unsigned v2u __attribute__((ext_vector_type(2))); v2u w; w.x = pk2(k[0], k[1]); w.y = pk2(k[2], k[3]);
                            *(v2u*)(kk + (size_t)row * 512 + col + 4 * n) = w;
                            asm volatile("" ::: "memory"); } } }
        } else {
            bf16_t* dst = vi + (size_t)((pn - 4) >> 1) * ((size_t)16384 * 512); const int cb = (pn & 1) * 256;
#pragma unroll
            for (int ai = 0; ai < 2; ++ai)
#pragma unroll
                for (int m = 0; m < 4; ++m) { const int row = row0 + ai * 128 + m * 16;
#pragma unroll
                    for (int bj = 0; bj < 2; ++bj) *(v4u*)(dst + (size_t)row * 512 + cb + bj * 128 + cl) = pack8(acc[ai][bj][m][0], acc[ai][bj][m][1]); }
        }
    }
};
}

namespace nv {
using op::bf2f; typedef unsigned short bf16_t;
__device__ __forceinline__ void lb_tab(const float* lbl, float* lbt) {
    for (int c = GTID; c < 512; c += GTHREADS) { const float l0 = lbl[c], l1 = lbl[512 + c]; const float mx = fmaxf(l0, l1); const float e0 = expf(l0 - mx), e1 = expf(l1 - mx); lbt[c] = e0 / (e0 + e1); }
}
__device__ __forceinline__ void hg_f(const float* lf, float* fb) { for (size_t i = GTID; i < (size_t)NTOK * 512; i += GTHREADS) fb[i] = expf(lf[i]); }
__device__ __forceinline__ void hg_rec2(const float* fb, const bf16_t* kk, const bf16_t* vi, const bf16_t* qh, float* ob) {
    if (blockIdx.x >= 16 || threadIdx.x >= 128) return;
    const int bh = blockIdx.x, b = bh >> 2, h = bh & 3, e = threadIdx.x;
    float S[128];
#pragma unroll
    for (int d = 0; d < 128; ++d) S[d] = 0.f;
    for (int t = 0; t < SEQ; ++t) {
        const size_t base = (size_t)(b * SEQ + t) * 512 + h * 128;
        const float v = bf2f(vi[base + e]);
        float o = 0.f;
#pragma unroll
        for (int d = 0; d < 128; ++d) { const float f = fb[base + d]; S[d] = f * S[d] + bf2f(kk[base + d]) * v; o += bf2f(qh[base + d]) * S[d]; }
        ob[base + e] = o;
    }
}
__device__ __forceinline__ void hg_out2(const float* ob, const bf16_t* gh, const float* g, float* rr) {
    const int lane = nv::tidx() & 63;
    for (int w = GWAVE; w < NTOK * 4; w += GWAVES) {
        const size_t base = (size_t)(w >> 2) * 512 + (w & 3) * 128;
        const float o0 = ob[base + lane], o1 = ob[base + 64 + lane];
        const float ss = wsum(o0 * o0 + o1 * o1); const float rs = 1.f / sqrtf(ss * (1.f / 128.f) + RMS_EPS);
        const float g0 = bf2f(gh[base + lane]), g1 = bf2f(gh[base + 64 + lane]);
        rr[base + lane] = o0 * rs * g[lane] * (g0 / (1.f + expf(-g0)));
        rr[base + 64 + lane] = o1 * rs * g[64 + lane] * (g1 / (1.f + expf(-g1)));
    }
}
__device__ __forceinline__ void mla_prep2(const bf16_t* cq, const bf16_t* ckv, const float* ssq_q, const float* ssq_kv, const float* gq, const float* gkv, float* cqn, float* ckvn) {
    for (size_t i = GTID; i < (size_t)NTOK * 256; i += GTHREADS) { const int r = (int)(i >> 8), c = (int)(i & 255);
        cqn[i] = bf2f(cq[i]) * (1.f / sqrtf(__hip_atomic_load(ssq_q + r, __ATOMIC_RELAXED, __HIP_MEMORY_SCOPE_AGENT) * (1.f / 256.f) + RMS_EPS)) * gq[c]; }
    for (size_t i = GTID; i < (size_t)NTOK * 128; i += GTHREADS) { const int r = (int)(i >> 7), c = (int)(i & 127);
        ckvn[i] = bf2f(ckv[i]) * (1.f / sqrtf(__hip_atomic_load(ssq_kv + r, __ATOMIC_RELAXED, __HIP_MEMORY_SCOPE_AGENT) * (1.f / 128.f) + RMS_EPS)) * gkv[c]; }
}
__host__ __device__ constexpr int rope_nat(int p) { return ((p & 7) < 4) ? 4 * (p >> 3) + (p & 7) : 16 + 4 * (p >> 3) + (p & 7) - 4; }
__device__ __forceinline__ void attn_naive2(const float* q, const float* kv, const bf16_t* kr, float* out) {
    const int lane = nv::tidx() & 63;
    for (int task = GWAVE; task < 2048; task += GWAVES) {
        const int tsk = __builtin_amdgcn_readfirstlane(task);
        const int qc = 63 - (tsk >> 5), h = tsk & 7, b = (tsk >> 3) & 3;
        const int t = qc * 64 + lane; const size_t row = (size_t)b * SEQ + t;
        const float scale = 0.10206207261596575f;
        float qv[96];
#pragma unroll
        for (int d = 0; d < 96; ++d) qv[d] = q[row * 768 + h * 96 + d] * scale;
        float o[64];
#pragma unroll
        for (int d = 0; d < 64; ++d) o[d] = 0.f;
        float m = -INFINITY, l = 0.f;
        const int nk = (qc + 1) * 64;
        for (int s = 0; s < nk; ++s) {
            const size_t kr_ = (size_t)b * SEQ + s;
            const float* kp = kv + kr_ * 1024 + h * 128; const bf16_t* rp = kr + kr_ * 32;
            float sc = 0.f;
#pragma unroll
            for (int d = 0; d < 64; ++d) sc += qv[d] * kp[d];
#pragma unroll
            for (int p = 0; p < 32; ++p) sc += qv[64 + rope_nat(p)] * bf2f(rp[p]);
            const float mn = fmaxf(m, sc); const float corr = expf(m - mn), pe = expf(sc - mn);
            l = l * corr + pe;
#pragma unroll
            for (int d = 0; d < 64; ++d) o[d] = o[d] * corr + pe * kp[64 + d];
            m = mn;
        }
        const float il = 1.f / l;
#pragma unroll
        for (int d = 0; d < 64; ++d) out[row * 512 + h * 64 + d] = o[d] * il;
    }
}
}

namespace op {
constexpr int MOE_CAP = 16384, MOE_MAXT = 160;
__device__ __forceinline__ void moe_build_tab(LAS int* tab, const int* cnt, int* tstart_g) {
    if (threadIdx.x < 64) {
        const int e = threadIdx.x & 31; const int c = __hip_atomic_load(cnt + e, __ATOMIC_RELAXED, __HIP_MEMORY_SCOPE_AGENT); const int t = (c + 255) >> 8;
        int incl = t;
#pragma unroll
        for (int o = 1; o < 32; o <<= 1) { const int v = __shfl_up(incl, o, 32); if (e >= o) incl += v; }
        const int start = incl - t;
        if (threadIdx.x < 32) { tab[1 + e] = c; tab[33 + e] = start; if (e == 31) tab[0] = incl; for (int j = 0; j < t; ++j) tab[65 + start + j] = e;
            if (blockIdx.x == 0 && tstart_g) tstart_g[e] = start; }
    }
    __syncthreads();
}
struct MoeOrder {
    const LAS int* tab; int G, c; const int* stok;
    __device__ __forceinline__ bool next(int i, Unit& u) const { const int L = i * G + c; const int T = tab[0]; if (L >= 4 * T) return false; const int mt = L >> 2; u.pm = mt; u.pn = tab[65 + mt] * 4 + (L & 3); return true; }
    __device__ __forceinline__ void a_ready(const Unit&) const {}
    __device__ __forceinline__ void done(const Unit&) const {}
    __device__ __forceinline__ int arow(const Unit& u, int r) const { const int e = u.pn >> 2; const int idx = (u.pm - tab[33 + e]) * 256 + r; return idx < tab[1 + e] ? stok[e * MOE_CAP + idx] : 16384; }
};
struct RowW13 { int which; __device__ __forceinline__ int row(int n) const { return 8 * (n >> 2) + (n & 3) + 4 * which; } __device__ __forceinline__ float scale(int, int) const { return 1.f; } };
struct RowScaleK { const float* g; int klim; __device__ __forceinline__ int row(int n) const { return n; } __device__ __forceinline__ float scale(int, int k) const { return k < klim ? g[k] : 1.f; } };

typedef unsigned v2u __attribute__((ext_vector_type(2)));
struct EpiMoe1 { static constexpr bool PERM = true, AFTER_DRAIN = false;
    bf16_t* H;
    __device__ __forceinline__ void operator()(const f32x4 (&acc)[2][2][4][2], const Unit& u, int wr, int wc, int fr, int fq) const {
        const int row0 = u.pm * 256 + wr * 64 + fr, col0 = 128 * (u.pn & 3) + 16 * wc + 4 * fq;
#pragma unroll
        for (int ai = 0; ai < 2; ++ai)
#pragma unroll
            for (int m = 0; m < 4; ++m) { bf16_t* rowp = H + (size_t)(row0 + ai * 128 + m * 16) * 512 + col0;
#pragma unroll
                for (int bj = 0; bj < 2; ++bj) { const f32x4 a = acc[ai][bj][m][0], b = acc[ai][bj][m][1]; float h[4];
#pragma unroll
                    for (int i = 0; i < 4; ++i) h[i] = a[i] * __builtin_amdgcn_rcpf(1.f + __expf(-a[i])) * b[i];
                    v2u w; w.x = pk2(h[0], h[1]); w.y = pk2(h[2], h[3]); *(v2u*)(rowp + 64 * bj) = w; } }
    }
};
struct EpiBf16P { static constexpr bool PERM = true, AFTER_DRAIN = false;
    bf16_t* O; int ldc; int pmask;
    __device__ __forceinline__ void operator()(const f32x4 (&acc)[2][2][4][2], const Unit& u, int wr, int wc, int fr, int fq) const {
        const int row0 = u.pm * 256 + wr * 64 + fr, col0 = 256 * (u.pn & pmask) + 32 * wc + 8 * fq;
#pragma unroll
        for (int ai = 0; ai < 2; ++ai)
#pragma unroll
            for (int m = 0; m < 4; ++m) { bf16_t* rowp = O + (size_t)(row0 + ai * 128 + m * 16) * ldc + col0;
#pragma unroll
                for (int bj = 0; bj < 2; ++bj) *(v4u*)(rowp + 128 * bj) = pack8(acc[ai][bj][m][0], acc[ai][bj][m][1]); }
    }
};
struct EpiMix { static constexpr bool PERM = false, AFTER_DRAIN = false;
    const float* x; float* t; float alpha;
    __device__ __forceinline__ void operator()(const f32x4 (&acc)[2][2][4][2], const Unit& u, int wr, int wc, int fr, int fq) const {
        const int row0 = u.pm * 256 + wr * 64 + fr, col0 = u.pn * 256 + wc * 32 + 4 * fq;
#pragma unroll
        for (int ai = 0; ai < 2; ++ai)
#pragma unroll
            for (int m = 0; m < 4; ++m) { const size_t ro = (size_t)(row0 + ai * 128 + m * 16) * 1024 + col0;
#pragma unroll
                for (int bj = 0; bj < 2; ++bj)
#pragma unroll
                    for (int n = 0; n < 2; ++n) { const size_t o = ro + bj * 128 + n * 16; *(f32x4*)(t + o) = alpha * *(const f32x4*)(x + o) + acc[ai][bj][m][n]; } }
    }
};
}

namespace nv {
__device__ __forceinline__ void a_norm2(const float* a, const float* g, bf16_t* AR) {
    const int lane = nv::tidx() & 63;
    for (int r = GWAVE; r < NTOK; r += GWAVES) {
        float v[8]; float ss = 0.f;
#pragma unroll
        for (int i = 0; i < 8; ++i) { v[i] = a[(size_t)r * 512 + lane + 64 * i]; ss += v[i] * v[i]; }
        ss = wsum(ss); const float rs = 1.f / sqrtf(ss * (1.f / 512.f) + RMS_EPS);
#pragma unroll
        for (int i = 0; i < 8; ++i) AR[(size_t)r * 1024 + lane + 64 * i] = (bf16_t)op::f2bf(v[i] * rs * g[lane + 64 * i]);
    }
}
__device__ __forceinline__ void hg_out3(const float* ob, const bf16_t* gh, const float* g, bf16_t* AR) {
    const int lane = nv::tidx() & 63;
    for (int w = GWAVE; w < NTOK * 4; w += GWAVES) {
        const size_t base = (size_t)(w >> 2) * 512 + (w & 3) * 128; const size_t ob_ = (size_t)(w >> 2) * 1024 + 512 + (w & 3) * 128;
        const float o0 = ob[base + lane], o1 = ob[base + 64 + lane];
        const float ss = wsum(o0 * o0 + o1 * o1); const float rs = 1.f / sqrtf(ss * (1.f / 128.f) + RMS_EPS);
        const float g0 = bf2f(gh[base + lane]), g1 = bf2f(gh[base + 64 + lane]);
        AR[ob_ + lane] = (bf16_t)op::f2bf(o0 * rs * g[lane] * (g0 / (1.f + expf(-g0))));
        AR[ob_ + 64 + lane] = (bf16_t)op::f2bf(o1 * rs * g[64 + lane] * (g1 / (1.f + expf(-g1))));
    }
}
__device__ __forceinline__ void ln_rows2(float* h, const float* g, const float* bb, bf16_t* hb) {
    const int lane = nv::tidx() & 63;
    for (int r = GWAVE; r < NTOK; r += GWAVES) {
        float v[16]; float s = 0.f;
#pragma unroll
        for (int i = 0; i < 16; ++i) { v[i] = h[(size_t)r * D + lane + 64 * i]; s += v[i]; }
        const float mean = wsum(s) * (1.f / D); float q = 0.f;
#pragma unroll
        for (int i = 0; i < 16; ++i) { v[i] -= mean; q += v[i] * v[i]; }
        const float rs = 1.f / sqrtf(wsum(q) * (1.f / D) + LN_EPS);
#pragma unroll
        for (int i = 0; i < 16; ++i) { const int c = lane + 64 * i; const float o = v[i] * rs * g[c] + bb[c]; h[(size_t)r * D + c] = o; hb[(size_t)r * D + c] = (bf16_t)op::f2bf(o); }
    }
    if (blockIdx.x == 0) for (int c = threadIdx.x; c < D; c += NTHREADS) hb[(size_t)NTOK * D + c] = 0;
}
__device__ __forceinline__ void router2(const float* h1, const float* wg, const float* bg, const float* we, const float* be, int* cnt, int* tok_e, int* tok_rank, float* tok_gate, int* stok) {
    const int lane = nv::tidx() & 63;
    for (int r = GWAVE; r < NTOK; r += GWAVES) {
        float lg[36];
#pragma unroll
        for (int c = 0; c < 36; ++c) lg[c] = 0.f;
        for (int i = 0; i < 16; ++i) { const int k = lane + 64 * i; const float xv = h1[(size_t)r * D + k];
#pragma unroll
            for (int c = 0; c < 4; ++c) lg[c] += xv * wg[k * 4 + c];
#pragma unroll
            for (int c = 0; c < 32; ++c) lg[4 + c] += xv * we[k * 32 + c]; }
#pragma unroll
        for (int c = 0; c < 36; ++c) lg[c] = wsum(lg[c]);
#pragma unroll
        for (int c = 0; c < 4; ++c) lg[c] += bg[c];
#pragma unroll
        for (int c = 0; c < 32; ++c) lg[4 + c] += be[c];
        int grp = 0; float gm = lg[0];
#pragma unroll
        for (int c = 1; c < 4; ++c) if (lg[c] > gm) { gm = lg[c]; grp = c; }
        float den = 0.f;
#pragma unroll
        for (int c = 0; c < 4; ++c) den += expf(lg[c] - gm);
        const float pgrp = 1.f / den;
        float ein[8];
#pragma unroll
        for (int j = 0; j < 8; ++j) ein[j] = grp == 0 ? lg[4 + j] : grp == 1 ? lg[12 + j] : grp == 2 ? lg[20 + j] : lg[28 + j];
        int i0 = 0; float v0 = ein[0];
#pragma unroll
        for (int j = 1; j < 8; ++j) if (ein[j] > v0) { v0 = ein[j]; i0 = j; }
        int i1 = -1; float v1 = -INFINITY;
#pragma unroll
        for (int j = 0; j < 8; ++j) if (j != i0 && ein[j] > v1) { v1 = ein[j]; i1 = j; }
        const float e1 = expf(v1 - v0); const float p0 = 1.f / (1.f + e1), p1 = e1 / (1.f + e1);
        if (lane == 0) {
            const int ea = grp * 8 + i0, eb = grp * 8 + i1;
            const int ra = atomicAdd(cnt + ea, 1), rb = atomicAdd(cnt + eb, 1);
            tok_e[2 * r] = ea; tok_e[2 * r + 1] = eb; tok_rank[2 * r] = ra; tok_rank[2 * r + 1] = rb;
            tok_gate[2 * r] = pgrp * p0; tok_gate[2 * r + 1] = pgrp * p1;
            stok[ea * op::MOE_CAP + ra] = r; stok[eb * op::MOE_CAP + rb] = r;
        }
    }
}
__device__ __forceinline__ void ln2_rows(const float* h1, const bf16_t* Y, const int* tok_e, const int* tok_rank, const float* tok_gate, const int* tstart, const float* g, const float* bb, float* out) {
    const int lane = nv::tidx() & 63;
    for (int r = GWAVE; r < NTOK; r += GWAVES) {
        const size_t r0 = (size_t)tstart[tok_e[2 * r]] * 256 + tok_rank[2 * r], r1 = (size_t)tstart[tok_e[2 * r + 1]] * 256 + tok_rank[2 * r + 1];
        const float g0 = tok_gate[2 * r], g1 = tok_gate[2 * r + 1];
        float v[16]; float s = 0.f;
#pragma unroll
        for (int i = 0; i < 16; ++i) { const int c = lane + 64 * i; v[i] = ALPHA * h1[(size_t)r * D + c] + g0 * bf2f(Y[r0 * D + c]) + g1 * bf2f(Y[r1 * D + c]); s += v[i]; }
        const float mean = wsum(s) * (1.f / D); float q = 0.f;
#pragma unroll
        for (int i = 0; i < 16; ++i) { v[i] -= mean; q += v[i] * v[i]; }
        const float rs = 1.f / sqrtf(wsum(q) * (1.f / D) + LN_EPS);
#pragma unroll
        for (int i = 0; i < 16; ++i) { const int c = lane + 64 * i; out[(size_t)r * D + c] = v[i] * rs * g[c] + bb[c]; }
    }
}
}

namespace hg {
using op::bf16_t; using op::bf2f; using op::f2bf; using op::pk2; using op::v4u; using op::v2u;
typedef short bf16x8 __attribute__((ext_vector_type(8)));
typedef float f32x4 __attribute__((ext_vector_type(4)));
constexpr int SEQ = 4096, NU = 1024;
constexpr int LDV = 72 * 2, LDK = 72 * 2, LDQ = 136 * 2, LDS_ = 136 * 2, LDA = 72 * 2;
__device__ __forceinline__ bf16x8 ldfrag(const LAS unsigned char* base, int row, int stride, int kbyte) { return *(const LAS bf16x8*)(base + row * stride + kbyte); }

__device__ __forceinline__ void stage_vT(LAS unsigned char* vT, const bf16_t* vsrc, int tid) {
#pragma unroll
    for (int j = 0; j < 2; ++j) { const int p = tid + 512 * j, s = p >> 4, e0 = (p & 15) * 8;
        const v4u w = *(const v4u*)(vsrc + (size_t)s * 512 + e0);
        const unsigned ww[4] = {w.x, w.y, w.z, w.w};
#pragma unroll
        for (int i = 0; i < 4; ++i) { *(LAS unsigned short*)(vT + (e0 + 2 * i) * LDV + s * 2) = (unsigned short)(ww[i] & 0xffffu); *(LAS unsigned short*)(vT + (e0 + 2 * i + 1) * LDV + s * 2) = (unsigned short)(ww[i] >> 16); } }
}
__device__ __forceinline__ void pass1(LAS unsigned char* lds, const float* lf, const bf16_t* kk, const bf16_t* vi, bf16_t* U, float* dl) {
    int tid_ = threadIdx.x; asm volatile("" : "+v"(tid_)); const int tid = tid_, lane = tid & 63, w = __builtin_amdgcn_readfirstlane(tid >> 6);
    LAS unsigned char* vT = lds; LAS unsigned char* kdT = lds + 128 * LDV; LAS float* segtot = (LAS float*)(lds + 128 * LDV + 128 * LDK);
    const int d = tid & 127, seg = tid >> 7, t0 = seg * 16;
    for (int u = blockIdx.x; u < NU; u += gridDim.x) {
        const int c = u & 63, bh = u >> 6, b = bh >> 2, h = bh & 3; const size_t row0 = (size_t)b * SEQ + c * 64;
        float cs[16]; float kv[16]; float run = 0.f;
#pragma unroll
        for (int i = 0; i < 16; ++i) { const size_t o = (row0 + t0 + i) * 512 + h * 128 + d; cs[i] = lf[o]; kv[i] = bf2f(kk[o]); }
        stage_vT(vT, vi + row0 * 512 + h * 128, tid);
#pragma unroll
        for (int i = 0; i < 16; ++i) { run += cs[i]; cs[i] = run; }
        segtot[seg * 128 + d] = run;
        __syncthreads();
        float off = 0.f, tot = 0.f;
#pragma unroll
        for (int s = 0; s < 4; ++s) { const float v = segtot[s * 128 + d]; tot += v; if (s < seg) off += v; }
        unsigned pk[8];
#pragma unroll
        for (int i = 0; i < 8; ++i) pk[i] = pk2(kv[2 * i] * __expf(tot - off - cs[2 * i]), kv[2 * i + 1] * __expf(tot - off - cs[2 * i + 1]));
        *(LAS v4u*)(kdT + d * LDK + t0 * 2) = (v4u){pk[0], pk[1], pk[2], pk[3]}; *(LAS v4u*)(kdT + d * LDK + t0 * 2 + 16) = (v4u){pk[4], pk[5], pk[6], pk[7]};
        if (seg == 0) dl[(size_t)u * 128 + d] = __expf(tot);
        __syncthreads();
        f32x4 acc[8];
#pragma unroll
        for (int j = 0; j < 8; ++j) acc[j] = (f32x4){0.f, 0.f, 0.f, 0.f};
#pragma unroll
        for (int ks = 0; ks < 2; ++ks) { const bf16x8 a = ldfrag(kdT, w * 16 + (lane & 15), LDK, ks * 64 + (lane >> 4) * 16);
#pragma unroll
            for (int j = 0; j < 8; ++j) { const bf16x8 bb = ldfrag(vT, j * 16 + (lane & 15), LDV, ks * 64 + (lane >> 4) * 16); acc[j] = __builtin_amdgcn_mfma_f32_16x16x32_bf16(a, bb, acc[j], 0, 0, 0); } }
        bf16_t* Uu = U + (size_t)u * 16384;
#pragma unroll
        for (int j = 0; j < 8; ++j) { v2u o; o.x = pk2(acc[j][0], acc[j][1]); o.y = pk2(acc[j][2], acc[j][3]); *(v2u*)(Uu + (j * 16 + (lane & 15)) * 128 + w * 16 + 4 * (lane >> 4)) = o; }
        __syncthreads();
    }
}
__device__ __forceinline__ void scan(const bf16_t* U, const float* dl, bf16_t* ST) {
    for (int gid = blockIdx.x * NTHREADS + threadIdx.x; gid < 16 * 128 * 64; gid += gridDim.x * NTHREADS) {
        const int dp = gid & 63, e = (gid >> 6) & 127, bh = gid >> 13;
        float s0 = 0.f, s1 = 0.f;
        for (int c0 = 0; c0 < 64; c0 += 16) {
            unsigned uv[16]; float2 dv[16];
#pragma unroll
            for (int i = 0; i < 16; ++i) { const size_t un = (size_t)bh * 64 + c0 + i; uv[i] = *(const unsigned*)(U + un * 16384 + e * 128 + 2 * dp); dv[i] = *(const float2*)(dl + un * 128 + 2 * dp); }
#pragma unroll
            for (int i = 0; i < 16; ++i) { const size_t un = (size_t)bh * 64 + c0 + i; *(unsigned*)(ST + un * 16384 + e * 128 + 2 * dp) = pk2(s0, s1);
                s0 = dv[i].x * s0 + __builtin_bit_cast(float, uv[i] << 16); s1 = dv[i].y * s1 + __builtin_bit_cast(float, uv[i] & 0xffff0000u); }
        }
    }
}
__device__ __forceinline__ void pass3(LAS unsigned char* lds, const float* lf, const bf16_t* kk, const bf16_t* vi, const bf16_t* qh, const bf16_t* gh, const bf16_t* ST, const float* gnorm, bf16_t* AR) {
    int tid_ = threadIdx.x; asm volatile("" : "+v"(tid_)); const int tid = tid_, lane = tid & 63, w = __builtin_amdgcn_readfirstlane(tid >> 6);
    LAS unsigned char* qeL = lds; LAS unsigned char* keL = qeL + 64 * LDQ; LAS unsigned char* qsL = keL + 64 * LDQ; LAS unsigned char* vT = qsL + 64 * LDQ;
    LAS unsigned char* STl = vT + 128 * LDV; LAS unsigned char* aL = STl + 128 * LDS_; LAS float* segtot = (LAS float*)(aL + 64 * LDA); LAS float* ssqL = segtot + 512;
    const int d = tid & 127, seg = tid >> 7, t0 = seg * 16;
    const int tt = w & 3, eg = w >> 2;
    for (int u = blockIdx.x; u < NU; u += gridDim.x) {
        const int c = u & 63, bh = u >> 6, b = bh >> 2, h = bh & 3; const size_t row0 = (size_t)b * SEQ + c * 64;
        float cs[16]; float kv[16], qv[16]; float run = 0.f;
#pragma unroll
        for (int i = 0; i < 16; ++i) { const size_t o = (row0 + t0 + i) * 512 + h * 128 + d; cs[i] = lf[o]; kv[i] = bf2f(kk[o]); qv[i] = bf2f(qh[o]); }
        stage_vT(vT, vi + row0 * 512 + h * 128, tid);
        { const bf16_t* Su = ST + (size_t)u * 16384;
#pragma unroll
            for (int j = 0; j < 4; ++j) { const int p = tid + 512 * j, e = p >> 4, d0 = (p & 15) * 8; *(LAS v4u*)(STl + e * LDS_ + d0 * 2) = *(const v4u*)(Su + e * 128 + d0); } }
#pragma unroll
        for (int i = 0; i < 16; ++i) { run += cs[i]; cs[i] = run; }
        segtot[seg * 128 + d] = run;
        __syncthreads();
        float off = 0.f;
#pragma unroll
        for (int s = 0; s < 3; ++s) { const float v = segtot[s * 128 + d]; if (s < seg) off += v; }
        const float bm = segtot[d] + segtot[128 + d];
#pragma unroll
        for (int i = 0; i < 16; ++i) { const float bt = off + cs[i]; const int t = t0 + i;
            *(LAS unsigned short*)(qeL + t * LDQ + d * 2) = (unsigned short)f2bf(qv[i] * __expf(fminf(bt - bm, 80.f)));
            *(LAS unsigned short*)(keL + t * LDQ + d * 2) = (unsigned short)f2bf(kv[i] * __expf(fminf(bm - bt, 80.f)));
            *(LAS unsigned short*)(qsL + t * LDQ + d * 2) = (unsigned short)f2bf(qv[i] * __expf(bt)); }
        __syncthreads();
#pragma unroll
        for (int j = 0; j < 2; ++j) { const int st = 2 * eg + j; f32x4 a = (f32x4){0.f, 0.f, 0.f, 0.f};
            if (st <= tt) {
#pragma unroll
                for (int ks = 0; ks < 4; ++ks) a = __builtin_amdgcn_mfma_f32_16x16x32_bf16(ldfrag(qeL, tt * 16 + (lane & 15), LDQ, ks * 64 + (lane >> 4) * 16), ldfrag(keL, st * 16 + (lane & 15), LDQ, ks * 64 + (lane >> 4) * 16), a, 0, 0, 0);
            }
            const int sI = st * 16 + (lane & 15);
#pragma unroll
            for (int r = 0; r < 4; ++r) { const int tI = tt * 16 + 4 * (lane >> 4) + r; *(LAS unsigned short*)(aL + tI * LDA + sI * 2) = (unsigned short)f2bf(sI <= tI ? a[r] : 0.f); } }
        float gv[4][4];
#pragma unroll
        for (int r = 0; r < 4; ++r)
#pragma unroll
            for (int j = 0; j < 4; ++j) gv[r][j] = bf2f(gh[(row0 + tt * 16 + 4 * (lane >> 4) + r) * 512 + h * 128 + (4 * eg + j) * 16 + (lane & 15)]);
        __syncthreads();
        f32x4 o[4];
#pragma unroll
        for (int j = 0; j < 4; ++j) o[j] = (f32x4){0.f, 0.f, 0.f, 0.f};
#pragma unroll
        for (int ks = 0; ks < 2; ++ks) { const bf16x8 a = ldfrag(aL, tt * 16 + (lane & 15), LDA, ks * 64 + (lane >> 4) * 16);
#pragma unroll
            for (int j = 0; j < 4; ++j) o[j] = __builtin_amdgcn_mfma_f32_16x16x32_bf16(a, ldfrag(vT, (4 * eg + j) * 16 + (lane & 15), LDV, ks * 64 + (lane >> 4) * 16), o[j], 0, 0, 0); }
#pragma unroll
        for (int ks = 0; ks < 4; ++ks) { const bf16x8 a = ldfrag(qsL, tt * 16 + (lane & 15), LDQ, ks * 64 + (lane >> 4) * 16);
#pragma unroll
            for (int j = 0; j < 4; ++j) o[j] = __builtin_amdgcn_mfma_f32_16x16x32_bf16(a, ldfrag(STl, (4 * eg + j) * 16 + (lane & 15), LDS_, ks * 64 + (lane >> 4) * 16), o[j], 0, 0, 0); }
        float ss[4];
#pragma unroll
        for (int r = 0; r < 4; ++r) { float s = 0.f;
#pragma unroll
            for (int j = 0; j < 4; ++j) s += o[j][r] * o[j][r];
            s += __shfl_xor(s, 1); s += __shfl_xor(s, 2); s += __shfl_xor(s, 4); s += __shfl_xor(s, 8); ss[r] = s; }
        if ((lane & 15) == 0) {
#pragma unroll
            for (int r = 0; r < 4; ++r) ssqL[eg * 64 + tt * 16 + 4 * (lane >> 4) + r] = ss[r]; }
        __syncthreads();
#pragma unroll
        for (int r = 0; r < 4; ++r) { const int tI = tt * 16 + 4 * (lane >> 4) + r; const float rs = 1.f / sqrtf((ssqL[tI] + ssqL[64 + tI]) * (1.f / 128.f) + 1e-6f);
#pragma unroll
            for (int j = 0; j < 4; ++j) { const int e = (4 * eg + j) * 16 + (lane & 15); const float g = gv[r][j];
                AR[(row0 + tI) * 1024 + 512 + h * 128 + e] = (bf16_t)f2bf(o[j][r] * rs * gnorm[e] * g * __builtin_amdgcn_rcpf(1.f + __expf(-g))); } }
        __syncthreads();
    }
}
}

namespace op {
struct RowQ { const float* g;
    __device__ __forceinline__ int row(int n) const { const int h = n / 96, j = n - 96 * h; if (j < 64) return n; const int jj = (j - 64) & 15, a = jj >> 2, b = jj & 3; return 96 * h + 64 + 8 * a + b + (j >= 80 ? 4 : 0); }
    __device__ __forceinline__ float scale(int, int k) const { return g[k]; } };
struct RowKV { const float* g;
    __device__ __forceinline__ int row(int n) const { const int h = n >> 7, j = n & 127; return j < 64 ? 64 * h + j : 512 + 64 * h + (j - 64); }
    __device__ __forceinline__ float scale(int, int k) const { return g[k]; } };
constexpr float QSCALE = 0.10206207261596575f * 1.4426950408889634f;
struct EpiQ { static constexpr bool PERM = true, AFTER_DRAIN = false;
    bf16_t* Q; const float* ssq; const float* cs;
    __device__ __forceinline__ void operator()(const f32x4 (&acc)[2][2][4][2], const Unit& u, int wr, int wc, int fr, int fq) const {
        const int row0 = u.pm * 256 + wr * 64 + fr;
#pragma unroll
        for (int ai = 0; ai < 2; ++ai)
#pragma unroll
            for (int m = 0; m < 4; ++m) { const int row = row0 + ai * 128 + m * 16; const float rs = QSCALE * __builtin_amdgcn_rsqf(ssq[row] * (1.f / 256.f) + 1e-6f);
#pragma unroll
                for (int bj = 0; bj < 2; ++bj) { const int gi = 8 * u.pn + 4 * bj + wc; f32x4 v0 = acc[ai][bj][m][0] * rs, v1 = acc[ai][bj][m][1] * rs;
                    if (gi % 3 == 2) { const f32x4 c = *(const f32x4*)(cs + (size_t)row * 32 + 4 * fq), sn = *(const f32x4*)(cs + (size_t)row * 32 + 16 + 4 * fq);
                        const f32x4 o1 = v0 * c - v1 * sn, o2 = v1 * c + v0 * sn; v0 = o1; v1 = o2; }
                    *(v4u*)(Q + (size_t)row * 768 + 32 * gi + 8 * fq) = pack8(v0, v1); } }
    }
};
struct EpiK { static constexpr bool PERM = true, AFTER_DRAIN = false;
    bf16_t* K; const float* ssq;
    __device__ __forceinline__ void operator()(const f32x4 (&acc)[2][2][4][2], const Unit& u, int wr, int wc, int fr, int fq) const {
        const int row0 = u.pm * 256 + wr * 64 + fr, col0 = 256 * u.pn + 32 * wc + 8 * fq;
#pragma unroll
        for (int ai = 0; ai < 2; ++ai)
#pragma unroll
            for (int m = 0; m < 4; ++m) { const int row = row0 + ai * 128 + m * 16; const float rs = __builtin_amdgcn_rsqf(ssq[row] * (1.f / 128.f) + 1e-6f);
#pragma unroll
                for (int bj = 0; bj < 2; ++bj) *(v4u*)(K + (size_t)row * 512 + col0 + 128 * bj) = pack8(acc[ai][bj][m][0] * rs, acc[ai][bj][m][1] * rs); }
    }
};
struct EpiVT { static constexpr bool PERM = true, AFTER_DRAIN = false;
    bf16_t* VT; const float* ssq;
    __device__ __forceinline__ void operator()(const f32x4 (&acc)[2][2][4][2], const Unit& u, int wr, int wc, int fr, int fq) const {
        const int row0 = u.pm * 256 + wr * 64 + fr, col0 = 256 * u.pn + 32 * wc + 8 * fq; const int p0 = (fq & 1) ? 4 : 0, p1 = (fq & 1) ? 12 : 8;
#pragma unroll
        for (int bj = 0; bj < 2; ++bj) { const int c0 = col0 + 128 * bj; const f32x4 s0 = *(const f32x4*)(ssq + c0), s1 = *(const f32x4*)(ssq + c0 + 4); f32x4 r0, r1;
#pragma unroll
            for (int i = 0; i < 4; ++i) { r0[i] = __builtin_amdgcn_rsqf(s0[i] * (1.f / 128.f) + 1e-6f); r1[i] = __builtin_amdgcn_rsqf(s1[i] * (1.f / 128.f) + 1e-6f); }
#pragma unroll
            for (int ai = 0; ai < 2; ++ai)
#pragma unroll
                for (int m = 0; m < 4; ++m) { bf16_t* rowp = VT + (size_t)(row0 + ai * 128 + m * 16) * 16384 + (c0 & ~15);
                    const f32x4 a = acc[ai][bj][m][0] * r0, b = acc[ai][bj][m][1] * r1;
                    v2u w0, w1; w0.x = pk2(a[0], a[1]); w0.y = pk2(a[2], a[3]); w1.x = pk2(b[0], b[1]); w1.y = pk2(b[2], b[3]);
                    *(v2u*)(rowp + p0) = w0; *(v2u*)(rowp + p1) = w1; } }
    }
};
struct EpiMix2 { static constexpr bool PERM = false, AFTER_DRAIN = false; static constexpr int MID_T = 8;
    const float* x; float* t; float alpha; const float* ssq_a;
    __device__ __forceinline__ void mid(f32x4 (&acc)[2][2][4][2], const Unit& u, int wr, int wc, int fr, int fq) const {
        const int row0 = u.pm * 256 + wr * 64 + fr;
#pragma unroll
        for (int ai = 0; ai < 2; ++ai)
#pragma unroll
            for (int m = 0; m < 4; ++m) { const float rs = __builtin_amdgcn_rsqf(ssq_a[row0 + ai * 128 + m * 16] * (1.f / 512.f) + 1e-6f);
#pragma unroll
                for (int bj = 0; bj < 2; ++bj)
#pragma unroll
                    for (int n = 0; n < 2; ++n) acc[ai][bj][m][n] *= rs; }
    }
    __device__ __forceinline__ void operator()(const f32x4 (&acc)[2][2][4][2], const Unit& u, int wr, int wc, int fr, int fq) const {
        const int row0 = u.pm * 256 + wr * 64 + fr, col0 = u.pn * 256 + wc * 32 + 4 * fq;
#pragma unroll
        for (int ai = 0; ai < 2; ++ai)
#pragma unroll
            for (int m = 0; m < 4; ++m) { const size_t ro = (size_t)(row0 + ai * 128 + m * 16) * 1024 + col0;
#pragma unroll
                for (int bj = 0; bj < 2; ++bj)
#pragma unroll
                    for (int n = 0; n < 2; ++n) { const size_t o = ro + bj * 128 + n * 16; *(f32x4*)(t + o) = alpha * *(const f32x4*)(x + o) + acc[ai][bj][m][n]; } }
    }
};
}

namespace at {
using op::bf16_t; using op::v4u; using op::pk2;
typedef short bf16x8 __attribute__((ext_vector_type(8)));
typedef float f32x16 __attribute__((ext_vector_type(16)));
constexpr int LDK = 208, LDV = 144, KBUF = 64 * LDK, VBUF = 64 * LDV, SEQ = 4096;
constexpr float THR = 8.f;
__device__ __forceinline__ int crow(int r, int hi) { return (r & 3) + 8 * (r >> 2) + 4 * hi; }
__device__ __forceinline__ void attn_phase(LAS unsigned char* lds, const bf16_t* Q, const bf16_t* Kn, const bf16_t* kr, const bf16_t* VT, bf16_t* AR, float* ssq_a) {
    int tid_ = threadIdx.x; asm volatile("" : "+v"(tid_)); const int tid = tid_, lane = tid & 63, w = __builtin_amdgcn_readfirstlane(tid >> 6), r32 = lane & 31, hi = lane >> 5;
    LAS unsigned char* Kb = lds; LAS unsigned char* Vb = lds + 2 * KBUF; LAS float* wsf = (LAS float*)(lds + 2 * KBUF + 2 * VBUF) + w * 64;
    const int krow = tid >> 3, kch = tid & 7, rrow = tid >> 2, rch = tid & 3;
    for (int pi = blockIdx.x; pi < 256; pi += gridDim.x) {
        const int bh = pi >> 3, sx = pi & 7, b = bh >> 3, h = bh & 7; const size_t tok0 = (size_t)b * SEQ;
#pragma unroll 1
        for (int uu = 0; uu < 2; ++uu) {
            const int qb = uu == 0 ? 15 - sx : sx; const int NT = 4 * qb + 4, qc = 4 * qb + (w >> 1);
            const size_t qrow = tok0 + qb * 256 + w * 32 + r32;
            bf16x8 qf[6];
#pragma unroll
            for (int ks = 0; ks < 6; ++ks) qf[ks] = *(const bf16x8*)(Q + qrow * 768 + h * 96 + ks * 16 + hi * 8);
            const bf16_t* ksrc = Kn + (tok0 + krow) * 512 + h * 64 + kch * 8; const bf16_t* rsrc = kr + (tok0 + rrow) * 32 + rch * 8; const bf16_t* vsrc = VT + (size_t)(h * 64 + krow) * 16384 + tok0 + kch * 8;
            v4u gk = *(const v4u*)ksrc, gv = *(const v4u*)vsrc, gr = (v4u){0u, 0u, 0u, 0u}; if (tid < 256) gr = *(const v4u*)rsrc;
            *(LAS v4u*)(Kb + krow * LDK + kch * 16) = gk; *(LAS v4u*)(Vb + krow * LDV + kch * 16) = gv; if (tid < 256) *(LAS v4u*)(Kb + rrow * LDK + 128 + rch * 16) = gr;
            __syncthreads();
            f32x16 o0, o1;
#pragma unroll
            for (int r = 0; r < 16; ++r) { o0[r] = 0.f; o1[r] = 0.f; }
            float mhat = 0.f, lsum = 0.f;
            for (int t = 0; t < NT; ++t) {
                const int cur = t & 1; const bool more = t + 1 < NT;
                if (more) { gk = *(const v4u*)(ksrc + (size_t)(t + 1) * 64 * 512); gv = *(const v4u*)(vsrc + (t + 1) * 64); if (tid < 256) gr = *(const v4u*)(rsrc + (size_t)(t + 1) * 64 * 32); }
                if (t <= qc) {
                    const LAS unsigned char* Kc = Kb + cur * KBUF + r32 * LDK + hi * 16; const LAS unsigned char* Vc = Vb + cur * VBUF + r32 * LDV + hi * 16;
                    f32x16 p0, p1;
#pragma unroll
                    for (int r = 0; r < 16; ++r) { p0[r] = 0.f; p1[r] = 0.f; }
#pragma unroll
                    for (int ks = 0; ks < 6; ++ks) { p0 = __builtin_amdgcn_mfma_f32_32x32x16_bf16(*(const LAS bf16x8*)(Kc + ks * 32), qf[ks], p0, 0, 0, 0);
                        p1 = __builtin_amdgcn_mfma_f32_32x32x16_bf16(*(const LAS bf16x8*)(Kc + 32 * LDK + ks * 32), qf[ks], p1, 0, 0, 0); }
                    float rm = fmaxf(p0[0], p1[0]);
#pragma unroll
                    for (int r = 1; r < 16; ++r) rm = fmaxf(rm, fmaxf(p0[r], p1[r]));
                    rm = fmaxf(rm, __shfl_xor(rm, 32)) - mhat;
                    const bool force = (t == 0);
                    if (__any(rm > THR) || force) {
                        const float dl = force ? rm : fmaxf(rm, 0.f); mhat += dl;
                        if (!force) { const float f = __builtin_amdgcn_exp2f(-dl); lsum *= f; if (hi == 0) wsf[r32] = f;
                            asm volatile("s_waitcnt lgkmcnt(0)" ::: "memory");
#pragma unroll
                            for (int r = 0; r < 16; ++r) { const float fr = wsf[crow(r, hi)]; o0[r] *= fr; o1[r] *= fr; } }
                    }
                    float sacc = 0.f;
#pragma unroll
                    for (int r = 0; r < 16; ++r) { p0[r] = __builtin_amdgcn_exp2f(p0[r] - mhat); p1[r] = __builtin_amdgcn_exp2f(p1[r] - mhat); sacc += p0[r] + p1[r]; }
                    lsum += sacc;
                    bf16x8 pa[4];
#pragma unroll
                    for (int s = 0; s < 2; ++s) { const v4u a = (v4u){pk2(p0[8 * s], p0[8 * s + 1]), pk2(p0[8 * s + 2], p0[8 * s + 3]), pk2(p0[8 * s + 4], p0[8 * s + 5]), pk2(p0[8 * s + 6], p0[8 * s + 7])};
                        const v4u c = (v4u){pk2(p1[8 * s], p1[8 * s + 1]), pk2(p1[8 * s + 2], p1[8 * s + 3]), pk2(p1[8 * s + 4], p1[8 * s + 5]), pk2(p1[8 * s + 6], p1[8 * s + 7])};
                        pa[s] = __builtin_bit_cast(bf16x8, a); pa[2 + s] = __builtin_bit_cast(bf16x8, c); }
#pragma unroll
                    for (int s = 0; s < 4; ++s) { o0 = __builtin_amdgcn_mfma_f32_32x32x16_bf16(pa[s], *(const LAS bf16x8*)(Vc + s * 32), o0, 0, 0, 0);
                        o1 = __builtin_amdgcn_mfma_f32_32x32x16_bf16(pa[s], *(const LAS bf16x8*)(Vc + 32 * LDV + s * 32), o1, 0, 0, 0); }
                }
                if (more) { const int nx = cur ^ 1; *(LAS v4u*)(Kb + nx * KBUF + krow * LDK + kch * 16) = gk; *(LAS v4u*)(Vb + nx * VBUF + krow * LDV + kch * 16) = gv; if (tid < 256) *(LAS v4u*)(Kb + nx * KBUF + rrow * LDK + 128 + rch * 16) = gr; }
                __syncthreads();
            }
            lsum += __shfl_xor(lsum, 32);
            if (hi == 0) wsf[32 + r32] = lsum;
            asm volatile("s_waitcnt lgkmcnt(0)" ::: "memory");
            const size_t orow0 = tok0 + qb * 256 + w * 32;
#pragma unroll
            for (int r = 0; r < 16; ++r) { const int q = crow(r, hi); const float il = 1.f / wsf[32 + q]; const float a = o0[r] * il, c = o1[r] * il;
                bf16_t* op_ = AR + (orow0 + q) * 1024 + h * 64 + r32; op_[0] = (bf16_t)op::f2bf(a); op_[32] = (bf16_t)op::f2bf(c);
                float s2 = a * a + c * c; s2 += __shfl_xor(s2, 1); s2 += __shfl_xor(s2, 2); s2 += __shfl_xor(s2, 4); s2 += __shfl_xor(s2, 8); s2 += __shfl_xor(s2, 16);
                if (r32 == 0) atomicAdd(ssq_a + orow0 + q, s2); }
        }
    }
}
}

struct Args { const float* in[22]; float* out; unsigned char* ws; };
constexpr size_t MiB = 1u << 20;
constexpr size_t WS_CTL = 260 * MiB, CTL_ZERO_BYTES = 1 * MiB;
constexpr int CW_BAR = 1024, CW_CNT = 8192, CW_SSQ_Q = 16384, CW_SSQ_KV = 32768, CW_SSQ_A = 49152;

__global__ void __launch_bounds__(NTHREADS, 2) mega_fwd(Args args) {
    extern __shared__ __attribute__((aligned(16))) unsigned char lds_raw[];
    using namespace nv;
    LAS unsigned char* lds = (LAS unsigned char*)lds_raw;
    volatile LAS unsigned* MISC = (volatile LAS unsigned*)(lds + 131072);
    if (threadIdx.x < 64) MISC[threadIdx.x] = 0u;
    __syncthreads();
    unsigned char* ws = args.ws;
    unsigned* ctl = (unsigned*)(ws + WS_CTL);
    XcdBarrier bar = xcd_barrier_post(ctl + CW_BAR, MISC + 8);
    const float* x = args.in[0]; const int* pos = (const int*)args.in[1]; const float* w_in = args.in[2];
    const float* q_norm_g = args.in[3]; const float* w_uq = args.in[4]; const float* kv_norm_g = args.in[5];
    const float* w_ukv = args.in[6]; const float* mla_out_g = args.in[7]; const float* lbl = args.in[8];
    const float* hg_norm_g = args.in[9]; const float* w_out = args.in[10]; const float* ln1_g = args.in[11];
    const float* ln1_b = args.in[12]; const float* wrg = args.in[13]; const float* brg = args.in[14];
    const float* wre = args.in[15]; const float* bre = args.in[16]; const float* w1 = args.in[17];
    const float* w3 = args.in[18]; const float* w2 = args.in[19]; const float* ln2_g = args.in[20]; const float* ln2_b = args.in[21];
    float* out = args.out;
    typedef op::bf16_t bf16_t;
    float*  lf   = (float*)(ws + 0);
    bf16_t* kk   = (bf16_t*)(ws + 32 * MiB);
    bf16_t* vi   = (bf16_t*)(ws + 48 * MiB);
    bf16_t* qh   = (bf16_t*)(ws + 64 * MiB);
    bf16_t* gh   = (bf16_t*)(ws + 80 * MiB);
    bf16_t* Ub   = (bf16_t*)(ws + 96 * MiB);
    bf16_t* AR   = (bf16_t*)(ws + 96 * MiB);
    float*  dlb  = (float*)(ws + 128 * MiB);
    float*  cs   = (float*)(ws + 129 * MiB);
    bf16_t* Qb   = (bf16_t*)(ws + 131 * MiB);
    bf16_t* Knb  = (bf16_t*)(ws + 155 * MiB);
    bf16_t* VTb  = (bf16_t*)(ws + 171 * MiB);
    bf16_t* xb   = (bf16_t*)(ws + 187 * MiB);
    bf16_t* STb  = (bf16_t*)(ws + 187 * MiB);
    bf16_t* cq   = (bf16_t*)(ws + 219 * MiB);
    bf16_t* ckv  = (bf16_t*)(ws + 227 * MiB);
    bf16_t* kr   = (bf16_t*)(ws + 231 * MiB);
    bf16_t* Win_t = (bf16_t*)(ws + 232 * MiB);
    bf16_t* Wuq_t = (bf16_t*)(ws + 237 * MiB);
    bf16_t* Wkv_t = (bf16_t*)(ws + 237 * MiB + 512 * 1024);
    bf16_t* Wout_t = (bf16_t*)(ws + 238 * MiB);
    float*  h1   = (float*)(ws + 0);
    bf16_t* h1b  = (bf16_t*)(ws + 64 * MiB);
    bf16_t* W13_t = (bf16_t*)(ws + 97 * MiB);
    bf16_t* W2_t = (bf16_t*)(ws + 161 * MiB);
    bf16_t* Hb   = (bf16_t*)(ws + 193 * MiB);
    int*    stok = (int*)(ws + 233 * MiB);
    bf16_t* Yb   = (bf16_t*)(ws + 64 * MiB);
    int* cnt = (int*)(ctl + CW_CNT);
    float* ssq_q = (float*)(ctl + CW_SSQ_Q); float* ssq_kv = (float*)(ctl + CW_SSQ_KV); float* ssq_a = (float*)(ctl + CW_SSQ_A);
    int* meta = (int*)(ws + WS_CTL + 1 * MiB);
    int* tstart_g = meta; float* lbt = (float*)(meta + 1024); int* tok_e = meta + 2048; int* tok_rank = tok_e + 2 * NTOK; float* tok_gate = (float*)(tok_rank + 2 * NTOK);
    LAS int* moetab = (LAS int*)(lds + 131072 + 1024);

    {
        int tl_ = threadIdx.x; asm volatile("" : "+v"(tl_)); const int wave = __builtin_amdgcn_readfirstlane(tl_ >> 6), lane = tl_ & 63;
        LAS float* scr = (LAS float*)(lds + wave * 16384);
        for (int it = GWAVE; it < (D / 64) * (INC / 32); it += GWAVES) op::transpose_item(w_in, D, INC, Win_t, scr, it, lane, op::RowProj{});
        for (int it = GWAVE; it < (D / 64) * (D / 32); it += GWAVES) op::transpose_item(w_out, D, D, Wout_t, scr, it, lane, op::RowScaleK{mla_out_g, 512});
        for (int it = GWAVE; it < (256 / 64) * (768 / 32); it += GWAVES) op::transpose_item(w_uq, 256, 768, Wuq_t, scr, it, lane, op::RowQ{q_norm_g});
        for (int it = GWAVE; it < (128 / 64) * (1024 / 32); it += GWAVES) op::transpose_item(w_ukv, 128, 1024, Wkv_t, scr, it, lane, op::RowKV{kv_norm_g});
        op::cvt_rows_bf16(x, xb, (size_t)NTOK * D);
        cs_tab(pos, cs);
        lb_tab(lbl, lbt);
    }
    xcd_barrier(bar);
    {
        pg8::Gemm g{xb, Win_t, NTOK, 2560, D}; pg8::StaticOrder S; S.init(NTOK, 2560, (int)gridDim.x, (int)blockIdx.x);
        op::EpiProj E{cq, ckv, kr, kk, vi, lf, ssq_q, ssq_kv, cs, lbt};
        pg8::gemm_phase<op::EpiProj, pg8::StaticOrder, true, true>(lds, g, S, E);
    }
    xcd_barrier(bar);
    hg::pass1(lds, lf, kk, vi, Ub, dlb);
    {
        pg8::Gemm g{cq, Wuq_t, NTOK, 768, 256}; pg8::StaticOrder S; S.init(NTOK, 768, (int)gridDim.x, (int)blockIdx.x);
        op::EpiQ E{Qb, ssq_q, cs};
        pg8::gemm_phase<op::EpiQ, pg8::StaticOrder, true, true>(lds, g, S, E);
    }
    {
        pg8::Gemm g{ckv, Wkv_t, NTOK, 512, 128}; pg8::StaticOrder S; S.init(NTOK, 512, (int)gridDim.x, (int)blockIdx.x);
        op::EpiK E{Knb, ssq_kv};
        pg8::gemm_phase<op::EpiK, pg8::StaticOrder, true, true>(lds, g, S, E);
    }
    {
        pg8::Gemm g{Wkv_t + 512 * 128, ckv, 512, NTOK, 128}; pg8::StaticOrder S; S.init(512, NTOK, (int)gridDim.x, (int)blockIdx.x);
        op::EpiVT E{VTb, ssq_kv};
        pg8::gemm_phase<op::EpiVT, pg8::StaticOrder, true, true>(lds, g, S, E);
    }
    xcd_barrier(bar);
    hg::scan(Ub, dlb, STb);
    xcd_barrier(bar);
    hg::pass3(lds, lf, kk, vi, qh, gh, STb, hg_norm_g, AR);
    at::attn_phase(lds, Qb, Knb, kr, VTb, AR, ssq_a);
    xcd_barrier(bar);
    {
        pg8::Gemm g{AR, Wout_t, NTOK, D, D}; pg8::StaticOrder S; S.init(NTOK, D, (int)gridDim.x, (int)blockIdx.x);
        op::EpiMix2 E{x, h1, ALPHA, ssq_a};
        pg8::gemm_phase<op::EpiMix2, pg8::StaticOrder, true, true>(lds, g, S, E);
    }
    xcd_barrier(bar);
    ln_rows2(h1, ln1_g, ln1_b, h1b);
    {
        int tl_ = threadIdx.x; asm volatile("" : "+v"(tl_)); const int wave = __builtin_amdgcn_readfirstlane(tl_ >> 6), lane = tl_ & 63;
        LAS float* scr = (LAS float*)(lds + wave * 16384);
        for (int it = GWAVE; it < 32 * 3 * 256; it += GWAVES) {
            const int e = it / 768, r = it % 768;
            if (r < 256) op::transpose_item(w1 + (size_t)e * D * 512, D, 512, W13_t + (size_t)e * D * D, scr, r, lane, op::RowW13{0});
            else if (r < 512) op::transpose_item(w3 + (size_t)e * D * 512, D, 512, W13_t + (size_t)e * D * D, scr, r - 256, lane, op::RowW13{1});
            else op::transpose_item(w2 + (size_t)e * 512 * D, 512, D, W2_t + (size_t)e * D * 512, scr, r - 512, lane, op::RowId{});
        }
    }
    xcd_barrier(bar);
    router2(h1, wrg, brg, wre, bre, cnt, tok_e, tok_rank, tok_gate, stok);
    xcd_barrier(bar);
    op::moe_build_tab(moetab, cnt, tstart_g);
    {
        pg8::Gemm g{h1b, W13_t, 0, 0, D}; op::MoeOrder S{moetab, (int)gridDim.x, (int)blockIdx.x, stok};
        op::EpiMoe1 E{Hb};
        pg8::gemm_phase<op::EpiMoe1, op::MoeOrder, true, true, true>(lds, g, S, E);
    }
    xcd_barrier(bar);
    {
        pg8::Gemm g{Hb, W2_t, 0, 0, 512}; op::MoeOrder S{moetab, (int)gridDim.x, (int)blockIdx.x, stok};
        op::EpiBf16P E{Yb, D, 3};
        pg8::gemm_phase<op::EpiBf16P, op::MoeOrder, true, true, false>(lds, g, S, E);
    }
    xcd_barrier(bar);
    ln2_rows(h1, Yb, tok_e, tok_rank, tok_gate, tstart_g, ln2_g, ln2_b, out);
}

extern "C" void kernel_launch(void* const* d_in, const int* in_sizes, int n_in, void* d_out, int out_size, void* d_ws, size_t ws_size, hipStream_t stream) {
    static int grid = 0;
    if (grid == 0) {
        if (n_in != 22 || ws_size < 264 * MiB) { fprintf(stderr, "kernel_launch: unexpected n_in %d / ws %zu\n", n_in, ws_size); grid = -1; return; }
        int dev = 0, cus = 0, per_cu = 0;
        if (hipGetDevice(&dev) != hipSuccess || hipDeviceGetAttribute(&cus, hipDeviceAttributeMultiprocessorCount, dev) != hipSuccess) { grid = -1; return; }
        if (hipFuncSetAttribute((const void*)mega_fwd, hipFuncAttributeMaxDynamicSharedMemorySize, LDS_BYTES) != hipSuccess) { fprintf(stderr, "kernel_launch: hipFuncSetAttribute failed\n"); grid = -1; return; }
        if (hipOccupancyMaxActiveBlocksPerMultiprocessor(&per_cu, (const void*)mega_fwd, NTHREADS, LDS_BYTES) != hipSuccess || per_cu < 1) { fprintf(stderr, "kernel_launch: occupancy query says %d\n", per_cu); (void)hipGetLastError(); }
        grid = cus;
    }
    if (grid < 0) return;
    if (hipMemsetAsync((char*)d_ws + WS_CTL, 0, CTL_ZERO_BYTES, stream) != hipSuccess) return;
    Args a{};
    for (int i = 0; i < 22; ++i) a.in[i] = (const float*)d_in[i];
    a.out = (float*)d_out; a.ws = (unsigned char*)d_ws;
    hipLaunchKernelGGL(mega_fwd, dim3(grid), dim3(NTHREADS), LDS_BYTES, stream, a);
}
```

```cpp
#include <hip/hip_runtime.h>
#include <cstdio>
#include <cstdint>
#include <cmath>

#define LAS __attribute__((address_space(3)))
constexpr int NTHREADS = 512, NWAVES = 8;
constexpr int LDS_BYTES = 147456;

#define XB_TMO      128
#define XB_XCNT(j)  (256  + 64 * (j))
#define XB_XSUB(j)  (1280 + 64 * (j))
#define XB_XGEN(j)  (2304 + 64 * (j))
#define XB_TOP      3328
#define XB_TOPGEN   3392
#define XCD_BAR_WORDS 3456
#define XB_SPIN_CAP (1u << 18)

__device__ __forceinline__ unsigned xb_ld(unsigned* p)              { return __hip_atomic_load(p, __ATOMIC_RELAXED, __HIP_MEMORY_SCOPE_AGENT); }
__device__ __forceinline__ unsigned xb_add(unsigned* p, unsigned v) { return __hip_atomic_fetch_add(p, v, __ATOMIC_RELAXED, __HIP_MEMORY_SCOPE_AGENT); }
__device__ __forceinline__ unsigned xb_xcc_id() { return (unsigned)__builtin_amdgcn_s_getreg((3 << 11) | 20) & 0xFu; }
#define XB_SPIN(cond, bar) do { unsigned _sp = 0; while (cond) { __builtin_amdgcn_s_sleep(1); \
    if ((++_sp & 255u) == 0u) { if (xb_ld(&(bar)[XB_TMO])) break; if (_sp > XB_SPIN_CAP) { atomicAdd(&(bar)[XB_TMO], 1u); break; } } } } while (0)

struct XcdBarrier {
    unsigned* bar; unsigned x;
    volatile LAS unsigned* st;
};

__device__ __forceinline__ XcdBarrier xcd_barrier_post(unsigned* bar, volatile LAS unsigned* st) {
    XcdBarrier b; b.bar = bar; b.x = xb_xcc_id(); b.st = st;
    if (threadIdx.x == 0) (void)xb_add(&bar[XB_XCNT(b.x)], 1u);
    return b;
}
__device__ __forceinline__ void xcd_barrier_complete(unsigned* bar, unsigned x, unsigned& nloc, unsigned& nx) {
    const unsigned G = gridDim.x * gridDim.y * gridDim.z;
    unsigned sum, cnt, mine, sp = 0u;
    for (;;) {
        sum = 0u; cnt = 0u; mine = 0u;
#pragma unroll
        for (unsigned j = 0; j < 16; ++j) { const unsigned c = xb_ld(&bar[XB_XCNT(j)]); sum += c; cnt += (c > 0u) ? 1u : 0u; mine = (j == x) ? c : mine; }
        if (sum == G) break;
        __builtin_amdgcn_s_sleep(1);
        if ((++sp & 255u) == 0u) { if (xb_ld(&bar[XB_TMO])) break; if (sp > XB_SPIN_CAP) { atomicAdd(&bar[XB_TMO], 1u); break; } }
    }
    nloc = mine > 0u ? mine : 1u; nx = cnt > 0u ? cnt : 1u;
}

__device__ __forceinline__ void xcd_barrier(const XcdBarrier& b) {
    asm volatile("s_waitcnt vmcnt(0)" ::: "memory");
    __syncthreads();
    if (threadIdx.x == 0) {
        unsigned* bar = b.bar;
        __builtin_amdgcn_s_waitcnt(0);
        unsigned nloc = b.st[0], nx = b.st[1];
        if (nloc == 0u) { xcd_barrier_complete(bar, b.x, nloc, nx); b.st[0] = nloc; b.st[1] = nx; }
        const unsigned old = xb_add(&bar[XB_XSUB(b.x)], 1u);
        const unsigned gen = old / nloc;
        if (old + 1u == (gen + 1u) * nloc) {
            __builtin_amdgcn_fence(__ATOMIC_RELEASE, "agent");
            asm volatile("s_waitcnt vmcnt(0)" ::: "memory");
            const unsigned og = xb_add(&bar[XB_TOP], 1u);
            const unsigned tg = og / nx;
            if (og + 1u == (tg + 1u) * nx) xb_add(&bar[XB_TOPGEN], 1u);
            else XB_SPIN(xb_ld(&bar[XB_TOPGEN]) == tg, bar);
            __builtin_amdgcn_fence(__ATOMIC_ACQUIRE, "agent");
            xb_add(&bar[XB_XGEN(b.x)], 1u);
            asm volatile("s_waitcnt vmcnt(0)" ::: "memory");
        } else {
            XB_SPIN(xb_ld(&bar[XB_XGEN(b.x)]) == gen, bar);
            __builtin_amdgcn_fence(__ATOMIC_ACQUIRE, "agent");
            asm volatile("s_waitcnt vmcnt(0)" ::: "memory");
        }
    }
    __syncthreads();
}
namespace pg8 {
#define PG8_LAS __attribute__((address_space(3)))
typedef unsigned short bf16_t;
typedef short bf16x8 __attribute__((ext_vector_type(8)));
typedef float f32x4 __attribute__((ext_vector_type(4)));
typedef unsigned u32x4 __attribute__((ext_vector_type(4)));
constexpr int BM = 256, BK = 64, HALF = 128, HTB = HALF * BK * 2  , STAGE_BYTES = 8 * HTB, NXCD = 8, WGM = 8;

__host__ __device__ __forceinline__ int lds_byte(int r, int c) { const int st = (r >> 4) * 2 + (c >> 5), rr = r & 15, cc = c & 31, ob = rr * 64 + cc * 2; return st * 1024 + (ob ^ (((ob >> 9) & 1) << 5)); }
__host__ __device__ __forceinline__ void stage_rc(int b, int& R, int& C) { const int st = b / 1024, sb = b % 1024, swz = sb ^ (((sb >> 9) & 1) << 5); R = (st >> 1) * 16 + swz / 64; C = (st & 1) * 32 + (swz % 64) / 2; }
__host__ __device__ __forceinline__ int perm32(int rho) { const int n = rho >> 4, i = rho & 15; return 8 * (i >> 2) + 4 * n + (i & 3); }

struct Unit { int pm, pn; };
struct Gemm { const bf16_t* A; const bf16_t* Bt; int M, N, K; };

struct StaticOrder {
    int nM, nN, nwg, G, c;
    __host__ __device__ void init(int M, int N, int G_, int c_) { nM = M / BM; nN = N / BM; nwg = nM * nN; G = G_; c = c_; }
    __host__ __device__ bool next(int i, Unit& u) const {
        const long L = (long)i * G + c; if (L >= nwg) return false;
        int wgid = (int)L; { const int q = nwg / NXCD, r = nwg % NXCD, xcd = wgid % NXCD, off = wgid / NXCD; wgid = (xcd < r ? xcd * (q + 1) : r * (q + 1) + (xcd - r) * q) + off; }
        const int nig = WGM * nN, gid = wgid / nig, fm = gid * WGM, gsz = (nM - fm) < WGM ? (nM - fm) : WGM;
        u.pm = fm + ((wgid % nig) % gsz); u.pn = (wgid % nig) / gsz; return true;
    }
    __device__ __forceinline__ void a_ready(const Unit&) const {}
    __device__ __forceinline__ void done(const Unit&) const {}
    __device__ __forceinline__ int arow(const Unit&, int) const { return 0; }
};

__device__ __forceinline__ unsigned cvt_pk_bf16(float lo, float hi) { unsigned r; asm volatile("v_cvt_pk_bf16_f32 %0, %1, %2" : "=v"(r) : "v"(lo), "v"(hi)); return r; }
typedef float f32x2 __attribute__((ext_vector_type(2)));
__device__ __forceinline__ f32x2 gelu_pk(f32x2 v) {
    const f32x2 av = __builtin_elementwise_abs(v), d = av * 0.2316418882f + 1.0f;
    f32x2 t; t.x = __builtin_amdgcn_rcpf(d.x); t.y = __builtin_amdgcn_rcpf(d.y);
    f32x2 q = t * 0.5307027145f + (-0.7265760135f); q = q * t + 0.7107068705f; q = q * t + (-0.142248368f); q = q * t + 0.127414796f; q = q * t;
    const f32x2 s = (v * v) * (-0.72134752044f);
    f32x2 e; e.x = __builtin_amdgcn_exp2f(s.x); e.y = __builtin_amdgcn_exp2f(s.y);
    const f32x2 m = v * (q * e), r = v - m;
    f32x2 o; o.x = v.x < 0.f ? m.x : r.x; o.y = v.y < 0.f ? m.y : r.y; return o;
}

template <int ACT  > struct EpiBf16 {
    static constexpr bool PERM = true, AFTER_DRAIN = false; static_assert(ACT == 0 || ACT == 1, "EpiBf16: ACT is 0 (none) or 1 (gelu_pk)");
    bf16_t* O; int ldc; const float* bias; int split_cols; size_t split_stride; float scale0;
    __device__ __forceinline__ void operator()(const f32x4 (&acc)[2][2][4][2], const Unit& u, int wr, int wc, int fr, int fq) const {
        const int row0 = u.pm * BM + wr * 64 + fr; int colt = u.pn * BM; bf16_t* base = O;
        float sc = 1.f; if (split_cols) { const int t = colt / split_cols; base += (size_t)t * split_stride; colt -= t * split_cols; if (t == 0) sc = scale0; }
        const int col0 = colt + wc * 32 + 8 * fq, bcol0 = u.pn * BM + wc * 32 + 8 * fq;
        f32x4 bv[2][2];
#pragma unroll
        for (int bj = 0; bj < 2; ++bj)
#pragma unroll
            for (int n = 0; n < 2; ++n) bv[bj][n] = bias ? *(const f32x4*)(bias + bcol0 + bj * HALF + 4 * n) : (f32x4){0.f, 0.f, 0.f, 0.f};
#pragma unroll
        for (int ai = 0; ai < 2; ++ai)
#pragma unroll
            for (int m = 0; m < 4; ++m) { bf16_t* rowp = base + (size_t)(row0 + ai * HALF + m * 16) * ldc + col0;
#pragma unroll
                for (int bj = 0; bj < 2; ++bj) { f32x4 v0 = acc[ai][bj][m][0] + bv[bj][0], v1 = acc[ai][bj][m][1] + bv[bj][1];
                    if (ACT == 1) { f32x2 a = gelu_pk((f32x2){v0[0], v0[1]}), b = gelu_pk((f32x2){v0[2], v0[3]}), c = gelu_pk((f32x2){v1[0], v1[1]}), d = gelu_pk((f32x2){v1[2], v1[3]});
                        v0 = (f32x4){a.x, a.y, b.x, b.y}; v1 = (f32x4){c.x, c.y, d.x, d.y}; }
                    v0 = v0 * sc; v1 = v1 * sc; u32x4 w; w.x = cvt_pk_bf16(v0[0], v0[1]); w.y = cvt_pk_bf16(v0[2], v0[3]); w.z = cvt_pk_bf16(v1[0], v1[1]); w.w = cvt_pk_bf16(v1[2], v1[3]);
                    *(u32x4*)(rowp + bj * HALF) = w; } }
    }
};

struct PanelStats {
    unsigned* xbuf;
    unsigned* cnt;
    unsigned* tmo;
    int ntn; float eps;
    unsigned code;
    __device__ __forceinline__ bool run(const f32x4 (&v)[2][2][4][2], const Unit& u, int wr, int wc, int fr, int fq, PG8_LAS unsigned char* lds, int wid, int lane) const {
        typedef float f32x2v __attribute__((ext_vector_type(2)));
        PG8_LAS f32x2v* P = (PG8_LAS f32x2v*)lds;
        PG8_LAS f32x2v* S = (PG8_LAS f32x2v*)(lds + 8192);
        PG8_LAS unsigned* flag = (PG8_LAS unsigned*)(lds + 8192 + 2048);
#pragma unroll
        for (int ai = 0; ai < 2; ++ai)
#pragma unroll
            for (int m = 0; m < 4; ++m) {
                float s = 0.f;
#pragma unroll
                for (int bj = 0; bj < 2; ++bj)
#pragma unroll
                    for (int n = 0; n < 2; ++n) { const f32x4 x = v[ai][bj][m][n]; s += (x[0] + x[1]) + (x[2] + x[3]); }
                s += __shfl_xor(s, 16); s += __shfl_xor(s, 32);
                const float mw = s * (1.0f / 64.0f); float q = 0.f;
#pragma unroll
                for (int bj = 0; bj < 2; ++bj)
#pragma unroll
                    for (int n = 0; n < 2; ++n) { const f32x4 d = v[ai][bj][m][n] - mw; q += (d[0] * d[0] + d[1] * d[1]) + (d[2] * d[2] + d[3] * d[3]); }
                q += __shfl_xor(q, 16); q += __shfl_xor(q, 32);
                if (fq == 0) P[(ai * HALF + wr * 64 + m * 16 + fr) * 4 + wc] = (f32x2v){mw, q};
            }
        asm volatile("s_waitcnt lgkmcnt(0)" ::: "memory"); __builtin_amdgcn_s_barrier(); asm volatile("" ::: "memory");
#if defined(BROKEN_EXCHANGE_NO_WAIT)
#warning BROKEN CONTROL BUILD: the row-statistics exchange does not wait; results are wrong by design
        if (blockIdx.x >= 64) { const long long t0_ = clock64(); while (clock64() - t0_ < 60000) __builtin_amdgcn_s_sleep(8); }
#endif
        const int row = wid * 32 + (lane & 31);
        if (lane < 32) {
            const f32x2v a = P[row * 4 + 0], b = P[row * 4 + 1], c = P[row * 4 + 2], d = P[row * 4 + 3];
            const float mt = (a.x + b.x + c.x + d.x) * 0.25f;
            const float da = a.x - mt, db = b.x - mt, dc = c.x - mt, dd = d.x - mt;
            const float m2 = (a.y + b.y) + (c.y + d.y) + 64.0f * ((da * da + db * db) + (dc * dc + dd * dd));
            unsigned long long* slot = (unsigned long long*)xbuf + ((size_t)(u.pm * BM + row) * 4 + u.pn);
            __hip_atomic_store(slot, ((unsigned long long)__float_as_uint(m2) << 32) | __float_as_uint(mt), __ATOMIC_RELAXED, __HIP_MEMORY_SCOPE_AGENT);
        }
        asm volatile("s_waitcnt vmcnt(0)" ::: "memory");
        if (lane == 0) __hip_atomic_fetch_add(cnt + 64 * u.pm, 1u, __ATOMIC_RELAXED, __HIP_MEMORY_SCOPE_AGENT);
        if (wid == 0) {
            bool dead = false; const unsigned long long t0 = __builtin_amdgcn_s_memrealtime(); const unsigned want = 8u * (unsigned)ntn;
            for (;;) {
#if defined(BROKEN_EXCHANGE_NO_WAIT)
                break;
#endif
                if ((unsigned)__builtin_amdgcn_readfirstlane(__hip_atomic_load(cnt + 64 * u.pm, __ATOMIC_RELAXED, __HIP_MEMORY_SCOPE_AGENT)) >= want) break;
                if (__builtin_amdgcn_s_memrealtime() - t0 > 2000000ull) {
                    if (lane == 0) { unsigned expect = 0u; __hip_atomic_compare_exchange_strong(tmo + 1, &expect, code | (unsigned)(u.pm & 0xff), __ATOMIC_RELAXED, __ATOMIC_RELAXED, __HIP_MEMORY_SCOPE_AGENT);
                                     __hip_atomic_store(tmo, 1u, __ATOMIC_RELAXED, __HIP_MEMORY_SCOPE_AGENT); }
                    dead = true; break; }
                __builtin_amdgcn_s_sleep(2);
            }
            __builtin_amdgcn_fence(__ATOMIC_ACQUIRE, "agent");
            if (lane == 0) flag[0] = dead ? 1u : 0u;
        }
        asm volatile("s_waitcnt vmcnt(0) lgkmcnt(0)" ::: "memory"); __builtin_amdgcn_s_barrier(); asm volatile("" ::: "memory");
        const bool bad = flag[0] != 0u;
        if (lane < 32) {
            const unsigned long long* slot = (const unsigned long long*)xbuf + (size_t)(u.pm * BM + row) * 4; float mt[4], m2[4]; float ms = 0.f;
#pragma unroll
            for (int t = 0; t < 4; ++t) { if (t < ntn) { const unsigned long long w = __hip_atomic_load(slot + t, __ATOMIC_RELAXED, __HIP_MEMORY_SCOPE_AGENT); mt[t] = __uint_as_float((unsigned)w); m2[t] = __uint_as_float((unsigned)(w >> 32)); } else { mt[t] = 0.f; m2[t] = 0.f; } ms += mt[t]; }
            const float mean = ms / (float)ntn; float q = 0.f;
#pragma unroll
            for (int t = 0; t < 4; ++t) if (t < ntn) { const float dm = mt[t] - mean; q += m2[t] + 256.0f * dm * dm; }
            S[row] = (f32x2v){mean, 1.0f / sqrtf(q / (256.0f * (float)ntn) + eps)};
        }
        asm volatile("s_waitcnt lgkmcnt(0)" ::: "memory"); __builtin_amdgcn_s_barrier(); asm volatile("" ::: "memory");
        return bad;
    }
};
struct EpiLnRes {
    static constexpr bool PERM = false, AFTER_DRAIN = true;
    const float* base; float* out; int ldc; const float* bias; PanelStats st; unsigned poison;
    __device__ __forceinline__ void fused(f32x4 (&acc)[2][2][4][2], const Unit& u, int wr, int wc, int fr, int fq, PG8_LAS unsigned char* lds, int wid, int lane) const {
        typedef float f32x2v __attribute__((ext_vector_type(2)));
        const PG8_LAS f32x2v* S = (const PG8_LAS f32x2v*)(lds + 8192);
        const int col0 = u.pn * BM + wc * 32 + 4 * fq;
#pragma unroll
        for (int bj = 0; bj < 2; ++bj)
#pragma unroll
            for (int n = 0; n < 2; ++n) { const f32x4 bv = bias ? *(const f32x4*)(bias + col0 + bj * HALF + n * 16) : (f32x4){0.f, 0.f, 0.f, 0.f};
#pragma unroll
                for (int ai = 0; ai < 2; ++ai)
#pragma unroll
                    for (int m = 0; m < 4; ++m) acc[ai][bj][m][n] += bv; }
        f32x4 pre[4][2][2];
#pragma unroll
        for (int m = 0; m < 4; ++m) { const size_t off = (size_t)(u.pm * BM + wr * 64 + m * 16 + fr) * ldc + col0;
#pragma unroll
            for (int bj = 0; bj < 2; ++bj)
#pragma unroll
                for (int n = 0; n < 2; ++n) pre[m][bj][n] = *(const f32x4*)(base + off + bj * HALF + n * 16); }
        const bool bad = st.run(acc, u, wr, wc, fr, fq, lds, wid, lane) || poison != 0u;
        const float qnan = __builtin_nanf("");
#pragma unroll
        for (int ai = 0; ai < 2; ++ai)
#pragma unroll
            for (int m = 0; m < 4; ++m) { const int r = ai * HALF + wr * 64 + m * 16 + fr; const f32x2v sr = S[r]; const size_t off = (size_t)(u.pm * BM + r) * ldc + col0;
#pragma unroll
                for (int bj = 0; bj < 2; ++bj)
#pragma unroll
                    for (int n = 0; n < 2; ++n) { const f32x4 bs = ai == 0 ? pre[m][bj][n] : *(const f32x4*)(base + off + bj * HALF + n * 16); f32x4 o = bs + (acc[ai][bj][m][n] - sr.x) * sr.y;
                        if (bad) o = (f32x4){qnan, qnan, qnan, qnan}; *(f32x4*)(out + off + bj * HALF + n * 16) = o; }
                if (m & 1) asm volatile("" ::: "memory"); }
    }
};
struct EpiLnResLn {
    static constexpr bool PERM = false, AFTER_DRAIN = true;
    const float* base; float* out; bf16_t* xn; int ldc; const float* bias; PanelStats st1, st2; unsigned poison;
    __device__ __forceinline__ void fused(f32x4 (&acc)[2][2][4][2], const Unit& u, int wr, int wc, int fr, int fq, PG8_LAS unsigned char* lds, int wid, int lane) const {
        typedef float f32x2v __attribute__((ext_vector_type(2))); typedef unsigned u32x2v __attribute__((ext_vector_type(2)));
        const PG8_LAS f32x2v* S = (const PG8_LAS f32x2v*)(lds + 8192);
        const int col0 = u.pn * BM + wc * 32 + 4 * fq;
#pragma unroll
        for (int bj = 0; bj < 2; ++bj)
#pragma unroll
            for (int n = 0; n < 2; ++n) { const f32x4 bv = bias ? *(const f32x4*)(bias + col0 + bj * HALF + n * 16) : (f32x4){0.f, 0.f, 0.f, 0.f};
#pragma unroll
                for (int ai = 0; ai < 2; ++ai)
#pragma unroll
                    for (int m = 0; m < 4; ++m) acc[ai][bj][m][n] += bv; }
        bool bad = st1.run(acc, u, wr, wc, fr, fq, lds, wid, lane) || poison != 0u;
        const float qnan = __builtin_nanf("");
#pragma unroll
        for (int ai = 0; ai < 2; ++ai)
#pragma unroll
            for (int m = 0; m < 4; ++m) { const int r = ai * HALF + wr * 64 + m * 16 + fr; const f32x2v sr = S[r]; const size_t off = (size_t)(u.pm * BM + r) * ldc + col0;
#pragma unroll
                for (int bj = 0; bj < 2; ++bj)
#pragma unroll
                    for (int n = 0; n < 2; ++n) { const f32x4 bs = *(const f32x4*)(base + off + bj * HALF + n * 16); acc[ai][bj][m][n] = bs + (acc[ai][bj][m][n] - sr.x) * sr.y; }
                asm volatile("" : "+v"(acc[ai][0][m][0]), "+v"(acc[ai][0][m][1]), "+v"(acc[ai][1][m][0]), "+v"(acc[ai][1][m][1]));
                if (m & 1) asm volatile("" ::: "memory"); }
        const bool bad1 = bad;
        bad = st2.run(acc, u, wr, wc, fr, fq, lds, wid, lane) || bad;
#pragma unroll
        for (int ai = 0; ai < 2; ++ai)
#pragma unroll
            for (int m = 0; m < 4; ++m) { const int r = ai * HALF + wr * 64 + m * 16 + fr; const f32x2v sr = S[r]; const size_t off = (size_t)(u.pm * BM + r) * ldc + col0;
#pragma unroll
                for (int bj = 0; bj < 2; ++bj)
#pragma unroll
                    for (int n = 0; n < 2; ++n) { const f32x4 x1 = acc[ai][bj][m][n]; *(f32x4*)(out + off + bj * HALF + n * 16) = bad1 ? (f32x4){qnan, qnan, qnan, qnan} : x1;
                        const f32x4 o = (x1 - sr.x) * sr.y; u32x2v w; w.x = cvt_pk_bf16(o[0], o[1]); w.y = cvt_pk_bf16(o[2], o[3]);
                        if (bad) { w.x = 0x7fc07fc0u; w.y = 0x7fc07fc0u; } *(u32x2v*)(xn + off + bj * HALF + n * 16) = w; }
                asm volatile("" ::: "memory"); }
    }
};

template <class E, class = void> struct has_mid { static constexpr bool value = false; };
template <class E> struct has_mid<E, decltype((void)E::MID_T)> { static constexpr bool value = true; };
template <class Epi, class Sched, bool ALIGN_EPI = false, bool SP2 = false, bool GATHER = false>
__device__ __forceinline__ void gemm_phase(PG8_LAS unsigned char* lds, const Gemm g, const Sched& S, const Epi& E) {
    int tid_ = threadIdx.x; asm volatile("" : "+v"(tid_));
    const int tid = tid_, wid = __builtin_amdgcn_readfirstlane(tid >> 6), lane = tid & 63, wr = wid >> 2, wc = wid & 3, fr = lane & 15, fq = lane >> 4;
    int K_ = g.K; asm volatile("" : "+s"(K_));
    const int K = K_, nt = K / BK;
    unsigned voffA[2], voffB[2]; int stR[2], stC[2]; static_assert(!GATHER || SP2, "GATHER needs SP2");
#pragma unroll
    for (int i = 0; i < 2; ++i) { int R, C; stage_rc(tid * 16 + i * 8192, R, C); stR[i] = R; stC[i] = C; const int Rb = Epi::PERM ? ((R & ~31) + perm32(R & 31)) : R;
        voffA[i] = (unsigned)(R * K + C) * 2u; voffB[i] = (unsigned)(Rb * K + C) * 2u; }
    const size_t kstep = (size_t)(BK * 2);
    const size_t hstep = (size_t)HALF * K * 2;
    const size_t tstep = 2 * hstep;
    const unsigned ldsw = (unsigned)wid * 1024u;
    const int aoff = lds_byte(wr * 64 + fr, fq * 8), boff = lds_byte(wc * 32 + fr, fq * 8);
#define PG8_SA(b, h) (((b) * 2 + (h)) * HTB)
#define PG8_SB(b, h) ((4 + (b) * 2 + (h)) * HTB)
#define PG8_STAGE(bufoff, gbase, voff) do { _Pragma("unroll") for (int _i = 0; _i < 2; ++_i) \
        __builtin_amdgcn_global_load_lds((const unsigned*)((const char*)(gbase) + (voff)[_i]), (PG8_LAS unsigned*)(lds + (bufoff) + ldsw + _i * 8192), 16, 0, 0); } while (0)
#define PG8_STAGE_A(bufoff, base, h, vsel) do { if constexpr (GATHER) { _Pragma("unroll") for (int _i = 0; _i < 2; ++_i) \
        __builtin_amdgcn_global_load_lds((const unsigned*)((const char*)(base) + (vsel)[h][_i]), (PG8_LAS unsigned*)(lds + (bufoff) + ldsw + _i * 8192), 16, 0, 0); } \
        else { PG8_STAGE(bufoff, (base) + (h) * hstep, voffA); } } while (0)
#define PG8_GOFF(dst, u) do { _Pragma("unroll") for (int _h = 0; _h < 2; ++_h) _Pragma("unroll") for (int _i = 0; _i < 2; ++_i) dst[_h][_i] = (unsigned)S.arow(u, _h * HALF + stR[_i]) * (unsigned)(K * 2) + (unsigned)(stC[_i] * 2); } while (0)
#define PG8_LDA(dst, b, h) do { _Pragma("unroll") for (int m = 0; m < 4; ++m) _Pragma("unroll") for (int k = 0; k < 2; ++k) dst[m][k] = *(const PG8_LAS bf16x8*)(lds + PG8_SA(b, h) + aoff + m * 2048 + k * 1024); } while (0)
#define PG8_LDB(dst, b, h) do { _Pragma("unroll") for (int n = 0; n < 2; ++n) _Pragma("unroll") for (int k = 0; k < 2; ++k) dst[n][k] = *(const PG8_LAS bf16x8*)(lds + PG8_SB(b, h) + boff + n * 2048 + k * 1024); } while (0)
#define PG8_MMA(ai, bj, At, Bt) do { __builtin_amdgcn_s_setprio(1); _Pragma("unroll") for (int m = 0; m < 4; ++m) _Pragma("unroll") for (int n = 0; n < 2; ++n) _Pragma("unroll") for (int k = 0; k < 2; ++k) \
        acc[ai][bj][m][n] = __builtin_amdgcn_mfma_f32_16x16x32_bf16(Bt[n][k], At[m][k], acc[ai][bj][m][n], 0, 0, 0); __builtin_amdgcn_s_setprio(0); } while (0)
#define PG8_WAIT_V(n) asm volatile("s_waitcnt vmcnt(" #n ")" ::: "memory")
#define PG8_WAIT_L(n) asm volatile("s_waitcnt lgkmcnt(" #n ")" ::: "memory")
#define PG8_BAR __builtin_amdgcn_s_barrier()
#define PG8_SCHED __builtin_amdgcn_sched_barrier(0)
    Unit cur, nxt; int ui = 0;
    if (!S.next(0, cur)) return;
    f32x4 acc[2][2][4][2];
#pragma unroll
    for (int a = 0; a < 2; ++a)
#pragma unroll
        for (int b = 0; b < 2; ++b)
#pragma unroll
            for (int m = 0; m < 4; ++m)
#pragma unroll
                for (int n = 0; n < 2; ++n) acc[a][b][m][n] = (f32x4){0.f, 0.f, 0.f, 0.f};
    bf16x8 At[4][2], B0[2][2], B1[2][2];
    unsigned gC[2][2] = {{0u, 0u}, {0u, 0u}}, gN[2][2] = {{0u, 0u}, {0u, 0u}}, gS[2][2] = {{0u, 0u}, {0u, 0u}};
    if constexpr (GATHER) PG8_GOFF(gC, cur);
    const char* cA = GATHER ? (const char*)g.A : (const char*)g.A + (size_t)cur.pm * tstep; const char* cB = (const char*)g.Bt + (size_t)cur.pn * tstep;
    S.a_ready(cur);
    if constexpr (SP2) {
        PG8_STAGE(PG8_SB(0, 0), cB, voffB); PG8_STAGE(PG8_SB(0, 1), cB + hstep, voffB); PG8_STAGE_A(PG8_SA(0, 0), cA, 0, gC); PG8_STAGE_A(PG8_SA(0, 1), cA, 1, gC);
        if (wr == 1) PG8_BAR;
        PG8_WAIT_V(2); PG8_BAR;
        PG8_STAGE(PG8_SB(1, 0), cB + kstep, voffB); PG8_STAGE_A(PG8_SA(1, 0), cA + kstep, 0, gC); PG8_STAGE(PG8_SB(1, 1), cB + hstep + kstep, voffB);
        PG8_WAIT_V(6); PG8_BAR;
    } else {
        PG8_STAGE(PG8_SB(0, 0), cB, voffB); PG8_STAGE(PG8_SA(0, 0), cA, voffA); PG8_STAGE(PG8_SB(0, 1), cB + hstep, voffB); PG8_STAGE(PG8_SA(0, 1), cA + hstep, voffA);
        if (wr == 1) PG8_BAR;
        PG8_WAIT_V(4); PG8_BAR;
        PG8_STAGE(PG8_SB(1, 0), cB + kstep, voffB); PG8_STAGE(PG8_SA(1, 0), cA + kstep, voffA); PG8_STAGE(PG8_SB(1, 1), cB + hstep + kstep, voffB);
        PG8_WAIT_V(6); PG8_BAR;
    }
    for (;;) {
        const bool has_next = S.next(ui + 1, nxt);
        if constexpr (GATHER) { if (has_next) PG8_GOFF(gN, nxt); else { _Pragma("unroll") for (int _h = 0; _h < 2; ++_h) _Pragma("unroll") for (int _i = 0; _i < 2; ++_i) gN[_h][_i] = gC[_h][_i]; } }
        const char* nA = GATHER ? (const char*)g.A : (has_next ? (const char*)g.A + (size_t)nxt.pm * tstep : cA); const char* nB = has_next ? (const char*)g.Bt + (size_t)nxt.pn * tstep : cB;
        for (int t = 0; t < nt; t += 2) {
            const bool last = (t == nt - 2);
            const char* a1 = cA + (size_t)(t + 1) * kstep;
            const char* a2 = last ? nA : cA + (size_t)(t + 2) * kstep; const char* b2 = last ? nB : cB + (size_t)(t + 2) * kstep;
            const char* a3 = a2 + kstep; const char* b3 = b2 + kstep;
            if (last && has_next) S.a_ready(nxt);
            if constexpr (has_mid<Epi>::value) { if (t == Epi::MID_T) E.mid(acc, cur, wr, wc, fr, fq); }
            if constexpr (GATHER) { _Pragma("unroll") for (int _h = 0; _h < 2; ++_h) _Pragma("unroll") for (int _i = 0; _i < 2; ++_i) gS[_h][_i] = last ? gN[_h][_i] : gC[_h][_i]; }
            if constexpr (SP2) {
            PG8_LDB(B0, 0, 0); PG8_LDB(B1, 0, 1); PG8_SCHED; PG8_LDA(At, 0, 0); PG8_STAGE_A(PG8_SA(1, 1), a1, 1, gC);
            PG8_WAIT_V(8); PG8_WAIT_L(0); PG8_BAR; PG8_MMA(0, 0, At, B0); PG8_MMA(0, 1, At, B1); PG8_BAR; PG8_SCHED;
            PG8_LDA(At, 0, 1); PG8_STAGE(PG8_SB(0, 0), b2, voffB); PG8_STAGE(PG8_SB(0, 1), b2 + hstep, voffB); PG8_STAGE_A(PG8_SA(0, 0), a2, 0, gS);
            PG8_WAIT_V(8); PG8_WAIT_L(0); PG8_BAR; PG8_MMA(1, 0, At, B0); PG8_MMA(1, 1, At, B1); PG8_BAR; PG8_SCHED;
            PG8_LDB(B0, 1, 0); PG8_LDB(B1, 1, 1); PG8_SCHED; PG8_LDA(At, 1, 0); PG8_STAGE_A(PG8_SA(0, 1), a2, 1, gS);
            PG8_WAIT_V(8); PG8_WAIT_L(0); PG8_BAR; PG8_MMA(0, 0, At, B0); PG8_MMA(0, 1, At, B1); PG8_BAR; PG8_SCHED;
            PG8_LDA(At, 1, 1); PG8_STAGE(PG8_SB(1, 0), b3, voffB); PG8_STAGE(PG8_SB(1, 1), b3 + hstep, voffB); PG8_STAGE_A(PG8_SA(1, 0), a3, 0, gS);
            PG8_WAIT_V(8); PG8_WAIT_L(0); PG8_BAR; PG8_MMA(1, 0, At, B0); PG8_MMA(1, 1, At, B1); PG8_BAR; PG8_SCHED;
            } else {
            PG8_LDB(B0, 0, 0); PG8_SCHED; PG8_LDA(At, 0, 0); PG8_STAGE(PG8_SA(1, 1), a1 + hstep, voffA);
            PG8_WAIT_L(8); PG8_BAR; PG8_WAIT_L(0); PG8_MMA(0, 0, At, B0); PG8_BAR; PG8_SCHED;
            PG8_LDB(B1, 0, 1); PG8_STAGE(PG8_SB(0, 0), b2, voffB);
            PG8_BAR; PG8_WAIT_L(0); PG8_MMA(0, 1, At, B1); PG8_BAR;
            PG8_LDA(At, 0, 1); PG8_STAGE(PG8_SA(0, 0), a2, voffA);
            PG8_BAR; PG8_WAIT_L(0); PG8_MMA(1, 0, At, B0); PG8_BAR; PG8_SCHED;
            PG8_STAGE(PG8_SB(0, 1), b2 + hstep, voffB);
            PG8_WAIT_V(6); PG8_BAR; PG8_MMA(1, 1, At, B1); PG8_BAR;
            PG8_LDB(B0, 1, 0); PG8_SCHED; PG8_LDA(At, 1, 0); PG8_STAGE(PG8_SA(0, 1), a2 + hstep, voffA);
            PG8_WAIT_L(8); PG8_BAR; PG8_WAIT_L(0); PG8_MMA(0, 0, At, B0); PG8_BAR; PG8_SCHED;
            PG8_LDB(B1, 1, 1); PG8_STAGE(PG8_SB(1, 0), b3, voffB);
            PG8_BAR; PG8_WAIT_L(0); PG8_MMA(0, 1, At, B1); PG8_BAR;
            PG8_LDA(At, 1, 1); PG8_STAGE(PG8_SA(1, 0), a3, voffA);
            PG8_BAR; PG8_WAIT_L(0); PG8_MMA(1, 0, At, B0); PG8_BAR; PG8_SCHED;
            PG8_STAGE(PG8_SB(1, 1), b3 + hstep, voffB);
            PG8_WAIT_V(6); PG8_BAR; PG8_MMA(1, 1, At, B1); PG8_BAR;
            }
        }
        if constexpr (ALIGN_EPI) { if (wr == 0) PG8_BAR; }
        if constexpr (!Epi::AFTER_DRAIN) { E(acc, cur, wr, wc, fr, fq); S.done(cur); }
        if (!has_next) break;
#pragma unroll
        for (int a = 0; a < 2; ++a)
#pragma unroll
            for (int b = 0; b < 2; ++b)
#pragma unroll
                for (int m = 0; m < 4; ++m)
#pragma unroll
                    for (int n = 0; n < 2; ++n) acc[a][b][m][n] = (f32x4){0.f, 0.f, 0.f, 0.f};
        cur = nxt; cA = nA; cB = nB; ++ui;
        if constexpr (GATHER) { _Pragma("unroll") for (int _h = 0; _h < 2; ++_h) _Pragma("unroll") for (int _i = 0; _i < 2; ++_i) gC[_h][_i] = gN[_h][_i]; }
        if constexpr (ALIGN_EPI) { if (wr == 1) PG8_BAR; }
    }
    PG8_WAIT_V(0);
    if constexpr (!ALIGN_EPI) { if (wr == 0) PG8_BAR; }
    PG8_BAR;
    if constexpr (Epi::AFTER_DRAIN) { E.fused(acc, cur, wr, wc, fr, fq, lds, wid, lane); S.done(cur); }
#undef PG8_SA
#undef PG8_SB
#undef PG8_STAGE
#undef PG8_STAGE_A
#undef PG8_GOFF
#undef PG8_LDA
#undef PG8_LDB
#undef PG8_MMA
#undef PG8_WAIT_V
#undef PG8_WAIT_L
#undef PG8_BAR
#undef PG8_SCHED
}
}

#ifndef PG8_SP2
#define PG8_SP2 true
#endif
#ifndef PG8_ALIGN
#define PG8_ALIGN true
#endif

namespace nv {
constexpr int NTOK = 16384, D = 1024, SEQ = 4096, INC = 2464;
constexpr int O_CQ = 0, O_CKV = 256, O_KR = 384, O_F = 416, O_I = 928, O_Q = 1440, O_G = 1952;
constexpr int NEXP = 32, PSLOTS = 36864, NBLK = 288;
constexpr float ALPHA = 1.189207115002721f;
constexpr float RMS_EPS = 1e-6f, LN_EPS = 1e-5f;

template <class F>
__device__ __forceinline__ void ngemm(LAS unsigned char* lds, int M, int N, int K, const F& f) {
    LAS float* As = (LAS float*)lds;
    LAS float* Bs = As + 16 * 132;
    const int tid = threadIdx.x, tx = tid & 15, ty = tid >> 4;
    const int tn = (N + 63) / 64, tm = (M + 127) / 128;
    for (int tile = blockIdx.x; tile < tn * tm; tile += gridDim.x) {
        const int m0 = (tile / tn) * 128, n0 = (tile % tn) * 64;
        float acc[4][4];
#pragma unroll
        for (int i = 0; i < 4; ++i)
#pragma unroll
            for (int j = 0; j < 4; ++j) acc[i][j] = 0.f;
        for (int k0 = 0; k0 < K; k0 += 16) {
#pragma unroll
            for (int i = 0; i < 4; ++i) { const int idx = tid + i * 512; const int r = idx >> 4, kk = idx & 15; As[kk * 132 + r] = (m0 + r < M) ? f.a(m0 + r, k0 + kk) : 0.f; }
#pragma unroll
            for (int i = 0; i < 2; ++i) { const int idx = tid + i * 512; const int kk = idx >> 6, c = idx & 63; Bs[kk * 68 + c] = (n0 + c < N) ? f.b(k0 + kk, n0 + c, m0) : 0.f; }
            __syncthreads();
#pragma unroll
            for (int kk = 0; kk < 16; ++kk) {
                float a[4], b[4];
#pragma unroll
                for (int i = 0; i < 4; ++i) { a[i] = As[kk * 132 + ty * 4 + i]; b[i] = Bs[kk * 68 + tx * 4 + i]; }
#pragma unroll
                for (int i = 0; i < 4; ++i)
#pragma unroll
                    for (int j = 0; j < 4; ++j) acc[i][j] += a[i] * b[j];
            }
            __syncthreads();
        }
#pragma unroll
        for (int i = 0; i < 4; ++i)
#pragma unroll
            for (int j = 0; j < 4; ++j) { const int r = m0 + ty * 4 + i, c = n0 + tx * 4 + j; if (r < M && c < N) f.epi(r, c, acc[i][j]); }
    }
}

struct ProjF { const float* x; const float* w; float* out;
    __device__ float a(int r, int k) const { return x[(size_t)r * D + k]; }
    __device__ float b(int k, int c, int) const { return w[(size_t)k * INC + c]; }
    __device__ void epi(int r, int c, float v) const { out[(size_t)r * INC + c] = v; } };
struct PlainF { const float* A; int lda; const float* B; int ldb; float* C; int ldc;
    __device__ float a(int r, int k) const { return A[(size_t)r * lda + k]; }
    __device__ float b(int k, int c, int) const { return B[(size_t)k * ldb + c]; }
    __device__ void epi(int r, int c, float v) const { C[(size_t)r * ldc + c] = v; } };
struct MixF { const float* an; const float* rr; const float* w; const float* x; float* t;
    __device__ float a(int r, int k) const { return k < 512 ? an[(size_t)r * 512 + k] : rr[(size_t)r * 512 + k - 512]; }
    __device__ float b(int k, int c, int) const { return w[(size_t)k * D + c]; }
    __device__ void epi(int r, int c, float v) const { t[(size_t)r * D + c] = ALPHA * x[(size_t)r * D + c] + v; } };
struct Moe1F { const float* h1; const int* slot_tok; const int* blk_exp; const float* w; float* H; int which;
    __device__ float a(int r, int k) const { const int tok = slot_tok[r]; return tok < NTOK ? h1[(size_t)tok * D + k] : 0.f; }
    __device__ float b(int k, int c, int m0) const { const int e = blk_exp[m0 >> 7]; return w[((size_t)e * D + k) * 512 + c]; }
    __device__ void epi(int r, int c, float v) const { float* p = H + (size_t)r * 512 + c; if (which == 0) *p = v / (1.f + expf(-v)); else *p *= v; } };
struct Moe2F { const float* H; const int* slot_tok; const float* slot_gate; const int* blk_exp; const float* w; float* acc;
    __device__ float a(int r, int k) const { return H[(size_t)r * 512 + k]; }
    __device__ float b(int k, int c, int m0) const { const int e = blk_exp[m0 >> 7]; return w[((size_t)e * 512 + k) * D + c]; }
    __device__ void epi(int r, int c, float v) const { const int tok = slot_tok[r]; if (tok < NTOK) atomicAdd(acc + (size_t)tok * D + c, slot_gate[r] * v); } };

__device__ __forceinline__ float wsum(float v) {
#pragma unroll
    for (int o = 1; o < 64; o <<= 1) v += __shfl_xor(v, o);
    return v;
}
__device__ __forceinline__ int tidx() { int t = threadIdx.x; asm volatile("" : "+v"(t)); return t; }
#define GTID (blockIdx.x * NTHREADS + nv::tidx())
#define GTHREADS (gridDim.x * NTHREADS)
#define GWAVE (blockIdx.x * NWAVES + (nv::tidx() >> 6))
#define GWAVES (gridDim.x * NWAVES)

__device__ __forceinline__ void hg_gate(float* proj, const float* lbl) {
    for (int i = GTID; i < NTOK * 512; i += GTHREADS) {
        const int r = i >> 9, c = i & 511;
        const float l0 = lbl[c], l1 = lbl[512 + c]; const float mx = fmaxf(l0, l1);
        const float e0 = expf(l0 - mx), e1 = expf(l1 - mx); const float lb = e0 / (e0 + e1);
        float* p = proj + (size_t)r * INC + O_F + c; const float z = *p;
        *p = lb + (1.f - lb) * (1.f / (1.f + expf(-z)));
    }
}
__device__ __forceinline__ void hg_rec(float* proj) {
    if (blockIdx.x >= 16 || threadIdx.x >= 128) return;
    const int bh = blockIdx.x, b = bh >> 2, h = bh & 3, e = threadIdx.x;
    float S[128];
#pragma unroll
    for (int d = 0; d < 128; ++d) S[d] = 0.f;
    for (int t = 0; t < SEQ; ++t) {
        float* row = proj + (size_t)(b * SEQ + t) * INC;
        const float v = row[O_I + h * 128 + e];
        const float* fr = row + O_F + h * 128; const float* qr = row + O_Q + h * 128;
        float o = 0.f;
#pragma unroll
        for (int d = 0; d < 128; ++d) { const float f = fr[d]; S[d] = f * S[d] + (1.f - f) * v; o += qr[d] * S[d]; }
        row[O_I + h * 128 + e] = o;
    }
}
__device__ __forceinline__ void hg_out(const float* proj, const float* g, float* rr) {
    const int lane = nv::tidx() & 63;
    for (int w = GWAVE; w < NTOK * 4; w += GWAVES) {
        const int r = w >> 2, h = w & 3; const float* row = proj + (size_t)r * INC;
        const float o0 = row[O_I + h * 128 + lane], o1 = row[O_I + h * 128 + 64 + lane];
        const float ss = wsum(o0 * o0 + o1 * o1); const float rs = 1.f / sqrtf(ss * (1.f / 128.f) + RMS_EPS);
        const float g0 = row[O_G + h * 128 + lane], g1 = row[O_G + h * 128 + 64 + lane];
        rr[(size_t)r * 512 + h * 128 + lane] = o0 * rs * g[lane] * (g0 / (1.f + expf(-g0)));
        rr[(size_t)r * 512 + h * 128 + 64 + lane] = o1 * rs * g[64 + lane] * (g1 / (1.f + expf(-g1)));
    }
}
__device__ __forceinline__ void cs_tab(const int* pos, float* cs) {
    for (int i = GTID; i < NTOK * 16; i += GTHREADS) {
        const int j = i & 15, r = i >> 4;
        const float invf = (float)pow(10000.0, -(double)(2 * j) / 32.0);
        const float ang = (float)pos[r] * invf;
        double s, c; sincos((double)ang, &s, &c);
        cs[(size_t)r * 32 + j] = (float)c; cs[(size_t)r * 32 + 16 + j] = (float)s;
    }
}
__device__ __forceinline__ void mla_prep(const float* proj, const float* gq, const float* gkv, const float* cs, float* cqn, float* ckvn, float* kr) {
    const int lane = nv::tidx() & 63;
    for (int r = GWAVE; r < NTOK; r += GWAVES) {
        const float* row = proj + (size_t)r * INC;
        float v[4]; float ss = 0.f;
#pragma unroll
        for (int i = 0; i < 4; ++i) { v[i] = row[O_CQ + lane + 64 * i]; ss += v[i] * v[i]; }
        ss = wsum(ss); float rs = 1.f / sqrtf(ss * (1.f / 256.f) + RMS_EPS);
#pragma unroll
        for (int i = 0; i < 4; ++i) cqn[(size_t)r * 256 + lane + 64 * i] = v[i] * rs * gq[lane + 64 * i];
        float u0 = row[O_CKV + lane], u1 = row[O_CKV + 64 + lane];
        ss = wsum(u0 * u0 + u1 * u1); rs = 1.f / sqrtf(ss * (1.f / 128.f) + RMS_EPS);
        ckvn[(size_t)r * 128 + lane] = u0 * rs * gkv[lane]; ckvn[(size_t)r * 128 + 64 + lane] = u1 * rs * gkv[64 + lane];
        if (lane < 16) { const float x1 = row[O_KR + lane], x2 = row[O_KR + 16 + lane]; const float c = cs[(size_t)r * 32 + lane], s = cs[(size_t)r * 32 + 16 + lane];
            kr[(size_t)r * 32 + lane] = x1 * c - x2 * s; kr[(size_t)r * 32 + 16 + lane] = x2 * c + x1 * s; }
    }
}
__device__ __forceinline__ void q_rope(float* q, const float* cs) {
    for (int i = GTID; i < NTOK * 8 * 16; i += GTHREADS) {
        const int j = i & 15, h = (i >> 4) & 7, r = i >> 7;
        float* p = q + (size_t)r * 768 + h * 96 + 64; const float x1 = p[j], x2 = p[16 + j]; const float c = cs[(size_t)r * 32 + j], s = cs[(size_t)r * 32 + 16 + j];
        p[j] = x1 * c - x2 * s; p[16 + j] = x2 * c + x1 * s;
    }
}
__device__ __forceinline__ void attn_naive(const float* q, const float* kv, const float* kr, float* out) {
    const int lane = nv::tidx() & 63;
    for (int task = GWAVE; task < 2048; task += GWAVES) {
        const int tsk = __builtin_amdgcn_readfirstlane(task);
        const int qc = 63 - (tsk >> 5), h = tsk & 7, b = (tsk >> 3) & 3;
        const int t = qc * 64 + lane; const size_t row = (size_t)b * SEQ + t;
        const float scale = 0.10206207261596575f;
        float qv[96];
#pragma unroll
        for (int d = 0; d < 96; ++d) qv[d] = q[row * 768 + h * 96 + d] * scale;
        float o[64];
#pragma unroll
        for (int d = 0; d < 64; ++d) o[d] = 0.f;
        float m = -INFINITY, l = 0.f;
        const int nk = (qc + 1) * 64;
        for (int s = 0; s < nk; ++s) {
            const size_t kr_ = (size_t)b * SEQ + s;
            const float* kp = kv + kr_ * 1024 + h * 128; const float* rp = kr + kr_ * 32;
            float sc = 0.f;
#pragma unroll
            for (int d = 0; d < 64; ++d) sc += qv[d] * kp[d];
#pragma unroll
            for (int d = 0; d < 32; ++d) sc += qv[64 + d] * rp[d];
            const float mn = fmaxf(m, sc); const float corr = expf(m - mn), p = expf(sc - mn);
            l = l * corr + p;
#pragma unroll
            for (int d = 0; d < 64; ++d) o[d] = o[d] * corr + p * kp[64 + d];
            m = mn;
        }
        const float il = 1.f / l;
#pragma unroll
        for (int d = 0; d < 64; ++d) out[row * 512 + h * 64 + d] = o[d] * il;
    }
}
__device__ __forceinline__ void a_norm(float* a, const float* g) {
    const int lane = nv::tidx() & 63;
    for (int r = GWAVE; r < NTOK; r += GWAVES) {
        float v[8]; float ss = 0.f;
#pragma unroll
        for (int i = 0; i < 8; ++i) { v[i] = a[(size_t)r * 512 + lane + 64 * i]; ss += v[i] * v[i]; }
        ss = wsum(ss); const float rs = 1.f / sqrtf(ss * (1.f / 512.f) + RMS_EPS);
#pragma unroll
        for (int i = 0; i < 8; ++i) a[(size_t)r * 512 + lane + 64 * i] = v[i] * rs * g[lane + 64 * i];
    }
}
__device__ __forceinline__ void ln_rows(const float* in, const float* add, float addscale_in, const float* g, const float* bb, float* out) {
    const int lane = nv::tidx() & 63;
    for (int r = GWAVE; r < NTOK; r += GWAVES) {
        float v[16]; float s = 0.f;
#pragma unroll
        for (int i = 0; i < 16; ++i) { const size_t o = (size_t)r * D + lane + 64 * i; v[i] = addscale_in * in[o] + (add ? add[o] : 0.f); s += v[i]; }
        const float mean = wsum(s) * (1.f / D); float q = 0.f;
#pragma unroll
        for (int i = 0; i < 16; ++i) { v[i] -= mean; q += v[i] * v[i]; }
        const float rs = 1.f / sqrtf(wsum(q) * (1.f / D) + LN_EPS);
#pragma unroll
        for (int i = 0; i < 16; ++i) { const int c = lane + 64 * i; out[(size_t)r * D + c] = v[i] * rs * g[c] + bb[c]; }
    }
}
__device__ __forceinline__ void router(const float* h1, const float* wg, const float* bg, const float* we, const float* be, int* cnt, int* tok_e, int* tok_rank, float* tok_gate) {
    const int lane = nv::tidx() & 63;
    for (int r = GWAVE; r < NTOK; r += GWAVES) {
        float lg[36];
#pragma unroll
        for (int c = 0; c < 36; ++c) lg[c] = 0.f;
        for (int i = 0; i < 16; ++i) { const int k = lane + 64 * i; const float xv = h1[(size_t)r * D + k];
#pragma unroll
            for (int c = 0; c < 4; ++c) lg[c] += xv * wg[k * 4 + c];
#pragma unroll
            for (int c = 0; c < 32; ++c) lg[4 + c] += xv * we[k * 32 + c]; }
#pragma unroll
        for (int c = 0; c < 36; ++c) lg[c] = wsum(lg[c]);
#pragma unroll
        for (int c = 0; c < 4; ++c) lg[c] += bg[c];
#pragma unroll
        for (int c = 0; c < 32; ++c) lg[4 + c] += be[c];
        int grp = 0; float gm = lg[0];
#pragma unroll
        for (int c = 1; c < 4; ++c) if (lg[c] > gm) { gm = lg[c]; grp = c; }
        float den = 0.f;
#pragma unroll
        for (int c = 0; c < 4; ++c) den += expf(lg[c] - gm);
        const float pgrp = 1.f / den;
        float ein[8];
#pragma unroll
        for (int j = 0; j < 8; ++j) ein[j] = grp == 0 ? lg[4 + j] : grp == 1 ? lg[12 + j] : grp == 2 ? lg[20 + j] : lg[28 + j];
        int i0 = 0; float v0 = ein[0];
#pragma unroll
        for (int j = 1; j < 8; ++j) if (ein[j] > v0) { v0 = ein[j]; i0 = j; }
        int i1 = -1; float v1 = -INFINITY;
#pragma unroll
        for (int j = 0; j < 8; ++j) if (j != i0 && ein[j] > v1) { v1 = ein[j]; i1 = j; }
        const float e1 = expf(v1 - v0); const float p0 = 1.f / (1.f + e1), p1 = e1 / (1.f + e1);
        if (lane == 0) {
            const int ea = grp * 8 + i0, eb = grp * 8 + i1;
            tok_e[2 * r] = ea; tok_e[2 * r + 1] = eb;
            tok_rank[2 * r] = atomicAdd(cnt + ea, 1); tok_rank[2 * r + 1] = atomicAdd(cnt + eb, 1);
            tok_gate[2 * r] = pgrp * p0; tok_gate[2 * r + 1] = pgrp * p1;
        }
    }
}
__device__ __forceinline__ void prefix(const int* cnt, int* pad_start, int* blk_exp) {
    if (threadIdx.x != 0 || blockIdx.x != 0) return;
    int acc = 0;
    for (int e = 0; e < NEXP; ++e) { pad_start[e] = acc; acc += ((__hip_atomic_load(cnt + e, __ATOMIC_RELAXED, __HIP_MEMORY_SCOPE_AGENT) + 127) / 128) * 128; pad_start[NEXP + e] = acc; }
    for (int b = 0; b < NBLK; ++b) { int c = 0; for (int e = 0; e < NEXP; ++e) c += (pad_start[NEXP + e] <= b * 128) ? 1 : 0; blk_exp[b] = c < NEXP - 1 ? c : NEXP - 1; }
}
__device__ __forceinline__ void slot_init(int* slot_tok, float* slot_gate) { for (int i = GTID; i < PSLOTS; i += GTHREADS) { slot_tok[i] = NTOK; slot_gate[i] = 0.f; } }
__device__ __forceinline__ void slot_fill(const int* tok_e, const int* tok_rank, const float* tok_gate, const int* pad_start, int* slot_tok, float* slot_gate) {
    for (int i = GTID; i < NTOK * 2; i += GTHREADS) { const int s = pad_start[tok_e[i]] + tok_rank[i]; slot_tok[s] = i >> 1; slot_gate[s] = tok_gate[i]; }
}
__device__ __forceinline__ void zero_f32(float* p, size_t n) { for (size_t i = GTID; i < n / 4; i += GTHREADS) ((float4*)p)[i] = make_float4(0.f, 0.f, 0.f, 0.f); }
}


namespace op {
using pg8::f32x4; using pg8::Unit; using pg8::bf16_t;
typedef unsigned v4u __attribute__((ext_vector_type(4)));
#define GAS __attribute__((address_space(1)))
__device__ __forceinline__ unsigned f2bf(float f) { unsigned u = __builtin_bit_cast(unsigned, f); return (u + 0x7fffu + ((u >> 16) & 1u)) >> 16; }
__device__ __forceinline__ unsigned pk2(float lo, float hi) { return f2bf(lo) | (f2bf(hi) << 16); }
__device__ __forceinline__ float bf2f(unsigned short b) { return __builtin_bit_cast(float, (unsigned)b << 16); }

template <class RowMap>
__device__ __forceinline__ void transpose_item(const float* W, int K, int N, bf16_t* WT, LAS float* scr, int item, int lane, const RowMap& rm) {
    const int nblk = N / 32, kb = item / nblk, nb = item % nblk, k0 = 64 * kb, n0 = 32 * nb;
#pragma unroll 8
    for (int i = 0; i < 32; ++i) { const int kk = 2 * i + (lane >> 5); scr[kk * 33 + (lane & 31)] = rm.scale(n0 + (lane & 31), k0 + kk) * W[(size_t)(k0 + kk) * N + n0 + (lane & 31)]; }
    asm volatile("s_waitcnt lgkmcnt(0)" ::: "memory");
    const int c = lane & 7;
#pragma unroll
    for (int j = 0; j < 4; ++j) { const int n = (lane >> 3) + 8 * j; const LAS float* s = scr + (8 * c) * 33 + n;
        v4u o; o.x = pk2(s[0 * 33], s[1 * 33]); o.y = pk2(s[2 * 33], s[3 * 33]); o.z = pk2(s[4 * 33], s[5 * 33]); o.w = pk2(s[6 * 33], s[7 * 33]);
        *(GAS v4u*)(WT + (size_t)rm.row(n0 + n) * K + k0 + 8 * c) = o; }
    asm volatile("s_waitcnt lgkmcnt(0)" ::: "memory");
}
struct RowId { __device__ __forceinline__ int row(int n) const { return n; } __device__ __forceinline__ float scale(int, int) const { return 1.f; } };

__device__ __forceinline__ void cvt_rows_bf16(const float* src, bf16_t* dst, size_t n) {
    for (size_t i = GTID; i < n / 8; i += GTHREADS) { const float4 a = ((const float4*)src)[2 * i], b = ((const float4*)src)[2 * i + 1];
        v4u o; o.x = pk2(a.x, a.y); o.y = pk2(a.z, a.w); o.z = pk2(b.x, b.y); o.w = pk2(b.z, b.w); ((v4u*)dst)[i] = o; }
}

struct EpiF32Nat { static constexpr bool PERM = false, AFTER_DRAIN = false;
    float* C; int ldc; int ncols;
    __device__ __forceinline__ void operator()(const f32x4 (&acc)[2][2][4][2], const Unit& u, int wr, int wc, int fr, int fq) const {
        const int row0 = u.pm * 256 + wr * 64 + fr, col0 = u.pn * 256 + wc * 32 + 4 * fq;
#pragma unroll
        for (int ai = 0; ai < 2; ++ai)
#pragma unroll
            for (int m = 0; m < 4; ++m) { float* rowp = C + (size_t)(row0 + ai * 128 + m * 16) * ldc;
#pragma unroll
                for (int bj = 0; bj < 2; ++bj)
#pragma unroll
                    for (int n = 0; n < 2; ++n) { const int c = col0 + bj * 128 + n * 16; if (c < ncols) *(f32x4*)(rowp + c) = acc[ai][bj][m][n]; } }
    }
};
}

namespace op {
struct RowProj {
    __device__ __forceinline__ int row(int n) const {
        if (n < 384) return n;
        if (n < 416) { const int j = n - 384, jj = j & 15, a = jj >> 2, b = jj & 3; return 384 + 8 * a + b + (j >= 16 ? 4 : 0); }
        return n + 96;
    }
    __device__ __forceinline__ float scale(int, int) const { return 1.f; }
};
__device__ __forceinline__ v4u pack8(const f32x4& v0, const f32x4& v1) { v4u w; w.x = pk2(v0[0], v0[1]); w.y = pk2(v0[2], v0[3]); w.z = pk2(v1[0], v1[1]); w.w = pk2(v1[2], v1[3]); return w; }
__device__ __forceinline__ float dot4(const f32x4& v) { return (v[0] * v[0] + v[1] * v[1]) + (v[2] * v[2] + v[3] * v[3]); }

struct EpiProj { static constexpr bool PERM = true, AFTER_DRAIN = false;
    bf16_t *cq, *ckv, *kr, *kk, *vi; float* lf; float *ssq_q, *ssq_kv; const float* cs; const float* lbt;
    __device__ __forceinline__ void operator()(const f32x4 (&acc)[2][2][4][2], const Unit& u, int wr, int wc, int fr, int fq) const {
        const int pn = u.pn; const int row0 = u.pm * 256 + wr * 64 + fr; const int cl = wc * 32 + 8 * fq;
        if (pn == 0) {
#pragma unroll
            for (int ai = 0; ai < 2; ++ai)
#pragma unroll
                for (int m = 0; m < 4; ++m) { const int row = row0 + ai * 128 + m * 16; float s = 0.f;
#pragma unroll
                    for (int bj = 0; bj < 2; ++bj) { const f32x4 v0 = acc[ai][bj][m][0], v1 = acc[ai][bj][m][1]; s += dot4(v0) + dot4(v1);
                        *(v4u*)(cq + (size_t)row * 256 + bj * 128 + cl) = pack8(v0, v1); }
                    s += __shfl_xor(s, 16); s += __shfl_xor(s, 32); if (fq == 0) atomicAdd(ssq_q + row, s); }
        } else if (pn == 1) {
#pragma unroll
            for (int ai = 0; ai < 2; ++ai)
#pragma unroll
                for (int m = 0; m < 4; ++m) { const int row = row0 + ai * 128 + m * 16;
                    const f32x4 v0 = acc[ai][0][m][0], v1 = acc[ai][0][m][1]; float s = dot4(v0) + dot4(v1);
                    *(v4u*)(ckv + (size_t)row * 128 + cl) = pack8(v0, v1);
                    s += __shfl_xor(s, 16); s += __shfl_xor(s, 32); if (fq == 0) atomicAdd(ssq_kv + row, s);
                    if (wc == 0) { const f32x4 x1 = acc[ai][1][m][0], x2 = acc[ai][1][m][1];
                        const f32x4 c = *(const f32x4*)(cs + (size_t)row * 32 + 4 * fq), sn = *(const f32x4*)(cs + (size_t)row * 32 + 16 + 4 * fq);
                        *(v4u*)(kr + (size_t)row * 32 + 8 * fq) = pack8(x1 * c - x2 * sn, x2 * c + x1 * sn); } }
        } else if (pn < 4) {
            const int cb = (pn - 2) * 256;
#pragma unroll
            for (int bj = 0; bj < 2; ++bj) { const int col = cb + bj * 128 + cl;
#pragma unroll
                for (int n = 0; n < 2; ++n) { const f32x4 lb = *(const f32x4*)(lbt + col + 4 * n);
#pragma unroll
                    for (int ai = 0; ai < 2; ++ai)
#pragma unroll
                        for (int m = 0; m < 4; ++m) { const int row = row0 + ai * 128 + m * 16; f32x4 l, k;
#pragma unroll
                            for (int i = 0; i < 4; ++i) { const float e = __expf(-acc[ai][bj][m][n][i]), sg = __builtin_amdgcn_rcpf(1.f + e); const float om = 1.f - lb[i]; l[i] = __logf(lb[i] + om * sg); k[i] = om * e * sg; }
                            *(f32x4*)(lf + (size_t)row * 512 + col + 4 * n) = l;
                            typedef unsigned v2u __attribute__((ext_vector_type(2))); v2u w; w.x = pk2(k[0], k[1]); w.y = pk2(k[2], k[3]);
                            *(v2u*)(kk + (size_t)row * 512 + col + 4 * n) = w;
                            asm volatile("" ::: "memory"); } } }
        } else {
            bf16_t* dst = vi + (size_t)((pn - 4) >> 1) * ((size_t)16384 * 512); const int cb = (pn & 1) * 256;
#pragma unroll
            for (int ai = 0; ai < 2; ++ai)
#pragma unroll
                for (int m = 0; m < 4; ++m) { const int row = row0 + ai * 128 + m * 16;
#pragma unroll
                    for (int bj = 0; bj < 2; ++bj) *(v4u*)(dst + (size_t)row * 512 + cb + bj * 128 + cl) = pack8(acc[ai][bj][m][0], acc[ai][bj][m][1]); }
        }
    }
};
}

namespace nv {
using op::bf2f; typedef unsigned short bf16_t;
__device__ __forceinline__ void lb_tab(const float* lbl, float* lbt) {
    for (int c = GTID; c < 512; c += GTHREADS) { const float l0 = lbl[c], l1 = lbl[512 + c]; const float mx = fmaxf(l0, l1); const float e0 = expf(l0 - mx), e1 = expf(l1 - mx); lbt[c] = e0 / (e0 + e1); }
}
__device__ __forceinline__ void hg_f(const float* lf, float* fb) { for (size_t i = GTID; i < (size_t)NTOK * 512; i += GTHREADS) fb[i] = expf(lf[i]); }
__device__ __forceinline__ void hg_rec2(const float* fb, const bf16_t* kk, const bf16_t* vi, const bf16_t* qh, float* ob) {
    if (blockIdx.x >= 16 || threadIdx.x >= 128) return;
    const int bh = blockIdx.x, b = bh >> 2, h = bh & 3, e = threadIdx.x;
    float S[128];
#pragma unroll
    for (int d = 0; d < 128; ++d) S[d] = 0.f;
    for (int t = 0; t < SEQ; ++t) {
        const size_t base = (size_t)(b * SEQ + t) * 512 + h * 128;
        const float v = bf2f(vi[base + e]);
        float o = 0.f;
#pragma unroll
        for (int d = 0; d < 128; ++d) { const float f = fb[base + d]; S[d] = f * S[d] + bf2f(kk[base + d]) * v; o += bf2f(qh[base + d]) * S[d]; }
        ob[base + e] = o;
    }
}
__device__ __forceinline__ void hg_out2(const float* ob, const bf16_t* gh, const float* g, float* rr) {
    const int lane = nv::tidx() & 63;
    for (int w = GWAVE; w < NTOK * 4; w += GWAVES) {
        const size_t base = (size_t)(w >> 2) * 512 + (w & 3) * 128;
        const float o0 = ob[base + lane], o1 = ob[base + 64 + lane];
        const float ss = wsum(o0 * o0 + o1 * o1); const float rs = 1.f / sqrtf(ss * (1.f / 128.f) + RMS_EPS);
        const float g0 = bf2f(gh[base + lane]), g1 = bf2f(gh[base + 64 + lane]);
        rr[base + lane] = o0 * rs * g[lane] * (g0 / (1.f + expf(-g0)));
        rr[base + 64 + lane] = o1 * rs * g[64 + lane] * (g1 / (1.f + expf(-g1)));
    }
}
__device__ __forceinline__ void mla_prep2(const bf16_t* cq, const bf16_t* ckv, const float* ssq_q, const float* ssq_kv, const float* gq, const float* gkv, float* cqn, float* ckvn) {
    for (size_t i = GTID; i < (size_t)NTOK * 256; i += GTHREADS) { const int r = (int)(i >> 8), c = (int)(i & 255);
        cqn[i] = bf2f(cq[i]) * (1.f / sqrtf(__hip_atomic_load(ssq_q + r, __ATOMIC_RELAXED, __HIP_MEMORY_SCOPE_AGENT) * (1.f / 256.f) + RMS_EPS)) * gq[c]; }
    for (size_t i = GTID; i < (size_t)NTOK * 128; i += GTHREADS) { const int r = (int)(i >> 7), c = (int)(i & 127);
        ckvn[i] = bf2f(ckv[i]) * (1.f / sqrtf(__hip_atomic_load(ssq_kv + r, __ATOMIC_RELAXED, __HIP_MEMORY_SCOPE_AGENT) * (1.f / 128.f) + RMS_EPS)) * gkv[c]; }
}
__host__ __device__ constexpr int rope_nat(int p) { return ((p & 7) < 4) ? 4 * (p >> 3) + (p & 7) : 16 + 4 * (p >> 3) + (p & 7) - 4; }
__device__ __forceinline__ void attn_naive2(const float* q, const float* kv, const bf16_t* kr, float* out) {
    const int lane = nv::tidx() & 63;
    for (int task = GWAVE; task < 2048; task += GWAVES) {
        const int tsk = __builtin_amdgcn_readfirstlane(task);
        const int qc = 63 - (tsk >> 5), h = tsk & 7, b = (tsk >> 3) & 3;
        const int t = qc * 64 + lane; const size_t row = (size_t)b * SEQ + t;
        const float scale = 0.10206207261596575f;
        float qv[96];
#pragma unroll
        for (int d = 0; d < 96; ++d) qv[d] = q[row * 768 + h * 96 + d] * scale;
        float o[64];
#pragma unroll
        for (int d = 0; d < 64; ++d) o[d] = 0.f;
        float m = -INFINITY, l = 0.f;
        const int nk = (qc + 1) * 64;
        for (int s = 0; s < nk; ++s) {
            const size_t kr_ = (size_t)b * SEQ + s;
            const float* kp = kv + kr_ * 1024 + h * 128; const bf16_t* rp = kr + kr_ * 32;
            float sc = 0.f;
#pragma unroll
            for (int d = 0; d < 64; ++d) sc += qv[d] * kp[d];
#pragma unroll
            for (int p = 0; p < 32; ++p) sc += qv[64 + rope_nat(p)] * bf2f(rp[p]);
            const float mn = fmaxf(m, sc); const float corr = expf(m - mn), pe = expf(sc - mn);
            l = l * corr + pe;
#pragma unroll
            for (int d = 0; d < 64; ++d) o[d] = o[d] * corr + pe * kp[64 + d];
            m = mn;
        }
        const float il = 1.f / l;
#pragma unroll
        for (int d = 0; d < 64; ++d) out[row * 512 + h * 64 + d] = o[d] * il;
    }
}
}

namespace op {
constexpr int MOE_CAP = 16384, MOE_MAXT = 160;
__device__ __forceinline__ void moe_build_tab(LAS int* tab, const int* cnt, int* tstart_g) {
    if (threadIdx.x < 64) {
        const int e = threadIdx.x & 31; const int c = __hip_atomic_load(cnt + e, __ATOMIC_RELAXED, __HIP_MEMORY_SCOPE_AGENT); const int t = (c + 255) >> 8;
        int incl = t;
#pragma unroll
        for (int o = 1; o < 32; o <<= 1) { const int v = __shfl_up(incl, o, 32); if (e >= o) incl += v; }
        const int start = incl - t;
        if (threadIdx.x < 32) { tab[1 + e] = c; tab[33 + e] = start; if (e == 31) tab[0] = incl; for (int j = 0; j < t; ++j) tab[65 + start + j] = e;
            if (blockIdx.x == 0 && tstart_g) tstart_g[e] = start; }
    }
    __syncthreads();
}
struct MoeOrder {
    const LAS int* tab; int G, c; const int* stok;
    __device__ __forceinline__ bool next(int i, Unit& u) const { const int L = i * G + c; const int T = tab[0]; if (L >= 4 * T) return false; const int mt = L >> 2; u.pm = mt; u.pn = tab[65 + mt] * 4 + (L & 3); return true; }
    __device__ __forceinline__ void a_ready(const Unit&) const {}
    __device__ __forceinline__ void done(const Unit&) const {}
    __device__ __forceinline__ int arow(const Unit& u, int r) const { const int e = u.pn >> 2; const int idx = (u.pm - tab[33 + e]) * 256 + r; return idx < tab[1 + e] ? stok[e * MOE_CAP + idx] : 16384; }
};
struct RowW13 { int which; __device__ __forceinline__ int row(int n) const { return 8 * (n >> 2) + (n & 3) + 4 * which; } __device__ __forceinline__ float scale(int, int) const { return 1.f; } };
struct RowScaleK { const float* g; int klim; __device__ __forceinline__ int row(int n) const { return n; } __device__ __forceinline__ float scale(int, int k) const { return k < klim ? g[k] : 1.f; } };

typedef unsigned v2u __attribute__((ext_vector_type(2)));
struct EpiMoe1 { static constexpr bool PERM = true, AFTER_DRAIN = false;
    bf16_t* H;
    __device__ __forceinline__ void operator()(const f32x4 (&acc)[2][2][4][2], const Unit& u, int wr, int wc, int fr, int fq) const {
        const int row0 = u.pm * 256 + wr * 64 + fr, col0 = 128 * (u.pn & 3) + 16 * wc + 4 * fq;
#pragma unroll
        for (int ai = 0; ai < 2; ++ai)
#pragma unroll
            for (int m = 0; m < 4; ++m) { bf16_t* rowp = H + (size_t)(row0 + ai * 128 + m * 16) * 512 + col0;
#pragma unroll
                for (int bj = 0; bj < 2; ++bj) { const f32x4 a = acc[ai][bj][m][0], b = acc[ai][bj][m][1]; float h[4];
#pragma unroll
                    for (int i = 0; i < 4; ++i) h[i] = a[i] * __builtin_amdgcn_rcpf(1.f + __expf(-a[i])) * b[i];
                    v2u w; w.x = pk2(h[0], h[1]); w.y = pk2(h[2], h[3]); *(v2u*)(rowp + 64 * bj) = w; } }
    }
};
struct EpiBf16P { static constexpr bool PERM = true, AFTER_DRAIN = false;
    bf16_t* O; int ldc; int pmask;
    __device__ __forceinline__ void operator()(const f32x4 (&acc)[2][2][4][2], const Unit& u, int wr, int wc, int fr, int fq) const {
        const int row0 = u.pm * 256 + wr * 64 + fr, col0 = 256 * (u.pn & pmask) + 32 * wc + 8 * fq;
#pragma unroll
        for (int ai = 0; ai < 2; ++ai)
#pragma unroll
            for (int m = 0; m < 4; ++m) { bf16_t* rowp = O + (size_t)(row0 + ai * 128 + m * 16) * ldc + col0;
#pragma unroll
                for (int bj = 0; bj < 2; ++bj) *(v4u*)(rowp + 128 * bj) = pack8(acc[ai][bj][m][0], acc[ai][bj][m][1]); }
    }
};
struct EpiMix { static constexpr bool PERM = false, AFTER_DRAIN = false;
    const float* x; float* t; float alpha;
    __device__ __forceinline__ void operator()(const f32x4 (&acc)[2][2][4][2], const Unit& u, int wr, int wc, int fr, int fq) const {
        const int row0 = u.pm * 256 + wr * 64 + fr, col0 = u.pn * 256 + wc * 32 + 4 * fq;
#pragma unroll
        for (int ai = 0; ai < 2; ++ai)
#pragma unroll
            for (int m = 0; m < 4; ++m) { const size_t ro = (size_t)(row0 + ai * 128 + m * 16) * 1024 + col0;
#pragma unroll
                for (int bj = 0; bj < 2; ++bj)
#pragma unroll
                    for (int n = 0; n < 2; ++n) { const size_t o = ro + bj * 128 + n * 16; *(f32x4*)(t + o) = alpha * *(const f32x4*)(x + o) + acc[ai][bj][m][n]; } }
    }
};
}

namespace nv {
__device__ __forceinline__ void a_norm2(const float* a, const float* g, bf16_t* AR) {
    const int lane = nv::tidx() & 63;
    for (int r = GWAVE; r < NTOK; r += GWAVES) {
        float v[8]; float ss = 0.f;
#pragma unroll
        for (int i = 0; i < 8; ++i) { v[i] = a[(size_t)r * 512 + lane + 64 * i]; ss += v[i] * v[i]; }
        ss = wsum(ss); const float rs = 1.f / sqrtf(ss * (1.f / 512.f) + RMS_EPS);
#pragma unroll
        for (int i = 0; i < 8; ++i) AR[(size_t)r * 1024 + lane + 64 * i] = (bf16_t)op::f2bf(v[i] * rs * g[lane + 64 * i]);
    }
}
__device__ __forceinline__ void hg_out3(const float* ob, const bf16_t* gh, const float* g, bf16_t* AR) {
    const int lane = nv::tidx() & 63;
    for (int w = GWAVE; w < NTOK * 4; w += GWAVES) {
        const size_t base = (size_t)(w >> 2) * 512 + (w & 3) * 128; const size_t ob_ = (size_t)(w >> 2) * 1024 + 512 + (w & 3) * 128;
        const float o0 = ob[base + lane], o1 = ob[base + 64 + lane];
        const float ss = wsum(o0 * o0 + o1 * o1); const float rs = 1.f / sqrtf(ss * (1.f / 128.f) + RMS_EPS);
        const float g0 = bf2f(gh[base + lane]), g1 = bf2f(gh[base + 64 + lane]);
        AR[ob_ + lane] = (bf16_t)op::f2bf(o0 * rs * g[lane] * (g0 / (1.f + expf(-g0))));
        AR[ob_ + 64 + lane] = (bf16_t)op::f2bf(o1 * rs * g[64 + lane] * (g1 / (1.f + expf(-g1))));
    }
}
__device__ __forceinline__ void ln_rows2(float* h, const float* g, const float* bb, bf16_t* hb) {
    const int lane = nv::tidx() & 63;
    for (int r = GWAVE; r < NTOK; r += GWAVES) {
        float v[16]; float s = 0.f;
#pragma unroll
        for (int i = 0; i < 16; ++i) { v[i] = h[(size_t)r * D + lane + 64 * i]; s += v[i]; }
        const float mean = wsum(s) * (1.f / D); float q = 0.f;
#pragma unroll
        for (int i = 0; i < 16; ++i) { v[i] -= mean; q += v[i] * v[i]; }
        const float rs = 1.f / sqrtf(wsum(q) * (1.f / D) + LN_EPS);
#pragma unroll
        for (int i = 0; i < 16; ++i) { const int c = lane + 64 * i; const float o = v[i] * rs * g[c] + bb[c]; h[(size_t)r * D + c] = o; hb[(size_t)r * D + c] = (bf16_t)op::f2bf(o); }
    }
    if (blockIdx.x == 0) for (int c = threadIdx.x; c < D; c += NTHREADS) hb[(size_t)NTOK * D + c] = 0;
}
__device__ __forceinline__ void router2(const float* h1, const float* wg, const float* bg, const float* we, const float* be, int* cnt, int* tok_e, int* tok_rank, float* tok_gate, int* stok) {
    const int lane = nv::tidx() & 63;
    for (int r = GWAVE; r < NTOK; r += GWAVES) {
        float lg[36];
#pragma unroll
        for (int c = 0; c < 36; ++c) lg[c] = 0.f;
        for (int i = 0; i < 16; ++i) { const int k = lane + 64 * i; const float xv = h1[(size_t)r * D + k];
#pragma unroll
            for (int c = 0; c < 4; ++c) lg[c] += xv * wg[k * 4 + c];
#pragma unroll
            for (int c = 0; c < 32; ++c) lg[4 + c] += xv * we[k * 32 + c]; }
#pragma unroll
        for (int c = 0; c < 36; ++c) lg[c] = wsum(lg[c]);
#pragma unroll
        for (int c = 0; c < 4; ++c) lg[c] += bg[c];
#pragma unroll
        for (int c = 0; c < 32; ++c) lg[4 + c] += be[c];
        int grp = 0; float gm = lg[0];
#pragma unroll
        for (int c = 1; c < 4; ++c) if (lg[c] > gm) { gm = lg[c]; grp = c; }
        float den = 0.f;
#pragma unroll
        for (int c = 0; c < 4; ++c) den += expf(lg[c] - gm);
        const float pgrp = 1.f / den;
        float ein[8];
#pragma unroll
        for (int j = 0; j < 8; ++j) ein[j] = grp == 0 ? lg[4 + j] : grp == 1 ? lg[12 + j] : grp == 2 ? lg[20 + j] : lg[28 + j];
        int i0 = 0; float v0 = ein[0];
#pragma unroll
        for (int j = 1; j < 8; ++j) if (ein[j] > v0) { v0 = ein[j]; i0 = j; }
        int i1 = -1; float v1 = -INFINITY;
#pragma unroll
        for (int j = 0; j < 8; ++j) if (j != i0 && ein[j] > v1) { v1 = ein[j]; i1 = j; }
        const float e1 = expf(v1 - v0); const float p0 = 1.f / (1.f + e1), p1 = e1 / (1.f + e1);
        if (lane == 0) {
            const int ea = grp * 8 + i0, eb = grp * 8 + i1;
            const int ra = atomicAdd(cnt + ea, 1), rb = atomicAdd(cnt + eb, 1);
            tok_e[2 * r] = ea; tok_e[2 * r + 1] = eb; tok_rank[2 * r] = ra; tok_rank[2 * r + 1] = rb;
            tok_gate[2 * r] = pgrp * p0; tok_gate[2 * r + 1] = pgrp * p1;
            stok[ea * op::MOE_CAP + ra] = r; stok[eb * op::MOE_CAP + rb] = r;
        }
    }
}
__device__ __forceinline__ void ln2_rows(const float* h1, const bf16_t* Y, const int* tok_e, const int* tok_rank, const float* tok_gate, const int* tstart, const float* g, const float* bb, float* out) {
    const int lane = nv::tidx() & 63;
    for (int r = GWAVE; r < NTOK; r += GWAVES) {
        const size_t r0 = (size_t)tstart[tok_e[2 * r]] * 256 + tok_rank[2 * r], r1 = (size_t)tstart[tok_e[2 * r + 1]] * 256 + tok_rank[2 * r + 1];
        const float g0 = tok_gate[2 * r], g1 = tok_gate[2 * r + 1];
        float v[16]; float s = 0.f;
#pragma unroll
        for (int i = 0; i < 16; ++i) { const int c = lane + 64 * i; v[i] = ALPHA * h1[(size_t)r * D + c] + g0 * bf2f(Y[r0 * D + c]) + g1 * bf2f(Y[r1 * D + c]); s += v[i]; }
        const float mean = wsum(s) * (1.f / D); float q = 0.f;
#pragma unroll
        for (int i = 0; i < 16; ++i) { v[i] -= mean; q += v[i] * v[i]; }
        const float rs = 1.f / sqrtf(wsum(q) * (1.f / D) + LN_EPS);
#pragma unroll
        for (int i = 0; i < 16; ++i) { const int c = lane + 64 * i; out[(size_t)r * D + c] = v[i] * rs * g[c] + bb[c]; }
    }
}
}

namespace hg {
using op::bf16_t; using op::bf2f; using op::f2bf; using op::pk2; using op::v4u; using op::v2u;
typedef short bf16x8 __attribute__((ext_vector_type(8)));
typedef float f32x4 __attribute__((ext_vector_type(4)));
constexpr int SEQ = 4096, NU = 1024;
constexpr int LDV = 72 * 2, LDK = 72 * 2, LDQ = 136 * 2, LDS_ = 136 * 2, LDA = 72 * 2;
__device__ __forceinline__ bf16x8 ldfrag(const LAS unsigned char* base, int row, int stride, int kbyte) { return *(const LAS bf16x8*)(base + row * stride + kbyte); }

__device__ __forceinline__ void stage_vT(LAS unsigned char* vT, const bf16_t* vsrc, int tid) {
#pragma unroll
    for (int j = 0; j < 2; ++j) { const int p = tid + 512 * j, s = p >> 4, e0 = (p & 15) * 8;
        const v4u w = *(const v4u*)(vsrc + (size_t)s * 512 + e0);
        const unsigned ww[4] = {w.x, w.y, w.z, w.w};
#pragma unroll
        for (int i = 0; i < 4; ++i) { *(LAS unsigned short*)(vT + (e0 + 2 * i) * LDV + s * 2) = (unsigned short)(ww[i] & 0xffffu); *(LAS unsigned short*)(vT + (e0 + 2 * i + 1) * LDV + s * 2) = (unsigned short)(ww[i] >> 16); } }
}
__device__ __forceinline__ void pass1(LAS unsigned char* lds, const float* lf, const bf16_t* kk, const bf16_t* vi, bf16_t* U, float* dl) {
    int tid_ = threadIdx.x; asm volatile("" : "+v"(tid_)); const int tid = tid_, lane = tid & 63, w = __builtin_amdgcn_readfirstlane(tid >> 6);
    LAS unsigned char* vT = lds; LAS unsigned char* kdT = lds + 128 * LDV; LAS float* segtot = (LAS float*)(lds + 128 * LDV + 128 * LDK);
    const int d = tid & 127, seg = tid >> 7, t0 = seg * 16;
    for (int u = blockIdx.x; u < NU; u += gridDim.x) {
        const int c = u & 63, bh = u >> 6, b = bh >> 2, h = bh & 3; const size_t row0 = (size_t)b * SEQ + c * 64;
        float cs[16]; float kv[16]; float run = 0.f;
#pragma unroll
        for (int i = 0; i < 16; ++i) { const size_t o = (row0 + t0 + i) * 512 + h * 128 + d; cs[i] = lf[o]; kv[i] = bf2f(kk[o]); }
        stage_vT(vT, vi + row0 * 512 + h * 128, tid);
#pragma unroll
        for (int i = 0; i < 16; ++i) { run += cs[i]; cs[i] = run; }
        segtot[seg * 128 + d] = run;
        __syncthreads();
        float off = 0.f, tot = 0.f;
#pragma unroll
        for (int s = 0; s < 4; ++s) { const float v = segtot[s * 128 + d]; tot += v; if (s < seg) off += v; }
        unsigned pk[8];
#pragma unroll
        for (int i = 0; i < 8; ++i) pk[i] = pk2(kv[2 * i] * __expf(tot - off - cs[2 * i]), kv[2 * i + 1] * __expf(tot - off - cs[2 * i + 1]));
        *(LAS v4u*)(kdT + d * LDK + t0 * 2) = (v4u){pk[0], pk[1], pk[2], pk[3]}; *(LAS v4u*)(kdT + d * LDK + t0 * 2 + 16) = (v4u){pk[4], pk[5], pk[6], pk[7]};
        if (seg == 0) dl[(size_t)u * 128 + d] = __expf(tot);
        __syncthreads();
        f32x4 acc[8];
#pragma unroll
        for (int j = 0; j < 8; ++j) acc[j] = (f32x4){0.f, 0.f, 0.f, 0.f};
#pragma unroll
        for (int ks = 0; ks < 2; ++ks) { const bf16x8 a = ldfrag(kdT, w * 16 + (lane & 15), LDK, ks * 64 + (lane >> 4) * 16);
#pragma unroll
            for (int j = 0; j < 8; ++j) { const bf16x8 bb = ldfrag(vT, j * 16 + (lane & 15), LDV, ks * 64 + (lane >> 4) * 16); acc[j] = __builtin_amdgcn_mfma_f32_16x16x32_bf16(a, bb, acc[j], 0, 0, 0); } }
        bf16_t* Uu = U + (size_t)u * 16384;
#pragma unroll
        for (int j = 0; j < 8; ++j) { v2u o; o.x = pk2(acc[j][0], acc[j][1]); o.y = pk2(acc[j][2], acc[j][3]); *(v2u*)(Uu + (j * 16 + (lane & 15)) * 128 + w * 16 + 4 * (lane >> 4)) = o; }
        __syncthreads();
    }
}
__device__ __forceinline__ void scan(const bf16_t* U, const float* dl, bf16_t* ST) {
    for (int gid = blockIdx.x * NTHREADS + threadIdx.x; gid < 16 * 128 * 64; gid += gridDim.x * NTHREADS) {
        const int dp = gid & 63, e = (gid >> 6) & 127, bh = gid >> 13;
        float s0 = 0.f, s1 = 0.f;
        for (int c0 = 0; c0 < 64; c0 += 16) {
            unsigned uv[16]; float2 dv[16];
#pragma unroll
            for (int i = 0; i < 16; ++i) { const size_t un = (size_t)bh * 64 + c0 + i; uv[i] = *(const unsigned*)(U + un * 16384 + e * 128 + 2 * dp); dv[i] = *(const float2*)(dl + un * 128 + 2 * dp); }
#pragma unroll
            for (int i = 0; i < 16; ++i) { const size_t un = (size_t)bh * 64 + c0 + i; *(unsigned*)(ST + un * 16384 + e * 128 + 2 * dp) = pk2(s0, s1);
                s0 = dv[i].x * s0 + __builtin_bit_cast(float, uv[i] << 16); s1 = dv[i].y * s1 + __builtin_bit_cast(float, uv[i] & 0xffff0000u); }
        }
    }
}
__device__ __forceinline__ void pass3(LAS unsigned char* lds, const float* lf, const bf16_t* kk, const bf16_t* vi, const bf16_t* qh, const bf16_t* gh, const bf16_t* ST, const float* gnorm, bf16_t* AR) {
    int tid_ = threadIdx.x; asm volatile("" : "+v"(tid_)); const int tid = tid_, lane = tid & 63, w = __builtin_amdgcn_readfirstlane(tid >> 6);
    LAS unsigned char* qeL = lds; LAS unsigned char* keL = qeL + 64 * LDQ; LAS unsigned char* qsL = keL + 64 * LDQ; LAS unsigned char* vT = qsL + 64 * LDQ;
    LAS unsigned char* STl = vT + 128 * LDV; LAS unsigned char* aL = STl + 128 * LDS_; LAS float* segtot = (LAS float*)(aL + 64 * LDA); LAS float* ssqL = segtot + 512;
    const int d = tid & 127, seg = tid >> 7, t0 = seg * 16;
    const int tt = w & 3, eg = w >> 2;
    for (int u = blockIdx.x; u < NU; u += gridDim.x) {
        const int c = u & 63, bh = u >> 6, b = bh >> 2, h = bh & 3; const size_t row0 = (size_t)b * SEQ + c * 64;
        float cs[16]; float kv[16], qv[16]; float run = 0.f;
#pragma unroll
        for (int i = 0; i < 16; ++i) { const size_t o = (row0 + t0 + i) * 512 + h * 128 + d; cs[i] = lf[o]; kv[i] = bf2f(kk[o]); qv[i] = bf2f(qh[o]); }
        stage_vT(vT, vi + row0 * 512 + h * 128, tid);
        { const bf16_t* Su = ST + (size_t)u * 16384;
#pragma unroll
            for (int j = 0; j < 4; ++j) { const int p = tid + 512 * j, e = p >> 4, d0 = (p & 15) * 8; *(LAS v4u*)(STl + e * LDS_ + d0 * 2) = *(const v4u*)(Su + e * 128 + d0); } }
#pragma unroll
        for (int i = 0; i < 16; ++i) { run += cs[i]; cs[i] = run; }
        segtot[seg * 128 + d] = run;
        __syncthreads();
        float off = 0.f;
#pragma unroll
        for (int s = 0; s < 3; ++s) { const float v = segtot[s * 128 + d]; if (s < seg) off += v; }
        const float bm = segtot[d] + segtot[128 + d];
#pragma unroll
        for (int i = 0; i < 16; ++i) { const float bt = off + cs[i]; const int t = t0 + i;
            *(LAS unsigned short*)(qeL + t * LDQ + d * 2) = (unsigned short)f2bf(qv[i] * __expf(fminf(bt - bm, 80.f)));
            *(LAS unsigned short*)(keL + t * LDQ + d * 2) = (unsigned short)f2bf(kv[i] * __expf(fminf(bm - bt, 80.f)));
            *(LAS unsigned short*)(qsL + t * LDQ + d * 2) = (unsigned short)f2bf(qv[i] * __expf(bt)); }
        __syncthreads();
#pragma unroll
        for (int j = 0; j < 2; ++j) { const int st = 2 * eg + j; f32x4 a = (f32x4){0.f, 0.f, 0.f, 0.f};
            if (st <= tt) {
#pragma unroll
                for (int ks = 0; ks < 4; ++ks) a = __builtin_amdgcn_mfma_f32_16x16x32_bf16(ldfrag(qeL, tt * 16 + (lane & 15), LDQ, ks * 64 + (lane >> 4) * 16), ldfrag(keL, st * 16 + (lane & 15), LDQ, ks * 64 + (lane >> 4) * 16), a, 0, 0, 0);
            }
            const int sI = st * 16 + (lane & 15);
#pragma unroll
            for (int r = 0; r < 4; ++r) { const int tI = tt * 16 + 4 * (lane >> 4) + r; *(LAS unsigned short*)(aL + tI * LDA + sI * 2) = (unsigned short)f2bf(sI <= tI ? a[r] : 0.f); } }
        float gv[4][4];
#pragma unroll
        for (int r = 0; r < 4; ++r)
#pragma unroll
            for (int j = 0; j < 4; ++j) gv[r][j] = bf2f(gh[(row0 + tt * 16 + 4 * (lane >> 4) + r) * 512 + h * 128 + (4 * eg + j) * 16 + (lane & 15)]);
        __syncthreads();
        f32x4 o[4];
#pragma unroll
        for (int j = 0; j < 4; ++j) o[j] = (f32x4){0.f, 0.f, 0.f, 0.f};
#pragma unroll
        for (int ks = 0; ks < 2; ++ks) { const bf16x8 a = ldfrag(aL, tt * 16 + (lane & 15), LDA, ks * 64 + (lane >> 4) * 16);
#pragma unroll
            for (int j = 0; j < 4; ++j) o[j] = __builtin_amdgcn_mfma_f32_16x16x32_bf16(a, ldfrag(vT, (4 * eg + j) * 16 + (lane & 15), LDV, ks * 64 + (lane >> 4) * 16), o[j], 0, 0, 0); }
#pragma unroll
        for (int ks = 0; ks < 4; ++ks) { const bf16x8 a = ldfrag(qsL, tt * 16 + (lane & 15), LDQ, ks * 64 + (lane >> 4) * 16);
#pragma unroll
            for (int j = 0; j < 4; ++j) o[j] = __builtin_amdgcn_mfma_f32_16x16x32_bf16(a, ldfrag(STl, (4 * eg + j) * 16 + (lane & 15), LDS_, ks * 64 + (lane >> 4) * 16), o[j], 0, 0, 0); }
        float ss[4];
#pragma unroll
        for (int r = 0; r < 4; ++r) { float s = 0.f;
#pragma unroll
            for (int j = 0; j < 4; ++j) s += o[j][r] * o[j][r];
            s += __shfl_xor(s, 1); s += __shfl_xor(s, 2); s += __shfl_xor(s, 4); s += __shfl_xor(s, 8); ss[r] = s; }
        if ((lane & 15) == 0) {
#pragma unroll
            for (int r = 0; r < 4; ++r) ssqL[eg * 64 + tt * 16 + 4 * (lane >> 4) + r] = ss[r]; }
        __syncthreads();
#pragma unroll
        for (int r = 0; r < 4; ++r) { const int tI = tt * 16 + 4 * (lane >> 4) + r; const float rs = 1.f / sqrtf((ssqL[tI] + ssqL[64 + tI]) * (1.f / 128.f) + 1e-6f);
#pragma unroll
            for (int j = 0; j < 4; ++j) { const int e = (4 * eg + j) * 16 + (lane & 15); const float g = gv[r][j];
                AR[(row0 + tI) * 1024 + 512 + h * 128 + e] = (bf16_t)f2bf(o[j][r] * rs * gnorm[e] * g * __builtin_amdgcn_rcpf(1.f + __expf(-g))); } }
        __syncthreads();
    }
}
}

namespace op {
struct RowQ { const float* g;
    __device__ __forceinline__ int row(int n) const { const int h = n / 96, j = n - 96 * h; if (j < 64) return n; const int jj = (j - 64) & 15, a = jj >> 2, b = jj & 3; return 96 * h + 64 + 8 * a + b + (j >= 80 ? 4 : 0); }
    __device__ __forceinline__ float scale(int, int k) const { return g[k]; } };
struct RowKV { const float* g;
    __device__ __forceinline__ int row(int n) const { const int h = n >> 7, j = n & 127; return j < 64 ? 64 * h + j : 512 + 64 * h + (j - 64); }
    __device__ __forceinline__ float scale(int, int k) const { return g[k]; } };
constexpr float QSCALE = 0.10206207261596575f * 1.4426950408889634f;
struct EpiQ { static constexpr bool PERM = true, AFTER_DRAIN = false;
    bf16_t* Q; const float* ssq; const float* cs;
    __device__ __forceinline__ void operator()(const f32x4 (&acc)[2][2][4][2], const Unit& u, int wr, int wc, int fr, int fq) const {
        const int row0 = u.pm * 256 + wr * 64 + fr;
#pragma unroll
        for (int ai = 0; ai < 2; ++ai)
#pragma unroll
            for (int m = 0; m < 4; ++m) { const int row = row0 + ai * 128 + m * 16; const float rs = QSCALE * __builtin_amdgcn_rsqf(ssq[row] * (1.f / 256.f) + 1e-6f);
#pragma unroll
                for (int bj = 0; bj < 2; ++bj) { const int gi = 8 * u.pn + 4 * bj + wc; f32x4 v0 = acc[ai][bj][m][0] * rs, v1 = acc[ai][bj][m][1] * rs;
                    if (gi % 3 == 2) { const f32x4 c = *(const f32x4*)(cs + (size_t)row * 32 + 4 * fq), sn = *(const f32x4*)(cs + (size_t)row * 32 + 16 + 4 * fq);
                        const f32x4 o1 = v0 * c - v1 * sn, o2 = v1 * c + v0 * sn; v0 = o1; v1 = o2; }
                    *(v4u*)(Q + (size_t)row * 768 + 32 * gi + 8 * fq) = pack8(v0, v1); } }
    }
};
struct EpiK { static constexpr bool PERM = true, AFTER_DRAIN = false;
    bf16_t* K; const float* ssq;
    __device__ __forceinline__ void operator()(const f32x4 (&acc)[2][2][4][2], const Unit& u, int wr, int wc, int fr, int fq) const {
        const int row0 = u.pm * 256 + wr * 64 + fr, col0 = 256 * u.pn + 32 * wc + 8 * fq;
#pragma unroll
        for (int ai = 0; ai < 2; ++ai)
#pragma unroll
            for (int m = 0; m < 4; ++m) { const int row = row0 + ai * 128 + m * 16; const float rs = __builtin_amdgcn_rsqf(ssq[row] * (1.f / 128.f) + 1e-6f);
#pragma unroll
                for (int bj = 0; bj < 2; ++bj) *(v4u*)(K + (size_t)row * 512 + col0 + 128 * bj) = pack8(acc[ai][bj][m][0] * rs, acc[ai][bj][m][1] * rs); }
    }
};
struct EpiVT { static constexpr bool PERM = true, AFTER_DRAIN = false;
    bf16_t* VT; const float* ssq;
    __device__ __forceinline__ void operator()(const f32x4 (&acc)[2][2][4][2], const Unit& u, int wr, int wc, int fr, int fq) const {
        const int row0 = u.pm * 256 + wr * 64 + fr, col0 = 256 * u.pn + 32 * wc + 8 * fq; const int p0 = (fq & 1) ? 4 : 0, p1 = (fq & 1) ? 12 : 8;
#pragma unroll
        for (int bj = 0; bj < 2; ++bj) { const int c0 = col0 + 128 * bj; const f32x4 s0 = *(const f32x4*)(ssq + c0), s1 = *(const f32x4*)(ssq + c0 + 4); f32x4 r0, r1;
#pragma unroll
            for (int i = 0; i < 4; ++i) { r0[i] = __builtin_amdgcn_rsqf(s0[i] * (1.f / 128.f) + 1e-6f); r1[i] = __builtin_amdgcn_rsqf(s1[i] * (1.f / 128.f) + 1e-6f); }
#pragma unroll
            for (int ai = 0; ai < 2; ++ai)
#pragma unroll
                for (int m = 0; m < 4; ++m) { bf16_t* rowp = VT + (size_t)(row0 + ai * 128 + m * 16) * 16384 + (c0 & ~15);
                    const f32x4 a = acc[ai][bj][m][0] * r0, b = acc[ai][bj][m][1] * r1;
                    v2u w0, w1; w0.x = pk2(a[0], a[1]); w0.y = pk2(a[2], a[3]); w1.x = pk2(b[0], b[1]); w1.y = pk2(b[2], b[3]);
                    *(v2u*)(rowp + p0) = w0; *(v2u*)(rowp + p1) = w1; } }
    }
};
struct EpiMix2 { static constexpr bool PERM = false, AFTER_DRAIN = false; static constexpr int MID_T = 8;
    const float* x; float* t; float alpha; const float* ssq_a;
    __device__ __forceinline__ void mid(f32x4 (&acc)[2][2][4][2], const Unit& u, int wr, int wc, int fr, int fq) const {
        const int row0 = u.pm * 256 + wr * 64 + fr;
#pragma unroll
        for (int ai = 0; ai < 2; ++ai)
#pragma unroll
            for (int m = 0; m < 4; ++m) { const float rs = __builtin_amdgcn_rsqf(ssq_a[row0 + ai * 128 + m * 16] * (1.f / 512.f) + 1e-6f);
#pragma unroll
                for (int bj = 0; bj < 2; ++bj)
#pragma unroll
                    for (int n = 0; n < 2; ++n) acc[ai][bj][m][n] *= rs; }
    }
    __device__ __forceinline__ void operator()(const f32x4 (&acc)[2][2][4][2], const Unit& u, int wr, int wc, int fr, int fq) const {
        const int row0 = u.pm * 256 + wr * 64 + fr, col0 = u.pn * 256 + wc * 32 + 4 * fq;
#pragma unroll
        for (int ai = 0; ai < 2; ++ai)
#pragma unroll
            for (int m = 0; m < 4; ++m) { const size_t ro = (size_t)(row0 + ai * 128 + m * 16) * 1024 + col0;
#pragma unroll
                for (int bj = 0; bj < 2; ++bj)
#pragma unroll
                    for (int n = 0; n < 2; ++n) { const size_t o = ro + bj * 128 + n * 16; *(f32x4*)(t + o) = alpha * *(const f32x4*)(x + o) + acc[ai][bj][m][n]; } }
    }
};
}

namespace at {
using op::bf16_t; using op::v4u; using op::pk2;
typedef short bf16x8 __attribute__((ext_vector_type(8)));
typedef float f32x16 __attribute__((ext_vector_type(16)));
constexpr int LDK = 208, LDV = 144, KBUF = 64 * LDK, VBUF = 64 * LDV, SEQ = 4096;
constexpr float THR = 8.f;
__device__ __forceinline__ int crow(int r, int hi) { return (r & 3) + 8 * (r >> 2) + 4 * hi; }
__device__ __forceinline__ void attn_phase(LAS unsigned char* lds, const bf16_t* Q, const bf16_t* Kn, const bf16_t* kr, const bf16_t* VT, bf16_t* AR, float* ssq_a) {
    int tid_ = threadIdx.x; asm volatile("" : "+v"(tid_)); const int tid = tid_, lane = tid & 63, w = __builtin_amdgcn_readfirstlane(tid >> 6), r32 = lane & 31, hi = lane >> 5;
    LAS unsigned char* Kb = lds; LAS unsigned char* Vb = lds + 2 * KBUF; LAS float* wsf = (LAS float*)(lds + 2 * KBUF + 2 * VBUF) + w * 64;
    const int krow = tid >> 3, kch = tid & 7, rrow = tid >> 2, rch = tid & 3;
    for (int pi = blockIdx.x; pi < 256; pi += gridDim.x) {
        const int bh = pi >> 3, sx = pi & 7, b = bh >> 3, h = bh & 7; const size_t tok0 = (size_t)b * SEQ;
#pragma unroll 1
        for (int uu = 0; uu < 2; ++uu) {
            const int qb = uu == 0 ? 15 - sx : sx; const int NT = 4 * qb + 4, qc = 4 * qb + (w >> 1);
            const size_t qrow = tok0 + qb * 256 + w * 32 + r32;
            bf16x8 qf[6];
#pragma unroll
            for (int ks = 0; ks < 6; ++ks) qf[ks] = *(const bf16x8*)(Q + qrow * 768 + h * 96 + ks * 16 + hi * 8);
            const bf16_t* ksrc = Kn + (tok0 + krow) * 512 + h * 64 + kch * 8; const bf16_t* rsrc = kr + (tok0 + rrow) * 32 + rch * 8; const bf16_t* vsrc = VT + (size_t)(h * 64 + krow) * 16384 + tok0 + kch * 8;
            v4u gk = *(const v4u*)ksrc, gv = *(const v4u*)vsrc, gr = (v4u){0u, 0u, 0u, 0u}; if (tid < 256) gr = *(const v4u*)rsrc;
            *(LAS v4u*)(Kb + krow * LDK + kch * 16) = gk; *(LAS v4u*)(Vb + krow * LDV + kch * 16) = gv; if (tid < 256) *(LAS v4u*)(Kb + rrow * LDK + 128 + rch * 16) = gr;
            __syncthreads();
            f32x16 o0, o1;
#pragma unroll
            for (int r = 0; r < 16; ++r) { o0[r] = 0.f; o1[r] = 0.f; }
            float mhat = 0.f, lsum = 0.f;
            for (int t = 0; t < NT; ++t) {
                const int cur = t & 1; const bool more = t + 1 < NT;
                if (more) { gk = *(const v4u*)(ksrc + (size_t)(t + 1) * 64 * 512); gv = *(const v4u*)(vsrc + (t + 1) * 64); if (tid < 256) gr = *(const v4u*)(rsrc + (size_t)(t + 1) * 64 * 32); }
                if (t <= qc) {
                    const LAS unsigned char* Kc = Kb + cur * KBUF + r32 * LDK + hi * 16; const LAS unsigned char* Vc = Vb + cur * VBUF + r32 * LDV + hi * 16;
                    f32x16 p0, p1;
#pragma unroll
                    for (int r = 0; r < 16; ++r) { p0[r] = 0.f; p1[r] = 0.f; }
#pragma unroll
                    for (int ks = 0; ks < 6; ++ks) { p0 = __builtin_amdgcn_mfma_f32_32x32x16_bf16(*(const LAS bf16x8*)(Kc + ks * 32), qf[ks], p0, 0, 0, 0);
                        p1 = __builtin_amdgcn_mfma_f32_32x32x16_bf16(*(const LAS bf16x8*)(Kc + 32 * LDK + ks * 32), qf[ks], p1, 0, 0, 0); }
                    float rm = fmaxf(p0[0], p1[0]);
#pragma unroll
                    for (int r = 1; r < 16; ++r) rm = fmaxf(rm, fmaxf(p0[r], p1[r]));
                    rm = fmaxf(rm, __shfl_xor(rm, 32)) - mhat;
                    const bool force = (t == 0);
                    if (__any(rm > THR) || force) {
                        const float dl = force ? rm : fmaxf(rm, 0.f); mhat += dl;
                        if (!force) { const float f = __builtin_amdgcn_exp2f(-dl); lsum *= f; if (hi == 0) wsf[r32] = f;
                            asm volatile("s_waitcnt lgkmcnt(0)" ::: "memory");
#pragma unroll
                            for (int r = 0; r < 16; ++r) { const float fr = wsf[crow(r, hi)]; o0[r] *= fr; o1[r] *= fr; } }
                    }
                    float sacc = 0.f;
#pragma unroll
                    for (int r = 0; r < 16; ++r) { p0[r] = __builtin_amdgcn_exp2f(p0[r] - mhat); p1[r] = __builtin_amdgcn_exp2f(p1[r] - mhat); sacc += p0[r] + p1[r]; }
                    lsum += sacc;
                    bf16x8 pa[4];
#pragma unroll
                    for (int s = 0; s < 2; ++s) { const v4u a = (v4u){pk2(p0[8 * s], p0[8 * s + 1]), pk2(p0[8 * s + 2], p0[8 * s + 3]), pk2(p0[8 * s + 4], p0[8 * s + 5]), pk2(p0[8 * s + 6], p0[8 * s + 7])};
                        const v4u c = (v4u){pk2(p1[8 * s], p1[8 * s + 1]), pk2(p1[8 * s + 2], p1[8 * s + 3]), pk2(p1[8 * s + 4], p1[8 * s + 5]), pk2(p1[8 * s + 6], p1[8 * s + 7])};
                        pa[s] = __builtin_bit_cast(bf16x8, a); pa[2 + s] = __builtin_bit_cast(bf16x8, c); }
#pragma unroll
                    for (int s = 0; s < 4; ++s) { o0 = __builtin_amdgcn_mfma_f32_32x32x16_bf16(pa[s], *(const LAS bf16x8*)(Vc + s * 32), o0, 0, 0, 0);
                        o1 = __builtin_amdgcn_mfma_f32_32x32x16_bf16(pa[s], *(const LAS bf16x8*)(Vc + 32 * LDV + s * 32), o1, 0, 0, 0); }
                }
                if (more) { const int nx = cur ^ 1; *(LAS v4u*)(Kb + nx * KBUF + krow * LDK + kch * 16) = gk; *(LAS v4u*)(Vb + nx * VBUF + krow * LDV + kch * 16) = gv; if (tid < 256) *(LAS v4u*)(Kb + nx * KBUF + rrow * LDK + 128 + rch * 16) = gr; }
                __syncthreads();
            }
            lsum += __shfl_xor(lsum, 32);
            if (hi == 0) wsf[32 + r32] = lsum;
            asm volatile("s_waitcnt lgkmcnt(0)" ::: "memory");
            const size_t orow0 = tok0 + qb * 256 + w * 32;
#pragma unroll
            for (int r = 0; r < 16; ++r) { const int q = crow(r, hi); const float il = 1.f / wsf[32 + q]; const float a = o0[r] * il, c = o1[r] * il;
                bf16_t* op_ = AR + (orow0 + q) * 1024 + h * 64 + r32; op_[0] = (bf16_t)op::f2bf(a); op_[32] = (bf16_t)op::f2bf(c);
                float s2 = a * a + c * c; s2 += __shfl_xor(s2, 1); s2 += __shfl_xor(s2, 2); s2 += __shfl_xor(s2, 4); s2 += __shfl_xor(s2, 8); s2 += __shfl_xor(s2, 16);
                if (r32 == 0) atomicAdd(ssq_a + orow0 + q, s2); }
        }
    }
}
}

namespace rt {
using op::bf16_t; using op::pk2;
typedef short bf16x8 __attribute__((ext_vector_type(8)));
typedef float f32x16 __attribute__((ext_vector_type(16)));
__device__ __forceinline__ void build_wr(const float* wg, const float* we, bf16_t* Wr_t) {
    for (int i = GTID; i < 64 * 1024; i += GTHREADS) { const int n = i >> 10, k = i & 1023; const float v = n < 32 ? we[k * 32 + n] : (n < 36 ? wg[k * 4 + n - 32] : 0.f); Wr_t[i] = (bf16_t)op::f2bf(v); }
}
__device__ __forceinline__ void router(const bf16_t* h1b, const bf16_t* Wr_t, const float* bg, const float* be, int* cnt, int* tok_e, int* tok_rank, float* tok_gate, int* stok) {
    const int lane = nv::tidx() & 63, r32 = lane & 31, hi = lane >> 5;
    for (int task = GWAVE; task < 512; task += GWAVES) {
        const int tok = task * 32 + r32;
        const bf16_t* hp = h1b + (size_t)tok * 1024 + hi * 8; const bf16_t* w0 = Wr_t + (size_t)r32 * 1024 + hi * 8; const bf16_t* w1 = w0 + 32 * 1024;
        f32x16 d0, d1;
#pragma unroll
        for (int r = 0; r < 16; ++r) { d0[r] = 0.f; d1[r] = 0.f; }
#pragma unroll 4
        for (int ks = 0; ks < 64; ++ks) { const bf16x8 b = *(const bf16x8*)(hp + ks * 16);
            d0 = __builtin_amdgcn_mfma_f32_32x32x16_bf16(*(const bf16x8*)(w0 + ks * 16), b, d0, 0, 0, 0);
            d1 = __builtin_amdgcn_mfma_f32_32x32x16_bf16(*(const bf16x8*)(w1 + ks * 16), b, d1, 0, 0, 0); }
        float ex[32];
#pragma unroll
        for (int r = 0; r < 16; ++r) { const float own = d0[r], oth = __shfl_xor(own, 32); const int n0 = (r & 3) + 8 * (r >> 2);
            ex[n0] = (hi == 0 ? own : oth) + be[n0]; ex[n0 + 4] = (hi == 0 ? oth : own) + be[n0 + 4]; }
        float gl[4];
#pragma unroll
        for (int c = 0; c < 4; ++c) { const float own = d1[c], oth = __shfl_xor(own, 32); gl[c] = (hi == 0 ? own : oth) + bg[c]; }
        int grp = 0; float gm = gl[0];
#pragma unroll
        for (int c = 1; c < 4; ++c) if (gl[c] > gm) { gm = gl[c]; grp = c; }
        float den = 0.f;
#pragma unroll
        for (int c = 0; c < 4; ++c) den += __expf(gl[c] - gm);
        const float pgrp = 1.f / den;
        float ein[8];
#pragma unroll
        for (int j = 0; j < 8; ++j) ein[j] = grp == 0 ? ex[j] : grp == 1 ? ex[8 + j] : grp == 2 ? ex[16 + j] : ex[24 + j];
        int i0 = 0; float v0 = ein[0];
#pragma unroll
        for (int j = 1; j < 8; ++j) if (ein[j] > v0) { v0 = ein[j]; i0 = j; }
        int i1 = -1; float v1 = -INFINITY;
#pragma unroll
        for (int j = 0; j < 8; ++j) if (j != i0 && ein[j] > v1) { v1 = ein[j]; i1 = j; }
        const float e1 = __expf(v1 - v0); const float p0 = 1.f / (1.f + e1), p1 = e1 / (1.f + e1);
        if (hi == 0) {
            const int ea = grp * 8 + i0, eb = grp * 8 + i1;
            const int ra = atomicAdd(cnt + ea, 1), rb = atomicAdd(cnt + eb, 1);
            tok_e[2 * tok] = ea; tok_e[2 * tok + 1] = eb; tok_rank[2 * tok] = ra; tok_rank[2 * tok + 1] = rb;
            tok_gate[2 * tok] = pgrp * p0; tok_gate[2 * tok + 1] = pgrp * p1;
            stok[ea * op::MOE_CAP + ra] = tok; stok[eb * op::MOE_CAP + rb] = tok;
        }
    }
}
}

#ifndef PROBE
#define PROBE 0
#endif
struct Args { const float* in[22]; float* out; unsigned char* ws; };
constexpr size_t MiB = 1u << 20;
constexpr size_t WS_CTL = 260 * MiB, CTL_ZERO_BYTES = 1 * MiB;
constexpr int CW_BAR = 1024, CW_CNT = 8192, CW_SSQ_Q = 16384, CW_SSQ_KV = 32768, CW_SSQ_A = 49152;

__global__ void __launch_bounds__(NTHREADS, 2) mega_fwd(Args args) {
    extern __shared__ __attribute__((aligned(16))) unsigned char lds_raw[];
    using namespace nv;
    LAS unsigned char* lds = (LAS unsigned char*)lds_raw;
    volatile LAS unsigned* MISC = (volatile LAS unsigned*)(lds + 131072);
    if (threadIdx.x < 64) MISC[threadIdx.x] = 0u;
    __syncthreads();
    unsigned char* ws = args.ws;
    unsigned* ctl = (unsigned*)(ws + WS_CTL);
    XcdBarrier bar = xcd_barrier_post(ctl + CW_BAR, MISC + 8);
    const float* x = args.in[0]; const int* pos = (const int*)args.in[1]; const float* w_in = args.in[2];
    const float* q_norm_g = args.in[3]; const float* w_uq = args.in[4]; const float* kv_norm_g = args.in[5];
    const float* w_ukv = args.in[6]; const float* mla_out_g = args.in[7]; const float* lbl = args.in[8];
    const float* hg_norm_g = args.in[9]; const float* w_out = args.in[10]; const float* ln1_g = args.in[11];
    const float* ln1_b = args.in[12]; const float* wrg = args.in[13]; const float* brg = args.in[14];
    const float* wre = args.in[15]; const float* bre = args.in[16]; const float* w1 = args.in[17];
    const float* w3 = args.in[18]; const float* w2 = args.in[19]; const float* ln2_g = args.in[20]; const float* ln2_b = args.in[21];
    float* out = args.out;
    typedef op::bf16_t bf16_t;
    float*  lf   = (float*)(ws + 0);
    bf16_t* kk   = (bf16_t*)(ws + 32 * MiB);
    bf16_t* vi   = (bf16_t*)(ws + 48 * MiB);
    bf16_t* qh   = (bf16_t*)(ws + 64 * MiB);
    bf16_t* gh   = (bf16_t*)(ws + 80 * MiB);
    bf16_t* Ub   = (bf16_t*)(ws + 96 * MiB);
    bf16_t* AR   = (bf16_t*)(ws + 96 * MiB);
    float*  dlb  = (float*)(ws + 128 * MiB);
    float*  cs   = (float*)(ws + 129 * MiB);
    bf16_t* Qb   = (bf16_t*)(ws + 131 * MiB);
    bf16_t* Knb  = (bf16_t*)(ws + 155 * MiB);
    bf16_t* VTb  = (bf16_t*)(ws + 171 * MiB);
    bf16_t* xb   = (bf16_t*)(ws + 187 * MiB);
    bf16_t* STb  = (bf16_t*)(ws + 187 * MiB);
    bf16_t* cq   = (bf16_t*)(ws + 219 * MiB);
    bf16_t* ckv  = (bf16_t*)(ws + 227 * MiB);
    bf16_t* kr   = (bf16_t*)(ws + 231 * MiB);
    bf16_t* Win_t = (bf16_t*)(ws + 232 * MiB);
    bf16_t* Wuq_t = (bf16_t*)(ws + 237 * MiB);
    bf16_t* Wkv_t = (bf16_t*)(ws + 237 * MiB + 512 * 1024);
    bf16_t* Wout_t = (bf16_t*)(ws + 238 * MiB);
    bf16_t* Wr_t = (bf16_t*)(ws + 240 * MiB);
    float*  h1   = (float*)(ws + 0);
    bf16_t* h1b  = (bf16_t*)(ws + 64 * MiB);
    bf16_t* W13_t = (bf16_t*)(ws + 97 * MiB);
    bf16_t* W2_t = (bf16_t*)(ws + 161 * MiB);
    bf16_t* Hb   = (bf16_t*)(ws + 193 * MiB);
    int*    stok = (int*)(ws + 233 * MiB);
    bf16_t* Yb   = (bf16_t*)(ws + 64 * MiB);
    int* cnt = (int*)(ctl + CW_CNT);
    float* ssq_q = (float*)(ctl + CW_SSQ_Q); float* ssq_kv = (float*)(ctl + CW_SSQ_KV); float* ssq_a = (float*)(ctl + CW_SSQ_A);
    int* meta = (int*)(ws + WS_CTL + 1 * MiB);
    int* tstart_g = meta; float* lbt = (float*)(meta + 1024); int* tok_e = meta + 2048; int* tok_rank = tok_e + 2 * NTOK; float* tok_gate = (float*)(tok_rank + 2 * NTOK);
    LAS int* moetab = (LAS int*)(lds + 131072 + 1024);

    {
        int tl_ = threadIdx.x; asm volatile("" : "+v"(tl_)); const int wave = __builtin_amdgcn_readfirstlane(tl_ >> 6), lane = tl_ & 63;
        LAS float* scr = (LAS float*)(lds + wave * 16384);
        for (int it = GWAVE; it < (D / 64) * (INC / 32); it += GWAVES) op::transpose_item(w_in, D, INC, Win_t, scr, it, lane, op::RowProj{});
        for (int it = GWAVE; it < (D / 64) * (D / 32); it += GWAVES) op::transpose_item(w_out, D, D, Wout_t, scr, it, lane, op::RowScaleK{mla_out_g, 512});
        for (int it = GWAVE; it < (256 / 64) * (768 / 32); it += GWAVES) op::transpose_item(w_uq, 256, 768, Wuq_t, scr, it, lane, op::RowQ{q_norm_g});
        for (int it = GWAVE; it < (128 / 64) * (1024 / 32); it += GWAVES) op::transpose_item(w_ukv, 128, 1024, Wkv_t, scr, it, lane, op::RowKV{kv_norm_g});
        op::cvt_rows_bf16(x, xb, (size_t)NTOK * D);
        cs_tab(pos, cs);
        lb_tab(lbl, lbt);
        rt::build_wr(wrg, wre, Wr_t);
    }
    xcd_barrier(bar);
    {
        pg8::Gemm g{xb, Win_t, NTOK, 2560, D}; pg8::StaticOrder S; S.init(NTOK, 2560, (int)gridDim.x, (int)blockIdx.x);
        op::EpiProj E{cq, ckv, kr, kk, vi, lf, ssq_q, ssq_kv, cs, lbt};
        pg8::gemm_phase<op::EpiProj, pg8::StaticOrder, true, true>(lds, g, S, E);
#if PROBE == 4
        { op::EpiProj E2 = E; E2.ssq_q = (float*)(ws + WS_CTL + 1 * MiB + 512 * 1024); E2.ssq_kv = E2.ssq_q + 16384; pg8::gemm_phase<op::EpiProj, pg8::StaticOrder, true, true>(lds, g, S, E2); }
#endif
    }
    xcd_barrier(bar);
    hg::pass1(lds, lf, kk, vi, Ub, dlb);
    {
        pg8::Gemm g{cq, Wuq_t, NTOK, 768, 256}; pg8::StaticOrder S; S.init(NTOK, 768, (int)gridDim.x, (int)blockIdx.x);
        op::EpiQ E{Qb, ssq_q, cs};
        pg8::gemm_phase<op::EpiQ, pg8::StaticOrder, true, true>(lds, g, S, E);
    }
    {
        pg8::Gemm g{ckv, Wkv_t, NTOK, 512, 128}; pg8::StaticOrder S; S.init(NTOK, 512, (int)gridDim.x, (int)blockIdx.x);
        op::EpiK E{Knb, ssq_kv};
        pg8::gemm_phase<op::EpiK, pg8::StaticOrder, true, true>(lds, g, S, E);
    }
    {
        pg8::Gemm g{Wkv_t + 512 * 128, ckv, 512, NTOK, 128}; pg8::StaticOrder S; S.init(512, NTOK, (int)gridDim.x, (int)blockIdx.x);
        op::EpiVT E{VTb, ssq_kv};
        pg8::gemm_phase<op::EpiVT, pg8::StaticOrder, true, true>(lds, g, S, E);
    }
    xcd_barrier(bar);
    hg::scan(Ub, dlb, STb);
    xcd_barrier(bar);
    hg::pass3(lds, lf, kk, vi, qh, gh, STb, hg_norm_g, AR);
#if PROBE == 2
    xcd_barrier(bar); hg::pass1(lds, lf, kk, vi, Ub + 0, dlb); xcd_barrier(bar); hg::scan(Ub, dlb, STb); xcd_barrier(bar); hg::pass3(lds, lf, kk, vi, qh, gh, STb, hg_norm_g, AR);
#endif
    at::attn_phase(lds, Qb, Knb, kr, VTb, AR, ssq_a);
#if PROBE == 1
    at::attn_phase(lds, Qb, Knb, kr, VTb, AR, (float*)(ws + WS_CTL + 1 * MiB + 512 * 1024));
#endif
    xcd_barrier(bar);
    {
        pg8::Gemm g{AR, Wout_t, NTOK, D, D}; pg8::StaticOrder S; S.init(NTOK, D, (int)gridDim.x, (int)blockIdx.x);
        op::EpiMix2 E{x, h1, ALPHA, ssq_a};
        pg8::gemm_phase<op::EpiMix2, pg8::StaticOrder, true, true>(lds, g, S, E);
    }
    xcd_barrier(bar);
    ln_rows2(h1, ln1_g, ln1_b, h1b);
    {
        int tl_ = threadIdx.x; asm volatile("" : "+v"(tl_)); const int wave = __builtin_amdgcn_readfirstlane(tl_ >> 6), lane = tl_ & 63;
        LAS float* scr = (LAS float*)(lds + wave * 16384);
        for (int it = GWAVE; it < 32 * 3 * 256; it += GWAVES) {
            const int e = it / 768, r = it % 768;
            if (r < 256) op::transpose_item(w1 + (size_t)e * D * 512, D, 512, W13_t + (size_t)e * D * D, scr, r, lane, op::RowW13{0});
            else if (r < 512) op::transpose_item(w3 + (size_t)e * D * 512, D, 512, W13_t + (size_t)e * D * D, scr, r - 256, lane, op::RowW13{1});
            else op::transpose_item(w2 + (size_t)e * 512 * D, 512, D, W2_t + (size_t)e * D * 512, scr, r - 512, lane, op::RowId{});
        }
    }
    xcd_barrier(bar);
    rt::router(h1b, Wr_t, brg, bre, cnt, tok_e, tok_rank, tok_gate, stok);
    xcd_barrier(bar);
    op::moe_build_tab(moetab, cnt, tstart_g);
    {
        pg8::Gemm g{h1b, W13_t, 0, 0, D}; op::MoeOrder S{moetab, (int)gridDim.x, (int)blockIdx.x, stok};
        op::EpiMoe1 E{Hb};
        pg8::gemm_phase<op::EpiMoe1, op::MoeOrder, true, true, true>(lds, g, S, E);
#if PROBE == 3
        pg8::gemm_phase<op::EpiMoe1, op::MoeOrder, true, true, true>(lds, g, S, E);
#endif
    }
    xcd_barrier(bar);
    {
        pg8::Gemm g{Hb, W2_t, 0, 0, 512}; op::MoeOrder S{moetab, (int)gridDim.x, (int)blockIdx.x, stok};
        op::EpiBf16P E{Yb, D, 3};
        pg8::gemm_phase<op::EpiBf16P, op::MoeOrder, true, true, false>(lds, g, S, E);
#if PROBE == 7
        pg8::gemm_phase<op::EpiBf16P, op::MoeOrder, true, true, false>(lds, g, S, E);
#endif
    }
    xcd_barrier(bar);
    ln2_rows(h1, Yb, tok_e, tok_rank, tok_gate, tstart_g, ln2_g, ln2_b, out);
#if PROBE == 6
    ln2_rows(h1, Yb, tok_e, tok_rank, tok_gate, tstart_g, ln2_g, ln2_b, out);
#endif
}

extern "C" void kernel_launch(void* const* d_in, const int* in_sizes, int n_in, void* d_out, int out_size, void* d_ws, size_t ws_size, hipStream_t stream) {
    static int grid = 0;
    if (grid == 0) {
        if (n_in != 22 || ws_size < 264 * MiB) { fprintf(stderr, "kernel_launch: unexpected n_in %d / ws %zu\n", n_in, ws_size); grid = -1; return; }
        int dev = 0, cus = 0, per_cu = 0;
        if (hipGetDevice(&dev) != hipSuccess || hipDeviceGetAttribute(&cus, hipDeviceAttributeMultiprocessorCount, dev) != hipSuccess) { grid = -1; return; }
        if (hipFuncSetAttribute((const void*)mega_fwd, hipFuncAttributeMaxDynamicSharedMemorySize, LDS_BYTES) != hipSuccess) { fprintf(stderr, "kernel_launch: hipFuncSetAttribute failed\n"); grid = -1; return; }
        if (hipOccupancyMaxActiveBlocksPerMultiprocessor(&per_cu, (const void*)mega_fwd, NTHREADS, LDS_BYTES) != hipSuccess || per_cu < 1) { fprintf(stderr, "kernel_launch: occupancy query says %d\n", per_cu); (void)hipGetLastError(); }
        grid = cus;
    }
    if (grid < 0) return;
    if (hipMemsetAsync((char*)d_ws + WS_CTL, 0, CTL_ZERO_BYTES, stream) != hipSuccess) return;
    Args a{};
    for (int i = 0; i < 22; ++i) a.in[i] = (const float*)d_in[i];
    a.out = (float*)d_out; a.ws = (unsigned char*)d_ws;
    hipLaunchKernelGGL(mega_fwd, dim3(grid), dim3(NTHREADS), LDS_BYTES, stream, a);
}
```

```cpp
#include <hip/hip_runtime.h>
#include <cstdio>
#include <cstdint>
#include <cmath>

#define LAS __attribute__((address_space(3)))
constexpr int NTHREADS = 512, NWAVES = 8;
constexpr int LDS_BYTES = 147456;

#define XB_TMO      128
#define XB_XCNT(j)  (256  + 64 * (j))
#define XB_XSUB(j)  (1280 + 64 * (j))
#define XB_XGEN(j)  (2304 + 64 * (j))
#define XB_TOP      3328
#define XB_TOPGEN   3392
#define XCD_BAR_WORDS 3456
#define XB_SPIN_CAP (1u << 18)

__device__ __forceinline__ unsigned xb_ld(unsigned* p)              { return __hip_atomic_load(p, __ATOMIC_RELAXED, __HIP_MEMORY_SCOPE_AGENT); }
__device__ __forceinline__ unsigned xb_add(unsigned* p, unsigned v) { return __hip_atomic_fetch_add(p, v, __ATOMIC_RELAXED, __HIP_MEMORY_SCOPE_AGENT); }
__device__ __forceinline__ unsigned xb_xcc_id() { return (unsigned)__builtin_amdgcn_s_getreg((3 << 11) | 20) & 0xFu; }
#define XB_SPIN(cond, bar) do { unsigned _sp = 0; while (cond) { __builtin_amdgcn_s_sleep(1); \
    if ((++_sp & 255u) == 0u) { if (xb_ld(&(bar)[XB_TMO])) break; if (_sp > XB_SPIN_CAP) { atomicAdd(&(bar)[XB_TMO], 1u); break; } } } } while (0)

struct XcdBarrier {
    unsigned* bar; unsigned x;
    volatile LAS unsigned* st;
};

__device__ __forceinline__ XcdBarrier xcd_barrier_post(unsigned* bar, volatile LAS unsigned* st) {
    XcdBarrier b; b.bar = bar; b.x = xb_xcc_id(); b.st = st;
    if (threadIdx.x == 0) (void)xb_add(&bar[XB_XCNT(b.x)], 1u);
    return b;
}
__device__ __forceinline__ void xcd_barrier_complete(unsigned* bar, unsigned x, unsigned& nloc, unsigned& nx) {
    const unsigned G = gridDim.x * gridDim.y * gridDim.z;
    unsigned sum, cnt, mine, sp = 0u;
    for (;;) {
        sum = 0u; cnt = 0u; mine = 0u;
#pragma unroll
        for (unsigned j = 0; j < 16; ++j) { const unsigned c = xb_ld(&bar[XB_XCNT(j)]); sum += c; cnt += (c > 0u) ? 1u : 0u; mine = (j == x) ? c : mine; }
        if (sum == G) break;
        __builtin_amdgcn_s_sleep(1);
        if ((++sp & 255u) == 0u) { if (xb_ld(&bar[XB_TMO])) break; if (sp > XB_SPIN_CAP) { atomicAdd(&bar[XB_TMO], 1u); break; } }
    }
    nloc = mine > 0u ? mine : 1u; nx = cnt > 0u ? cnt : 1u;
}

__device__ __forceinline__ void xcd_barrier(const XcdBarrier& b) {
    asm volatile("s_waitcnt vmcnt(0)" ::: "memory");
    __syncthreads();
    if (threadIdx.x == 0) {
        unsigned* bar = b.bar;
        __builtin_amdgcn_s_waitcnt(0);
        unsigned nloc = b.st[0], nx = b.st[1];
        if (nloc == 0u) { xcd_barrier_complete(bar, b.x, nloc, nx); b.st[0] = nloc; b.st[1] = nx; }
        const unsigned old = xb_add(&bar[XB_XSUB(b.x)], 1u);
        const unsigned gen = old / nloc;
        if (old + 1u == (gen + 1u) * nloc) {
            __builtin_amdgcn_fence(__ATOMIC_RELEASE, "agent");
            asm volatile("s_waitcnt vmcnt(0)" ::: "memory");
            const unsigned og = xb_add(&bar[XB_TOP], 1u);
            const unsigned tg = og / nx;
            if (og + 1u == (tg + 1u) * nx) xb_add(&bar[XB_TOPGEN], 1u);
            else XB_SPIN(xb_ld(&bar[XB_TOPGEN]) == tg, bar);
            __builtin_amdgcn_fence(__ATOMIC_ACQUIRE, "agent");
            xb_add(&bar[XB_XGEN(b.x)], 1u);
            asm volatile("s_waitcnt vmcnt(0)" ::: "memory");
        } else {
            XB_SPIN(xb_ld(&bar[XB_XGEN(b.x)]) == gen, bar);
            __builtin_amdgcn_fence(__ATOMIC_ACQUIRE, "agent");
            asm volatile("s_waitcnt vmcnt(0)" ::: "memory");
        }
    }
    __syncthreads();
}
namespace pg8 {
#define PG8_LAS __attribute__((address_space(3)))
typedef unsigned short bf16_t;
typedef short bf16x8 __attribute__((ext_vector_type(8)));
typedef float f32x4 __attribute__((ext_vector_type(4)));
typedef unsigned u32x4 __attribute__((ext_vector_type(4)));
constexpr int BM = 256, BK = 64, HALF = 128, HTB = HALF * BK * 2  , STAGE_BYTES = 8 * HTB, NXCD = 8, WGM = 8;

__host__ __device__ __forceinline__ int lds_byte(int r, int c) { const int st = (r >> 4) * 2 + (c >> 5), rr = r & 15, cc = c & 31, ob = rr * 64 + cc * 2; return st * 1024 + (ob ^ (((ob >> 9) & 1) << 5)); }
__host__ __device__ __forceinline__ void stage_rc(int b, int& R, int& C) { const int st = b / 1024, sb = b % 1024, swz = sb ^ (((sb >> 9) & 1) << 5); R = (st >> 1) * 16 + swz / 64; C = (st & 1) * 32 + (swz % 64) / 2; }
__host__ __device__ __forceinline__ int perm32(int rho) { const int n = rho >> 4, i = rho & 15; return 8 * (i >> 2) + 4 * n + (i & 3); }

struct Unit { int pm, pn; };
struct Gemm { const bf16_t* A; const bf16_t* Bt; int M, N, K; };

struct StaticOrder {
    int nM, nN, nwg, G, c;
    __host__ __device__ void init(int M, int N, int G_, int c_) { nM = M / BM; nN = N / BM; nwg = nM * nN; G = G_; c = c_; }
    __host__ __device__ bool next(int i, Unit& u) const {
        const long L = (long)i * G + c; if (L >= nwg) return false;
        int wgid = (int)L; { const int q = nwg / NXCD, r = nwg % NXCD, xcd = wgid % NXCD, off = wgid / NXCD; wgid = (xcd < r ? xcd * (q + 1) : r * (q + 1) + (xcd - r) * q) + off; }
        const int nig = WGM * nN, gid = wgid / nig, fm = gid * WGM, gsz = (nM - fm) < WGM ? (nM - fm) : WGM;
        u.pm = fm + ((wgid % nig) % gsz); u.pn = (wgid % nig) / gsz; return true;
    }
    __device__ __forceinline__ void a_ready(const Unit&) const {}
    __device__ __forceinline__ void done(const Unit&) const {}
    __device__ __forceinline__ int arow(const Unit&, int) const { return 0; }
};

__device__ __forceinline__ unsigned cvt_pk_bf16(float lo, float hi) { unsigned r; asm volatile("v_cvt_pk_bf16_f32 %0, %1, %2" : "=v"(r) : "v"(lo), "v"(hi)); return r; }
typedef float f32x2 __attribute__((ext_vector_type(2)));
__device__ __forceinline__ f32x2 gelu_pk(f32x2 v) {
    const f32x2 av = __builtin_elementwise_abs(v), d = av * 0.2316418882f + 1.0f;
    f32x2 t; t.x = __builtin_amdgcn_rcpf(d.x); t.y = __builtin_amdgcn_rcpf(d.y);
    f32x2 q = t * 0.5307027145f + (-0.7265760135f); q = q * t + 0.7107068705f; q = q * t + (-0.142248368f); q = q * t + 0.127414796f; q = q * t;
    const f32x2 s = (v * v) * (-0.72134752044f);
    f32x2 e; e.x = __builtin_amdgcn_exp2f(s.x); e.y = __builtin_amdgcn_exp2f(s.y);
    const f32x2 m = v * (q * e), r = v - m;
    f32x2 o; o.x = v.x < 0.f ? m.x : r.x; o.y = v.y < 0.f ? m.y : r.y; return o;
}

template <int ACT  > struct EpiBf16 {
    static constexpr bool PERM = true, AFTER_DRAIN = false; static_assert(ACT == 0 || ACT == 1, "EpiBf16: ACT is 0 (none) or 1 (gelu_pk)");
    bf16_t* O; int ldc; const float* bias; int split_cols; size_t split_stride; float scale0;
    __device__ __forceinline__ void operator()(const f32x4 (&acc)[2][2][4][2], const Unit& u, int wr, int wc, int fr, int fq) const {
        const int row0 = u.pm * BM + wr * 64 + fr; int colt = u.pn * BM; bf16_t* base = O;
        float sc = 1.f; if (split_cols) { const int t = colt / split_cols; base += (size_t)t * split_stride; colt -= t * split_cols; if (t == 0) sc = scale0; }
        const int col0 = colt + wc * 32 + 8 * fq, bcol0 = u.pn * BM + wc * 32 + 8 * fq;
        f32x4 bv[2][2];
#pragma unroll
        for (int bj = 0; bj < 2; ++bj)
#pragma unroll
            for (int n = 0; n < 2; ++n) bv[bj][n] = bias ? *(const f32x4*)(bias + bcol0 + bj * HALF + 4 * n) : (f32x4){0.f, 0.f, 0.f, 0.f};
#pragma unroll
        for (int ai = 0; ai < 2; ++ai)
#pragma unroll
            for (int m = 0; m < 4; ++m) { bf16_t* rowp = base + (size_t)(row0 + ai * HALF + m * 16) * ldc + col0;
#pragma unroll
                for (int bj = 0; bj < 2; ++bj) { f32x4 v0 = acc[ai][bj][m][0] + bv[bj][0], v1 = acc[ai][bj][m][1] + bv[bj][1];
                    if (ACT == 1) { f32x2 a = gelu_pk((f32x2){v0[0], v0[1]}), b = gelu_pk((f32x2){v0[2], v0[3]}), c = gelu_pk((f32x2){v1[0], v1[1]}), d = gelu_pk((f32x2){v1[2], v1[3]});
                        v0 = (f32x4){a.x, a.y, b.x, b.y}; v1 = (f32x4){c.x, c.y, d.x, d.y}; }
                    v0 = v0 * sc; v1 = v1 * sc; u32x4 w; w.x = cvt_pk_bf16(v0[0], v0[1]); w.y = cvt_pk_bf16(v0[2], v0[3]); w.z = cvt_pk_bf16(v1[0], v1[1]); w.w = cvt_pk_bf16(v1[2], v1[3]);
                    *(u32x4*)(rowp + bj * HALF) = w; } }
    }
};

struct PanelStats {
    unsigned* xbuf;
    unsigned* cnt;
    unsigned* tmo;
    int ntn; float eps;
    unsigned code;
    __device__ __forceinline__ bool run(const f32x4 (&v)[2][2][4][2], const Unit& u, int wr, int wc, int fr, int fq, PG8_LAS unsigned char* lds, int wid, int lane) const {
        typedef float f32x2v __attribute__((ext_vector_type(2)));
        PG8_LAS f32x2v* P = (PG8_LAS f32x2v*)lds;
        PG8_LAS f32x2v* S = (PG8_LAS f32x2v*)(lds + 8192);
        PG8_LAS unsigned* flag = (PG8_LAS unsigned*)(lds + 8192 + 2048);
#pragma unroll
        for (int ai = 0; ai < 2; ++ai)
#pragma unroll
            for (int m = 0; m < 4; ++m) {
                float s = 0.f;
#pragma unroll
                for (int bj = 0; bj < 2; ++bj)
#pragma unroll
                    for (int n = 0; n < 2; ++n) { const f32x4 x = v[ai][bj][m][n]; s += (x[0] + x[1]) + (x[2] + x[3]); }
                s += __shfl_xor(s, 16); s += __shfl_xor(s, 32);
                const float mw = s * (1.0f / 64.0f); float q = 0.f;
#pragma unroll
                for (int bj = 0; bj < 2; ++bj)
#pragma unroll
                    for (int n = 0; n < 2; ++n) { const f32x4 d = v[ai][bj][m][n] - mw; q += (d[0] * d[0] + d[1] * d[1]) + (d[2] * d[2] + d[3] * d[3]); }
                q += __shfl_xor(q, 16); q += __shfl_xor(q, 32);
                if (fq == 0) P[(ai * HALF + wr * 64 + m * 16 + fr) * 4 + wc] = (f32x2v){mw, q};
            }
        asm volatile("s_waitcnt lgkmcnt(0)" ::: "memory"); __builtin_amdgcn_s_barrier(); asm volatile("" ::: "memory");
#if defined(BROKEN_EXCHANGE_NO_WAIT)
#warning BROKEN CONTROL BUILD: the row-statistics exchange does not wait; results are wrong by design
        if (blockIdx.x >= 64) { const long long t0_ = clock64(); while (clock64() - t0_ < 60000) __builtin_amdgcn_s_sleep(8); }
#endif
        const int row = wid * 32 + (lane & 31);
        if (lane < 32) {
            const f32x2v a = P[row * 4 + 0], b = P[row * 4 + 1], c = P[row * 4 + 2], d = P[row * 4 + 3];
            const float mt = (a.x + b.x + c.x + d.x) * 0.25f;
            const float da = a.x - mt, db = b.x - mt, dc = c.x - mt, dd = d.x - mt;
            const float m2 = (a.y + b.y) + (c.y + d.y) + 64.0f * ((da * da + db * db) + (dc * dc + dd * dd));
            unsigned long long* slot = (unsigned long long*)xbuf + ((size_t)(u.pm * BM + row) * 4 + u.pn);
            __hip_atomic_store(slot, ((unsigned long long)__float_as_uint(m2) << 32) | __float_as_uint(mt), __ATOMIC_RELAXED, __HIP_MEMORY_SCOPE_AGENT);
        }
        asm volatile("s_waitcnt vmcnt(0)" ::: "memory");
        if (lane == 0) __hip_atomic_fetch_add(cnt + 64 * u.pm, 1u, __ATOMIC_RELAXED, __HIP_MEMORY_SCOPE_AGENT);
        if (wid == 0) {
            bool dead = false; const unsigned long long t0 = __builtin_amdgcn_s_memrealtime(); const unsigned want = 8u * (unsigned)ntn;
            for (;;) {
#if defined(BROKEN_EXCHANGE_NO_WAIT)
                break;
#endif
                if ((unsigned)__builtin_amdgcn_readfirstlane(__hip_atomic_load(cnt + 64 * u.pm, __ATOMIC_RELAXED, __HIP_MEMORY_SCOPE_AGENT)) >= want) break;
                if (__builtin_amdgcn_s_memrealtime() - t0 > 2000000ull) {
                    if (lane == 0) { unsigned expect = 0u; __hip_atomic_compare_exchange_strong(tmo + 1, &expect, code | (unsigned)(u.pm & 0xff), __ATOMIC_RELAXED, __ATOMIC_RELAXED, __HIP_MEMORY_SCOPE_AGENT);
                                     __hip_atomic_store(tmo, 1u, __ATOMIC_RELAXED, __HIP_MEMORY_SCOPE_AGENT); }
                    dead = true; break; }
                __builtin_amdgcn_s_sleep(2);
            }
            __builtin_amdgcn_fence(__ATOMIC_ACQUIRE, "agent");
            if (lane == 0) flag[0] = dead ? 1u : 0u;
        }
        asm volatile("s_waitcnt vmcnt(0) lgkmcnt(0)" ::: "memory"); __builtin_amdgcn_s_barrier(); asm volatile("" ::: "memory");
        const bool bad = flag[0] != 0u;
        if (lane < 32) {
            const unsigned long long* slot = (const unsigned long long*)xbuf + (size_t)(u.pm * BM + row) * 4; float mt[4], m2[4]; float ms = 0.f;
#pragma unroll
            for (int t = 0; t < 4; ++t) { if (t < ntn) { const unsigned long long w = __hip_atomic_load(slot + t, __ATOMIC_RELAXED, __HIP_MEMORY_SCOPE_AGENT); mt[t] = __uint_as_float((unsigned)w); m2[t] = __uint_as_float((unsigned)(w >> 32)); } else { mt[t] = 0.f; m2[t] = 0.f; } ms += mt[t]; }
            const float mean = ms / (float)ntn; float q = 0.f;
#pragma unroll
            for (int t = 0; t < 4; ++t) if (t < ntn) { const float dm = mt[t] - mean; q += m2[t] + 256.0f * dm * dm; }
            S[row] = (f32x2v){mean, 1.0f / sqrtf(q / (256.0f * (float)ntn) + eps)};
        }
        asm volatile("s_waitcnt lgkmcnt(0)" ::: "memory"); __builtin_amdgcn_s_barrier(); asm volatile("" ::: "memory");
        return bad;
    }
};
struct EpiLnRes {
    static constexpr bool PERM = false, AFTER_DRAIN = true;
    const float* base; float* out; int ldc; const float* bias; PanelStats st; unsigned poison;
    __device__ __forceinline__ void fused(f32x4 (&acc)[2][2][4][2], const Unit& u, int wr, int wc, int fr, int fq, PG8_LAS unsigned char* lds, int wid, int lane) const {
        typedef float f32x2v __attribute__((ext_vector_type(2)));
        const PG8_LAS f32x2v* S = (const PG8_LAS f32x2v*)(lds + 8192);
        const int col0 = u.pn * BM + wc * 32 + 4 * fq;
#pragma unroll
        for (int bj = 0; bj < 2; ++bj)
#pragma unroll
            for (int n = 0; n < 2; ++n) { const f32x4 bv = bias ? *(const f32x4*)(bias + col0 + bj * HALF + n * 16) : (f32x4){0.f, 0.f, 0.f, 0.f};
#pragma unroll
                for (int ai = 0; ai < 2; ++ai)
#pragma unroll
                    for (int m = 0; m < 4; ++m) acc[ai][bj][m][n] += bv; }
        f32x4 pre[4][2][2];
#pragma unroll
        for (int m = 0; m < 4; ++m) { const size_t off = (size_t)(u.pm * BM + wr * 64 + m * 16 + fr) * ldc + col0;
#pragma unroll
            for (int bj = 0; bj < 2; ++bj)
#pragma unroll
                for (int n = 0; n < 2; ++n) pre[m][bj][n] = *(const f32x4*)(base + off + bj * HALF + n * 16); }
        const bool bad = st.run(acc, u, wr, wc, fr, fq, lds, wid, lane) || poison != 0u;
        const float qnan = __builtin_nanf("");
#pragma unroll
        for (int ai = 0; ai < 2; ++ai)
#pragma unroll
            for (int m = 0; m < 4; ++m) { const int r = ai * HALF + wr * 64 + m * 16 + fr; const f32x2v sr = S[r]; const size_t off = (size_t)(u.pm * BM + r) * ldc + col0;
#pragma unroll
                for (int bj = 0; bj < 2; ++bj)
#pragma unroll
                    for (int n = 0; n < 2; ++n) { const f32x4 bs = ai == 0 ? pre[m][bj][n] : *(const f32x4*)(base + off + bj * HALF + n * 16); f32x4 o = bs + (acc[ai][bj][m][n] - sr.x) * sr.y;
                        if (bad) o = (f32x4){qnan, qnan, qnan, qnan}; *(f32x4*)(out + off + bj * HALF + n * 16) = o; }
                if (m & 1) asm volatile("" ::: "memory"); }
    }
};
struct EpiLnResLn {
    static constexpr bool PERM = false, AFTER_DRAIN = true;
    const float* base; float* out; bf16_t* xn; int ldc; const float* bias; PanelStats st1, st2; unsigned poison;
    __device__ __forceinline__ void fused(f32x4 (&acc)[2][2][4][2], const Unit& u, int wr, int wc, int fr, int fq, PG8_LAS unsigned char* lds, int wid, int lane) const {
        typedef float f32x2v __attribute__((ext_vector_type(2))); typedef unsigned u32x2v __attribute__((ext_vector_type(2)));
        const PG8_LAS f32x2v* S = (const PG8_LAS f32x2v*)(lds + 8192);
        const int col0 = u.pn * BM + wc * 32 + 4 * fq;
#pragma unroll
        for (int bj = 0; bj < 2; ++bj)
#pragma unroll
            for (int n = 0; n < 2; ++n) { const f32x4 bv = bias ? *(const f32x4*)(bias + col0 + bj * HALF + n * 16) : (f32x4){0.f, 0.f, 0.f, 0.f};
#pragma unroll
                for (int ai = 0; ai < 2; ++ai)
#pragma unroll
                    for (int m = 0; m < 4; ++m) acc[ai][bj][m][n] += bv; }
        bool bad = st1.run(acc, u, wr, wc, fr, fq, lds, wid, lane) || poison != 0u;
        const float qnan = __builtin_nanf("");
#pragma unroll
        for (int ai = 0; ai < 2; ++ai)
#pragma unroll
            for (int m = 0; m < 4; ++m) { const int r = ai * HALF + wr * 64 + m * 16 + fr; const f32x2v sr = S[r]; const size_t off = (size_t)(u.pm * BM + r) * ldc + col0;
#pragma unroll
                for (int bj = 0; bj < 2; ++bj)
#pragma unroll
                    for (int n = 0; n < 2; ++n) { const f32x4 bs = *(const f32x4*)(base + off + bj * HALF + n * 16); acc[ai][bj][m][n] = bs + (acc[ai][bj][m][n] - sr.x) * sr.y; }
                asm volatile("" : "+v"(acc[ai][0][m][0]), "+v"(acc[ai][0][m][1]), "+v"(acc[ai][1][m][0]), "+v"(acc[ai][1][m][1]));
                if (m & 1) asm volatile("" ::: "memory"); }
        const bool bad1 = bad;
        bad = st2.run(acc, u, wr, wc, fr, fq, lds, wid, lane) || bad;
#pragma unroll
        for (int ai = 0; ai < 2; ++ai)
#pragma unroll
            for (int m = 0; m < 4; ++m) { const int r = ai * HALF + wr * 64 + m * 16 + fr; const f32x2v sr = S[r]; const size_t off = (size_t)(u.pm * BM + r) * ldc + col0;
#pragma unroll
                for (int bj = 0; bj < 2; ++bj)
#pragma unroll
                    for (int n = 0; n < 2; ++n) { const f32x4 x1 = acc[ai][bj][m][n]; *(f32x4*)(out + off + bj * HALF + n * 16) = bad1 ? (f32x4){qnan, qnan, qnan, qnan} : x1;
                        const f32x4 o = (x1 - sr.x) * sr.y; u32x2v w; w.x = cvt_pk_bf16(o[0], o[1]); w.y = cvt_pk_bf16(o[2], o[3]);
                        if (bad) { w.x = 0x7fc07fc0u; w.y = 0x7fc07fc0u; } *(u32x2v*)(xn + off + bj * HALF + n * 16) = w; }
                asm volatile("" ::: "memory"); }
    }
};

template <class E, class = void> struct has_mid { static constexpr bool value = false; };
template <class E> struct has_mid<E, decltype((void)E::MID_T)> { static constexpr bool value = true; };
template <class Epi, class Sched, bool ALIGN_EPI = false, bool SP2 = false, bool GATHER = false>
__device__ __forceinline__ void gemm_phase(PG8_LAS unsigned char* lds, const Gemm g, const Sched& S, const Epi& E) {
    int tid_ = threadIdx.x; asm volatile("" : "+v"(tid_));
    const int tid = tid_, wid = __builtin_amdgcn_readfirstlane(tid >> 6), lane = tid & 63, wr = wid >> 2, wc = wid & 3, fr = lane & 15, fq = lane >> 4;
    int K_ = g.K; asm volatile("" : "+s"(K_));
    const int K = K_, nt = K / BK;
    unsigned voffA[2], voffB[2]; int stR[2], stC[2]; static_assert(!GATHER || SP2, "GATHER needs SP2");
#pragma unroll
    for (int i = 0; i < 2; ++i) { int R, C; stage_rc(tid * 16 + i * 8192, R, C); stR[i] = R; stC[i] = C; const int Rb = Epi::PERM ? ((R & ~31) + perm32(R & 31)) : R;
        voffA[i] = (unsigned)(R * K + C) * 2u; voffB[i] = (unsigned)(Rb * K + C) * 2u; }
    const size_t kstep = (size_t)(BK * 2);
    const size_t hstep = (size_t)HALF * K * 2;
    const size_t tstep = 2 * hstep;
    const unsigned ldsw = (unsigned)wid * 1024u;
    const int aoff = lds_byte(wr * 64 + fr, fq * 8), boff = lds_byte(wc * 32 + fr, fq * 8);
#define PG8_SA(b, h) (((b) * 2 + (h)) * HTB)
#define PG8_SB(b, h) ((4 + (b) * 2 + (h)) * HTB)
#define PG8_STAGE(bufoff, gbase, voff) do { _Pragma("unroll") for (int _i = 0; _i < 2; ++_i) \
        __builtin_amdgcn_global_load_lds((const unsigned*)((const char*)(gbase) + (voff)[_i]), (PG8_LAS unsigned*)(lds + (bufoff) + ldsw + _i * 8192), 16, 0, 0); } while (0)
#define PG8_STAGE_A(bufoff, base, h, vsel) do { if constexpr (GATHER) { _Pragma("unroll") for (int _i = 0; _i < 2; ++_i) \
        __builtin_amdgcn_global_load_lds((const unsigned*)((const char*)(base) + (vsel)[h][_i]), (PG8_LAS unsigned*)(lds + (bufoff) + ldsw + _i * 8192), 16, 0, 0); } \
        else { PG8_STAGE(bufoff, (base) + (h) * hstep, voffA); } } while (0)
#define PG8_GOFF(dst, u) do { _Pragma("unroll") for (int _h = 0; _h < 2; ++_h) _Pragma("unroll") for (int _i = 0; _i < 2; ++_i) dst[_h][_i] = (unsigned)S.arow(u, _h * HALF + stR[_i]) * (unsigned)(K * 2) + (unsigned)(stC[_i] * 2); } while (0)
#define PG8_LDA(dst, b, h) do { _Pragma("unroll") for (int m = 0; m < 4; ++m) _Pragma("unroll") for (int k = 0; k < 2; ++k) dst[m][k] = *(const PG8_LAS bf16x8*)(lds + PG8_SA(b, h) + aoff + m * 2048 + k * 1024); } while (0)
#define PG8_LDB(dst, b, h) do { _Pragma("unroll") for (int n = 0; n < 2; ++n) _Pragma("unroll") for (int k = 0; k < 2; ++k) dst[n][k] = *(const PG8_LAS bf16x8*)(lds + PG8_SB(b, h) + boff + n * 2048 + k * 1024); } while (0)
#define PG8_MMA(ai, bj, At, Bt) do { __builtin_amdgcn_s_setprio(1); _Pragma("unroll") for (int m = 0; m < 4; ++m) _Pragma("unroll") for (int n = 0; n < 2; ++n) _Pragma("unroll") for (int k = 0; k < 2; ++k) \
        acc[ai][bj][m][n] = __builtin_amdgcn_mfma_f32_16x16x32_bf16(Bt[n][k], At[m][k], acc[ai][bj][m][n], 0, 0, 0); __builtin_amdgcn_s_setprio(0); } while (0)
#define PG8_WAIT_V(n) asm volatile("s_waitcnt vmcnt(" #n ")" ::: "memory")
#define PG8_WAIT_L(n) asm volatile("s_waitcnt lgkmcnt(" #n ")" ::: "memory")
#define PG8_BAR __builtin_amdgcn_s_barrier()
#define PG8_SCHED __builtin_amdgcn_sched_barrier(0)
    Unit cur, nxt; int ui = 0;
    if (!S.next(0, cur)) return;
    f32x4 acc[2][2][4][2];
#pragma unroll
    for (int a = 0; a < 2; ++a)
#pragma unroll
        for (int b = 0; b < 2; ++b)
#pragma unroll
            for (int m = 0; m < 4; ++m)
#pragma unroll
                for (int n = 0; n < 2; ++n) acc[a][b][m][n] = (f32x4){0.f, 0.f, 0.f, 0.f};
    bf16x8 At[4][2], B0[2][2], B1[2][2];
    unsigned gC[2][2] = {{0u, 0u}, {0u, 0u}}, gN[2][2] = {{0u, 0u}, {0u, 0u}}, gS[2][2] = {{0u, 0u}, {0u, 0u}};
    if constexpr (GATHER) PG8_GOFF(gC, cur);
    const char* cA = GATHER ? (const char*)g.A : (const char*)g.A + (size_t)cur.pm * tstep; const char* cB = (const char*)g.Bt + (size_t)cur.pn * tstep;
    S.a_ready(cur);
    if constexpr (SP2) {
        PG8_STAGE(PG8_SB(0, 0), cB, voffB); PG8_STAGE(PG8_SB(0, 1), cB + hstep, voffB); PG8_STAGE_A(PG8_SA(0, 0), cA, 0, gC); PG8_STAGE_A(PG8_SA(0, 1), cA, 1, gC);
        if (wr == 1) PG8_BAR;
        PG8_WAIT_V(2); PG8_BAR;
        PG8_STAGE(PG8_SB(1, 0), cB + kstep, voffB); PG8_STAGE_A(PG8_SA(1, 0), cA + kstep, 0, gC); PG8_STAGE(PG8_SB(1, 1), cB + hstep + kstep, voffB);
        PG8_WAIT_V(6); PG8_BAR;
    } else {
        PG8_STAGE(PG8_SB(0, 0), cB, voffB); PG8_STAGE(PG8_SA(0, 0), cA, voffA); PG8_STAGE(PG8_SB(0, 1), cB + hstep, voffB); PG8_STAGE(PG8_SA(0, 1), cA + hstep, voffA);
        if (wr == 1) PG8_BAR;
        PG8_WAIT_V(4); PG8_BAR;
        PG8_STAGE(PG8_SB(1, 0), cB + kstep, voffB); PG8_STAGE(PG8_SA(1, 0), cA + kstep, voffA); PG8_STAGE(PG8_SB(1, 1), cB + hstep + kstep, voffB);
        PG8_WAIT_V(6); PG8_BAR;
    }
    for (;;) {
        const bool has_next = S.next(ui + 1, nxt);
        if constexpr (GATHER) { if (has_next) PG8_GOFF(gN, nxt); else { _Pragma("unroll") for (int _h = 0; _h < 2; ++_h) _Pragma("unroll") for (int _i = 0; _i < 2; ++_i) gN[_h][_i] = gC[_h][_i]; } }
        const char* nA = GATHER ? (const char*)g.A : (has_next ? (const char*)g.A + (size_t)nxt.pm * tstep : cA); const char* nB = has_next ? (const char*)g.Bt + (size_t)nxt.pn * tstep : cB;
        for (int t = 0; t < nt; t += 2) {
            const bool last = (t == nt - 2);
            const char* a1 = cA + (size_t)(t + 1) * kstep;
            const char* a2 = last ? nA : cA + (size_t)(t + 2) * kstep; const char* b2 = last ? nB : cB + (size_t)(t + 2) * kstep;
            const char* a3 = a2 + kstep; const char* b3 = b2 + kstep;
            if (last && has_next) S.a_ready(nxt);
            if constexpr (has_mid<Epi>::value) { if (t == Epi::MID_T) E.mid(acc, cur, wr, wc, fr, fq); }
            if constexpr (GATHER) { _Pragma("unroll") for (int _h = 0; _h < 2; ++_h) _Pragma("unroll") for (int _i = 0; _i < 2; ++_i) gS[_h][_i] = last ? gN[_h][_i] : gC[_h][_i]; }
            if constexpr (SP2) {
            PG8_LDB(B0, 0, 0); PG8_LDB(B1, 0, 1); PG8_SCHED; PG8_LDA(At, 0, 0); PG8_STAGE_A(PG8_SA(1, 1), a1, 1, gC);
            PG8_WAIT_V(8); PG8_WAIT_L(0); PG8_BAR; PG8_MMA(0, 0, At, B0); PG8_MMA(0, 1, At, B1); PG8_BAR; PG8_SCHED;
            PG8_LDA(At, 0, 1); PG8_STAGE(PG8_SB(0, 0), b2, voffB); PG8_STAGE(PG8_SB(0, 1), b2 + hstep, voffB); PG8_STAGE_A(PG8_SA(0, 0), a2, 0, gS);
            PG8_WAIT_V(8); PG8_WAIT_L(0); PG8_BAR; PG8_MMA(1, 0, At, B0); PG8_MMA(1, 1, At, B1); PG8_BAR; PG8_SCHED;
            PG8_LDB(B0, 1, 0); PG8_LDB(B1, 1, 1); PG8_SCHED; PG8_LDA(At, 1, 0); PG8_STAGE_A(PG8_SA(0, 1), a2, 1, gS);
            PG8_WAIT_V(8); PG8_WAIT_L(0); PG8_BAR; PG8_MMA(0, 0, At, B0); PG8_MMA(0, 1, At, B1); PG8_BAR; PG8_SCHED;
            PG8_LDA(At, 1, 1); PG8_STAGE(PG8_SB(1, 0), b3, voffB); PG8_STAGE(PG8_SB(1, 1), b3 + hstep, voffB); PG8_STAGE_A(PG8_SA(1, 0), a3, 0, gS);
            PG8_WAIT_V(8); PG8_WAIT_L(0); PG8_BAR; PG8_MMA(1, 0, At, B0); PG8_MMA(1, 1, At, B1); PG8_BAR; PG8_SCHED;
            } else {
            PG8_LDB(B0, 0, 0); PG8_SCHED; PG8_LDA(At, 0, 0); PG8_STAGE(PG8_SA(1, 1), a1 + hstep, voffA);
            PG8_WAIT_L(8); PG8_BAR; PG8_WAIT_L(0); PG8_MMA(0, 0, At, B0); PG8_BAR; PG8_SCHED;
            PG8_LDB(B1, 0, 1); PG8_STAGE(PG8_SB(0, 0), b2, voffB);
            PG8_BAR; PG8_WAIT_L(0); PG8_MMA(0, 1, At, B1); PG8_BAR;
            PG8_LDA(At, 0, 1); PG8_STAGE(PG8_SA(0, 0), a2, voffA);
            PG8_BAR; PG8_WAIT_L(0); PG8_MMA(1, 0, At, B0); PG8_BAR; PG8_SCHED;
            PG8_STAGE(PG8_SB(0, 1), b2 + hstep, voffB);
            PG8_WAIT_V(6); PG8_BAR; PG8_MMA(1, 1, At, B1); PG8_BAR;
            PG8_LDB(B0, 1, 0); PG8_SCHED; PG8_LDA(At, 1, 0); PG8_STAGE(PG8_SA(0, 1), a2 + hstep, voffA);
            PG8_WAIT_L(8); PG8_BAR; PG8_WAIT_L(0); PG8_MMA(0, 0, At, B0); PG8_BAR; PG8_SCHED;
            PG8_LDB(B1, 1, 1); PG8_STAGE(PG8_SB(1, 0), b3, voffB);
            PG8_BAR; PG8_WAIT_L(0); PG8_MMA(0, 1, At, B1); PG8_BAR;
            PG8_LDA(At, 1, 1); PG8_STAGE(PG8_SA(1, 0), a3, voffA);
            PG8_BAR; PG8_WAIT_L(0); PG8_MMA(1, 0, At, B0); PG8_BAR; PG8_SCHED;
            PG8_STAGE(PG8_SB(1, 1), b3 + hstep, voffB);
            PG8_WAIT_V(6); PG8_BAR; PG8_MMA(1, 1, At, B1); PG8_BAR;
            }
        }
        if constexpr (ALIGN_EPI) { if (wr == 0) PG8_BAR; }
        if constexpr (!Epi::AFTER_DRAIN) { E(acc, cur, wr, wc, fr, fq); S.done(cur); }
        if (!has_next) break;
#pragma unroll
        for (int a = 0; a < 2; ++a)
#pragma unroll
            for (int b = 0; b < 2; ++b)
#pragma unroll
                for (int m = 0; m < 4; ++m)
#pragma unroll
                    for (int n = 0; n < 2; ++n) acc[a][b][m][n] = (f32x4){0.f, 0.f, 0.f, 0.f};
        cur = nxt; cA = nA; cB = nB; ++ui;
        if constexpr (GATHER) { _Pragma("unroll") for (int _h = 0; _h < 2; ++_h) _Pragma("unroll") for (int _i = 0; _i < 2; ++_i) gC[_h][_i] = gN[_h][_i]; }
        if constexpr (ALIGN_EPI) { if (wr == 1) PG8_BAR; }
    }
    PG8_WAIT_V(0);
    if constexpr (!ALIGN_EPI) { if (wr == 0) PG8_BAR; }
    PG8_BAR;
    if constexpr (Epi::AFTER_DRAIN) { E.fused(acc, cur, wr, wc, fr, fq, lds, wid, lane); S.done(cur); }
#undef PG8_SA
#undef PG8_SB
#undef PG8_STAGE
#undef PG8_STAGE_A
#undef PG8_GOFF
#undef PG8_LDA
#undef PG8_LDB
#undef PG8_MMA
#undef PG8_WAIT_V
#undef PG8_WAIT_L
#undef PG8_BAR
#undef PG8_SCHED
}
}

#ifndef PG8_SP2
#define PG8_SP2 true
#endif
#ifndef PG8_ALIGN
#define PG8_ALIGN true
#endif

namespace nv {
constexpr int NTOK = 16384, D = 1024, SEQ = 4096, INC = 2464;
constexpr int O_CQ = 0, O_CKV = 256, O_KR = 384, O_F = 416, O_I = 928, O_Q = 1440, O_G = 1952;
constexpr int NEXP = 32, PSLOTS = 36864, NBLK = 288;
constexpr float ALPHA = 1.189207115002721f;
constexpr float RMS_EPS = 1e-6f, LN_EPS = 1e-5f;

template <class F>
__device__ __forceinline__ void ngemm(LAS unsigned char* lds, int M, int N, int K, const F& f) {
    LAS float* As = (LAS float*)lds;
    LAS float* Bs = As + 16 * 132;
    const int tid = threadIdx.x, tx = tid & 15, ty = tid >> 4;
    const int tn = (N + 63) / 64, tm = (M + 127) / 128;
    for (int tile = blockIdx.x; tile < tn * tm; tile += gridDim.x) {
        const int m0 = (tile / tn) * 128, n0 = (tile % tn) * 64;
        float acc[4][4];
#pragma unroll
        for (int i = 0; i < 4; ++i)
#pragma unroll
            for (int j = 0; j < 4; ++j) acc[i][j] = 0.f;
        for (int k0 = 0; k0 < K; k0 += 16) {
#pragma unroll
            for (int i = 0; i < 4; ++i) { const int idx = tid + i * 512; const int r = idx >> 4, kk = idx & 15; As[kk * 132 + r] = (m0 + r < M) ? f.a(m0 + r, k0 + kk) : 0.f; }
#pragma unroll
            for (int i = 0; i < 2; ++i) { const int idx = tid + i * 512; const int kk = idx >> 6, c = idx & 63; Bs[kk * 68 + c] = (n0 + c < N) ? f.b(k0 + kk, n0 + c, m0) : 0.f; }
            __syncthreads();
#pragma unroll
            for (int kk = 0; kk < 16; ++kk) {
                float a[4], b[4];
#pragma unroll
                for (int i = 0; i < 4; ++i) { a[i] = As[kk * 132 + ty * 4 + i]; b[i] = Bs[kk * 68 + tx * 4 + i]; }
#pragma unroll
                for (int i = 0; i < 4; ++i)
#pragma unroll
                    for (int j = 0; j < 4; ++j) acc[i][j] += a[i] * b[j];
            }
            __syncthreads();
        }
#pragma unroll
        for (int i = 0; i < 4; ++i)
#pragma unroll
            for (int j = 0; j < 4; ++j) { const int r = m0 + ty * 4 + i, c = n0 + tx * 4 + j; if (r < M && c < N) f.epi(r, c, acc[i][j]); }
    }
}

struct ProjF { const float* x; const float* w; float* out;
    __device__ float a(int r, int k) const { return x[(size_t)r * D + k]; }
    __device__ float b(int k, int c, int) const { return w[(size_t)k * INC + c]; }
    __device__ void epi(int r, int c, float v) const { out[(size_t)r * INC + c] = v; } };
struct PlainF { const float* A; int lda; const float* B; int ldb; float* C; int ldc;
    __device__ float a(int r, int k) const { return A[(size_t)r * lda + k]; }
    __device__ float b(int k, int c, int) const { return B[(size_t)k * ldb + c]; }
    __device__ void epi(int r, int c, float v) const { C[(size_t)r * ldc + c] = v; } };
struct MixF { const float* an; const float* rr; const float* w; const float* x; float* t;
    __device__ float a(int r, int k) const { return k < 512 ? an[(size_t)r * 512 + k] : rr[(size_t)r * 512 + k - 512]; }
    __device__ float b(int k, int c, int) const { return w[(size_t)k * D + c]; }
    __device__ void epi(int r, int c, float v) const { t[(size_t)r * D + c] = ALPHA * x[(size_t)r * D + c] + v; } };
struct Moe1F { const float* h1; const int* slot_tok; const int* blk_exp; const float* w; float* H; int which;
    __device__ float a(int r, int k) const { const int tok = slot_tok[r]; return tok < NTOK ? h1[(size_t)tok * D + k] : 0.f; }
    __device__ float b(int k, int c, int m0) const { const int e = blk_exp[m0 >> 7]; return w[((size_t)e * D + k) * 512 + c]; }
    __device__ void epi(int r, int c, float v) const { float* p = H + (size_t)r * 512 + c; if (which == 0) *p = v / (1.f + expf(-v)); else *p *= v; } };
struct Moe2F { const float* H; const int* slot_tok; const float* slot_gate; const int* blk_exp; const float* w; float* acc;
    __device__ float a(int r, int k) const { return H[(size_t)r * 512 + k]; }
    __device__ float b(int k, int c, int m0) const { const int e = blk_exp[m0 >> 7]; return w[((size_t)e * 512 + k) * D + c]; }
    __device__ void epi(int r, int c, float v) const { const int tok = slot_tok[r]; if (tok < NTOK) atomicAdd(acc + (size_t)tok * D + c, slot_gate[r] * v); } };

__device__ __forceinline__ float wsum(float v) {
#pragma unroll
    for (int o = 1; o < 64; o <<= 1) v += __shfl_xor(v, o);
    return v;
}
__device__ __forceinline__ int tidx() { int t = threadIdx.x; asm volatile("" : "+v"(t)); return t; }
#define GTID (blockIdx.x * NTHREADS + nv::tidx())
#define GTHREADS (gridDim.x * NTHREADS)
#define GWAVE (blockIdx.x * NWAVES + (nv::tidx() >> 6))
#define GWAVES (gridDim.x * NWAVES)

__device__ __forceinline__ void hg_gate(float* proj, const float* lbl) {
    for (int i = GTID; i < NTOK * 512; i += GTHREADS) {
        const int r = i >> 9, c = i & 511;
        const float l0 = lbl[c], l1 = lbl[512 + c]; const float mx = fmaxf(l0, l1);
        const float e0 = expf(l0 - mx), e1 = expf(l1 - mx); const float lb = e0 / (e0 + e1);
        float* p = proj + (size_t)r * INC + O_F + c; const float z = *p;
        *p = lb + (1.f - lb) * (1.f / (1.f + expf(-z)));
    }
}
__device__ __forceinline__ void hg_rec(float* proj) {
    if (blockIdx.x >= 16 || threadIdx.x >= 128) return;
    const int bh = blockIdx.x, b = bh >> 2, h = bh & 3, e = threadIdx.x;
    float S[128];
#pragma unroll
    for (int d = 0; d < 128; ++d) S[d] = 0.f;
    for (int t = 0; t < SEQ; ++t) {
        float* row = proj + (size_t)(b * SEQ + t) * INC;
        const float v = row[O_I + h * 128 + e];
        const float* fr = row + O_F + h * 128; const float* qr = row + O_Q + h * 128;
        float o = 0.f;
#pragma unroll
        for (int d = 0; d < 128; ++d) { const float f = fr[d]; S[d] = f * S[d] + (1.f - f) * v; o += qr[d] * S[d]; }
        row[O_I + h * 128 + e] = o;
    }
}
__device__ __forceinline__ void hg_out(const float* proj, const float* g, float* rr) {
    const int lane = nv::tidx() & 63;
    for (int w = GWAVE; w < NTOK * 4; w += GWAVES) {
        const int r = w >> 2, h = w & 3; const float* row = proj + (size_t)r * INC;
        const float o0 = row[O_I + h * 128 + lane], o1 = row[O_I + h * 128 + 64 + lane];
        const float ss = wsum(o0 * o0 + o1 * o1); const float rs = 1.f / sqrtf(ss * (1.f / 128.f) + RMS_EPS);
        const float g0 = row[O_G + h * 128 + lane], g1 = row[O_G + h * 128 + 64 + lane];
        rr[(size_t)r * 512 + h * 128 + lane] = o0 * rs * g[lane] * (g0 / (1.f + expf(-g0)));
        rr[(size_t)r * 512 + h * 128 + 64 + lane] = o1 * rs * g[64 + lane] * (g1 / (1.f + expf(-g1)));
    }
}
__device__ __forceinline__ void cs_tab(const int* pos, float* cs) {
    for (int i = GTID; i < NTOK * 16; i += GTHREADS) {
        const int j = i & 15, r = i >> 4;
        const float invf = (float)pow(10000.0, -(double)(2 * j) / 32.0);
        const float ang = (float)pos[r] * invf;
        double s, c; sincos((double)ang, &s, &c);
        cs[(size_t)r * 32 + j] = (float)c; cs[(size_t)r * 32 + 16 + j] = (float)s;
    }
}
__device__ __forceinline__ void mla_prep(const float* proj, const float* gq, const float* gkv, const float* cs, float* cqn, float* ckvn, float* kr) {
    const int lane = nv::tidx() & 63;
    for (int r = GWAVE; r < NTOK; r += GWAVES) {
        const float* row = proj + (size_t)r * INC;
        float v[4]; float ss = 0.f;
#pragma unroll
        for (int i = 0; i < 4; ++i) { v[i] = row[O_CQ + lane + 64 * i]; ss += v[i] * v[i]; }
        ss = wsum(ss); float rs = 1.f / sqrtf(ss * (1.f / 256.f) + RMS_EPS);
#pragma unroll
        for (int i = 0; i < 4; ++i) cqn[(size_t)r * 256 + lane + 64 * i] = v[i] * rs * gq[lane + 64 * i];
        float u0 = row[O_CKV + lane], u1 = row[O_CKV + 64 + lane];
        ss = wsum(u0 * u0 + u1 * u1); rs = 1.f / sqrtf(ss * (1.f / 128.f) + RMS_EPS);
        ckvn[(size_t)r * 128 + lane] = u0 * rs * gkv[lane]; ckvn[(size_t)r * 128 + 64 + lane] = u1 * rs * gkv[64 + lane];
        if (lane < 16) { const float x1 = row[O_KR + lane], x2 = row[O_KR + 16 + lane]; const float c = cs[(size_t)r * 32 + lane], s = cs[(size_t)r * 32 + 16 + lane];
            kr[(size_t)r * 32 + lane] = x1 * c - x2 * s; kr[(size_t)r * 32 + 16 + lane] = x2 * c + x1 * s; }
    }
}
__device__ __forceinline__ void q_rope(float* q, const float* cs) {
    for (int i = GTID; i < NTOK * 8 * 16; i += GTHREADS) {
        const int j = i & 15, h = (i >> 4) & 7, r = i >> 7;
        float* p = q + (size_t)r * 768 + h * 96 + 64; const float x1 = p[j], x2 = p[16 + j]; const float c = cs[(size_t)r * 32 + j], s = cs[(size_t)r * 32 + 16 + j];
        p[j] = x1 * c - x2 * s; p[16 + j] = x2 * c + x1 * s;
    }
}
__device__ __forceinline__ void attn_naive(const float* q, const float* kv, const float* kr, float* out) {
    const int lane = nv::tidx() & 63;
    for (int task = GWAVE; task < 2048; task += GWAVES) {
        const int tsk = __builtin_amdgcn_readfirstlane(task);
        const int qc = 63 - (tsk >> 5), h = tsk & 7, b = (tsk >> 3) & 3;
        const int t = qc * 64 + lane; const size_t row = (size_t)b * SEQ + t;
        const float scale = 0.10206207261596575f;
        float qv[96];
#pragma unroll
        for (int d = 0; d < 96; ++d) qv[d] = q[row * 768 + h * 96 + d] * scale;
        float o[64];
#pragma unroll
        for (int d = 0; d < 64; ++d) o[d] = 0.f;
        float m = -INFINITY, l = 0.f;
        const int nk = (qc + 1) * 64;
        for (int s = 0; s < nk; ++s) {
            const size_t kr_ = (size_t)b * SEQ + s;
            const float* kp = kv + kr_ * 1024 + h * 128; const float* rp = kr + kr_ * 32;
            float sc = 0.f;
#pragma unroll
            for (int d = 0; d < 64; ++d) sc += qv[d] * kp[d];
#pragma unroll
            for (int d = 0; d < 32; ++d) sc += qv[64 + d] * rp[d];
            const float mn = fmaxf(m, sc); const float corr = expf(m - mn), p = expf(sc - mn);
            l = l * corr + p;
#pragma unroll
            for (int d = 0; d < 64; ++d) o[d] = o[d] * corr + p * kp[64 + d];
            m = mn;
        }
        const float il = 1.f / l;
#pragma unroll
        for (int d = 0; d < 64; ++d) out[row * 512 + h * 64 + d] = o[d] * il;
    }
}
__device__ __forceinline__ void a_norm(float* a, const float* g) {
    const int lane = nv::tidx() & 63;
    for (int r = GWAVE; r < NTOK; r += GWAVES) {
        float v[8]; float ss = 0.f;
#pragma unroll
        for (int i = 0; i < 8; ++i) { v[i] = a[(size_t)r * 512 + lane + 64 * i]; ss += v[i] * v[i]; }
        ss = wsum(ss); const float rs = 1.f / sqrtf(ss * (1.f / 512.f) + RMS_EPS);
#pragma unroll
        for (int i = 0; i < 8; ++i) a[(size_t)r * 512 + lane + 64 * i] = v[i] * rs * g[lane + 64 * i];
    }
}
__device__ __forceinline__ void ln_rows(const float* in, const float* add, float addscale_in, const float* g, const float* bb, float* out) {
    const int lane = nv::tidx() & 63;
    for (int r = GWAVE; r < NTOK; r += GWAVES) {
        float v[16]; float s = 0.f;
#pragma unroll
        for (int i = 0; i < 16; ++i) { const size_t o = (size_t)r * D + lane + 64 * i; v[i] = addscale_in * in[o] + (add ? add[o] : 0.f); s += v[i]; }
        const float mean = wsum(s) * (1.f / D); float q = 0.f;
#pragma unroll
        for (int i = 0; i < 16; ++i) { v[i] -= mean; q += v[i] * v[i]; }
        const float rs = 1.f / sqrtf(wsum(q) * (1.f / D) + LN_EPS);
#pragma unroll
        for (int i = 0; i < 16; ++i) { const int c = lane + 64 * i; out[(size_t)r * D + c] = v[i] * rs * g[c] + bb[c]; }
    }
}
__device__ __forceinline__ void router(const float* h1, const float* wg, const float* bg, const float* we, const float* be, int* cnt, int* tok_e, int* tok_rank, float* tok_gate) {
    const int lane = nv::tidx() & 63;
    for (int r = GWAVE; r < NTOK; r += GWAVES) {
        float lg[36];
#pragma unroll
        for (int c = 0; c < 36; ++c) lg[c] = 0.f;
        for (int i = 0; i < 16; ++i) { const int k = lane + 64 * i; const float xv = h1[(size_t)r * D + k];
#pragma unroll
            for (int c = 0; c < 4; ++c) lg[c] += xv * wg[k * 4 + c];
#pragma unroll
            for (int c = 0; c < 32; ++c) lg[4 + c] += xv * we[k * 32 + c]; }
#pragma unroll
        for (int c = 0; c < 36; ++c) lg[c] = wsum(lg[c]);
#pragma unroll
        for (int c = 0; c < 4; ++c) lg[c] += bg[c];
#pragma unroll
        for (int c = 0; c < 32; ++c) lg[4 + c] += be[c];
        int grp = 0; float gm = lg[0];
#pragma unroll
        for (int c = 1; c < 4; ++c) if (lg[c] > gm) { gm = lg[c]; grp = c; }
        float den = 0.f;
#pragma unroll
        for (int c = 0; c < 4; ++c) den += expf(lg[c] - gm);
        const float pgrp = 1.f / den;
        float ein[8];
#pragma unroll
        for (int j = 0; j < 8; ++j) ein[j] = grp == 0 ? lg[4 + j] : grp == 1 ? lg[12 + j] : grp == 2 ? lg[20 + j] : lg[28 + j];
        int i0 = 0; float v0 = ein[0];
#pragma unroll
        for (int j = 1; j < 8; ++j) if (ein[j] > v0) { v0 = ein[j]; i0 = j; }
        int i1 = -1; float v1 = -INFINITY;
#pragma unroll
        for (int j = 0; j < 8; ++j) if (j != i0 && ein[j] > v1) { v1 = ein[j]; i1 = j; }
        const float e1 = expf(v1 - v0); const float p0 = 1.f / (1.f + e1), p1 = e1 / (1.f + e1);
        if (lane == 0) {
            const int ea = grp * 8 + i0, eb = grp * 8 + i1;
            tok_e[2 * r] = ea; tok_e[2 * r + 1] = eb;
            tok_rank[2 * r] = atomicAdd(cnt + ea, 1); tok_rank[2 * r + 1] = atomicAdd(cnt + eb, 1);
            tok_gate[2 * r] = pgrp * p0; tok_gate[2 * r + 1] = pgrp * p1;
        }
    }
}
__device__ __forceinline__ void prefix(const int* cnt, int* pad_start, int* blk_exp) {
    if (threadIdx.x != 0 || blockIdx.x != 0) return;
    int acc = 0;
    for (int e = 0; e < NEXP; ++e) { pad_start[e] = acc; acc += ((__hip_atomic_load(cnt + e, __ATOMIC_RELAXED, __HIP_MEMORY_SCOPE_AGENT) + 127) / 128) * 128; pad_start[NEXP + e] = acc; }
    for (int b = 0; b < NBLK; ++b) { int c = 0; for (int e = 0; e < NEXP; ++e) c += (pad_start[NEXP + e] <= b * 128) ? 1 : 0; blk_exp[b] = c < NEXP - 1 ? c : NEXP - 1; }
}
__device__ __forceinline__ void slot_init(int* slot_tok, float* slot_gate) { for (int i = GTID; i < PSLOTS; i += GTHREADS) { slot_tok[i] = NTOK; slot_gate[i] = 0.f; } }
__device__ __forceinline__ void slot_fill(const int* tok_e, const int* tok_rank, const float* tok_gate, const int* pad_start, int* slot_tok, float* slot_gate) {
    for (int i = GTID; i < NTOK * 2; i += GTHREADS) { const int s = pad_start[tok_e[i]] + tok_rank[i]; slot_tok[s] = i >> 1; slot_gate[s] = tok_gate[i]; }
}
__device__ __forceinline__ void zero_f32(float* p, size_t n) { for (size_t i = GTID; i < n / 4; i += GTHREADS) ((float4*)p)[i] = make_float4(0.f, 0.f, 0.f, 0.f); }
}


namespace op {
using pg8::f32x4; using pg8::Unit; using pg8::bf16_t;
typedef unsigned v4u __attribute__((ext_vector_type(4)));
#define GAS __attribute__((address_space(1)))
__device__ __forceinline__ unsigned f2bf(float f) { unsigned u = __builtin_bit_cast(unsigned, f); return (u + 0x7fffu + ((u >> 16) & 1u)) >> 16; }
__device__ __forceinline__ unsigned pk2(float lo, float hi) { return f2bf(lo) | (f2bf(hi) << 16); }
__device__ __forceinline__ float bf2f(unsigned short b) { return __builtin_bit_cast(float, (unsigned)b << 16); }

template <class RowMap>
__device__ __forceinline__ void transpose_item(const float* W, int K, int N, bf16_t* WT, LAS float* scr, int item, int lane, const RowMap& rm) {
    const int nblk = N / 32, kb = item / nblk, nb = item % nblk, k0 = 64 * kb, n0 = 32 * nb;
#pragma unroll 8
    for (int i = 0; i < 32; ++i) { const int kk = 2 * i + (lane >> 5); scr[kk * 33 + (lane & 31)] = rm.scale(n0 + (lane & 31), k0 + kk) * W[(size_t)(k0 + kk) * N + n0 + (lane & 31)]; }
    asm volatile("s_waitcnt lgkmcnt(0)" ::: "memory");
    const int c = lane & 7;
#pragma unroll
    for (int j = 0; j < 4; ++j) { const int n = (lane >> 3) + 8 * j; const LAS float* s = scr + (8 * c) * 33 + n;
        v4u o; o.x = pk2(s[0 * 33], s[1 * 33]); o.y = pk2(s[2 * 33], s[3 * 33]); o.z = pk2(s[4 * 33], s[5 * 33]); o.w = pk2(s[6 * 33], s[7 * 33]);
        *(GAS v4u*)(WT + (size_t)rm.row(n0 + n) * K + k0 + 8 * c) = o; }
    asm volatile("s_waitcnt lgkmcnt(0)" ::: "memory");
}
struct RowId { __device__ __forceinline__ int row(int n) const { return n; } __device__ __forceinline__ float scale(int, int) const { return 1.f; } };

__device__ __forceinline__ void cvt_rows_bf16(const float* src, bf16_t* dst, size_t n) {
    for (size_t i = GTID; i < n / 8; i += GTHREADS) { const float4 a = ((const float4*)src)[2 * i], b = ((const float4*)src)[2 * i + 1];
        v4u o; o.x = pk2(a.x, a.y); o.y = pk2(a.z, a.w); o.z = pk2(b.x, b.y); o.w = pk2(b.z, b.w); ((v4u*)dst)[i] = o; }
}

struct EpiF32Nat { static constexpr bool PERM = false, AFTER_DRAIN = false;
    float* C; int ldc; int ncols;
    __device__ __forceinline__ void operator()(const f32x4 (&acc)[2][2][4][2], const Unit& u, int wr, int wc, int fr, int fq) const {
        const int row0 = u.pm * 256 + wr * 64 + fr, col0 = u.pn * 256 + wc * 32 + 4 * fq;
#pragma unroll
        for (int ai = 0; ai < 2; ++ai)
#pragma unroll
            for (int m = 0; m < 4; ++m) { float* rowp = C + (size_t)(row0 + ai * 128 + m * 16) * ldc;
#pragma unroll
                for (int bj = 0; bj < 2; ++bj)
#pragma unroll
                    for (int n = 0; n < 2; ++n) { const int c = col0 + bj * 128 + n * 16; if (c < ncols) *(f32x4*)(rowp + c) = acc[ai][bj][m][n]; } }
    }
};
}

namespace op {
struct RowProj {
    __device__ __forceinline__ int row(int n) const {
        if (n < 384) return n;
        if (n < 416) { const int j = n - 384, jj = j & 15, a = jj >> 2, b = jj & 3; return 384 + 8 * a + b + (j >= 16 ? 4 : 0); }
        return n + 96;
    }
    __device__ __forceinline__ float scale(int, int) const { return 1.f; }
};
__device__ __forceinline__ v4u pack8(const f32x4& v0, const f32x4& v1) { v4u w; w.x = pk2(v0[0], v0[1]); w.y = pk2(v0[2], v0[3]); w.z = pk2(v1[0], v1[1]); w.w = pk2(v1[2], v1[3]); return w; }
__device__ __forceinline__ float dot4(const f32x4& v) { return (v[0] * v[0] + v[1] * v[1]) + (v[2] * v[2] + v[3] * v[3]); }

struct EpiProj { static constexpr bool PERM = true, AFTER_DRAIN = false;
    bf16_t *cq, *ckv, *kr, *kk, *vi; float* lf; float *ssq_q, *ssq_kv; const float* cs; const float* lbt;
    __device__ __forceinline__ void operator()(const f32x4 (&acc)[2][2][4][2], const Unit& u, int wr, int wc, int fr, int fq) const {
        const int pn = u.pn; const int row0 = u.pm * 256 + wr * 64 + fr; const int cl = wc * 32 + 8 * fq;
        if (pn == 0) {
#pragma unroll
            for (int ai = 0; ai < 2; ++ai)
#pragma unroll
                for (int m = 0; m < 4; ++m) { const int row = row0 + ai * 128 + m * 16; float s = 0.f;
#pragma unroll
                    for (int bj = 0; bj < 2; ++bj) { const f32x4 v0 = acc[ai][bj][m][0], v1 = acc[ai][bj][m][1]; s += dot4(v0) + dot4(v1);
                        *(v4u*)(cq + (size_t)row * 256 + bj * 128 + cl) = pack8(v0, v1); }
                    s += __shfl_xor(s, 16); s += __shfl_xor(s, 32); if (fq == 0) atomicAdd(ssq_q + row, s); }
        } else if (pn == 1) {
#pragma unroll
            for (int ai = 0; ai < 2; ++ai)
#pragma unroll
                for (int m = 0; m < 4; ++m) { const int row = row0 + ai * 128 + m * 16;
                    const f32x4 v0 = acc[ai][0][m][0], v1 = acc[ai][0][m][1]; float s = dot4(v0) + dot4(v1);
                    *(v4u*)(ckv + (size_t)row * 128 + cl) = pack8(v0, v1);
                    s += __shfl_xor(s, 16); s += __shfl_xor(s, 32); if (fq == 0) atomicAdd(ssq_kv + row, s);
                    if (wc == 0) { const f32x4 x1 = acc[ai][1][m][0], x2 = acc[ai][1][m][1];
                        const f32x4 c = *(const f32x4*)(cs + (size_t)row * 32 + 4 * fq), sn = *(const f32x4*)(cs + (size_t)row * 32 + 16 + 4 * fq);
                        *(v4u*)(kr + (size_t)row * 32 + 8 * fq) = pack8(x1 * c - x2 * sn, x2 * c + x1 * sn); } }
        } else if (pn < 4) {
            const int cb = (pn - 2) * 256;
#pragma unroll
            for (int bj = 0; bj < 2; ++bj) { const int col = cb + bj * 128 + cl;
#pragma unroll
                for (int n = 0; n < 2; ++n) { const f32x4 lb = *(const f32x4*)(lbt + col + 4 * n);
#pragma unroll
                    for (int ai = 0; ai < 2; ++ai)
#pragma unroll
                        for (int m = 0; m < 4; ++m) { const int row = row0 + ai * 128 + m * 16; f32x4 l, k;
#pragma unroll
                            for (int i = 0; i < 4; ++i) { const float e = __expf(-acc[ai][bj][m][n][i]), sg = __builtin_amdgcn_rcpf(1.f + e); const float om = 1.f - lb[i]; l[i] = __logf(lb[i] + om * sg); k[i] = om * e * sg; }
                            *(f32x4*)(lf + (size_t)row * 512 + col + 4 * n) = l;
                            typedef unsigned v2u __attribute__((ext_vector_type(2))); v2u w; w.x = pk2(k[0], k[1]); w.y = pk2(k[2], k[3]);
                            *(v2u*)(kk + (size_t)row * 512 + col + 4 * n) = w;
                            asm volatile("" ::: "memory"); } } }
        } else {
            bf16_t* dst = vi + (size_t)((pn - 4) >> 1) * ((size_t)16384 * 512); const int cb = (pn & 1) * 256;
#pragma unroll
            for (int ai = 0; ai < 2; ++ai)
#pragma unroll
                for (int m = 0; m < 4; ++m) { const int row = row0 + ai * 128 + m * 16;
#pragma unroll
                    for (int bj = 0; bj < 2; ++bj) *(v4u*)(dst + (size_t)row * 512 + cb + bj * 128 + cl) = pack8(acc[ai][bj][m][0], acc[ai][bj][m][1]); }
        }
    }
};
}

namespace nv {
using op::bf2f; typedef unsigned short bf16_t;
__device__ __forceinline__ void lb_tab(const float* lbl, float* lbt) {
    for (int c = GTID; c < 512; c += GTHREADS) { const float l0 = lbl[c], l1 = lbl[512 + c]; const float mx = fmaxf(l0, l1); const float e0 = expf(l0 - mx), e1 = expf(l1 - mx); lbt[c] = e0 / (e0 + e1); }
}
__device__ __forceinline__ void hg_f(const float* lf, float* fb) { for (size_t i = GTID; i < (size_t)NTOK * 512; i += GTHREADS) fb[i] = expf(lf[i]); }
__device__ __forceinline__ void hg_rec2(const float* fb, const bf16_t* kk, const bf16_t* vi, const bf16_t* qh, float* ob) {
    if (blockIdx.x >= 16 || threadIdx.x >= 128) return;
    const int bh = blockIdx.x, b = bh >> 2, h = bh & 3, e = threadIdx.x;
    float S[128];
#pragma unroll
    for (int d = 0; d < 128; ++d) S[d] = 0.f;
    for (int t = 0; t < SEQ; ++t) {
        const size_t base = (size_t)(b * SEQ + t) * 512 + h * 128;
        const float v = bf2f(vi[base + e]);
        float o = 0.f;
#pragma unroll
        for (int d = 0; d < 128; ++d) { const float f = fb[base + d]; S[d] = f * S[d] + bf2f(kk[base + d]) * v; o += bf2f(qh[base + d]) * S[d]; }
        ob[base + e] = o;
    }
}
__device__ __forceinline__ void hg_out2(const float* ob, const bf16_t* gh, const float* g, float* rr) {
    const int lane = nv::tidx() & 63;
    for (int w = GWAVE; w < NTOK * 4; w += GWAVES) {
        const size_t base = (size_t)(w >> 2) * 512 + (w & 3) * 128;
        const float o0 = ob[base + lane], o1 = ob[base + 64 + lane];
        const float ss = wsum(o0 * o0 + o1 * o1); const float rs = 1.f / sqrtf(ss * (1.f / 128.f) + RMS_EPS);
        const float g0 = bf2f(gh[base + lane]), g1 = bf2f(gh[base + 64 + lane]);
        rr[base + lane] = o0 * rs * g[lane] * (g0 / (1.f + expf(-g0)));
        rr[base + 64 + lane] = o1 * rs * g[64 + lane] * (g1 / (1.f + expf(-g1)));
    }
}
__device__ __forceinline__ void mla_prep2(const bf16_t* cq, const bf16_t* ckv, const float* ssq_q, const float* ssq_kv, const float* gq, const float* gkv, float* cqn, float* ckvn) {
    for (size_t i = GTID; i < (size_t)NTOK * 256; i += GTHREADS) { const int r = (int)(i >> 8), c = (int)(i & 255);
        cqn[i] = bf2f(cq[i]) * (1.f / sqrtf(__hip_atomic_load(ssq_q + r, __ATOMIC_RELAXED, __HIP_MEMORY_SCOPE_AGENT) * (1.f / 256.f) + RMS_EPS)) * gq[c]; }
    for (size_t i = GTID; i < (size_t)NTOK * 128; i += GTHREADS) { const int r = (int)(i >> 7), c = (int)(i & 127);
        ckvn[i] = bf2f(ckv[i]) * (1.f / sqrtf(__hip_atomic_load(ssq_kv + r, __ATOMIC_RELAXED, __HIP_MEMORY_SCOPE_AGENT) * (1.f / 128.f) + RMS_EPS)) * gkv[c]; }
}
__host__ __device__ constexpr int rope_nat(int p) { return ((p & 7) < 4) ? 4 * (p >> 3) + (p & 7) : 16 + 4 * (p >> 3) + (p & 7) - 4; }
__device__ __forceinline__ void attn_naive2(const float* q, const float* kv, const bf16_t* kr, float* out) {
    const int lane = nv::tidx() & 63;
    for (int task = GWAVE; task < 2048; task += GWAVES) {
        const int tsk = __builtin_amdgcn_readfirstlane(task);
        const int qc = 63 - (tsk >> 5), h = tsk & 7, b = (tsk >> 3) & 3;
        const int t = qc * 64 + lane; const size_t row = (size_t)b * SEQ + t;
        const float scale = 0.10206207261596575f;
        float qv[96];
#pragma unroll
        for (int d = 0; d < 96; ++d) qv[d] = q[row * 768 + h * 96 + d] * scale;
        float o[64];
#pragma unroll
        for (int d = 0; d < 64; ++d) o[d] = 0.f;
        float m = -INFINITY, l = 0.f;
        const int nk = (qc + 1) * 64;
        for (int s = 0; s < nk; ++s) {
            const size_t kr_ = (size_t)b * SEQ + s;
            const float* kp = kv + kr_ * 1024 + h * 128; const bf16_t* rp = kr + kr_ * 32;
            float sc = 0.f;
#pragma unroll
            for (int d = 0; d < 64; ++d) sc += qv[d] * kp[d];
#pragma unroll
            for (int p = 0; p < 32; ++p) sc += qv[64 + rope_nat(p)] * bf2f(rp[p]);
            const float mn = fmaxf(m, sc); const float corr = expf(m - mn), pe = expf(sc - mn);
            l = l * corr + pe;
#pragma unroll
            for (int d = 0; d < 64; ++d) o[d] = o[d] * corr + pe * kp[64 + d];
            m = mn;
        }
        const float il = 1.f / l;
#pragma unroll
        for (int d = 0; d < 64; ++d) out[row * 512 + h * 64 + d] = o[d] * il;
    }
}
}

namespace op {
constexpr int MOE_CAP = 16384, MOE_MAXT = 160;
__device__ __forceinline__ void moe_build_tab(LAS int* tab, const int* cnt, int* tstart_g) {
    if (threadIdx.x < 64) {
        const int e = threadIdx.x & 31; const int c = __hip_atomic_load(cnt + e, __ATOMIC_RELAXED, __HIP_MEMORY_SCOPE_AGENT); const int t = (c + 255) >> 8;
        int incl = t;
#pragma unroll
        for (int o = 1; o < 32; o <<= 1) { const int v = __shfl_up(incl, o, 32); if (e >= o) incl += v; }
        const int start = incl - t;
        if (threadIdx.x < 32) { tab[1 + e] = c; tab[33 + e] = start; if (e == 31) tab[0] = incl; for (int j = 0; j < t; ++j) tab[65 + start + j] = e;
            if (blockIdx.x == 0 && tstart_g) tstart_g[e] = start; }
    }
    __syncthreads();
}
struct MoeOrder {
    const LAS int* tab; int G, c; const int* stok;
    __device__ __forceinline__ bool next(int i, Unit& u) const { const int L = i * G + c; const int T = tab[0]; if (L >= 4 * T) return false; const int mt = L >> 2; u.pm = mt; u.pn = tab[65 + mt] * 4 + (L & 3); return true; }
    __device__ __forceinline__ void a_ready(const Unit&) const {}
    __device__ __forceinline__ void done(const Unit&) const {}
    __device__ __forceinline__ int arow(const Unit& u, int r) const { const int e = u.pn >> 2; const int idx = (u.pm - tab[33 + e]) * 256 + r; return idx < tab[1 + e] ? stok[e * MOE_CAP + idx] : 16384; }
};
struct RowW13 { int which; __device__ __forceinline__ int row(int n) const { return 8 * (n >> 2) + (n & 3) + 4 * which; } __device__ __forceinline__ float scale(int, int) const { return 1.f; } };
struct RowScaleK { const float* g; int klim; __device__ __forceinline__ int row(int n) const { return n; } __device__ __forceinline__ float scale(int, int k) const { return k < klim ? g[k] : 1.f; } };

typedef unsigned v2u __attribute__((ext_vector_type(2)));
struct EpiMoe1 { static constexpr bool PERM = true, AFTER_DRAIN = false;
    bf16_t* H;
    __device__ __forceinline__ void operator()(const f32x4 (&acc)[2][2][4][2], const Unit& u, int wr, int wc, int fr, int fq) const {
        const int row0 = u.pm * 256 + wr * 64 + fr, col0 = 128 * (u.pn & 3) + 16 * wc + 4 * fq;
#pragma unroll
        for (int ai = 0; ai < 2; ++ai)
#pragma unroll
            for (int m = 0; m < 4; ++m) { bf16_t* rowp = H + (size_t)(row0 + ai * 128 + m * 16) * 512 + col0;
#pragma unroll
                for (int bj = 0; bj < 2; ++bj) { const f32x4 a = acc[ai][bj][m][0], b = acc[ai][bj][m][1]; float h[4];
#pragma unroll
                    for (int i = 0; i < 4; ++i) h[i] = a[i] * __builtin_amdgcn_rcpf(1.f + __expf(-a[i])) * b[i];
                    v2u w; w.x = pk2(h[0], h[1]); w.y = pk2(h[2], h[3]); *(v2u*)(rowp + 64 * bj) = w; } }
    }
};
struct EpiBf16P { static constexpr bool PERM = true, AFTER_DRAIN = false;
    bf16_t* O; int ldc; int pmask;
    __device__ __forceinline__ void operator()(const f32x4 (&acc)[2][2][4][2], const Unit& u, int wr, int wc, int fr, int fq) const {
        const int row0 = u.pm * 256 + wr * 64 + fr, col0 = 256 * (u.pn & pmask) + 32 * wc + 8 * fq;
#pragma unroll
        for (int ai = 0; ai < 2; ++ai)
#pragma unroll
            for (int m = 0; m < 4; ++m) { bf16_t* rowp = O + (size_t)(row0 + ai * 128 + m * 16) * ldc + col0;
#pragma unroll
                for (int bj = 0; bj < 2; ++bj) *(v4u*)(rowp + 128 * bj) = pack8(acc[ai][bj][m][0], acc[ai][bj][m][1]); }
    }
};
struct EpiMix { static constexpr bool PERM = false, AFTER_DRAIN = false;
    const float* x; float* t; float alpha;
    __device__ __forceinline__ void operator()(const f32x4 (&acc)[2][2][4][2], const Unit& u, int wr, int wc, int fr, int fq) const {
        const int row0 = u.pm * 256 + wr * 64 + fr, col0 = u.pn * 256 + wc * 32 + 4 * fq;
#pragma unroll
        for (int ai = 0; ai < 2; ++ai)
#pragma unroll
            for (int m = 0; m < 4; ++m) { const size_t ro = (size_t)(row0 + ai * 128 + m * 16) * 1024 + col0;
#pragma unroll
                for (int bj = 0; bj < 2; ++bj)
#pragma unroll
                    for (int n = 0; n < 2; ++n) { const size_t o = ro + bj * 128 + n * 16; *(f32x4*)(t + o) = alpha * *(const f32x4*)(x + o) + acc[ai][bj][m][n]; } }
    }
};
}

namespace nv {
__device__ __forceinline__ void a_norm2(const float* a, const float* g, bf16_t* AR) {
    const int lane = nv::tidx() & 63;
    for (int r = GWAVE; r < NTOK; r += GWAVES) {
        float v[8]; float ss = 0.f;
#pragma unroll
        for (int i = 0; i < 8; ++i) { v[i] = a[(size_t)r * 512 + lane + 64 * i]; ss += v[i] * v[i]; }
        ss = wsum(ss); const float rs = 1.f / sqrtf(ss * (1.f / 512.f) + RMS_EPS);
#pragma unroll
        for (int i = 0; i < 8; ++i) AR[(size_t)r * 1024 + lane + 64 * i] = (bf16_t)op::f2bf(v[i] * rs * g[lane + 64 * i]);
    }
}
__device__ __forceinline__ void hg_out3(const float* ob, const bf16_t* gh, const float* g, bf16_t* AR) {
    const int lane = nv::tidx() & 63;
    for (int w = GWAVE; w < NTOK * 4; w += GWAVES) {
        const size_t base = (size_t)(w >> 2) * 512 + (w & 3) * 128; const size_t ob_ = (size_t)(w >> 2) * 1024 + 512 + (w & 3) * 128;
        const float o0 = ob[base + lane], o1 = ob[base + 64 + lane];
        const float ss = wsum(o0 * o0 + o1 * o1); const float rs = 1.f / sqrtf(ss * (1.f / 128.f) + RMS_EPS);
        const float g0 = bf2f(gh[base + lane]), g1 = bf2f(gh[base + 64 + lane]);
        AR[ob_ + lane] = (bf16_t)op::f2bf(o0 * rs * g[lane] * (g0 / (1.f + expf(-g0))));
        AR[ob_ + 64 + lane] = (bf16_t)op::f2bf(o1 * rs * g[64 + lane] * (g1 / (1.f + expf(-g1))));
    }
}
__device__ __forceinline__ void ln_rows2(float* h, const float* g, const float* bb, bf16_t* hb) {
    const int lane = nv::tidx() & 63;
    for (int r = GWAVE; r < NTOK; r += GWAVES) {
        float v[16]; float s = 0.f;
#pragma unroll
        for (int i = 0; i < 16; ++i) { v[i] = h[(size_t)r * D + lane + 64 * i]; s += v[i]; }
        const float mean = wsum(s) * (1.f / D); float q = 0.f;
#pragma unroll
        for (int i = 0; i < 16; ++i) { v[i] -= mean; q += v[i] * v[i]; }
        const float rs = 1.f / sqrtf(wsum(q) * (1.f / D) + LN_EPS);
#pragma unroll
        for (int i = 0; i < 16; ++i) { const int c = lane + 64 * i; const float o = v[i] * rs * g[c] + bb[c]; h[(size_t)r * D + c] = o; hb[(size_t)r * D + c] = (bf16_t)op::f2bf(o); }
    }
    if (blockIdx.x == 0) for (int c = threadIdx.x; c < D; c += NTHREADS) hb[(size_t)NTOK * D + c] = 0;
}
__device__ __forceinline__ void router2(const float* h1, const float* wg, const float* bg, const float* we, const float* be, int* cnt, int* tok_e, int* tok_rank, float* tok_gate, int* stok) {
    const int lane = nv::tidx() & 63;
    for (int r = GWAVE; r < NTOK; r += GWAVES) {
        float lg[36];
#pragma unroll
        for (int c = 0; c < 36; ++c) lg[c] = 0.f;
        for (int i = 0; i < 16; ++i) { const int k = lane + 64 * i; const float xv = h1[(size_t)r * D + k];
#pragma unroll
            for (int c = 0; c < 4; ++c) lg[c] += xv * wg[k * 4 + c];
#pragma unroll
            for (int c = 0; c < 32; ++c) lg[4 + c] += xv * we[k * 32 + c]; }
#pragma unroll
        for (int c = 0; c < 36; ++c) lg[c] = wsum(lg[c]);
#pragma unroll
        for (int c = 0; c < 4; ++c) lg[c] += bg[c];
#pragma unroll
        for (int c = 0; c < 32; ++c) lg[4 + c] += be[c];
        int grp = 0; float gm = lg[0];
#pragma unroll
        for (int c = 1; c < 4; ++c) if (lg[c] > gm) { gm = lg[c]; grp = c; }
        float den = 0.f;
#pragma unroll
        for (int c = 0; c < 4; ++c) den += expf(lg[c] - gm);
        const float pgrp = 1.f / den;
        float ein[8];
#pragma unroll
        for (int j = 0; j < 8; ++j) ein[j] = grp == 0 ? lg[4 + j] : grp == 1 ? lg[12 + j] : grp == 2 ? lg[20 + j] : lg[28 + j];
        int i0 = 0; float v0 = ein[0];
#pragma unroll
        for (int j = 1; j < 8; ++j) if (ein[j] > v0) { v0 = ein[j]; i0 = j; }
        int i1 = -1; float v1 = -INFINITY;
#pragma unroll
        for (int j = 0; j < 8; ++j) if (j != i0 && ein[j] > v1) { v1 = ein[j]; i1 = j; }
        const float e1 = expf(v1 - v0); const float p0 = 1.f / (1.f + e1), p1 = e1 / (1.f + e1);
        if (lane == 0) {
            const int ea = grp * 8 + i0, eb = grp * 8 + i1;
            const int ra = atomicAdd(cnt + ea, 1), rb = atomicAdd(cnt + eb, 1);
            tok_e[2 * r] = ea; tok_e[2 * r + 1] = eb; tok_rank[2 * r] = ra; tok_rank[2 * r + 1] = rb;
            tok_gate[2 * r] = pgrp * p0; tok_gate[2 * r + 1] = pgrp * p1;
            stok[ea * op::MOE_CAP + ra] = r; stok[eb * op::MOE_CAP + rb] = r;
        }
    }
}
__device__ __forceinline__ void ln2_rows(const float* h1, const bf16_t* Y, const int* tok_e, const int* tok_rank, const float* tok_gate, const int* tstart, const float* g, const float* bb, float* out) {
    const int lane = nv::tidx() & 63;
    for (int r = GWAVE; r < NTOK; r += GWAVES) {
        const size_t r0 = (size_t)tstart[tok_e[2 * r]] * 256 + tok_rank[2 * r], r1 = (size_t)tstart[tok_e[2 * r + 1]] * 256 + tok_rank[2 * r + 1];
        const float g0 = tok_gate[2 * r], g1 = tok_gate[2 * r + 1];
        float v[16]; float s = 0.f;
#pragma unroll
        for (int i = 0; i < 16; ++i) { const int c = lane + 64 * i; v[i] = ALPHA * h1[(size_t)r * D + c] + g0 * bf2f(Y[r0 * D + c]) + g1 * bf2f(Y[r1 * D + c]); s += v[i]; }
        const float mean = wsum(s) * (1.f / D); float q = 0.f;
#pragma unroll
        for (int i = 0; i < 16; ++i) { v[i] -= mean; q += v[i] * v[i]; }
        const float rs = 1.f / sqrtf(wsum(q) * (1.f / D) + LN_EPS);
#pragma unroll
        for (int i = 0; i < 16; ++i) { const int c = lane + 64 * i; out[(size_t)r * D + c] = v[i] * rs * g[c] + bb[c]; }
    }
}
}

namespace hg {
using op::bf16_t; using op::bf2f; using op::f2bf; using op::pk2; using op::v4u; using op::v2u;
typedef short bf16x8 __attribute__((ext_vector_type(8)));
typedef float f32x4 __attribute__((ext_vector_type(4)));
constexpr int SEQ = 4096, NU = 1024;
constexpr int LDV = 72 * 2, LDK = 72 * 2, LDQ = 136 * 2, LDS_ = 136 * 2, LDA = 72 * 2;
__device__ __forceinline__ bf16x8 ldfrag(const LAS unsigned char* base, int row, int stride, int kbyte) { return *(const LAS bf16x8*)(base + row * stride + kbyte); }

__device__ __forceinline__ void stage_vT(LAS unsigned char* vT, const bf16_t* vsrc, int tid) {
#pragma unroll
    for (int j = 0; j < 2; ++j) { const int p = tid + 512 * j, s = p >> 4, e0 = (p & 15) * 8;
        const v4u w = *(const v4u*)(vsrc + (size_t)s * 512 + e0);
        const unsigned ww[4] = {w.x, w.y, w.z, w.w};
#pragma unroll
        for (int i = 0; i < 4; ++i) { *(LAS unsigned short*)(vT + (e0 + 2 * i) * LDV + s * 2) = (unsigned short)(ww[i] & 0xffffu); *(LAS unsigned short*)(vT + (e0 + 2 * i + 1) * LDV + s * 2) = (unsigned short)(ww[i] >> 16); } }
}
__device__ __forceinline__ void pass1(LAS unsigned char* lds, const float* lf, const bf16_t* kk, const bf16_t* vi, bf16_t* U, float* dl) {
    int tid_ = threadIdx.x; asm volatile("" : "+v"(tid_)); const int tid = tid_, lane = tid & 63, w = __builtin_amdgcn_readfirstlane(tid >> 6);
    LAS unsigned char* vT = lds; LAS unsigned char* kdT = lds + 128 * LDV; LAS float* segtot = (LAS float*)(lds + 128 * LDV + 128 * LDK);
    const int d = tid & 127, seg = tid >> 7, t0 = seg * 16;
    for (int u = blockIdx.x; u < NU; u += gridDim.x) {
        const int c = u & 63, bh = u >> 6, b = bh >> 2, h = bh & 3; const size_t row0 = (size_t)b * SEQ + c * 64;
        float cs[16]; float kv[16]; float run = 0.f;
#pragma unroll
        for (int i = 0; i < 16; ++i) { const size_t o = (row0 + t0 + i) * 512 + h * 128 + d; cs[i] = lf[o]; kv[i] = bf2f(kk[o]); }
        stage_vT(vT, vi + row0 * 512 + h * 128, tid);
#pragma unroll
        for (int i = 0; i < 16; ++i) { run += cs[i]; cs[i] = run; }
        segtot[seg * 128 + d] = run;
        __syncthreads();
        float off = 0.f, tot = 0.f;
#pragma unroll
        for (int s = 0; s < 4; ++s) { const float v = segtot[s * 128 + d]; tot += v; if (s < seg) off += v; }
        unsigned pk[8];
#pragma unroll
        for (int i = 0; i < 8; ++i) pk[i] = pk2(kv[2 * i] * __expf(tot - off - cs[2 * i]), kv[2 * i + 1] * __expf(tot - off - cs[2 * i + 1]));
        *(LAS v4u*)(kdT + d * LDK + t0 * 2) = (v4u){pk[0], pk[1], pk[2], pk[3]}; *(LAS v4u*)(kdT + d * LDK + t0 * 2 + 16) = (v4u){pk[4], pk[5], pk[6], pk[7]};
        if (seg == 0) dl[(size_t)u * 128 + d] = __expf(tot);
        __syncthreads();
        f32x4 acc[8];
#pragma unroll
        for (int j = 0; j < 8; ++j) acc[j] = (f32x4){0.f, 0.f, 0.f, 0.f};
#pragma unroll
        for (int ks = 0; ks < 2; ++ks) { const bf16x8 a = ldfrag(kdT, w * 16 + (lane & 15), LDK, ks * 64 + (lane >> 4) * 16);
#pragma unroll
            for (int j = 0; j < 8; ++j) { const bf16x8 bb = ldfrag(vT, j * 16 + (lane & 15), LDV, ks * 64 + (lane >> 4) * 16); acc[j] = __builtin_amdgcn_mfma_f32_16x16x32_bf16(a, bb, acc[j], 0, 0, 0); } }
        bf16_t* Uu = U + (size_t)u * 16384;
#pragma unroll
        for (int j = 0; j < 8; ++j) { v2u o; o.x = pk2(acc[j][0], acc[j][1]); o.y = pk2(acc[j][2], acc[j][3]); *(v2u*)(Uu + (j * 16 + (lane & 15)) * 128 + w * 16 + 4 * (lane >> 4)) = o; }
        __syncthreads();
    }
}
__device__ __forceinline__ void scan(const bf16_t* U, const float* dl, bf16_t* ST) {
    for (int gid = blockIdx.x * NTHREADS + threadIdx.x; gid < 16 * 128 * 64; gid += gridDim.x * NTHREADS) {
        const int dp = gid & 63, e = (gid >> 6) & 127, bh = gid >> 13;
        float s0 = 0.f, s1 = 0.f;
        for (int c0 = 0; c0 < 64; c0 += 16) {
            unsigned uv[16]; float2 dv[16];
#pragma unroll
            for (int i = 0; i < 16; ++i) { const size_t un = (size_t)bh * 64 + c0 + i; uv[i] = *(const unsigned*)(U + un * 16384 + e * 128 + 2 * dp); dv[i] = *(const float2*)(dl + un * 128 + 2 * dp); }
#pragma unroll
            for (int i = 0; i < 16; ++i) { const size_t un = (size_t)bh * 64 + c0 + i; *(unsigned*)(ST + un * 16384 + e * 128 + 2 * dp) = pk2(s0, s1);
                s0 = dv[i].x * s0 + __builtin_bit_cast(float, uv[i] << 16); s1 = dv[i].y * s1 + __builtin_bit_cast(float, uv[i] & 0xffff0000u); }
        }
    }
}
__device__ __forceinline__ void pass3(LAS unsigned char* lds, const float* lf, const bf16_t* kk, const bf16_t* vi, const bf16_t* qh, const bf16_t* gh, const bf16_t* ST, const float* gnorm, bf16_t* AR) {
    int tid_ = threadIdx.x; asm volatile("" : "+v"(tid_)); const int tid = tid_, lane = tid & 63, w = __builtin_amdgcn_readfirstlane(tid >> 6);
    LAS unsigned char* qeL = lds; LAS unsigned char* keL = qeL + 64 * LDQ; LAS unsigned char* qsL = keL + 64 * LDQ; LAS unsigned char* vT = qsL + 64 * LDQ;
    LAS unsigned char* STl = vT + 128 * LDV; LAS unsigned char* aL = STl + 128 * LDS_; LAS float* segtot = (LAS float*)(aL + 64 * LDA); LAS float* ssqL = segtot + 512;
    const int d = tid & 127, seg = tid >> 7, t0 = seg * 16;
    const int tt = w & 3, eg = w >> 2;
    for (int u = blockIdx.x; u < NU; u += gridDim.x) {
        const int c = u & 63, bh = u >> 6, b = bh >> 2, h = bh & 3; const size_t row0 = (size_t)b * SEQ + c * 64;
        float cs[16]; float kv[16], qv[16]; float run = 0.f;
#pragma unroll
        for (int i = 0; i < 16; ++i) { const size_t o = (row0 + t0 + i) * 512 + h * 128 + d; cs[i] = lf[o]; kv[i] = bf2f(kk[o]); qv[i] = bf2f(qh[o]); }
        stage_vT(vT, vi + row0 * 512 + h * 128, tid);
        { const bf16_t* Su = ST + (size_t)u * 16384;
#pragma unroll
            for (int j = 0; j < 4; ++j) { const int p = tid + 512 * j, e = p >> 4, d0 = (p & 15) * 8; *(LAS v4u*)(STl + e * LDS_ + d0 * 2) = *(const v4u*)(Su + e * 128 + d0); } }
#pragma unroll
        for (int i = 0; i < 16; ++i) { run += cs[i]; cs[i] = run; }
        segtot[seg * 128 + d] = run;
        __syncthreads();
        float off = 0.f;
#pragma unroll
        for (int s = 0; s < 3; ++s) { const float v = segtot[s * 128 + d]; if (s < seg) off += v; }
        const float bm = segtot[d] + segtot[128 + d];
#pragma unroll
        for (int i = 0; i < 16; ++i) { const float bt = off + cs[i]; const int t = t0 + i;
            *(LAS unsigned short*)(qeL + t * LDQ + d * 2) = (unsigned short)f2bf(qv[i] * __expf(fminf(bt - bm, 80.f)));
            *(LAS unsigned short*)(keL + t * LDQ + d * 2) = (unsigned short)f2bf(kv[i] * __expf(fminf(bm - bt, 80.f)));
            *(LAS unsigned short*)(qsL + t * LDQ + d * 2) = (unsigned short)f2bf(qv[i] * __expf(bt)); }
        __syncthreads();
#pragma unroll
        for (int j = 0; j < 2; ++j) { const int st = 2 * eg + j; f32x4 a = (f32x4){0.f, 0.f, 0.f, 0.f};
            if (st <= tt) {
#pragma unroll
                for (int ks = 0; ks < 4; ++ks) a = __builtin_amdgcn_mfma_f32_16x16x32_bf16(ldfrag(qeL, tt * 16 + (lane & 15), LDQ, ks * 64 + (lane >> 4) * 16), ldfrag(keL, st * 16 + (lane & 15), LDQ, ks * 64 + (lane >> 4) * 16), a, 0, 0, 0);
            }
            const int sI = st * 16 + (lane & 15);
#pragma unroll
            for (int r = 0; r < 4; ++r) { const int tI = tt * 16 + 4 * (lane >> 4) + r; *(LAS unsigned short*)(aL + tI * LDA + sI * 2) = (unsigned short)f2bf(sI <= tI ? a[r] : 0.f); } }
        float gv[4][4];
#pragma unroll
        for (int r = 0; r < 4; ++r)
#pragma unroll
            for (int j = 0; j < 4; ++j) gv[r][j] = bf2f(gh[(row0 + tt * 16 + 4 * (lane >> 4) + r) * 512 + h * 128 + (4 * eg + j) * 16 + (lane & 15)]);
        __syncthreads();
        f32x4 o[4];
#pragma unroll
        for (int j = 0; j < 4; ++j) o[j] = (f32x4){0.f, 0.f, 0.f, 0.f};
#pragma unroll
        for (int ks = 0; ks < 2; ++ks) { const bf16x8 a = ldfrag(aL, tt * 16 + (lane & 15), LDA, ks * 64 + (lane >> 4) * 16);
#pragma unroll
            for (int j = 0; j < 4; ++j) o[j] = __builtin_amdgcn_mfma_f32_16x16x32_bf16(a, ldfrag(vT, (4 * eg + j) * 16 + (lane & 15), LDV, ks * 64 + (lane >> 4) * 16), o[j], 0, 0, 0); }
#pragma unroll
        for (int ks = 0; ks < 4; ++ks) { const bf16x8 a = ldfrag(qsL, tt * 16 + (lane & 15), LDQ, ks * 64 + (lane >> 4) * 16);
#pragma unroll
            for (int j = 0; j < 4; ++j) o[j] = __builtin_amdgcn_mfma_f32_16x16x32_bf16(a, ldfrag(STl, (4 * eg + j) * 16 + (lane & 15), LDS_, ks * 64 + (lane >> 4) * 16), o[j], 0, 0, 0); }
        float ss[4];
#pragma unroll
        for (int r = 0; r < 4; ++r) { float s = 0.f;
#pragma unroll
            for (int j = 0; j < 4; ++j) s += o[j][r] * o[j][r];
            s += __shfl_xor(s, 1); s += __shfl_xor(s, 2); s += __shfl_xor(s, 4); s += __shfl_xor(s, 8); ss[r] = s; }
        if ((lane & 15) == 0) {
#pragma unroll
            for (int r = 0; r < 4; ++r) ssqL[eg * 64 + tt * 16 + 4 * (lane >> 4) + r] = ss[r]; }
        __syncthreads();
#pragma unroll
        for (int r = 0; r < 4; ++r) { const int tI = tt * 16 + 4 * (lane >> 4) + r; const float rs = 1.f / sqrtf((ssqL[tI] + ssqL[64 + tI]) * (1.f / 128.f) + 1e-6f);
#pragma unroll
            for (int j = 0; j < 4; ++j) { const int e = (4 * eg + j) * 16 + (lane & 15); const float g = gv[r][j];
                AR[(row0 + tI) * 1024 + 512 + h * 128 + e] = (bf16_t)f2bf(o[j][r] * rs * gnorm[e] * g * __builtin_amdgcn_rcpf(1.f + __expf(-g))); } }
        __syncthreads();
    }
}
}

namespace op {
struct RowQ { const float* g;
    __device__ __forceinline__ int row(int n) const { const int h = n / 96, j = n - 96 * h; if (j < 64) return n; const int jj = (j - 64) & 15, a = jj >> 2, b = jj & 3; return 96 * h + 64 + 8 * a + b + (j >= 80 ? 4 : 0); }
    __device__ __forceinline__ float scale(int, int k) const { return g[k]; } };
struct RowKV { const float* g;
    __device__ __forceinline__ int row(int n) const { const int h = n >> 7, j = n & 127; return j < 64 ? 64 * h + j : 512 + 64 * h + (j - 64); }
    __device__ __forceinline__ float scale(int, int k) const { return g[k]; } };
constexpr float QSCALE = 0.10206207261596575f * 1.4426950408889634f;
struct EpiQ { static constexpr bool PERM = true, AFTER_DRAIN = false;
    bf16_t* Q; const float* ssq; const float* cs;
    __device__ __forceinline__ void operator()(const f32x4 (&acc)[2][2][4][2], const Unit& u, int wr, int wc, int fr, int fq) const {
        const int row0 = u.pm * 256 + wr * 64 + fr;
#pragma unroll
        for (int ai = 0; ai < 2; ++ai)
#pragma unroll
            for (int m = 0; m < 4; ++m) { const int row = row0 + ai * 128 + m * 16; const float rs = QSCALE * __builtin_amdgcn_rsqf(ssq[row] * (1.f / 256.f) + 1e-6f);
#pragma unroll
                for (int bj = 0; bj < 2; ++bj) { const int gi = 8 * u.pn + 4 * bj + wc; f32x4 v0 = acc[ai][bj][m][0] * rs, v1 = acc[ai][bj][m][1] * rs;
                    if (gi % 3 == 2) { const f32x4 c = *(const f32x4*)(cs + (size_t)row * 32 + 4 * fq), sn = *(const f32x4*)(cs + (size_t)row * 32 + 16 + 4 * fq);
                        const f32x4 o1 = v0 * c - v1 * sn, o2 = v1 * c + v0 * sn; v0 = o1; v1 = o2; }
                    *(v4u*)(Q + (size_t)row * 768 + 32 * gi + 8 * fq) = pack8(v0, v1); } }
    }
};
struct EpiK { static constexpr bool PERM = true, AFTER_DRAIN = false;
    bf16_t* K; const float* ssq;
    __device__ __forceinline__ void operator()(const f32x4 (&acc)[2][2][4][2], const Unit& u, int wr, int wc, int fr, int fq) const {
        const int row0 = u.pm * 256 + wr * 64 + fr, col0 = 256 * u.pn + 32 * wc + 8 * fq;
#pragma unroll
        for (int ai = 0; ai < 2; ++ai)
#pragma unroll
            for (int m = 0; m < 4; ++m) { const int row = row0 + ai * 128 + m * 16; const float rs = __builtin_amdgcn_rsqf(ssq[row] * (1.f / 128.f) + 1e-6f);
#pragma unroll
                for (int bj = 0; bj < 2; ++bj) *(v4u*)(K + (size_t)row * 512 + col0 + 128 * bj) = pack8(acc[ai][bj][m][0] * rs, acc[ai][bj][m][1] * rs); }
    }
};
struct EpiVT { static constexpr bool PERM = true, AFTER_DRAIN = false;
    bf16_t* VT; const float* ssq;
    __device__ __forceinline__ void operator()(const f32x4 (&acc)[2][2][4][2], const Unit& u, int wr, int wc, int fr, int fq) const {
        const int row0 = u.pm * 256 + wr * 64 + fr, col0 = 256 * u.pn + 32 * wc + 8 * fq; const int p0 = (fq & 1) ? 4 : 0, p1 = (fq & 1) ? 12 : 8;
#pragma unroll
        for (int bj = 0; bj < 2; ++bj) { const int c0 = col0 + 128 * bj; const f32x4 s0 = *(const f32x4*)(ssq + c0), s1 = *(const f32x4*)(ssq + c0 + 4); f32x4 r0, r1;
#pragma unroll
            for (int i = 0; i < 4; ++i) { r0[i] = __builtin_amdgcn_rsqf(s0[i] * (1.f / 128.f) + 1e-6f); r1[i] = __builtin_amdgcn_rsqf(s1[i] * (1.f / 128.f) + 1e-6f); }
#pragma unroll
            for (int ai = 0; ai < 2; ++ai)
#pragma unroll
                for (int m = 0; m < 4; ++m) { bf16_t* rowp = VT + (size_t)(row0 + ai * 128 + m * 16) * 16384 + (c0 & ~15);
                    const f32x4 a = acc[ai][bj][m][0] * r0, b = acc[ai][bj][m][1] * r1;
                    v2u w0, w1; w0.x = pk2(a[0], a[1]); w0.y = pk2(a[2], a[3]); w1.x = pk2(b[0], b[1]); w1.y = pk2(b[2], b[3]);
                    *(v2u*)(rowp + p0) = w0; *(v2u*)(rowp + p1) = w1; } }
    }
};
struct EpiMix2 { static constexpr bool PERM = false, AFTER_DRAIN = false; static constexpr int MID_T = 8;
    const float* x; float* t; float alpha; const float* ssq_a;
    __device__ __forceinline__ void mid(f32x4 (&acc)[2][2][4][2], const Unit& u, int wr, int wc, int fr, int fq) const {
        const int row0 = u.pm * 256 + wr * 64 + fr;
#pragma unroll
        for (int ai = 0; ai < 2; ++ai)
#pragma unroll
            for (int m = 0; m < 4; ++m) { const float rs = __builtin_amdgcn_rsqf(ssq_a[row0 + ai * 128 + m * 16] * (1.f / 512.f) + 1e-6f);
#pragma unroll
                for (int bj = 0; bj < 2; ++bj)
#pragma unroll
                    for (int n = 0; n < 2; ++n) acc[ai][bj][m][n] *= rs; }
    }
    __device__ __forceinline__ void operator()(const f32x4 (&acc)[2][2][4][2], const Unit& u, int wr, int wc, int fr, int fq) const {
        const int row0 = u.pm * 256 + wr * 64 + fr, col0 = u.pn * 256 + wc * 32 + 4 * fq;
#pragma unroll
        for (int ai = 0; ai < 2; ++ai)
#pragma unroll
            for (int m = 0; m < 4; ++m) { const size_t ro = (size_t)(row0 + ai * 128 + m * 16) * 1024 + col0;
#pragma unroll
                for (int bj = 0; bj < 2; ++bj)
#pragma unroll
                    for (int n = 0; n < 2; ++n) { const size_t o = ro + bj * 128 + n * 16; *(f32x4*)(t + o) = alpha * *(const f32x4*)(x + o) + acc[ai][bj][m][n]; } }
    }
};
}

namespace at {
using op::bf16_t; using op::v4u; using op::pk2;
typedef short bf16x8 __attribute__((ext_vector_type(8)));
typedef float f32x16 __attribute__((ext_vector_type(16)));
constexpr int LDK = 208, LDV = 144, KBUF = 64 * LDK, VBUF = 64 * LDV, SEQ = 4096;
constexpr float THR = 8.f;
__device__ __forceinline__ int crow(int r, int hi) { return (r & 3) + 8 * (r >> 2) + 4 * hi; }
__device__ __forceinline__ void attn_phase(LAS unsigned char* lds, const bf16_t* Q, const bf16_t* Kn, const bf16_t* kr, const bf16_t* VT, bf16_t* AR, float* ssq_a) {
    int tid_ = threadIdx.x; asm volatile("" : "+v"(tid_)); const int tid = tid_, lane = tid & 63, w = __builtin_amdgcn_readfirstlane(tid >> 6), r32 = lane & 31, hi = lane >> 5;
    LAS unsigned char* Kb = lds; LAS unsigned char* Vb = lds + 2 * KBUF; LAS float* wsf = (LAS float*)(lds + 2 * KBUF + 2 * VBUF) + w * 64;
    const int krow = tid >> 3, kch = tid & 7, rrow = tid >> 2, rch = tid & 3;
    for (int pi = blockIdx.x; pi < 256; pi += gridDim.x) {
        const int bh = pi >> 3, sx = pi & 7, b = bh >> 3, h = bh & 7; const size_t tok0 = (size_t)b * SEQ;
#pragma unroll 1
        for (int uu = 0; uu < 2; ++uu) {
            const int qb = uu == 0 ? 15 - sx : sx; const int NT = 4 * qb + 4, qc = 4 * qb + (w >> 1);
            const size_t qrow = tok0 + qb * 256 + w * 32 + r32;
            bf16x8 qf[6];
#pragma unroll
            for (int ks = 0; ks < 6; ++ks) qf[ks] = *(const bf16x8*)(Q + qrow * 768 + h * 96 + ks * 16 + hi * 8);
            const bf16_t* ksrc = Kn + (tok0 + krow) * 512 + h * 64 + kch * 8; const bf16_t* rsrc = kr + (tok0 + rrow) * 32 + rch * 8; const bf16_t* vsrc = VT + (size_t)(h * 64 + krow) * 16384 + tok0 + kch * 8;
            v4u gk = *(const v4u*)ksrc, gv = *(const v4u*)vsrc, gr = (v4u){0u, 0u, 0u, 0u}; if (tid < 256) gr = *(const v4u*)rsrc;
            *(LAS v4u*)(Kb + krow * LDK + kch * 16) = gk; *(LAS v4u*)(Vb + krow * LDV + kch * 16) = gv; if (tid < 256) *(LAS v4u*)(Kb + rrow * LDK + 128 + rch * 16) = gr;
            __syncthreads();
            f32x16 o0, o1;
#pragma unroll
            for (int r = 0; r < 16; ++r) { o0[r] = 0.f; o1[r] = 0.f; }
            float mhat = 0.f, lsum = 0.f;
            for (int t = 0; t < NT; ++t) {
                const int cur = t & 1; const bool more = t + 1 < NT;
                if (more) { gk = *(const v4u*)(ksrc + (size_t)(t + 1) * 64 * 512); gv = *(const v4u*)(vsrc + (t + 1) * 64); if (tid < 256) gr = *(const v4u*)(rsrc + (size_t)(t + 1) * 64 * 32); }
                if (t <= qc) {
                    const LAS unsigned char* Kc = Kb + cur * KBUF + r32 * LDK + hi * 16; const LAS unsigned char* Vc = Vb + cur * VBUF + r32 * LDV + hi * 16;
                    f32x16 p0, p1;
#pragma unroll
                    for (int r = 0; r < 16; ++r) { p0[r] = 0.f; p1[r] = 0.f; }
#pragma unroll
                    for (int ks = 0; ks < 6; ++ks) { p0 = __builtin_amdgcn_mfma_f32_32x32x16_bf16(*(const LAS bf16x8*)(Kc + ks * 32), qf[ks], p0, 0, 0, 0);
                        p1 = __builtin_amdgcn_mfma_f32_32x32x16_bf16(*(const LAS bf16x8*)(Kc + 32 * LDK + ks * 32), qf[ks], p1, 0, 0, 0); }
                    float rm = fmaxf(p0[0], p1[0]);
#pragma unroll
                    for (int r = 1; r < 16; ++r) rm = fmaxf(rm, fmaxf(p0[r], p1[r]));
                    rm = fmaxf(rm, __shfl_xor(rm, 32)) - mhat;
                    const bool force = (t == 0);
                    if (__any(rm > THR) || force) {
                        const float dl = force ? rm : fmaxf(rm, 0.f); mhat += dl;
                        if (!force) { const float f = __builtin_amdgcn_exp2f(-dl); lsum *= f; if (hi == 0) wsf[r32] = f;
                            asm volatile("s_waitcnt lgkmcnt(0)" ::: "memory");
#pragma unroll
                            for (int r = 0; r < 16; ++r) { const float fr = wsf[crow(r, hi)]; o0[r] *= fr; o1[r] *= fr; } }
                    }
                    float sacc = 0.f;
#pragma unroll
                    for (int r = 0; r < 16; ++r) { p0[r] = __builtin_amdgcn_exp2f(p0[r] - mhat); p1[r] = __builtin_amdgcn_exp2f(p1[r] - mhat); sacc += p0[r] + p1[r]; }
                    lsum += sacc;
                    bf16x8 pa[4];
#pragma unroll
                    for (int s = 0; s < 2; ++s) { const v4u a = (v4u){pk2(p0[8 * s], p0[8 * s + 1]), pk2(p0[8 * s + 2], p0[8 * s + 3]), pk2(p0[8 * s + 4], p0[8 * s + 5]), pk2(p0[8 * s + 6], p0[8 * s + 7])};
                        const v4u c = (v4u){pk2(p1[8 * s], p1[8 * s + 1]), pk2(p1[8 * s + 2], p1[8 * s + 3]), pk2(p1[8 * s + 4], p1[8 * s + 5]), pk2(p1[8 * s + 6], p1[8 * s + 7])};
                        pa[s] = __builtin_bit_cast(bf16x8, a); pa[2 + s] = __builtin_bit_cast(bf16x8, c); }
#pragma unroll
                    for (int s = 0; s < 4; ++s) { o0 = __builtin_amdgcn_mfma_f32_32x32x16_bf16(pa[s], *(const LAS bf16x8*)(Vc + s * 32), o0, 0, 0, 0);
                        o1 = __builtin_amdgcn_mfma_f32_32x32x16_bf16(pa[s], *(const LAS bf16x8*)(Vc + 32 * LDV + s * 32), o1, 0, 0, 0); }
                }
                if (more) { const int nx = cur ^ 1; *(LAS v4u*)(Kb + nx * KBUF + krow * LDK + kch * 16) = gk; *(LAS v4u*)(Vb + nx * VBUF + krow * LDV + kch * 16) = gv; if (tid < 256) *(LAS v4u*)(Kb + nx * KBUF + rrow * LDK + 128 + rch * 16) = gr; }
                __syncthreads();
            }
            lsum += __shfl_xor(lsum, 32);
            if (hi == 0) wsf[32 + r32] = lsum;
            asm volatile("s_waitcnt lgkmcnt(0)" ::: "memory");
            const size_t orow0 = tok0 + qb * 256 + w * 32;
#pragma unroll
            for (int r = 0; r < 16; ++r) { const int q = crow(r, hi); const float il = 1.f / wsf[32 + q]; const float a = o0[r] * il, c = o1[r] * il;
                bf16_t* op_ = AR + (orow0 + q) * 1024 + h * 64 + r32; op_[0] = (bf16_t)op::f2bf(a); op_[32] = (bf16_t)op::f2bf(c);
                float s2 = a * a + c * c; s2 += __shfl_xor(s2, 1); s2 += __shfl_xor(s2, 2); s2 += __shfl_xor(s2, 4); s2 += __shfl_xor(s2, 8); s2 += __shfl_xor(s2, 16);
                if (r32 == 0) atomicAdd(ssq_a + orow0 + q, s2); }
        }
    }
}
}

namespace rt {
using op::bf16_t; using op::pk2;
typedef short bf16x8 __attribute__((ext_vector_type(8)));
typedef float f32x16 __attribute__((ext_vector_type(16)));
__device__ __forceinline__ void build_wr(const float* wg, const float* we, bf16_t* Wr_t) {
    for (int i = GTID; i < 64 * 1024; i += GTHREADS) { const int n = i >> 10, k = i & 1023; const float v = n < 32 ? we[k * 32 + n] : (n < 36 ? wg[k * 4 + n - 32] : 0.f); Wr_t[i] = (bf16_t)op::f2bf(v); }
}
__device__ __forceinline__ void router(const bf16_t* h1b, const bf16_t* Wr_t, const float* bg, const float* be, int* cnt, int* tok_e, int* tok_rank, float* tok_gate, int* stok) {
    const int lane = nv::tidx() & 63, r32 = lane & 31, hi = lane >> 5;
    for (int task = GWAVE; task < 512; task += GWAVES) {
        const int tok = task * 32 + r32;
        const bf16_t* hp = h1b + (size_t)tok * 1024 + hi * 8; const bf16_t* w0 = Wr_t + (size_t)r32 * 1024 + hi * 8; const bf16_t* w1 = w0 + 32 * 1024;
        f32x16 d0, d1;
#pragma unroll
        for (int r = 0; r < 16; ++r) { d0[r] = 0.f; d1[r] = 0.f; }
#pragma unroll 4
        for (int ks = 0; ks < 64; ++ks) { const bf16x8 b = *(const bf16x8*)(hp + ks * 16);
            d0 = __builtin_amdgcn_mfma_f32_32x32x16_bf16(*(const bf16x8*)(w0 + ks * 16), b, d0, 0, 0, 0);
            d1 = __builtin_amdgcn_mfma_f32_32x32x16_bf16(*(const bf16x8*)(w1 + ks * 16), b, d1, 0, 0, 0); }
        float ex[32];
#pragma unroll
        for (int r = 0; r < 16; ++r) { const float own = d0[r], oth = __shfl_xor(own, 32); const int n0 = (r & 3) + 8 * (r >> 2);
            ex[n0] = (hi == 0 ? own : oth) + be[n0]; ex[n0 + 4] = (hi == 0 ? oth : own) + be[n0 + 4]; }
        float gl[4];
#pragma unroll
        for (int c = 0; c < 4; ++c) { const float own = d1[c], oth = __shfl_xor(own, 32); gl[c] = (hi == 0 ? own : oth) + bg[c]; }
        int grp = 0; float gm = gl[0];
#pragma unroll
        for (int c = 1; c < 4; ++c) if (gl[c] > gm) { gm = gl[c]; grp = c; }
        float den = 0.f;
#pragma unroll
        for (int c = 0; c < 4; ++c) den += __expf(gl[c] - gm);
        const float pgrp = 1.f / den;
        float ein[8];
#pragma unroll
        for (int j = 0; j < 8; ++j) ein[j] = grp == 0 ? ex[j] : grp == 1 ? ex[8 + j] : grp == 2 ? ex[16 + j] : ex[24 + j];
        int i0 = 0; float v0 = ein[0];
#pragma unroll
        for (int j = 1; j < 8; ++j) if (ein[j] > v0) { v0 = ein[j]; i0 = j; }
        int i1 = -1; float v1 = -INFINITY;
#pragma unroll
        for (int j = 0; j < 8; ++j) if (j != i0 && ein[j] > v1) { v1 = ein[j]; i1 = j; }
        const float e1 = __expf(v1 - v0); const float p0 = 1.f / (1.f + e1), p1 = e1 / (1.f + e1);
        if (hi == 0) {
            const int ea = grp * 8 + i0, eb = grp * 8 + i1;
            const int ra = atomicAdd(cnt + ea, 1), rb = atomicAdd(cnt + eb, 1);
            tok_e[2 * tok] = ea; tok_e[2 * tok + 1] = eb; tok_rank[2 * tok] = ra; tok_rank[2 * tok + 1] = rb;
            tok_gate[2 * tok] = pgrp * p0; tok_gate[2 * tok + 1] = pgrp * p1;
            stok[ea * op::MOE_CAP + ra] = tok; stok[eb * op::MOE_CAP + rb] = tok;
        }
    }
}
}

namespace ln {
using op::bf16_t; using op::pk2; using op::v2u;
typedef float f32x4 __attribute__((ext_vector_type(4)));
__device__ __forceinline__ float wsum(float v) {
#pragma unroll
    for (int o = 1; o < 64; o <<= 1) v += __shfl_xor(v, o);
    return v;
}
__device__ __forceinline__ f32x4 bf4(v2u w) { f32x4 r; r[0] = __builtin_bit_cast(float, w.x << 16); r[1] = __builtin_bit_cast(float, w.x & 0xffff0000u); r[2] = __builtin_bit_cast(float, w.y << 16); r[3] = __builtin_bit_cast(float, w.y & 0xffff0000u); return r; }
__device__ __forceinline__ void ln1_rows(float* h, const float* g, const float* bb, bf16_t* hb) {
    const int lane = nv::tidx() & 63;
    for (int r = GWAVE; r < 16384; r += GWAVES) {
        float* hp = h + (size_t)r * 1024 + 4 * lane; f32x4 v[4]; float s = 0.f;
#pragma unroll
        for (int j = 0; j < 4; ++j) { v[j] = *(const f32x4*)(hp + 256 * j); s += (v[j][0] + v[j][1]) + (v[j][2] + v[j][3]); }
        const float mean = wsum(s) * (1.f / 1024.f); float q = 0.f;
#pragma unroll
        for (int j = 0; j < 4; ++j) { v[j] = v[j] - mean; q += (v[j][0] * v[j][0] + v[j][1] * v[j][1]) + (v[j][2] * v[j][2] + v[j][3] * v[j][3]); }
        const float rs = __builtin_amdgcn_rsqf(wsum(q) * (1.f / 1024.f) + 1e-5f);
#pragma unroll
        for (int j = 0; j < 4; ++j) { const f32x4 o = v[j] * rs * *(const f32x4*)(g + 256 * j + 4 * lane) + *(const f32x4*)(bb + 256 * j + 4 * lane);
            *(f32x4*)(hp + 256 * j) = o; v2u w; w.x = pk2(o[0], o[1]); w.y = pk2(o[2], o[3]); *(v2u*)(hb + (size_t)r * 1024 + 256 * j + 4 * lane) = w; }
    }
    if (blockIdx.x == 0) for (int c = nv::tidx(); c < 1024; c += NTHREADS) hb[(size_t)16384 * 1024 + c] = 0;
}
__device__ __forceinline__ void ln2_rows(const float* h1, const bf16_t* Y, const int* tok_e, const int* tok_rank, const float* tok_gate, const int* tstart, const float* g, const float* bb, float* out, float alpha) {
    const int lane = nv::tidx() & 63;
    for (int r = GWAVE; r < 16384; r += GWAVES) {
        const size_t r0 = (size_t)tstart[tok_e[2 * r]] * 256 + tok_rank[2 * r], r1 = (size_t)tstart[tok_e[2 * r + 1]] * 256 + tok_rank[2 * r + 1];
        const float g0 = tok_gate[2 * r], g1 = tok_gate[2 * r + 1];
        const float* hp = h1 + (size_t)r * 1024 + 4 * lane; const bf16_t* y0 = Y + r0 * 1024 + 4 * lane; const bf16_t* y1 = Y + r1 * 1024 + 4 * lane;
        f32x4 v[4]; float s = 0.f;
#pragma unroll
        for (int j = 0; j < 4; ++j) { v[j] = alpha * *(const f32x4*)(hp + 256 * j) + g0 * bf4(*(const v2u*)(y0 + 256 * j)) + g1 * bf4(*(const v2u*)(y1 + 256 * j)); s += (v[j][0] + v[j][1]) + (v[j][2] + v[j][3]); }
        const float mean = wsum(s) * (1.f / 1024.f); float q = 0.f;
#pragma unroll
        for (int j = 0; j < 4; ++j) { v[j] = v[j] - mean; q += (v[j][0] * v[j][0] + v[j][1] * v[j][1]) + (v[j][2] * v[j][2] + v[j][3] * v[j][3]); }
        const float rs = __builtin_amdgcn_rsqf(wsum(q) * (1.f / 1024.f) + 1e-5f);
#pragma unroll
        for (int j = 0; j < 4; ++j) *(f32x4*)(out + (size_t)r * 1024 + 256 * j + 4 * lane) = v[j] * rs * *(const f32x4*)(g + 256 * j + 4 * lane) + *(const f32x4*)(bb + 256 * j + 4 * lane);
    }
}
}

#ifndef PROBE
#define PROBE 0
#endif
struct Args { const float* in[22]; float* out; unsigned char* ws; };
constexpr size_t MiB = 1u << 20;
constexpr size_t WS_CTL = 260 * MiB, CTL_ZERO_BYTES = 1 * MiB;
constexpr int CW_BAR = 1024, CW_CNT = 8192, CW_SSQ_Q = 16384, CW_SSQ_KV = 32768, CW_SSQ_A = 49152;

__global__ void __launch_bounds__(NTHREADS, 2) mega_fwd(Args args) {
    extern __shared__ __attribute__((aligned(16))) unsigned char lds_raw[];
    using namespace nv;
    LAS unsigned char* lds = (LAS unsigned char*)lds_raw;
    volatile LAS unsigned* MISC = (volatile LAS unsigned*)(lds + 131072);
    if (threadIdx.x < 64) MISC[threadIdx.x] = 0u;
    __syncthreads();
    unsigned char* ws = args.ws;
    unsigned* ctl = (unsigned*)(ws + WS_CTL);
    XcdBarrier bar = xcd_barrier_post(ctl + CW_BAR, MISC + 8);
    const float* x = args.in[0]; const int* pos = (const int*)args.in[1]; const float* w_in = args.in[2];
    const float* q_norm_g = args.in[3]; const float* w_uq = args.in[4]; const float* kv_norm_g = args.in[5];
    const float* w_ukv = args.in[6]; const float* mla_out_g = args.in[7]; const float* lbl = args.in[8];
    const float* hg_norm_g = args.in[9]; const float* w_out = args.in[10]; const float* ln1_g = args.in[11];
    const float* ln1_b = args.in[12]; const float* wrg = args.in[13]; const float* brg = args.in[14];
    const float* wre = args.in[15]; const float* bre = args.in[16]; const float* w1 = args.in[17];
    const float* w3 = args.in[18]; const float* w2 = args.in[19]; const float* ln2_g = args.in[20]; const float* ln2_b = args.in[21];
    float* out = args.out;
    typedef op::bf16_t bf16_t;
    float*  lf   = (float*)(ws + 0);
    bf16_t* kk   = (bf16_t*)(ws + 32 * MiB);
    bf16_t* vi   = (bf16_t*)(ws + 48 * MiB);
    bf16_t* qh   = (bf16_t*)(ws + 64 * MiB);
    bf16_t* gh   = (bf16_t*)(ws + 80 * MiB);
    bf16_t* Ub   = (bf16_t*)(ws + 96 * MiB);
    bf16_t* AR   = (bf16_t*)(ws + 96 * MiB);
    float*  dlb  = (float*)(ws + 128 * MiB);
    float*  cs   = (float*)(ws + 129 * MiB);
    bf16_t* Qb   = (bf16_t*)(ws + 131 * MiB);
    bf16_t* Knb  = (bf16_t*)(ws + 155 * MiB);
    bf16_t* VTb  = (bf16_t*)(ws + 171 * MiB);
    bf16_t* xb   = (bf16_t*)(ws + 187 * MiB);
    bf16_t* STb  = (bf16_t*)(ws + 187 * MiB);
    bf16_t* cq   = (bf16_t*)(ws + 219 * MiB);
    bf16_t* ckv  = (bf16_t*)(ws + 227 * MiB);
    bf16_t* kr   = (bf16_t*)(ws + 231 * MiB);
    bf16_t* Win_t = (bf16_t*)(ws + 232 * MiB);
    bf16_t* Wuq_t = (bf16_t*)(ws + 237 * MiB);
    bf16_t* Wkv_t = (bf16_t*)(ws + 237 * MiB + 512 * 1024);
    bf16_t* Wout_t = (bf16_t*)(ws + 238 * MiB);
    bf16_t* Wr_t = (bf16_t*)(ws + 240 * MiB);
    float*  h1   = (float*)(ws + 0);
    bf16_t* h1b  = (bf16_t*)(ws + 64 * MiB);
    bf16_t* W13_t = (bf16_t*)(ws + 97 * MiB);
    bf16_t* W2_t = (bf16_t*)(ws + 161 * MiB);
    bf16_t* Hb   = (bf16_t*)(ws + 193 * MiB);
    int*    stok = (int*)(ws + 233 * MiB);
    bf16_t* Yb   = (bf16_t*)(ws + 64 * MiB);
    int* cnt = (int*)(ctl + CW_CNT);
    float* ssq_q = (float*)(ctl + CW_SSQ_Q); float* ssq_kv = (float*)(ctl + CW_SSQ_KV); float* ssq_a = (float*)(ctl + CW_SSQ_A);
    int* meta = (int*)(ws + WS_CTL + 1 * MiB);
    int* tstart_g = meta; float* lbt = (float*)(meta + 1024); int* tok_e = meta + 2048; int* tok_rank = tok_e + 2 * NTOK; float* tok_gate = (float*)(tok_rank + 2 * NTOK);
    LAS int* moetab = (LAS int*)(lds + 131072 + 1024);

    {
        int tl_ = threadIdx.x; asm volatile("" : "+v"(tl_)); const int wave = __builtin_amdgcn_readfirstlane(tl_ >> 6), lane = tl_ & 63;
        LAS float* scr = (LAS float*)(lds + wave * 16384);
        for (int it = GWAVE; it < (D / 64) * (INC / 32); it += GWAVES) op::transpose_item(w_in, D, INC, Win_t, scr, it, lane, op::RowProj{});
        for (int it = GWAVE; it < (D / 64) * (D / 32); it += GWAVES) op::transpose_item(w_out, D, D, Wout_t, scr, it, lane, op::RowScaleK{mla_out_g, 512});
        for (int it = GWAVE; it < (256 / 64) * (768 / 32); it += GWAVES) op::transpose_item(w_uq, 256, 768, Wuq_t, scr, it, lane, op::RowQ{q_norm_g});
        for (int it = GWAVE; it < (128 / 64) * (1024 / 32); it += GWAVES) op::transpose_item(w_ukv, 128, 1024, Wkv_t, scr, it, lane, op::RowKV{kv_norm_g});
        op::cvt_rows_bf16(x, xb, (size_t)NTOK * D);
        cs_tab(pos, cs);
        lb_tab(lbl, lbt);
        rt::build_wr(wrg, wre, Wr_t);
    }
    xcd_barrier(bar);
    {
        pg8::Gemm g{xb, Win_t, NTOK, 2560, D}; pg8::StaticOrder S; S.init(NTOK, 2560, (int)gridDim.x, (int)blockIdx.x);
        op::EpiProj E{cq, ckv, kr, kk, vi, lf, ssq_q, ssq_kv, cs, lbt};
        pg8::gemm_phase<op::EpiProj, pg8::StaticOrder, true, true>(lds, g, S, E);
#if PROBE == 4
        { op::EpiProj E2 = E; E2.ssq_q = (float*)(ws + WS_CTL + 1 * MiB + 512 * 1024); E2.ssq_kv = E2.ssq_q + 16384; pg8::gemm_phase<op::EpiProj, pg8::StaticOrder, true, true>(lds, g, S, E2); }
#endif
    }
    xcd_barrier(bar);
    hg::pass1(lds, lf, kk, vi, Ub, dlb);
    {
        pg8::Gemm g{cq, Wuq_t, NTOK, 768, 256}; pg8::StaticOrder S; S.init(NTOK, 768, (int)gridDim.x, (int)blockIdx.x);
        op::EpiQ E{Qb, ssq_q, cs};
        pg8::gemm_phase<op::EpiQ, pg8::StaticOrder, true, true>(lds, g, S, E);
    }
    {
        pg8::Gemm g{ckv, Wkv_t, NTOK, 512, 128}; pg8::StaticOrder S; S.init(NTOK, 512, (int)gridDim.x, (int)blockIdx.x);
        op::EpiK E{Knb, ssq_kv};
        pg8::gemm_phase<op::EpiK, pg8::StaticOrder, true, true>(lds, g, S, E);
    }
    {
        pg8::Gemm g{Wkv_t + 512 * 128, ckv, 512, NTOK, 128}; pg8::StaticOrder S; S.init(512, NTOK, (int)gridDim.x, (int)blockIdx.x);
        op::EpiVT E{VTb, ssq_kv};
        pg8::gemm_phase<op::EpiVT, pg8::StaticOrder, true, true>(lds, g, S, E);
    }
    xcd_barrier(bar);
    hg::scan(Ub, dlb, STb);
    xcd_barrier(bar);
    hg::pass3(lds, lf, kk, vi, qh, gh, STb, hg_norm_g, AR);
#if PROBE == 2
    xcd_barrier(bar); hg::pass1(lds, lf, kk, vi, Ub + 0, dlb); xcd_barrier(bar); hg::scan(Ub, dlb, STb); xcd_barrier(bar); hg::pass3(lds, lf, kk, vi, qh, gh, STb, hg_norm_g, AR);
#endif
    at::attn_phase(lds, Qb, Knb, kr, VTb, AR, ssq_a);
#if PROBE == 1
    at::attn_phase(lds, Qb, Knb, kr, VTb, AR, (float*)(ws + WS_CTL + 1 * MiB + 512 * 1024));
#endif
    xcd_barrier(bar);
    {
        pg8::Gemm g{AR, Wout_t, NTOK, D, D}; pg8::StaticOrder S; S.init(NTOK, D, (int)gridDim.x, (int)blockIdx.x);
        op::EpiMix2 E{x, h1, ALPHA, ssq_a};
        pg8::gemm_phase<op::EpiMix2, pg8::StaticOrder, true, true>(lds, g, S, E);
    }
    xcd_barrier(bar);
    ln::ln1_rows(h1, ln1_g, ln1_b, h1b);
    {
        int tl_ = threadIdx.x; asm volatile("" : "+v"(tl_)); const int wave = __builtin_amdgcn_readfirstlane(tl_ >> 6), lane = tl_ & 63;
        LAS float* scr = (LAS float*)(lds + wave * 16384);
        for (int it = GWAVE; it < 32 * 3 * 256; it += GWAVES) {
            const int e = it / 768, r = it % 768;
            if (r < 256) op::transpose_item(w1 + (size_t)e * D * 512, D, 512, W13_t + (size_t)e * D * D, scr, r, lane, op::RowW13{0});
            else if (r < 512) op::transpose_item(w3 + (size_t)e * D * 512, D, 512, W13_t + (size_t)e * D * D, scr, r - 256, lane, op::RowW13{1});
            else op::transpose_item(w2 + (size_t)e * 512 * D, 512, D, W2_t + (size_t)e * D * 512, scr, r - 512, lane, op::RowId{});
        }
    }
    xcd_barrier(bar);
    rt::router(h1b, Wr_t, brg, bre, cnt, tok_e, tok_rank, tok_gate, stok);
    xcd_barrier(bar);
    op::moe_build_tab(moetab, cnt, tstart_g);
    {
        pg8::Gemm g{h1b, W13_t, 0, 0, D}; op::MoeOrder S{moetab, (int)gridDim.x, (int)blockIdx.x, stok};
        op::EpiMoe1 E{Hb};
        pg8::gemm_phase<op::EpiMoe1, op::MoeOrder, true, true, true>(lds, g, S, E);
#if PROBE == 3
        pg8::gemm_phase<op::EpiMoe1, op::MoeOrder, true, true, true>(lds, g, S, E);
#endif
    }
    xcd_barrier(bar);
    {
        pg8::Gemm g{Hb, W2_t, 0, 0, 512}; op::MoeOrder S{moetab, (int)gridDim.x, (int)blockIdx.x, stok};
        op::EpiBf16P E{Yb, D, 3};
        pg8::gemm_phase<op::EpiBf16P, op::MoeOrder, true, true, false>(lds, g, S, E);
#if PROBE == 7
        pg8::gemm_phase<op::EpiBf16P, op::MoeOrder, true, true, false>(lds, g, S, E);
#endif
    }
    xcd_barrier(bar);
    ln::ln2_rows(h1, Yb, tok_e, tok_rank, tok_gate, tstart_g, ln2_g, ln2_b, out, ALPHA);
#if PROBE == 6
    ln::ln2_rows(h1, Yb, tok_e, tok_rank, tok_gate, tstart_g, ln2_g, ln2_b, out, ALPHA);
#endif
}

extern "C" void kernel_launch(void* const* d_in, const int* in_sizes, int n_in, void* d_out, int out_size, void* d_ws, size_t ws_size, hipStream_t stream) {
    static int grid = 0;
    if (grid == 0) {
        if (n_in != 22 || ws_size < 264 * MiB) { fprintf(stderr, "kernel_launch: unexpected n_in %d / ws %zu\n", n_in, ws_size); grid = -1; return; }
        int dev = 0, cus = 0, per_cu = 0;
        if (hipGetDevice(&dev) != hipSuccess || hipDeviceGetAttribute(&cus, hipDeviceAttributeMultiprocessorCount, dev) != hipSuccess) { grid = -1; return; }
        if (hipFuncSetAttribute((const void*)mega_fwd, hipFuncAttributeMaxDynamicSharedMemorySize, LDS_BYTES) != hipSuccess) { fprintf(stderr, "kernel_launch: hipFuncSetAttribute failed\n"); grid = -1; return; }
        if (hipOccupancyMaxActiveBlocksPerMultiprocessor(&per_cu, (const void*)mega_fwd, NTHREADS, LDS_BYTES) != hipSuccess || per_cu < 1) { fprintf(stderr, "kernel_launch: occupancy query says %d\n", per_cu); (void)hipGetLastError(); }
        grid = cus;
    }
    if (grid < 0) return;
    if (hipMemsetAsync((char*)d_ws + WS_CTL, 0, CTL_ZERO_BYTES, stream) != hipSuccess) return;
    Args a{};
    for (int i = 0; i < 22; ++i) a.in[i] = (const float*)d_in[i];
    a.out = (float*)d_out; a.ws = (unsigned char*)d_ws;
    hipLaunchKernelGGL(mega_fwd, dim3(grid), dim3(NTHREADS), LDS_BYTES, stream, a);
}
```
